# Optimizing an MI355X kernel written in HIP

```python
import jax
import jax.numpy as jnp
from jax import lax

D_MODEL = 4096
BATCH = 2
SEQ = 8192
DEPTH = 1

CHUNK = 64
ATT_BLOCK = 128
DSA_BLOCK = 64
ROPE_THETA = 500000.0
EPS = 1e-6

D_FF = 11008

MLA_HEADS = 12
MLA_Q_RANK = 1536
MLA_KV_RANK = 512
MLA_NOPE = 128
MLA_ROPE = 64
MLA_V = 128

DSA_HEADS = 12
DSA_HEAD_DIM = 128
DSA_ROT = DSA_HEAD_DIM // 4
DSA_MAX_TOPK = 256
IDX_HEADS = 32
IDX_DIM = 64
IDX_ROT = IDX_DIM // 4

MEM_LEN = 256
MEM_HEADS = 4
MEM_HEAD_DIM = 256

N_BRANCH = 3

IN_SIZES = (
    MLA_Q_RANK,
    MLA_KV_RANK,
    MLA_ROPE,
    DSA_HEADS * DSA_HEAD_DIM,
    DSA_HEADS * DSA_HEAD_DIM,
    DSA_HEADS * DSA_HEAD_DIM,
    IDX_HEADS * IDX_DIM,
    IDX_DIM,
    IDX_HEADS,
    MEM_HEADS * MEM_HEAD_DIM,
)
D_IN = sum(IN_SIZES)

kernel_name = 'hybrid_chunk_causal_mla_dsa_memory_macaron'


def _rmsnorm(x, g):
    xf = x.astype(jnp.float32)
    y = xf * lax.rsqrt(jnp.mean(xf * xf, axis=-1, keepdims=True) + EPS)
    return (y * g.astype(jnp.float32)).astype(x.dtype)


def _rope(x, positions, rot_dim):
    half = rot_dim // 2
    inv_freq = ROPE_THETA ** (-jnp.arange(half, dtype=jnp.float32) / half)
    ang = positions.astype(jnp.float32)[:, :, None] * inv_freq
    cos = jnp.cos(ang)[:, :, None, :]
    sin = jnp.sin(ang)[:, :, None, :]
    xr = x[..., :rot_dim].astype(jnp.float32)
    x1, x2 = xr[..., :half], xr[..., half:]
    rot = jnp.concatenate([x1 * cos - x2 * sin, x2 * cos + x1 * sin], axis=-1).astype(x.dtype)
    return jnp.concatenate([rot, x[..., rot_dim:]], axis=-1)


def _split_cols(y, sizes):
    out, start = [], 0
    for n in sizes:
        out.append(y[..., start:start + n])
        start += n
    return out


def _swiglu(h, w_gate, w_up, w_down):
    return (jax.nn.silu(h @ w_gate) * (h @ w_up)) @ w_down


def _chunk_causal_attention(q, k, v):
    B, S, H, Dk = q.shape
    scale = Dk ** -0.5
    nblk = S // ATT_BLOCK
    key_chunk = jnp.arange(S) // CHUNK
    q_blocks = jnp.moveaxis(q.reshape(B, nblk, ATT_BLOCK, H, Dk), 1, 0)

    def one_block(args):
        q_blk, bi = args
        q_chunk = (bi * ATT_BLOCK + jnp.arange(ATT_BLOCK)) // CHUNK
        visible = key_chunk[None, :] <= q_chunk[:, None]
        s = jnp.einsum('bqhd,bshd->bhqs', q_blk, k, preferred_element_type=jnp.float32) * scale
        s = jnp.where(visible[None, None], s, -jnp.inf)
        p = jax.nn.softmax(s, axis=-1).astype(v.dtype)
        return jnp.einsum('bhqs,bshd->bqhd', p, v)

    o = lax.map(one_block, (q_blocks, jnp.arange(nblk)))
    return jnp.moveaxis(o, 0, 1).reshape(B, S, H * v.shape[-1])


def _mla_branch(c_q, c_kv, k_r, positions, g_cq, w_uq, g_ckv, w_ukv, g_q, g_k):
    B, S, _ = c_q.shape
    q = (_rmsnorm(c_q, g_cq) @ w_uq).reshape(B, S, MLA_HEADS, MLA_ROPE + MLA_NOPE)
    kv = (_rmsnorm(c_kv, g_ckv) @ w_ukv).reshape(B, S, MLA_HEADS, MLA_NOPE + MLA_V)
    k_nope, v = kv[..., :MLA_NOPE], kv[..., MLA_NOPE:]
    k_rope = jnp.broadcast_to(k_r[:, :, None, :], (B, S, MLA_HEADS, MLA_ROPE))
    k = jnp.concatenate([k_rope, k_nope], axis=-1)
    q = _rope(_rmsnorm(q, g_q), positions, MLA_ROPE)
    k = _rope(_rmsnorm(k, g_k), positions, MLA_ROPE)
    return _chunk_causal_attention(q, k, v)


def _dsa_branch(q_d, k_d, v_d, q_i, k_i, w_i, positions, g_q, g_k):
    B, S, _ = q_d.shape
    H, Dh = DSA_HEADS, DSA_HEAD_DIM
    topk = min(DSA_MAX_TOPK, S // 4)
    q = _rope(_rmsnorm(q_d.reshape(B, S, H, Dh), g_q), positions, DSA_ROT)
    k = _rope(_rmsnorm(k_d.reshape(B, S, H, Dh), g_k), positions, DSA_ROT)
    k_flat = k.reshape(B, S, H * Dh)
    v_flat = v_d
    qi = _rope(q_i.reshape(B, S, IDX_HEADS, IDX_DIM), positions, IDX_ROT)
    ki = _rope(k_i[:, :, None, :], positions, IDX_ROT)[:, :, 0, :]
    nblk = S // DSA_BLOCK
    key_chunk = jnp.arange(S) // CHUNK
    scale = Dh ** -0.5

    def to_blocks(a):
        return jnp.moveaxis(a.reshape((B, nblk, DSA_BLOCK) + a.shape[2:]), 1, 0)

    gather_rows = jax.vmap(lambda a, i: a[i])

    def one_block(args):
        q_blk, qi_blk, wi_blk, bi = args
        q_chunk = (bi * DSA_BLOCK + jnp.arange(DSA_BLOCK)) // CHUNK
        admissible = key_chunk[None, :] <= q_chunk[:, None]
        logits = jnp.einsum('bqhd,bsd->bqhs', qi_blk, ki,
                            preferred_element_type=jnp.float32) * (IDX_DIM ** -0.5)
        score = jnp.einsum('bqhs,bqh->bqs', jax.nn.relu(logits),
                           wi_blk.astype(jnp.float32)) * (IDX_HEADS ** -0.5)
        score = jnp.where(admissible[None], score, -jnp.inf)
        top_val, top_idx = lax.top_k(score, topk)
        valid = jnp.isfinite(top_val)
        flat_idx = top_idx.reshape(B, DSA_BLOCK * topk)
        k_sel = gather_rows(k_flat, flat_idx).reshape(B, DSA_BLOCK, topk, H, Dh)
        v_sel = gather_rows(v_flat, flat_idx).reshape(B, DSA_BLOCK, topk, H, Dh)
        s = jnp.einsum('bqhd,bqkhd->bhqk', q_blk, k_sel, preferred_element_type=jnp.float32) * scale
        s = jnp.where(valid[:, None], s, -jnp.inf)
        p = jax.nn.softmax(s, axis=-1).astype(v_sel.dtype)
        return jnp.einsum('bhqk,bqkhd->bqhd', p, v_sel)

    o = lax.map(one_block, (to_blocks(q), to_blocks(qi), to_blocks(w_i), jnp.arange(nblk)))
    return jnp.moveaxis(o, 0, 1).reshape(B, S, H * Dh)


def _memory_branch(q_m, mem, g_mem, w_mem_kv, g_q, g_k):
    B, S, _ = q_m.shape
    M = mem.shape[1]
    q = _rmsnorm(q_m.reshape(B, S, MEM_HEADS, MEM_HEAD_DIM), g_q)
    kv = _rmsnorm(mem, g_mem) @ w_mem_kv
    k = _rmsnorm(kv[..., :MEM_HEADS * MEM_HEAD_DIM].reshape(B, M, MEM_HEADS, MEM_HEAD_DIM), g_k)
    v = kv[..., MEM_HEADS * MEM_HEAD_DIM:].reshape(B, M, MEM_HEADS, MEM_HEAD_DIM)
    s = jnp.einsum('bshd,bmhd->bhsm', q, k, preferred_element_type=jnp.float32) * (MEM_HEAD_DIM ** -0.5)
    p = jax.nn.softmax(s, axis=-1).astype(v.dtype)
    return jnp.einsum('bhsm,bmhd->bshd', p, v).reshape(B, S, MEM_HEADS * MEM_HEAD_DIM)


def _hybrid_mixer(h, mem, positions, w_in, g_cq, w_uq, g_ckv, w_ukv, g_q_mla, g_k_mla,
                  g_q_dsa, g_k_dsa, g_mem, w_mem_kv, g_q_mem, g_k_mem,
                  w_o_mla, w_o_dsa, w_o_mem, w_gate, w_out):
    c_q, c_kv, k_r, q_d, k_d, v_d, q_i, k_i, w_i, q_m = _split_cols(h @ w_in, IN_SIZES)
    y_mla = _mla_branch(c_q, c_kv, k_r, positions, g_cq, w_uq, g_ckv, w_ukv, g_q_mla, g_k_mla)
    y_dsa = _dsa_branch(q_d, k_d, v_d, q_i, k_i, w_i, positions, g_q_dsa, g_k_dsa)
    y_mem = _memory_branch(q_m, mem, g_mem, w_mem_kv, g_q_mem, g_k_mem)
    branches = ((y_mla, w_o_mla), (y_dsa, w_o_dsa), (y_mem, w_o_mem))
    gated = [jax.nn.sigmoid(h @ w_gate[i]) * (y @ w_o) for i, (y, w_o) in enumerate(branches)]
    return (gated[0] + gated[1] + gated[2]) @ w_out


def setup_inputs(seed: int = 0) -> dict:
    key = jax.random.key(seed)
    keys = jax.random.split(key, 32)
    counter = [0]

    def nk():
        k = keys[counter[0]]
        counter[0] += 1
        return k

    def w(shape, fan_in):
        return jax.random.normal(nk(), shape, jnp.float32) * fan_in ** -0.5

    def g(shape):
        return 1.0 + 0.02 * jax.random.normal(nk(), shape, jnp.float32)

    L, D = DEPTH, D_MODEL
    x = jax.random.normal(nk(), (BATCH, SEQ, D), jnp.float32)
    mem = jax.random.normal(nk(), (BATCH, MEM_LEN, D), jnp.float32)
    offset = jax.random.randint(nk(), (BATCH, 1), 0, 16) * CHUNK
    positions = (offset + jnp.arange(SEQ, dtype=jnp.int32)[None, :]).astype(jnp.int32)
    return {
        'x': x,
        'mem': mem,
        'positions': positions,
        'g_ff1': g((L, D)),
        'w_ff1_gate': w((L, D, D_FF), D),
        'w_ff1_up': w((L, D, D_FF), D),
        'w_ff1_down': w((L, D_FF, D), D_FF),
        'g_mix': g((L, D)),
        'w_in': w((L, D, D_IN), D),
        'g_cq': g((L, MLA_Q_RANK)),
        'w_uq': w((L, MLA_Q_RANK, MLA_HEADS * (MLA_ROPE + MLA_NOPE)), MLA_Q_RANK),
        'g_ckv': g((L, MLA_KV_RANK)),
        'w_ukv': w((L, MLA_KV_RANK, MLA_HEADS * (MLA_NOPE + MLA_V)), MLA_KV_RANK),
        'g_q_mla': g((L, MLA_ROPE + MLA_NOPE)),
        'g_k_mla': g((L, MLA_ROPE + MLA_NOPE)),
        'g_q_dsa': g((L, DSA_HEAD_DIM)),
        'g_k_dsa': g((L, DSA_HEAD_DIM)),
        'g_mem': g((L, D)),
        'w_mem_kv': w((L, D, 2 * MEM_HEADS * MEM_HEAD_DIM), D),
        'g_q_mem': g((L, MEM_HEAD_DIM)),
        'g_k_mem': g((L, MEM_HEAD_DIM)),
        'w_o_mla': w((L, MLA_HEADS * MLA_V, D), MLA_HEADS * MLA_V),
        'w_o_dsa': w((L, DSA_HEADS * DSA_HEAD_DIM, D), DSA_HEADS * DSA_HEAD_DIM),
        'w_o_mem': w((L, MEM_HEADS * MEM_HEAD_DIM, D), MEM_HEADS * MEM_HEAD_DIM),
        'w_gate': w((L, N_BRANCH, D, D), D),
        'w_out': w((L, D, D), D),
        'g_ff2': g((L, D)),
        'w_ff2_gate': w((L, D, D_FF), D),
        'w_ff2_up': w((L, D, D_FF), D),
        'w_ff2_down': w((L, D_FF, D), D_FF),
    }


def reference(x, mem, positions, g_ff1, w_ff1_gate, w_ff1_up, w_ff1_down, g_mix, w_in,
              g_cq, w_uq, g_ckv, w_ukv, g_q_mla, g_k_mla, g_q_dsa, g_k_dsa,
              g_mem, w_mem_kv, g_q_mem, g_k_mem, w_o_mla, w_o_dsa, w_o_mem,
              w_gate, w_out, g_ff2, w_ff2_gate, w_ff2_up, w_ff2_down):
    for l in range(DEPTH):
        x = x + 0.5 * _swiglu(_rmsnorm(x, g_ff1[l]), w_ff1_gate[l], w_ff1_up[l], w_ff1_down[l])
        h = _rmsnorm(x, g_mix[l])
        x = x + _hybrid_mixer(h, mem, positions, w_in[l], g_cq[l], w_uq[l], g_ckv[l], w_ukv[l],
                              g_q_mla[l], g_k_mla[l], g_q_dsa[l], g_k_dsa[l],
                              g_mem[l], w_mem_kv[l], g_q_mem[l], g_k_mem[l],
                              w_o_mla[l], w_o_dsa[l], w_o_mem[l], w_gate[l], w_out[l])
        x = x + 0.5 * _swiglu(_rmsnorm(x, g_ff2[l]), w_ff2_gate[l], w_ff2_up[l], w_ff2_down[l])
    return x
```

```cpp
#include <hip/hip_runtime.h>
#include <cstdio>
#include <cstdint>
namespace pg8 {
#define PG8_LAS __attribute__((address_space(3)))
typedef unsigned short bf16_t;
typedef short bf16x8 __attribute__((ext_vector_type(8)));
typedef float f32x4 __attribute__((ext_vector_type(4)));
typedef unsigned u32x4 __attribute__((ext_vector_type(4)));
constexpr int BM = 256, BK = 64, HALF = 128, HTB = HALF * BK * 2  , STAGE_BYTES = 8 * HTB, NXCD = 8, WGM = 8;

__host__ __device__ __forceinline__ int lds_byte(int r, int c) { const int st = (r >> 4) * 2 + (c >> 5), rr = r & 15, cc = c & 31, ob = rr * 64 + cc * 2; return st * 1024 + (ob ^ (((ob >> 9) & 1) << 5)); }
__host__ __device__ __forceinline__ void stage_rc(int b, int& R, int& C) { const int st = b / 1024, sb = b % 1024, swz = sb ^ (((sb >> 9) & 1) << 5); R = (st >> 1) * 16 + swz / 64; C = (st & 1) * 32 + (swz % 64) / 2; }
__host__ __device__ __forceinline__ int perm32(int rho) { const int n = rho >> 4, i = rho & 15; return 8 * (i >> 2) + 4 * n + (i & 3); }

struct Unit { int pm, pn; };
struct Gemm { const bf16_t* A; const bf16_t* Bt; int M, N, K; };

struct StaticOrder {
    int nM, nN, nwg, G, c;
    __host__ __device__ void init(int M, int N, int G_, int c_) { nM = M / BM; nN = N / BM; nwg = nM * nN; G = G_; c = c_; }
    __host__ __device__ bool next(int i, Unit& u) const {
        const long L = (long)i * G + c; if (L >= nwg) return false;
        int wgid = (int)L; { const int q = nwg / NXCD, r = nwg % NXCD, xcd = wgid % NXCD, off = wgid / NXCD; wgid = (xcd < r ? xcd * (q + 1) : r * (q + 1) + (xcd - r) * q) + off; }
        const int nig = WGM * nN, gid = wgid / nig, fm = gid * WGM, gsz = (nM - fm) < WGM ? (nM - fm) : WGM;
        u.pm = fm + ((wgid % nig) % gsz); u.pn = (wgid % nig) / gsz; return true;
    }
    __device__ __forceinline__ void a_ready(const Unit&) const {}
    __device__ __forceinline__ void done(const Unit&) const {}
};
__device__ __forceinline__ unsigned cvt_pk_bf16(float lo, float hi) { unsigned r; asm volatile("v_cvt_pk_bf16_f32 %0, %1, %2" : "=v"(r) : "v"(lo), "v"(hi)); return r; }
__device__ __forceinline__ float sigmoid_f(float x) { return __builtin_amdgcn_rcpf(1.0f + __builtin_amdgcn_exp2f(-1.4426950408889634f * x)); }
struct EpiPlain {
    static constexpr bool PERM = true, AFTER_DRAIN = false;
    bf16_t* O; int ldc;
    __device__ __forceinline__ void operator()(const f32x4 (&acc)[2][2][4][2], const Unit& u, int wr, int wc, int fr, int fq) const {
        const int row0 = u.pm * BM + wr * 64 + fr, col0 = u.pn * BM + wc * 32 + 8 * fq;
#pragma unroll
        for (int ai = 0; ai < 2; ++ai)
#pragma unroll
            for (int m = 0; m < 4; ++m) { bf16_t* rowp = O + (size_t)(row0 + ai * HALF + m * 16) * ldc + col0;
#pragma unroll
                for (int bj = 0; bj < 2; ++bj) { const f32x4 v0 = acc[ai][bj][m][0], v1 = acc[ai][bj][m][1];
                    u32x4 w; w.x = cvt_pk_bf16(v0[0], v0[1]); w.y = cvt_pk_bf16(v0[2], v0[3]); w.z = cvt_pk_bf16(v1[0], v1[1]); w.w = cvt_pk_bf16(v1[2], v1[3]);
                    *(u32x4*)(rowp + bj * HALF) = w; } }
    }
};
struct EpiSwiGLU {
    static constexpr bool PERM = true, AFTER_DRAIN = false;
    bf16_t* O; int ldc;
    __device__ __forceinline__ void operator()(const f32x4 (&acc)[2][2][4][2], const Unit& u, int wr, int wc, int fr, int fq) const {
        const int row0 = u.pm * BM + wr * 64 + fr, col0 = u.pn * HALF + wc * 32 + 8 * fq;
#pragma unroll
        for (int ai = 0; ai < 2; ++ai)
#pragma unroll
            for (int m = 0; m < 4; ++m) { bf16_t* rowp = O + (size_t)(row0 + ai * HALF + m * 16) * ldc + col0;
                f32x4 r0, r1;
#pragma unroll
                for (int j = 0; j < 4; ++j) { const float g0 = acc[ai][0][m][0][j], g1 = acc[ai][0][m][1][j];
                    r0[j] = g0 * sigmoid_f(g0) * acc[ai][1][m][0][j]; r1[j] = g1 * sigmoid_f(g1) * acc[ai][1][m][1][j]; }
                u32x4 w; w.x = cvt_pk_bf16(r0[0], r0[1]); w.y = cvt_pk_bf16(r0[2], r0[3]); w.z = cvt_pk_bf16(r1[0], r1[1]); w.w = cvt_pk_bf16(r1[2], r1[3]);
                *(u32x4*)rowp = w; }
    }
};
struct EpiResid {
    static constexpr bool PERM = false, AFTER_DRAIN = false;
    const float* base; float* out; int ldc; float scale;
    __device__ __forceinline__ void operator()(const f32x4 (&acc)[2][2][4][2], const Unit& u, int wr, int wc, int fr, int fq) const {
        const int row0 = u.pm * BM + wr * 64 + fr, col0 = u.pn * BM + wc * 32 + 4 * fq;
#pragma unroll
        for (int ai = 0; ai < 2; ++ai)
#pragma unroll
            for (int m = 0; m < 4; ++m) { const size_t off = (size_t)(row0 + ai * HALF + m * 16) * ldc + col0;
#pragma unroll
                for (int bj = 0; bj < 2; ++bj)
#pragma unroll
                    for (int n = 0; n < 2; ++n) { const f32x4 b = *(const f32x4*)(base + off + bj * HALF + n * 16);
                        *(f32x4*)(out + off + bj * HALF + n * 16) = b + acc[ai][bj][m][n] * scale; } }
    }
};
struct EpiInProj {
    static constexpr bool PERM = true, AFTER_DRAIN = false;
    bf16_t* P; int ldp; int np; bf16_t* G; int ldg;
    __device__ __forceinline__ void operator()(const f32x4 (&acc)[2][2][4][2], const Unit& u, int wr, int wc, int fr, int fq) const {
        const int row0 = u.pm * BM + wr * 64 + fr; const bool isg = u.pn >= np;
        bf16_t* O = isg ? G : P; const int ldc = isg ? ldg : ldp; const int col0 = (isg ? u.pn - np : u.pn) * BM + wc * 32 + 8 * fq;
#pragma unroll
        for (int ai = 0; ai < 2; ++ai)
#pragma unroll
            for (int m = 0; m < 4; ++m) { bf16_t* rowp = O + (size_t)(row0 + ai * HALF + m * 16) * ldc + col0;
#pragma unroll
                for (int bj = 0; bj < 2; ++bj) { f32x4 v0 = acc[ai][bj][m][0], v1 = acc[ai][bj][m][1];
                    if (isg) {
#pragma unroll
                        for (int j = 0; j < 4; ++j) { v0[j] = sigmoid_f(v0[j]); v1[j] = sigmoid_f(v1[j]); } }
                    u32x4 w; w.x = cvt_pk_bf16(v0[0], v0[1]); w.y = cvt_pk_bf16(v0[2], v0[3]); w.z = cvt_pk_bf16(v1[0], v1[1]); w.w = cvt_pk_bf16(v1[2], v1[3]);
                    *(u32x4*)(rowp + bj * HALF) = w; } }
    }
};
template <int BR> struct EpiGate {
    static constexpr bool PERM = true, AFTER_DRAIN = false;
    const bf16_t* G; int ldg; int gcol0; float* GS; bf16_t* GSb; int ld;
    __device__ __forceinline__ void operator()(const f32x4 (&acc)[2][2][4][2], const Unit& u, int wr, int wc, int fr, int fq) const {
        const int row0 = u.pm * BM + wr * 64 + fr, col0 = u.pn * BM + wc * 32 + 8 * fq;
#pragma unroll
        for (int ai = 0; ai < 2; ++ai)
#pragma unroll
            for (int m = 0; m < 4; ++m) { const int row = row0 + ai * HALF + m * 16;
#pragma unroll
                for (int bj = 0; bj < 2; ++bj) { const int col = col0 + bj * HALF;
                    const u32x4 gw = *(const u32x4*)(G + (size_t)row * ldg + gcol0 + col);
                    f32x4 g0, g1;
                    g0[0] = __uint_as_float(gw.x << 16); g0[1] = __uint_as_float(gw.x & 0xffff0000u); g0[2] = __uint_as_float(gw.y << 16); g0[3] = __uint_as_float(gw.y & 0xffff0000u);
                    g1[0] = __uint_as_float(gw.z << 16); g1[1] = __uint_as_float(gw.z & 0xffff0000u); g1[2] = __uint_as_float(gw.w << 16); g1[3] = __uint_as_float(gw.w & 0xffff0000u);
                    f32x4 t0 = g0 * acc[ai][bj][m][0], t1 = g1 * acc[ai][bj][m][1];
                    float* gp = GS + (size_t)row * ld + col;
                    if (BR >= 1) { t0 = t0 + *(const f32x4*)gp; t1 = t1 + *(const f32x4*)(gp + 4); }
                    if (BR <= 1) { *(f32x4*)gp = t0; *(f32x4*)(gp + 4) = t1; }
                    else { u32x4 w; w.x = cvt_pk_bf16(t0[0], t0[1]); w.y = cvt_pk_bf16(t0[2], t0[3]); w.z = cvt_pk_bf16(t1[0], t1[1]); w.w = cvt_pk_bf16(t1[2], t1[3]);
                        *(u32x4*)(GSb + (size_t)row * ld + col) = w; } } }
    }
};
template <class Epi, class Sched, bool ALIGN_EPI = false, bool SP2 = false>
__device__ __forceinline__ void gemm_phase(PG8_LAS unsigned char* lds, const Gemm g, const Sched& S, const Epi& E) {
    const int tid = threadIdx.x, wid = __builtin_amdgcn_readfirstlane(tid >> 6), lane = tid & 63, wr = wid >> 2, wc = wid & 3, fr = lane & 15, fq = lane >> 4;
    const int K = g.K, nt = K / BK;
    unsigned voffA[2], voffB[2];
#pragma unroll
    for (int i = 0; i < 2; ++i) { int R, C; stage_rc(tid * 16 + i * 8192, R, C); const int Rb = Epi::PERM ? ((R & ~31) + perm32(R & 31)) : R;
        voffA[i] = (unsigned)(R * K + C) * 2u; voffB[i] = (unsigned)(Rb * K + C) * 2u; }
    const size_t kstep = (size_t)(BK * 2);
    const size_t hstep = (size_t)HALF * K * 2;
    const size_t tstep = 2 * hstep;
    const unsigned ldsw = (unsigned)wid * 1024u;
    const int aoff = lds_byte(wr * 64 + fr, fq * 8), boff = lds_byte(wc * 32 + fr, fq * 8);
#define PG8_SA(b, h) (((b) * 2 + (h)) * HTB)
#define PG8_SB(b, h) ((4 + (b) * 2 + (h)) * HTB)
#define PG8_STAGE(bufoff, gbase, voff) do { _Pragma("unroll") for (int _i = 0; _i < 2; ++_i) \
        __builtin_amdgcn_global_load_lds((const unsigned*)((const char*)(gbase) + (voff)[_i]), (PG8_LAS unsigned*)(lds + (bufoff) + ldsw + _i * 8192), 16, 0, 0); } while (0)
#define PG8_LDA(dst, b, h) do { _Pragma("unroll") for (int m = 0; m < 4; ++m) _Pragma("unroll") for (int k = 0; k < 2; ++k) dst[m][k] = *(const PG8_LAS bf16x8*)(lds + PG8_SA(b, h) + aoff + m * 2048 + k * 1024); } while (0)
#define PG8_LDB(dst, b, h) do { _Pragma("unroll") for (int n = 0; n < 2; ++n) _Pragma("unroll") for (int k = 0; k < 2; ++k) dst[n][k] = *(const PG8_LAS bf16x8*)(lds + PG8_SB(b, h) + boff + n * 2048 + k * 1024); } while (0)
#define PG8_MMA(ai, bj, At, Bt) do { __builtin_amdgcn_s_setprio(1); _Pragma("unroll") for (int m = 0; m < 4; ++m) _Pragma("unroll") for (int n = 0; n < 2; ++n) _Pragma("unroll") for (int k = 0; k < 2; ++k) \
        acc[ai][bj][m][n] = __builtin_amdgcn_mfma_f32_16x16x32_bf16(Bt[n][k], At[m][k], acc[ai][bj][m][n], 0, 0, 0); __builtin_amdgcn_s_setprio(0); } while (0)
#define PG8_WAIT_V(n) asm volatile("s_waitcnt vmcnt(" #n ")" ::: "memory")
#define PG8_WAIT_L(n) asm volatile("s_waitcnt lgkmcnt(" #n ")" ::: "memory")
#define PG8_BAR __builtin_amdgcn_s_barrier()
#define PG8_SCHED __builtin_amdgcn_sched_barrier(0)
    Unit cur, nxt; int ui = 0;
    if (!S.next(0, cur)) return;
    f32x4 acc[2][2][4][2];
#pragma unroll
    for (int a = 0; a < 2; ++a)
#pragma unroll
        for (int b = 0; b < 2; ++b)
#pragma unroll
            for (int m = 0; m < 4; ++m)
#pragma unroll
                for (int n = 0; n < 2; ++n) acc[a][b][m][n] = (f32x4){0.f, 0.f, 0.f, 0.f};
    bf16x8 At[4][2], B0[2][2], B1[2][2];
    const char* cA = (const char*)g.A + (size_t)cur.pm * tstep; const char* cB = (const char*)g.Bt + (size_t)cur.pn * tstep;
    S.a_ready(cur);
    if constexpr (SP2) {
        PG8_STAGE(PG8_SB(0, 0), cB, voffB); PG8_STAGE(PG8_SB(0, 1), cB + hstep, voffB); PG8_STAGE(PG8_SA(0, 0), cA, voffA); PG8_STAGE(PG8_SA(0, 1), cA + hstep, voffA);
        if (wr == 1) PG8_BAR;
        PG8_WAIT_V(2); PG8_BAR;
        PG8_STAGE(PG8_SB(1, 0), cB + kstep, voffB); PG8_STAGE(PG8_SA(1, 0), cA + kstep, voffA); PG8_STAGE(PG8_SB(1, 1), cB + hstep + kstep, voffB);
        PG8_WAIT_V(6); PG8_BAR;
    } else {
        PG8_STAGE(PG8_SB(0, 0), cB, voffB); PG8_STAGE(PG8_SA(0, 0), cA, voffA); PG8_STAGE(PG8_SB(0, 1), cB + hstep, voffB); PG8_STAGE(PG8_SA(0, 1), cA + hstep, voffA);
        if (wr == 1) PG8_BAR;
        PG8_WAIT_V(4); PG8_BAR;
        PG8_STAGE(PG8_SB(1, 0), cB + kstep, voffB); PG8_STAGE(PG8_SA(1, 0), cA + kstep, voffA); PG8_STAGE(PG8_SB(1, 1), cB + hstep + kstep, voffB);
        PG8_WAIT_V(6); PG8_BAR;
    }
    for (;;) {
        const bool has_next = S.next(ui + 1, nxt);
        const char* nA = has_next ? (const char*)g.A + (size_t)nxt.pm * tstep : cA; const char* nB = has_next ? (const char*)g.Bt + (size_t)nxt.pn * tstep : cB;
        for (int t = 0; t < nt; t += 2) {
            const bool last = (t == nt - 2);
            const char* a1 = cA + (size_t)(t + 1) * kstep;
            const char* a2 = last ? nA : cA + (size_t)(t + 2) * kstep; const char* b2 = last ? nB : cB + (size_t)(t + 2) * kstep;
            const char* a3 = a2 + kstep; const char* b3 = b2 + kstep;
            if (last && has_next) S.a_ready(nxt);
            if constexpr (SP2) {
            PG8_LDB(B0, 0, 0); PG8_LDB(B1, 0, 1); PG8_SCHED; PG8_LDA(At, 0, 0); PG8_STAGE(PG8_SA(1, 1), a1 + hstep, voffA);
            PG8_WAIT_V(8); PG8_WAIT_L(0); PG8_BAR; PG8_MMA(0, 0, At, B0); PG8_MMA(0, 1, At, B1); PG8_BAR; PG8_SCHED;
            PG8_LDA(At, 0, 1); PG8_STAGE(PG8_SB(0, 0), b2, voffB); PG8_STAGE(PG8_SB(0, 1), b2 + hstep, voffB); PG8_STAGE(PG8_SA(0, 0), a2, voffA);
            PG8_WAIT_V(8); PG8_WAIT_L(0); PG8_BAR; PG8_MMA(1, 0, At, B0); PG8_MMA(1, 1, At, B1); PG8_BAR; PG8_SCHED;
            PG8_LDB(B0, 1, 0); PG8_LDB(B1, 1, 1); PG8_SCHED; PG8_LDA(At, 1, 0); PG8_STAGE(PG8_SA(0, 1), a2 + hstep, voffA);
            PG8_WAIT_V(8); PG8_WAIT_L(0); PG8_BAR; PG8_MMA(0, 0, At, B0); PG8_MMA(0, 1, At, B1); PG8_BAR; PG8_SCHED;
            PG8_LDA(At, 1, 1); PG8_STAGE(PG8_SB(1, 0), b3, voffB); PG8_STAGE(PG8_SB(1, 1), b3 + hstep, voffB); PG8_STAGE(PG8_SA(1, 0), a3, voffA);
            PG8_WAIT_V(8); PG8_WAIT_L(0); PG8_BAR; PG8_MMA(1, 0, At, B0); PG8_MMA(1, 1, At, B1); PG8_BAR; PG8_SCHED;
            } else {
            PG8_LDB(B0, 0, 0); PG8_SCHED; PG8_LDA(At, 0, 0); PG8_STAGE(PG8_SA(1, 1), a1 + hstep, voffA);
            PG8_WAIT_L(8); PG8_BAR; PG8_WAIT_L(0); PG8_MMA(0, 0, At, B0); PG8_BAR; PG8_SCHED;
            PG8_LDB(B1, 0, 1); PG8_STAGE(PG8_SB(0, 0), b2, voffB);
            PG8_BAR; PG8_WAIT_L(0); PG8_MMA(0, 1, At, B1); PG8_BAR;
            PG8_LDA(At, 0, 1); PG8_STAGE(PG8_SA(0, 0), a2, voffA);
            PG8_BAR; PG8_WAIT_L(0); PG8_MMA(1, 0, At, B0); PG8_BAR; PG8_SCHED;
            PG8_STAGE(PG8_SB(0, 1), b2 + hstep, voffB);
            PG8_WAIT_V(6); PG8_BAR; PG8_MMA(1, 1, At, B1); PG8_BAR;
            PG8_LDB(B0, 1, 0); PG8_SCHED; PG8_LDA(At, 1, 0); PG8_STAGE(PG8_SA(0, 1), a2 + hstep, voffA);
            PG8_WAIT_L(8); PG8_BAR; PG8_WAIT_L(0); PG8_MMA(0, 0, At, B0); PG8_BAR; PG8_SCHED;
            PG8_LDB(B1, 1, 1); PG8_STAGE(PG8_SB(1, 0), b3, voffB);
            PG8_BAR; PG8_WAIT_L(0); PG8_MMA(0, 1, At, B1); PG8_BAR;
            PG8_LDA(At, 1, 1); PG8_STAGE(PG8_SA(1, 0), a3, voffA);
            PG8_BAR; PG8_WAIT_L(0); PG8_MMA(1, 0, At, B0); PG8_BAR; PG8_SCHED;
            PG8_STAGE(PG8_SB(1, 1), b3 + hstep, voffB);
            PG8_WAIT_V(6); PG8_BAR; PG8_MMA(1, 1, At, B1); PG8_BAR;
            }
        }
        if constexpr (ALIGN_EPI) { if (wr == 0) PG8_BAR; }
        if constexpr (!Epi::AFTER_DRAIN) { E(acc, cur, wr, wc, fr, fq); S.done(cur); }
        if (!has_next) break;
#pragma unroll
        for (int a = 0; a < 2; ++a)
#pragma unroll
            for (int b = 0; b < 2; ++b)
#pragma unroll
                for (int m = 0; m < 4; ++m)
#pragma unroll
                    for (int n = 0; n < 2; ++n) acc[a][b][m][n] = (f32x4){0.f, 0.f, 0.f, 0.f};
        cur = nxt; cA = nA; cB = nB; ++ui;
        if constexpr (ALIGN_EPI) { if (wr == 1) PG8_BAR; }
    }
    PG8_WAIT_V(0);
    if constexpr (!ALIGN_EPI) { if (wr == 0) PG8_BAR; }
    PG8_BAR;
    if constexpr (Epi::AFTER_DRAIN) { E.fused(acc, cur, wr, wc, fr, fq, lds, wid, lane); S.done(cur); }
#undef PG8_SA
#undef PG8_SB
#undef PG8_STAGE
#undef PG8_LDA
#undef PG8_LDB
#undef PG8_MMA
#undef PG8_WAIT_V
#undef PG8_WAIT_L
#undef PG8_BAR
#undef PG8_SCHED
}
}
constexpr int NWAVES = 8;
constexpr int BATCH = 2, SEQ = 8192, DM = 4096, DFF = 11008, MTOK = BATCH * SEQ;
constexpr int MEMLEN = 256, MROWS = BATCH * MEMLEN;
constexpr float EPS = 1e-6f;
constexpr int NPC = 9984, NPT = NPC / 256;
constexpr int PC_CQ = 0, PC_CKV = 1536, PC_QD = 2048, PC_KD = 3584, PC_VD = 5120, PC_QI = 6656, PC_QM = 8704, PC_KR = 9728, PC_KI = 9792, PC_WI = 9856;
constexpr int NGC = 3 * DM;
constexpr int NIN = NPC + NGC;
constexpr int NGU = 2 * DFF;
constexpr float LOG2E = 1.4426950408889634f;
constexpr float QS_MLA = 0.07216878364870322f * LOG2E;
constexpr float QS_DSA = 0.08838834764831845f * LOG2E;
constexpr float QS_MEM = 0.0625f * LOG2E;
constexpr float LOG2_THETA = 18.931568569324174f;

constexpr size_t MiB = 1u << 20;
constexpr size_t WS_CTL = 0, CTL_ZERO_BYTES = 1 * MiB;
constexpr size_t WS_WGU = 1 * MiB;
constexpr size_t WS_WD = 173 * MiB;
constexpr size_t WS_SC = 1 * MiB;
constexpr size_t WS_WIN = 259 * MiB;
constexpr size_t WS_WUQ = 433 * MiB, WS_WUKV = 440 * MiB, WS_WMKV = 443 * MiB, WS_WOMLA = 459 * MiB, WS_WODSA = 471 * MiB, WS_WOMEM = 483 * MiB, WS_WOUT = 491 * MiB;
constexpr size_t WS_A = 523 * MiB;
constexpr size_t WS_BIG = 651 * MiB;
constexpr size_t WS_HMID = WS_BIG;
constexpr size_t WS_G = WS_BIG;
constexpr size_t WS_P = 1035 * MiB;
constexpr size_t WS_QMLARAW = 1035 * MiB, WS_KVRAW = 1107 * MiB, WS_QMLA = 1203 * MiB, WS_KMLA = 1275 * MiB;
constexpr size_t WS_GS = 1035 * MiB;
constexpr size_t WS_CQN = 1347 * MiB, WS_CKVN = 1395 * MiB, WS_QD = 1411 * MiB, WS_KD = 1459 * MiB, WS_VD = 1507 * MiB, WS_QI = 1555 * MiB, WS_KI = 1619 * MiB, WS_WI = 1621 * MiB, WS_KR = 1623 * MiB, WS_QM = 1625 * MiB;
constexpr size_t WS_YMLA = 1657 * MiB, WS_YDSA = 1705 * MiB, WS_YMEM = 1753 * MiB, WS_BM = 1785 * MiB, WS_MEMN = 1801 * MiB, WS_MKVRAW = 1805 * MiB, WS_MEMK = 1807 * MiB, WS_END = 1808 * MiB;
constexpr size_t SC_BATCH = (size_t)4096 * 8256;
static_assert(WS_SC + 2 * SC_BATCH * 4 <= WS_WIN, "scores fit the FFN weight region");
static_assert(WS_WGU + (size_t)NGU * DM * 2 <= WS_WD && WS_WD + (size_t)DM * DFF * 2 <= WS_WIN, "FFN weights");
static_assert(WS_WIN + (size_t)NIN * DM * 2 <= WS_WUQ, "win");
static_assert(WS_HMID + (size_t)MTOK * DFF * 2 <= WS_P && WS_G + (size_t)MTOK * NGC * 2 <= WS_P && WS_P + (size_t)MTOK * NPC * 2 <= WS_CQN, "big region");
static_assert(WS_GS + (size_t)MTOK * DM * 4 <= WS_CQN, "GS");
constexpr int CW_BAR = 4096, CW_QUEUE = 8192;

constexpr int RING_BYTES = 131072, MISC_OFF = RING_BYTES, LDS_BYTES = 147456;

#define GAS __attribute__((address_space(1)))
#define LAS __attribute__((address_space(3)))
#define DI __device__ __forceinline__
typedef unsigned short bf16;
typedef unsigned v4u __attribute__((ext_vector_type(4)));
typedef unsigned v2u __attribute__((ext_vector_type(2)));
typedef float f32x4 __attribute__((ext_vector_type(4)));
typedef float f32x16 __attribute__((ext_vector_type(16)));
typedef short bf16x8 __attribute__((ext_vector_type(8)));
typedef short s16x4 __attribute__((ext_vector_type(4)));
#define LDS_WAIT() asm volatile("s_waitcnt lgkmcnt(0)" ::: "memory")
DI float bf2f(bf16 v) { return __uint_as_float(((unsigned)v) << 16); }
DI unsigned f2bf(float f) { unsigned u = __float_as_uint(f); return (u + 0x7fffu + ((u >> 16) & 1u)) >> 16; }
DI unsigned pk2(float lo, float hi) { return f2bf(lo) | (f2bf(hi) << 16); }
DI float wave_sum(float v) {
#pragma unroll
    for (int o = 1; o < 64; o <<= 1) v += __shfl_xor(v, o);
    return v;
}
DI void sincos_rev(float ang, float& s, float& c) {
    double rev = (double)ang * 0.15915494309189535; rev -= __builtin_rint(rev);
    const float fr = (float)rev; s = __builtin_amdgcn_sinf(fr); c = __builtin_amdgcn_cosf(fr);
}
DI float inv_freq(int i, int half) { return __builtin_amdgcn_exp2f(-(float)i * (LOG2_THETA / (float)half)); }
#define XB_TMO      128
#define XB_XCNT(j)  (256  + 64 * (j))
#define XB_XSUB(j)  (1280 + 64 * (j))
#define XB_XGEN(j)  (2304 + 64 * (j))
#define XB_TOP      3328
#define XB_TOPGEN   3392
#define XCD_BAR_WORDS 3456
#define XB_SPIN_CAP (1u << 18)

__device__ __forceinline__ unsigned xb_ld(unsigned* p)              { return __hip_atomic_load(p, __ATOMIC_RELAXED, __HIP_MEMORY_SCOPE_AGENT); }
__device__ __forceinline__ unsigned xb_add(unsigned* p, unsigned v) { return __hip_atomic_fetch_add(p, v, __ATOMIC_RELAXED, __HIP_MEMORY_SCOPE_AGENT); }
__device__ __forceinline__ unsigned xb_xcc_id() { return (unsigned)__builtin_amdgcn_s_getreg((3 << 11) | 20) & 0xFu; }
#define XB_SPIN(cond, bar) do { unsigned _sp = 0; while (cond) { __builtin_amdgcn_s_sleep(1); \
    if ((++_sp & 255u) == 0u) { if (xb_ld(&(bar)[XB_TMO])) break; if (_sp > XB_SPIN_CAP) { atomicAdd(&(bar)[XB_TMO], 1u); break; } } } } while (0)

struct XcdBarrier {
    unsigned* bar; unsigned x;
    volatile LAS unsigned* st;
};

__device__ __forceinline__ XcdBarrier xcd_barrier_post(unsigned* bar, volatile LAS unsigned* st) {
    XcdBarrier b; b.bar = bar; b.x = xb_xcc_id(); b.st = st;
    if (threadIdx.x == 0) (void)xb_add(&bar[XB_XCNT(b.x)], 1u);
    return b;
}
__device__ __forceinline__ void xcd_barrier_complete(unsigned* bar, unsigned x, unsigned& nloc, unsigned& nx) {
    const unsigned G = gridDim.x * gridDim.y * gridDim.z;
    unsigned sum, cnt, mine, sp = 0u;
    for (;;) {
        sum = 0u; cnt = 0u; mine = 0u;
#pragma unroll
        for (unsigned j = 0; j < 16; ++j) { const unsigned c = xb_ld(&bar[XB_XCNT(j)]); sum += c; cnt += (c > 0u) ? 1u : 0u; mine = (j == x) ? c : mine; }
        if (sum == G) break;
        __builtin_amdgcn_s_sleep(1);
        if ((++sp & 255u) == 0u) { if (xb_ld(&bar[XB_TMO])) break; if (sp > XB_SPIN_CAP) { atomicAdd(&bar[XB_TMO], 1u); break; } }
    }
    nloc = mine > 0u ? mine : 1u; nx = cnt > 0u ? cnt : 1u;
}

__device__ __forceinline__ void xcd_barrier(const XcdBarrier& b) {
    asm volatile("s_waitcnt vmcnt(0)" ::: "memory");
    __syncthreads();
    if (threadIdx.x == 0) {
        unsigned* bar = b.bar;
        __builtin_amdgcn_s_waitcnt(0);
        unsigned nloc = b.st[0], nx = b.st[1];
        if (nloc == 0u) { xcd_barrier_complete(bar, b.x, nloc, nx); b.st[0] = nloc; b.st[1] = nx; }
        const unsigned old = xb_add(&bar[XB_XSUB(b.x)], 1u);
        const unsigned gen = old / nloc;
        if (old + 1u == (gen + 1u) * nloc) {
            __builtin_amdgcn_fence(__ATOMIC_RELEASE, "agent");
            asm volatile("s_waitcnt vmcnt(0)" ::: "memory");
            const unsigned og = xb_add(&bar[XB_TOP], 1u);
            const unsigned tg = og / nx;
            if (og + 1u == (tg + 1u) * nx) xb_add(&bar[XB_TOPGEN], 1u);
            else XB_SPIN(xb_ld(&bar[XB_TOPGEN]) == tg, bar);
            __builtin_amdgcn_fence(__ATOMIC_ACQUIRE, "agent");
            xb_add(&bar[XB_XGEN(b.x)], 1u);
            asm volatile("s_waitcnt vmcnt(0)" ::: "memory");
        } else {
            XB_SPIN(xb_ld(&bar[XB_XGEN(b.x)]) == gen, bar);
            __builtin_amdgcn_fence(__ATOMIC_ACQUIRE, "agent");
            asm volatile("s_waitcnt vmcnt(0)" ::: "memory");
        }
    }
    __syncthreads();
}
struct Ctx {
    LAS unsigned char* lds;
    int tid, lane, wave, G, gw, NGW;
};

DI void conv_item(const float* W, int ldw, int col0, int k0, bf16* WT, int K, int drow0, bool zero, LAS float* scr, int lane) {
#pragma unroll 8
    for (int i = 0; i < 32; ++i) { const int kk = 2 * i + (lane >> 5); scr[kk * 33 + (lane & 31)] = zero ? 0.f : W[(size_t)(k0 + kk) * ldw + col0 + (lane & 31)]; }
    LDS_WAIT(); asm volatile("" ::: "memory");
    const int c = lane & 7;
#pragma unroll
    for (int j = 0; j < 4; ++j) { const int n = (lane >> 3) + 8 * j; const LAS float* s = scr + (8 * c) * 33 + n;
        v4u o; o.x = pk2(s[0 * 33], s[1 * 33]); o.y = pk2(s[2 * 33], s[3 * 33]); o.z = pk2(s[4 * 33], s[5 * 33]); o.w = pk2(s[6 * 33], s[7 * 33]);
        *(GAS v4u*)(WT + (size_t)(drow0 + n) * K + k0 + 8 * c) = o; }
    LDS_WAIT(); asm volatile("" ::: "memory");
}
DI int inproj_src(int d) {
    if (d < 2048) return d;
    if (d < 8704) return d + 64;
    if (d < 9728) return d + 160;
    if (d < 9792) return d - 7680;
    if (d < 9888) return d - 1024;
    return -1;
}
DI void conv_ffn(const Ctx& C, const float* wg, const float* wu, const float* wd, bf16* WGUt, bf16* WDt) {
    LAS float* scr = (LAS float*)(C.lds + C.wave * 16384);
    constexpr int I_GU = (DM / 64) * (NGU / 32), I_D = (DFF / 64) * (DM / 32);
    for (int it = C.gw; it < I_GU + I_D; it += C.NGW) {
        if (it < I_GU) { const int nblk = NGU / 32, kb = it / nblk, nb = it % nblk, n0 = nb * 32, pn = n0 >> 8, bj = (n0 >> 7) & 1, c = n0 & 127;
            conv_item(bj ? wu : wg, DFF, 128 * pn + c, 64 * kb, WGUt, DM, n0, false, scr, C.lane); }
        else { const int r = it - I_GU, nblk = DM / 32, kb = r / nblk, nb = r % nblk;
            conv_item(wd, DM, 32 * nb, 64 * kb, WDt, DFF, 32 * nb, false, scr, C.lane); }
    }
}
DI void conv_plain(const Ctx& C, const float* w, int K, int N, bf16* wt, int& base, int total_dummy) { (void)base; (void)total_dummy;
    LAS float* scr = (LAS float*)(C.lds + C.wave * 16384);
    const int nblk = N / 32, items = (K / 64) * nblk;
    for (int it = C.gw; it < items; it += C.NGW) { const int kb = it / nblk, nb = it % nblk; conv_item(w, N, 32 * nb, 64 * kb, wt, K, 32 * nb, false, scr, C.lane); }
}
DI void conv_win(const Ctx& C, const float* w_in, const float* w_gate, bf16* wt) {
    LAS float* scr = (LAS float*)(C.lds + C.wave * 16384);
    constexpr int nblk = NIN / 32, items = (DM / 64) * nblk;
    for (int it = C.gw; it < items; it += C.NGW) { const int kb = it / nblk, nb = it % nblk, n0 = 32 * nb;
        if (n0 < NPC) { const int sc = inproj_src(n0); conv_item(w_in, 9888, sc < 0 ? 0 : sc, 64 * kb, wt, DM, n0, sc < 0, scr, C.lane); }
        else { const int gi = n0 - NPC, br = gi / DM, col = gi % DM; conv_item(w_gate + (size_t)br * DM * DM, DM, col, 64 * kb, wt, DM, n0, false, scr, C.lane); } }
}
DI void rms_row4096(const float* xrow, const float* g, bf16* orow, int lane) {
    const GAS f32x4* xr = (const GAS f32x4*)xrow + lane; const GAS f32x4* gr = (const GAS f32x4*)g + lane;
    f32x4 v[16]; float s = 0.f;
#pragma unroll
    for (int j = 0; j < 16; ++j) { v[j] = xr[64 * j]; s += (v[j].x * v[j].x + v[j].y * v[j].y) + (v[j].z * v[j].z + v[j].w * v[j].w); }
    const float rstd = rsqrtf(wave_sum(s) * (1.f / 4096.f) + EPS);
    GAS v2u* o8 = (GAS v2u*)orow + lane;
#pragma unroll
    for (int j = 0; j < 16; ++j) { const f32x4 gg = gr[64 * j]; v2u o; o.x = pk2(v[j].x * rstd * gg.x, v[j].y * rstd * gg.y); o.y = pk2(v[j].z * rstd * gg.z, v[j].w * rstd * gg.w); o8[64 * j] = o; }
}
DI void rms_rows(const Ctx& C, const float* x, const float* g, bf16* o, int rows) {
    for (int m = C.gw; m < rows; m += C.NGW) rms_row4096(x + (size_t)m * DM, g, o + (size_t)m * DM, C.lane);
}

struct PP1 { const bf16* P; const int* pos; const float *g_cq, *g_ckv, *g_qd, *g_kd, *g_qm;
             bf16 *CQn, *CKVn, *Qd, *Kd, *Vd, *Qi, *Ki, *Kr, *Qm; float* Wi; };
DI void pp1_token(const PP1& A, int t, int lane) {
    const bf16* pr = A.P + (size_t)t * NPC;
    const float pos = (float)A.pos[t];
    float sn_d, cs_d, sn_i, cs_i;
    sincos_rev(pos * inv_freq(lane & 15, 16), sn_d, cs_d);
    sincos_rev(pos * inv_freq(lane & 7, 8), sn_i, cs_i);
    {
        float x[24]; float ss = 0.f;
#pragma unroll
        for (int k = 0; k < 24; ++k) { x[k] = bf2f(pr[PC_CQ + lane + 64 * k]); ss += x[k] * x[k]; }
        const float rstd = rsqrtf(wave_sum(ss) * (1.f / 1536.f) + EPS);
#pragma unroll
        for (int k = 0; k < 24; ++k) A.CQn[(size_t)t * 1536 + lane + 64 * k] = (bf16)f2bf(x[k] * rstd * A.g_cq[lane + 64 * k]);
    }
    {
        float x[8]; float ss = 0.f;
#pragma unroll
        for (int k = 0; k < 8; ++k) { x[k] = bf2f(pr[PC_CKV + lane + 64 * k]); ss += x[k] * x[k]; }
        const float rstd = rsqrtf(wave_sum(ss) * (1.f / 512.f) + EPS);
#pragma unroll
        for (int k = 0; k < 8; ++k) A.CKVn[(size_t)t * 512 + lane + 64 * k] = (bf16)f2bf(x[k] * rstd * A.g_ckv[lane + 64 * k]);
    }
#pragma unroll 1
    for (int qk = 0; qk < 2; ++qk) {
        const int pc = qk ? PC_KD : PC_QD; const float* g = qk ? A.g_kd : A.g_qd; bf16* O = qk ? A.Kd : A.Qd; const float sc = qk ? 1.0f : QS_DSA;
        const float g0 = g[lane], g1 = g[64 + lane];
#pragma unroll 4
        for (int h = 0; h < 12; ++h) {
            const float x0 = bf2f(pr[pc + h * 128 + lane]), x1 = bf2f(pr[pc + h * 128 + 64 + lane]);
            const float rstd = rsqrtf(wave_sum(x0 * x0 + x1 * x1) * (1.f / 128.f) + EPS);
            float y0 = x0 * rstd * g0; const float y1 = x1 * rstd * g1;
            const float pr0 = __shfl_xor(y0, 16);
            if (lane < 16) y0 = y0 * cs_d - pr0 * sn_d; else if (lane < 32) y0 = y0 * cs_d + pr0 * sn_d;
            O[(size_t)t * 1536 + h * 128 + lane] = (bf16)f2bf(y0 * sc); O[(size_t)t * 1536 + h * 128 + 64 + lane] = (bf16)f2bf(y1 * sc);
        }
    }
#pragma unroll
    for (int k = 0; k < 24; ++k) A.Vd[(size_t)t * 1536 + lane + 64 * k] = pr[PC_VD + lane + 64 * k];
#pragma unroll 4
    for (int h = 0; h < 32; ++h) {
        float x = bf2f(pr[PC_QI + h * 64 + lane]); const float px = __shfl_xor(x, 8);
        if (lane < 8) x = x * cs_i - px * sn_i; else if (lane < 16) x = x * cs_i + px * sn_i;
        A.Qi[(size_t)t * 2048 + h * 64 + lane] = (bf16)f2bf(x);
    }
    {
        float x = bf2f(pr[PC_KI + lane]); const float px = __shfl_xor(x, 8);
        if (lane < 8) x = x * cs_i - px * sn_i; else if (lane < 16) x = x * cs_i + px * sn_i;
        A.Ki[(size_t)t * 64 + lane] = (bf16)f2bf(x);
        if (lane < 32) A.Wi[(size_t)t * 32 + lane] = bf2f(pr[PC_WI + lane]);
        A.Kr[(size_t)t * 64 + lane] = pr[PC_KR + lane];
    }
#pragma unroll
    for (int h = 0; h < 4; ++h) {
        float x[4]; float ss = 0.f;
#pragma unroll
        for (int k = 0; k < 4; ++k) { x[k] = bf2f(pr[PC_QM + h * 256 + lane + 64 * k]); ss += x[k] * x[k]; }
        const float rstd = rsqrtf(wave_sum(ss) * (1.f / 256.f) + EPS) * QS_MEM;
#pragma unroll
        for (int k = 0; k < 4; ++k) A.Qm[(size_t)t * 1024 + h * 256 + lane + 64 * k] = (bf16)f2bf(x[k] * rstd * A.g_qm[lane + 64 * k]);
    }
}
struct PP2 { const bf16 *QmlaRaw, *KVraw, *Kr, *MKVraw; const int* pos; const float *g_q, *g_k, *g_km; bf16 *Qmla, *Kmla, *MemK; };
DI void pp2_token(const PP2& A, int t, int lane) {
    const float pos = (float)A.pos[t];
    float sn, cs; sincos_rev(pos * inv_freq(lane & 31, 32), sn, cs);
    const float gq0 = A.g_q[lane], gq1 = A.g_q[64 + lane], gq2 = A.g_q[128 + lane], gk0 = A.g_k[lane], gk1 = A.g_k[64 + lane], gk2 = A.g_k[128 + lane];
    const float kr = bf2f(A.Kr[(size_t)t * 64 + lane]);
#pragma unroll 2
    for (int h = 0; h < 12; ++h) {
        {   const bf16* q = A.QmlaRaw + (size_t)t * 2304 + h * 192;
            const float x0 = bf2f(q[lane]), x1 = bf2f(q[64 + lane]), x2 = bf2f(q[128 + lane]);
            const float rstd = rsqrtf(wave_sum(x0 * x0 + x1 * x1 + x2 * x2) * (1.f / 192.f) + EPS);
            float y0 = x0 * rstd * gq0; const float y1 = x1 * rstd * gq1, y2 = x2 * rstd * gq2;
            const float p0 = __shfl_xor(y0, 32); y0 = (lane < 32) ? y0 * cs - p0 * sn : y0 * cs + p0 * sn;
            bf16* o = A.Qmla + (size_t)t * 2304 + h * 192;
            o[lane] = (bf16)f2bf(y0 * QS_MLA); o[64 + lane] = (bf16)f2bf(y1 * QS_MLA); o[128 + lane] = (bf16)f2bf(y2 * QS_MLA); }
        {   const bf16* kv = A.KVraw + (size_t)t * 3072 + h * 256;
            const float x0 = kr, x1 = bf2f(kv[lane]), x2 = bf2f(kv[64 + lane]);
            const float rstd = rsqrtf(wave_sum(x0 * x0 + x1 * x1 + x2 * x2) * (1.f / 192.f) + EPS);
            float y0 = x0 * rstd * gk0; const float y1 = x1 * rstd * gk1, y2 = x2 * rstd * gk2;
            const float p0 = __shfl_xor(y0, 32); y0 = (lane < 32) ? y0 * cs - p0 * sn : y0 * cs + p0 * sn;
            bf16* o = A.Kmla + (size_t)t * 2304 + h * 192;
            o[lane] = (bf16)f2bf(y0); o[64 + lane] = (bf16)f2bf(y1); o[128 + lane] = (bf16)f2bf(y2); }
    }
}
DI void pp2_memrow(const PP2& A, int r, int lane) {
#pragma unroll
    for (int h = 0; h < 4; ++h) {
        float x[4]; float ss = 0.f;
#pragma unroll
        for (int k = 0; k < 4; ++k) { x[k] = bf2f(A.MKVraw[(size_t)r * 2048 + h * 256 + lane + 64 * k]); ss += x[k] * x[k]; }
        const float rstd = rsqrtf(wave_sum(ss) * (1.f / 256.f) + EPS);
#pragma unroll
        for (int k = 0; k < 4; ++k) A.MemK[(size_t)r * 1024 + h * 256 + lane + 64 * k] = (bf16)f2bf(x[k] * rstd * A.g_km[lane + 64 * k]);
    }
}

#define MFMA32(a, b, c) __builtin_amdgcn_mfma_f32_32x32x16_bf16((a), (b), (c), 0, 0, 0)
DI float half_swap_sum(float v) { auto rr = __builtin_amdgcn_permlane32_swap(__float_as_uint(v), __float_as_uint(v), false, false); return __uint_as_float(rr[0]) + __uint_as_float(rr[1]); }
DI float half_swap_max(float v) { auto rr = __builtin_amdgcn_permlane32_swap(__float_as_uint(v), __float_as_uint(v), false, false); return fmaxf(__uint_as_float(rr[0]), __uint_as_float(rr[1])); }
DI size_t sc_block_off(int b, int bi) { return (size_t)b * SC_BATCH + (size_t)4096 * (size_t)(bi * (bi + 1) / 2); }
DI void idx_item(int p, const bf16* Qi, const bf16* Ki, const float* Wi, float* Sc, int wave, int lane) {
    const int b = p >> 7, r = p & 127, hs = r & 1, k = r >> 1, r32 = lane & 31, hi = lane >> 5;
#pragma unroll 1
    for (int which = 0; which < 2; ++which) {
        const int bi = which ? 127 - k : k, nt32 = (bi + 1) * 2, ncol = (bi + 1) * 64;
        float* scb = Sc + sc_block_off(b, bi);
#pragma unroll 1
        for (int pass = 0; pass < 2; ++pass) {
            const int qa = 32 * hs + 4 * wave + 2 * pass, ta = b * SEQ + bi * 64 + qa;
            bf16x8 A0[4], A1[4]; f32x4 w0[4], w1[4];
#pragma unroll
            for (int d0 = 0; d0 < 4; ++d0) { A0[d0] = *(const bf16x8*)(Qi + (size_t)ta * 2048 + r32 * 64 + d0 * 16 + hi * 8); A1[d0] = *(const bf16x8*)(Qi + (size_t)(ta + 1) * 2048 + r32 * 64 + d0 * 16 + hi * 8); }
#pragma unroll
            for (int g = 0; g < 4; ++g) { w0[g] = *(const f32x4*)(Wi + (size_t)ta * 32 + 8 * g + 4 * hi); w1[g] = *(const f32x4*)(Wi + (size_t)(ta + 1) * 32 + 8 * g + 4 * hi); }
            float* o0 = scb + (size_t)qa * ncol + r32; float* o1 = o0 + ncol;
#pragma unroll 2
            for (int kt = 0; kt < nt32; ++kt) {
                const bf16* kp = Ki + (size_t)(b * SEQ + kt * 32 + r32) * 64 + hi * 8;
                bf16x8 B[4];
#pragma unroll
                for (int d0 = 0; d0 < 4; ++d0) B[d0] = *(const bf16x8*)(kp + d0 * 16);
                f32x16 c0, c1;
#pragma unroll
                for (int i = 0; i < 16; ++i) { c0[i] = 0.f; c1[i] = 0.f; }
#pragma unroll
                for (int d0 = 0; d0 < 4; ++d0) { c0 = MFMA32(A0[d0], B[d0], c0); c1 = MFMA32(A1[d0], B[d0], c1); }
                float s0 = 0.f, s1 = 0.f;
#pragma unroll
                for (int i = 0; i < 16; ++i) { s0 = fmaf(w0[i >> 2][i & 3], fmaxf(c0[i], 0.f), s0); s1 = fmaf(w1[i >> 2][i & 3], fmaxf(c1[i], 0.f), s1); }
                s0 = half_swap_sum(s0); s1 = half_swap_sum(s1);
                if (hi == 0) { o0[kt * 32] = s0; o1[kt * 32] = s1; }
            }
        }
    }
}
DI void select_row(const float* Sc, unsigned long long* BM64, int t, int lane, LAS unsigned long long* scr) {
    const int b = t / SEQ, s = t % SEQ, bi = s >> 6, n = (bi + 1) * 64;
    const float* row = Sc + sc_block_off(b, bi) + (size_t)(s & 63) * n;
    unsigned long long* out = BM64 + (size_t)t * 128;
    if (n <= 256) {
        const unsigned long long w0 = (lane < n / 64) ? ~0ull : 0ull;
        out[lane] = w0; out[64 + lane] = 0ull; return;
    }
    unsigned key[128];
#pragma unroll
    for (int i = 0; i < 128; ++i) { unsigned kk = 0u; if (64 * i < n) { const unsigned u = __float_as_uint(row[64 * i + lane]); kk = (u & 0x80000000u) ? ~u : (u | 0x80000000u); } key[i] = kk; }
    unsigned prefix = 0u;
#pragma unroll 1
    for (int bit = 31; bit >= 0; --bit) {
        const unsigned cand = prefix | (1u << bit); int cnt = 0;
#pragma unroll
        for (int i = 0; i < 128; ++i) cnt += (key[i] >= cand) ? 1 : 0;
#pragma unroll
        for (int o = 1; o < 64; o <<= 1) cnt += __shfl_xor(cnt, o);
        if (cnt >= 256) prefix = cand;
    }
    int cgt = 0;
#pragma unroll
    for (int i = 0; i < 128; ++i) cgt += (key[i] > prefix) ? 1 : 0;
#pragma unroll
    for (int o = 1; o < 64; o <<= 1) cgt += __shfl_xor(cgt, o);
    const int need = __builtin_amdgcn_readfirstlane(256 - cgt);
    int run = 0;
#pragma unroll
    for (int i = 0; i < 128; ++i) {
        const bool gt = key[i] > prefix, eq = key[i] == prefix;
        const unsigned long long eqb = __ballot(eq);
        const int rank = run + (int)__builtin_amdgcn_mbcnt_hi((unsigned)(eqb >> 32), __builtin_amdgcn_mbcnt_lo((unsigned)eqb, 0u));
        const unsigned long long take = __ballot(gt || (eq && rank < need));
        run += __popcll(eqb);
        if (lane == 0) scr[i] = take;
        if ((i & 7) == 7) __builtin_amdgcn_sched_barrier(0);
    }
    const unsigned long long mine0 = scr[lane], mine1 = scr[64 + lane];
    out[lane] = mine0; out[64 + lane] = mine1;
}
typedef short v4i16_t __attribute__((ext_vector_type(4)));
DI s16x4 vtr(const LAS unsigned char* p) { return __builtin_bit_cast(s16x4, __builtin_amdgcn_ds_read_tr16_b64_v4i16((LAS v4i16_t*)p)); }
DI unsigned cvtpk(float lo, float hi) { unsigned r; asm volatile("v_cvt_pk_bf16_f32 %0, %1, %2" : "=v"(r) : "v"(lo), "v"(hi)); return r; }
constexpr int VSTR = 320;
template <int DK> struct AttnLds { static constexpr int KSTR = DK * 2 + 16, KB = 64 * KSTR, VB = 64 * VSTR, K0 = 0, V0 = 2 * KB, TOTAL = 2 * KB + 2 * VB; };
static_assert(AttnLds<256>::TOTAL <= RING_BYTES, "attention LDS");

template <int DK, int MODE>
DI void attn_unit(LAS unsigned char* lds, const bf16* Qp, int LDQ, const bf16* Kp, int LDK, const bf16* Vp, int LDV, bf16* Op, int LDO, int NT, int chunk0, const unsigned* BMrow) {
    typedef AttnLds<DK> L;
    constexpr int ND = DK / 16, KCH = DK / 8, NKC = DK / 64;
    int tid_ = threadIdx.x; asm volatile("" : "+v"(tid_));
    const int tid = tid_, wid = __builtin_amdgcn_readfirstlane(tid >> 6), lane = tid & 63, r32 = lane & 31, hi = lane >> 5;
    const int mychunk = chunk0 + (wid >> 1);
    constexpr bool QLOOP = (DK > 192);
    bf16x8 qr[ND];
    const bf16* qw = Qp + (size_t)(wid * 32 + r32) * LDQ + hi * 8;
    if (!QLOOP) {
#pragma unroll
        for (int d0 = 0; d0 < ND; ++d0) qr[d0] = *(const bf16x8*)(qw + d0 * 16); }
    const unsigned* bmw = (MODE == 1) ? BMrow + (size_t)(wid * 32 + r32) * 256 : nullptr;
    int krow_[NKC], kcc_[NKC];
#pragma unroll
    for (int i = 0; i < NKC; ++i) { const int c = tid + 512 * i; krow_[i] = c / KCH; kcc_[i] = c % KCH; }
    const int vrow0 = tid >> 4, vcc = tid & 15;
    v4u kst[NKC], vst[2];
#define ATT_LOAD(j) do { const int key0_ = (j) * 64; \
        _Pragma("unroll") for (int i_ = 0; i_ < NKC; ++i_) kst[i_] = *(const v4u*)(Kp + (size_t)(key0_ + krow_[i_]) * LDK + kcc_[i_] * 8); \
        vst[0] = *(const v4u*)(Vp + (size_t)(key0_ + vrow0) * LDV + vcc * 8); vst[1] = *(const v4u*)(Vp + (size_t)(key0_ + 32 + vrow0) * LDV + vcc * 8); } while (0)
#define ATT_WRITE(buf) do { \
        _Pragma("unroll") for (int i_ = 0; i_ < NKC; ++i_) *(LAS v4u*)(lds + L::K0 + (buf) * L::KB + krow_[i_] * L::KSTR + kcc_[i_] * 16) = kst[i_]; \
        *(LAS v4u*)(lds + L::V0 + (buf) * L::VB + vrow0 * VSTR + vcc * 16) = vst[0]; *(LAS v4u*)(lds + L::V0 + (buf) * L::VB + (32 + vrow0) * VSTR + vcc * 16) = vst[1]; } while (0)
    float m_run = -1e30f, l_run = 0.f;
    f32x16 o[4];
#pragma unroll
    for (int d = 0; d < 4; ++d)
#pragma unroll
        for (int i = 0; i < 16; ++i) o[d][i] = 0.f;
    const int kbase = r32 * L::KSTR + hi * 16;
    const int q4 = (lane >> 2) & 3, p4 = lane & 3, blk = (lane >> 4) & 1;
    const int vbase = (4 * hi + q4) * VSTR + blk * 32 + p4 * 8;
    ATT_LOAD(0); ATT_WRITE(0);
    __syncthreads();
#pragma unroll 1
    for (int j = 0; j < NT; ++j) {
        const int cur = j & 1;
        const bool active = (MODE == 2) || (j <= mychunk);
        unsigned mw0 = 0xffffffffu, mw1 = 0xffffffffu;
        if (MODE == 1) { if (active) { const v2u mm = *(const v2u*)(bmw + 2 * j); mw0 = mm.x >> (4 * hi); mw1 = mm.y >> (4 * hi); } }
        if (j + 1 < NT) ATT_LOAD(j + 1);
        if (active) {
            f32x16 p0, p1;
#pragma unroll
            for (int i = 0; i < 16; ++i) { p0[i] = 0.f; p1[i] = 0.f; }
            const LAS unsigned char* kb = lds + L::K0 + cur * L::KB + kbase;
            const bf16* qwl = qw; if (QLOOP) asm volatile("" : "+v"(qwl));
#pragma unroll
            for (int d0 = 0; d0 < ND; ++d0) {
                const bf16x8 a0 = *(const LAS bf16x8*)(kb + d0 * 32), a1 = *(const LAS bf16x8*)(kb + 32 * L::KSTR + d0 * 32);
                const bf16x8 qf = QLOOP ? *(const bf16x8*)(qwl + d0 * 16) : qr[d0];
                p0 = MFMA32(a0, qf, p0); p1 = MFMA32(a1, qf, p1);
                if ((d0 & 3) == 3) __builtin_amdgcn_sched_barrier(0);
            }
            if (MODE == 1) {
#pragma unroll
                for (int i = 0; i < 16; ++i) { const unsigned bit = 1u << ((i & 3) + 8 * (i >> 2));
                    p0[i] = (mw0 & bit) ? p0[i] : -INFINITY; p1[i] = (mw1 & bit) ? p1[i] : -INFINITY; }
            }
            float tmax = p0[0];
#pragma unroll
            for (int i = 1; i < 16; ++i) tmax = fmaxf(tmax, p0[i]);
#pragma unroll
            for (int i = 0; i < 16; ++i) tmax = fmaxf(tmax, p1[i]);
            tmax = half_swap_max(tmax);
            const float m_new = fmaxf(m_run, tmax), alpha = __builtin_amdgcn_exp2f(m_run - m_new);
            m_run = m_new;
            float ps = 0.f;
#pragma unroll
            for (int i = 0; i < 16; ++i) { p0[i] = __builtin_amdgcn_exp2f(p0[i] - m_new); ps += p0[i]; }
#pragma unroll
            for (int i = 0; i < 16; ++i) { p1[i] = __builtin_amdgcn_exp2f(p1[i] - m_new); ps += p1[i]; }
            ps = half_swap_sum(ps);
            l_run = l_run * alpha + ps;
            if (__any(alpha < 1.0f)) {
#pragma unroll
                for (int d = 0; d < 4; ++d)
#pragma unroll
                    for (int i = 0; i < 16; ++i) o[d][i] *= alpha;
            }
            bf16x8 pb[4];
#pragma unroll
            for (int s = 0; s < 4; ++s) { v4u w;
                if (s < 2) { w.x = cvtpk(p0[8 * s + 0], p0[8 * s + 1]); w.y = cvtpk(p0[8 * s + 2], p0[8 * s + 3]); w.z = cvtpk(p0[8 * s + 4], p0[8 * s + 5]); w.w = cvtpk(p0[8 * s + 6], p0[8 * s + 7]); }
                else { const int s2 = s - 2; w.x = cvtpk(p1[8 * s2 + 0], p1[8 * s2 + 1]); w.y = cvtpk(p1[8 * s2 + 2], p1[8 * s2 + 3]); w.z = cvtpk(p1[8 * s2 + 4], p1[8 * s2 + 5]); w.w = cvtpk(p1[8 * s2 + 6], p1[8 * s2 + 7]); }
                pb[s] = __builtin_bit_cast(bf16x8, w); }
            const LAS unsigned char* vb = lds + L::V0 + cur * L::VB + vbase;
#pragma unroll
            for (int d0 = 0; d0 < 4; ++d0)
#pragma unroll
                for (int s = 0; s < 4; ++s) {
                    const s16x4 lo = vtr(vb + (16 * s) * VSTR + d0 * 64), hh = vtr(vb + (16 * s + 8) * VSTR + d0 * 64);
                    const bf16x8 va = (bf16x8){lo[0], lo[1], lo[2], lo[3], hh[0], hh[1], hh[2], hh[3]};
                    o[d0] = MFMA32(va, pb[s], o[d0]);
                    if (s == 3) __builtin_amdgcn_sched_barrier(0);
                }
        }
        if (j + 1 < NT) ATT_WRITE(cur ^ 1);
        __syncthreads();
    }
    const float rl = 1.0f / l_run;
    bf16* ow = Op + (size_t)(wid * 32 + r32) * LDO + 4 * hi;
#pragma unroll
    for (int d0 = 0; d0 < 4; ++d0)
#pragma unroll
        for (int g = 0; g < 4; ++g) { v2u w; w.x = cvtpk(o[d0][4 * g] * rl, o[d0][4 * g + 1] * rl); w.y = cvtpk(o[d0][4 * g + 2] * rl, o[d0][4 * g + 3] * rl);
            *(v2u*)(ow + 32 * d0 + 8 * g) = w; }
#undef ATT_LOAD
#undef ATT_WRITE
}
#ifndef MK_MULTI
#define MK_MULTI 0
#endif
#ifndef DBG_SKIP_MIXER
#define DBG_SKIP_MIXER 0
#endif
constexpr int NPH = 16;
#ifndef ATT_MASK
#define ATT_MASK 7
#endif
struct Args { const float* in[30]; float* out; unsigned char* ws; int ph_lo, ph_hi; };
static_assert(sizeof(Args) == 30 * 8 + 8 + 8 + 8, "no padding");

DI void ffn_up_phase(LAS unsigned char* lds, const bf16* A, const bf16* WGUt, bf16* Hmid, int G) {
    pg8::Gemm g{A, WGUt, MTOK, NGU, DM}; pg8::StaticOrder S; S.init(MTOK, NGU, G, (int)blockIdx.x);
    pg8::EpiSwiGLU E{Hmid, DFF};
    pg8::gemm_phase<pg8::EpiSwiGLU, pg8::StaticOrder, true, true>(lds, g, S, E);
}
DI void ffn_down_phase(LAS unsigned char* lds, const bf16* Hmid, const bf16* WDt, const float* base, float* out, int G) {
    pg8::Gemm g{Hmid, WDt, MTOK, DM, DFF}; pg8::StaticOrder S; S.init(MTOK, DM, G, (int)blockIdx.x);
    pg8::EpiResid E{base, out, DM, 0.5f};
    pg8::gemm_phase<pg8::EpiResid, pg8::StaticOrder, true, true>(lds, g, S, E);
}

__global__ void __launch_bounds__(NWAVES * 64, 2) mega_fwd(Args args) {
    extern __shared__ __attribute__((aligned(16))) unsigned char lds_raw[];
    LAS unsigned char* lds = (LAS unsigned char*)lds_raw;
    Ctx C; C.lds = lds; C.tid = threadIdx.x; C.lane = C.tid & 63; C.wave = __builtin_amdgcn_readfirstlane(C.tid >> 6);
    C.G = gridDim.x; C.gw = blockIdx.x * NWAVES + C.wave; C.NGW = C.G * NWAVES;
    unsigned char* ws = args.ws;
    unsigned* ctl = (unsigned*)(ws + WS_CTL);
    volatile LAS unsigned* MISC = (volatile LAS unsigned*)(lds + MISC_OFF);
    for (int u = C.tid; u < (LDS_BYTES - MISC_OFF) / 4; u += NWAVES * 64) ((LAS unsigned*)(lds + MISC_OFF))[u] = 0u;
    __syncthreads();
    const int lo = args.ph_lo, hi = args.ph_hi;
    XcdBarrier bar; bar.bar = ctl + CW_BAR; bar.x = 0; bar.st = nullptr;
    if (hi - lo > 1) bar = xcd_barrier_post(ctl + CW_BAR, MISC);
#ifndef PH_MASK
#define PH_MASK 0xffff
#endif
#define IN(k) ((((PH_MASK) >> (k)) & 1) && lo <= (k) && (k) < hi)
#define SEAM(k) do { if (IN(k) && IN((k) + 1)) xcd_barrier(bar); } while (0)

    const float* x = args.in[0]; const float* mem = args.in[1]; const int* positions = (const int*)args.in[2];
    float* X = args.out;
    bf16* WGUt = (bf16*)(ws + WS_WGU); bf16* WDt = (bf16*)(ws + WS_WD); bf16* WINt = (bf16*)(ws + WS_WIN);
    bf16* WUQt = (bf16*)(ws + WS_WUQ); bf16* WUKVt = (bf16*)(ws + WS_WUKV); bf16* WMKVt = (bf16*)(ws + WS_WMKV);
    bf16* WOMLAt = (bf16*)(ws + WS_WOMLA); bf16* WODSAt = (bf16*)(ws + WS_WODSA); bf16* WOMEMt = (bf16*)(ws + WS_WOMEM); bf16* WOUTt = (bf16*)(ws + WS_WOUT);
    bf16* Abuf = (bf16*)(ws + WS_A); bf16* Hmid = (bf16*)(ws + WS_HMID); bf16* Gt = (bf16*)(ws + WS_G); bf16* P = (bf16*)(ws + WS_P);
    bf16* QmlaRaw = (bf16*)(ws + WS_QMLARAW); bf16* KVraw = (bf16*)(ws + WS_KVRAW); bf16* Qmla = (bf16*)(ws + WS_QMLA); bf16* Kmla = (bf16*)(ws + WS_KMLA);
    float* GS = (float*)(ws + WS_GS);
    bf16* CQn = (bf16*)(ws + WS_CQN); bf16* CKVn = (bf16*)(ws + WS_CKVN); bf16* Qd = (bf16*)(ws + WS_QD); bf16* Kd = (bf16*)(ws + WS_KD); bf16* Vd = (bf16*)(ws + WS_VD);
    bf16* Qi = (bf16*)(ws + WS_QI); bf16* Ki = (bf16*)(ws + WS_KI); float* Wi = (float*)(ws + WS_WI); bf16* Kr = (bf16*)(ws + WS_KR); bf16* Qm = (bf16*)(ws + WS_QM);
    bf16* Ymla = (bf16*)(ws + WS_YMLA); bf16* Ydsa = (bf16*)(ws + WS_YDSA); bf16* Ymem = (bf16*)(ws + WS_YMEM);
    unsigned* BM = (unsigned*)(ws + WS_BM); bf16* memn = (bf16*)(ws + WS_MEMN); bf16* MKVraw = (bf16*)(ws + WS_MKVRAW); bf16* MemK = (bf16*)(ws + WS_MEMK);
    float* Sc = (float*)(ws + WS_SC);

    if (IN(0)) {
        conv_ffn(C, args.in[4], args.in[5], args.in[6], WGUt, WDt);
#if !DBG_SKIP_MIXER
        conv_win(C, args.in[8], args.in[24], WINt);
        int dummy = 0;
        conv_plain(C, args.in[10], 1536, 2304, WUQt, dummy, 0);
        conv_plain(C, args.in[12], 512, 3072, WUKVt, dummy, 0);
        conv_plain(C, args.in[18], 4096, 2048, WMKVt, dummy, 0);
        conv_plain(C, args.in[21], 1536, 4096, WOMLAt, dummy, 0);
        conv_plain(C, args.in[22], 1536, 4096, WODSAt, dummy, 0);
        conv_plain(C, args.in[23], 1024, 4096, WOMEMt, dummy, 0);
        conv_plain(C, args.in[25], 4096, 4096, WOUTt, dummy, 0);
        rms_rows(C, mem, args.in[17], memn, MROWS);
#endif
        rms_rows(C, x, args.in[3], Abuf, MTOK);
    }
    SEAM(0);
    if (IN(1)) ffn_up_phase(lds, Abuf, WGUt, Hmid, C.G);
    SEAM(1);
    if (IN(2)) ffn_down_phase(lds, Hmid, WDt, x, X, C.G);
    SEAM(2);
#if !DBG_SKIP_MIXER
    if (IN(3)) rms_rows(C, X, args.in[7], Abuf, MTOK);
    SEAM(3);
    if (IN(4)) {
        pg8::Gemm g{Abuf, WINt, MTOK, NIN, DM}; pg8::StaticOrder S; S.init(MTOK, NIN, C.G, (int)blockIdx.x);
        pg8::EpiInProj E{P, NPC, NPT, Gt, NGC};
        pg8::gemm_phase<pg8::EpiInProj, pg8::StaticOrder, true, true>(lds, g, S, E);
    }
    SEAM(4);
    if (IN(5)) {
        PP1 A{P, positions, args.in[9], args.in[11], args.in[15], args.in[16], args.in[19], CQn, CKVn, Qd, Kd, Vd, Qi, Ki, Kr, Qm, Wi};
        for (int t = C.gw; t < MTOK; t += C.NGW) pp1_token(A, t, C.lane);
    }
    SEAM(5);
    if (IN(6)) {
        { pg8::Gemm g{CQn, WUQt, MTOK, 2304, 1536}; pg8::StaticOrder S; S.init(MTOK, 2304, C.G, (int)blockIdx.x); pg8::EpiPlain E{QmlaRaw, 2304};
          pg8::gemm_phase<pg8::EpiPlain, pg8::StaticOrder, true, true>(lds, g, S, E); }
        { pg8::Gemm g{CKVn, WUKVt, MTOK, 3072, 512}; pg8::StaticOrder S; S.init(MTOK, 3072, C.G, (int)blockIdx.x); pg8::EpiPlain E{KVraw, 3072};
          pg8::gemm_phase<pg8::EpiPlain, pg8::StaticOrder, true, true>(lds, g, S, E); }
        { pg8::Gemm g{memn, WMKVt, MROWS, 2048, DM}; pg8::StaticOrder S; S.init(MROWS, 2048, C.G, (int)blockIdx.x); pg8::EpiPlain E{MKVraw, 2048};
          pg8::gemm_phase<pg8::EpiPlain, pg8::StaticOrder, true, true>(lds, g, S, E); }
    }
    SEAM(6);
    if (IN(7)) {
        PP2 A{QmlaRaw, KVraw, Kr, MKVraw, positions, args.in[13], args.in[14], args.in[20], Qmla, Kmla, MemK};
        for (int t = C.gw; t < MTOK; t += C.NGW) pp2_token(A, t, C.lane);
        for (int r = C.gw; r < MROWS; r += C.NGW) pp2_memrow(A, r, C.lane);
    }
    SEAM(7);
    if (IN(8)) { for (int p = blockIdx.x; p < 256; p += C.G) idx_item(p, Qi, Ki, Wi, Sc, C.wave, C.lane); }
    SEAM(8);
    if (IN(9)) { for (int t = C.gw; t < MTOK; t += C.NGW) select_row(Sc, (unsigned long long*)BM, t, C.lane, (LAS unsigned long long*)(lds + C.wave * 1024)); }
    SEAM(9);
    if (IN(10)) {
        for (;;) {
            if (C.tid == 0) MISC[4] = __hip_atomic_fetch_add(ctl + CW_QUEUE, 1u, __ATOMIC_RELAXED, __HIP_MEMORY_SCOPE_AGENT);
            __syncthreads();
            const int u = __builtin_amdgcn_readfirstlane((int)MISC[4]);
            __syncthreads();
            if (u >= 2048) break;
            if (u < 1536) {
                const int qt = 31 - u / 48, r = u % 48, type = r / 24, bh = r % 24, b = bh / 12, h = bh % 12;
                const size_t row0 = (size_t)b * SEQ + 256 * qt, krow0 = (size_t)b * SEQ;
                if (type == 0) { if (ATT_MASK & 1) attn_unit<192, 0>(lds, Qmla + row0 * 2304 + h * 192, 2304, Kmla + krow0 * 2304 + h * 192, 2304, KVraw + krow0 * 3072 + h * 256 + 128, 3072,
                                                 Ymla + row0 * 1536 + h * 128, 1536, 4 * qt + 4, 4 * qt, nullptr); }
                else if (ATT_MASK & 2) attn_unit<128, 1>(lds, Qd + row0 * 1536 + h * 128, 1536, Kd + krow0 * 1536 + h * 128, 1536, Vd + krow0 * 1536 + h * 128, 1536,
                                       Ydsa + row0 * 1536 + h * 128, 1536, 4 * qt + 4, 4 * qt, BM + row0 * 256);
            } else {
                const int v = u - 1536, b = v >> 8, h = (v >> 6) & 3, qt = (v >> 1) & 31, dvh = v & 1;
                const size_t row0 = (size_t)b * SEQ + 256 * qt, krow0 = (size_t)b * MEMLEN;
                if (ATT_MASK & 4) attn_unit<256, 2>(lds, Qm + row0 * 1024 + h * 256, 1024, MemK + krow0 * 1024 + h * 256, 1024, MKVraw + krow0 * 2048 + 1024 + h * 256 + dvh * 128, 2048,
                                  Ymem + row0 * 1024 + h * 256 + dvh * 128, 1024, 4, 0, nullptr);
            }
        }
    }
    SEAM(10);
    if (IN(11)) {
        { pg8::Gemm g{Ymla, WOMLAt, MTOK, DM, 1536}; pg8::StaticOrder S; S.init(MTOK, DM, C.G, (int)blockIdx.x); pg8::EpiGate<0> E{Gt, NGC, 0, GS, Abuf, DM};
          pg8::gemm_phase<pg8::EpiGate<0>, pg8::StaticOrder, true, true>(lds, g, S, E); }
        { pg8::Gemm g{Ydsa, WODSAt, MTOK, DM, 1536}; pg8::StaticOrder S; S.init(MTOK, DM, C.G, (int)blockIdx.x); pg8::EpiGate<1> E{Gt, NGC, DM, GS, Abuf, DM};
          pg8::gemm_phase<pg8::EpiGate<1>, pg8::StaticOrder, true, true>(lds, g, S, E); }
        { pg8::Gemm g{Ymem, WOMEMt, MTOK, DM, 1024}; pg8::StaticOrder S; S.init(MTOK, DM, C.G, (int)blockIdx.x); pg8::EpiGate<2> E{Gt, NGC, 2 * DM, GS, Abuf, DM};
          pg8::gemm_phase<pg8::EpiGate<2>, pg8::StaticOrder, true, true>(lds, g, S, E); }
    }
    SEAM(11);
    if (IN(12)) {
        pg8::Gemm g{Abuf, WOUTt, MTOK, DM, DM}; pg8::StaticOrder S; S.init(MTOK, DM, C.G, (int)blockIdx.x); pg8::EpiResid E{X, X, DM, 1.0f};
        pg8::gemm_phase<pg8::EpiResid, pg8::StaticOrder, true, true>(lds, g, S, E);
    }
    SEAM(12);
#endif
    if (IN(13)) { conv_ffn(C, args.in[27], args.in[28], args.in[29], WGUt, WDt); rms_rows(C, X, args.in[26], Abuf, MTOK); }
    SEAM(13);
    if (IN(14)) ffn_up_phase(lds, Abuf, WGUt, Hmid, C.G);
    SEAM(14);
    if (IN(15)) ffn_down_phase(lds, Hmid, WDt, X, X, C.G);
#undef IN
#undef SEAM
}

extern "C" void kernel_launch(void* const* d_in, const int* in_sizes, int n_in, void* d_out, int out_size, void* d_ws, size_t ws_size, hipStream_t stream) {
    static int grid = 0;
    if (grid == 0) {
        if (n_in != 30 || in_sizes[0] != MTOK * DM || out_size != MTOK * DM || ws_size < WS_END) {
            fprintf(stderr, "kernel_launch: built for 30 inputs, x/out of %d floats, >= %zu bytes of workspace; got n_in %d, in0 %d, out %d, ws %zu; nothing launched\n", MTOK * DM, (size_t)WS_END, n_in, n_in > 0 ? in_sizes[0] : -1, out_size, ws_size);
            grid = -1; return; }
        int dev = 0, cus = 0, per_cu = 0;
        if (hipGetDevice(&dev) != hipSuccess || hipDeviceGetAttribute(&cus, hipDeviceAttributeMultiprocessorCount, dev) != hipSuccess) { fprintf(stderr, "kernel_launch: device query failed\n"); grid = -1; return; }
        if (hipFuncSetAttribute((const void*)mega_fwd, hipFuncAttributeMaxDynamicSharedMemorySize, LDS_BYTES) != hipSuccess) { fprintf(stderr, "kernel_launch: hipFuncSetAttribute failed\n"); grid = -1; return; }
        if (hipOccupancyMaxActiveBlocksPerMultiprocessor(&per_cu, (const void*)mega_fwd, NWAVES * 64, LDS_BYTES) != hipSuccess || per_cu < 1)
            fprintf(stderr, "kernel_launch: note: occupancy query reports %d workgroups per CU\n", per_cu);
        (void)hipGetLastError();
        grid = cus;
    }
    if (grid < 0) return;
    if (hipMemsetAsync((char*)d_ws + WS_CTL, 0, CTL_ZERO_BYTES, stream) != hipSuccess) { fprintf(stderr, "kernel_launch: memset failed\n"); return; }
    Args a{};
    for (int i = 0; i < 30; ++i) a.in[i] = (const float*)d_in[i];
    a.out = (float*)d_out; a.ws = (unsigned char*)d_ws;
#if MK_MULTI
    for (int k = 0; k < NPH; ++k) { a.ph_lo = k; a.ph_hi = k + 1; hipLaunchKernelGGL(mega_fwd, dim3(grid), dim3(NWAVES * 64), LDS_BYTES, stream, a); }
#else
    a.ph_lo = 0; a.ph_hi = NPH;
    hipLaunchKernelGGL(mega_fwd, dim3(grid), dim3(NWAVES * 64), LDS_BYTES, stream, a);
#endif
    const hipError_t le = hipPeekAtLastError();
    if (le != hipSuccess) fprintf(stderr, "kernel_launch: launch failed: %s\n", hipGetErrorName(le));
}
```

```cpp
#include <hip/hip_runtime.h>
#include <cstdio>
#include <cstdint>
namespace pg8 {
#define PG8_LAS __attribute__((address_space(3)))
typedef unsigned short bf16_t;
typedef short bf16x8 __attribute__((ext_vector_type(8)));
typedef float f32x4 __attribute__((ext_vector_type(4)));
typedef unsigned u32x4 __attribute__((ext_vector_type(4)));
constexpr int BM = 256, BK = 64, HALF = 128, HTB = HALF * BK * 2  , STAGE_BYTES = 8 * HTB, NXCD = 8, WGM = 8;

__host__ __device__ __forceinline__ int lds_byte(int r, int c) { const int st = (r >> 4) * 2 + (c >> 5), rr = r & 15, cc = c & 31, ob = rr * 64 + cc * 2; return st * 1024 + (ob ^ (((ob >> 9) & 1) << 5)); }
__host__ __device__ __forceinline__ void stage_rc(int b, int& R, int& C) { const int st = b / 1024, sb = b % 1024, swz = sb ^ (((sb >> 9) & 1) << 5); R = (st >> 1) * 16 + swz / 64; C = (st & 1) * 32 + (swz % 64) / 2; }
__host__ __device__ __forceinline__ int perm32(int rho) { const int n = rho >> 4, i = rho & 15; return 8 * (i >> 2) + 4 * n + (i & 3); }

struct Unit { int pm, pn; };
struct Gemm { const bf16_t* A; const bf16_t* Bt; int M, N, K; };

struct StaticOrder {
    int nM, nN, nwg, G, c;
    __host__ __device__ void init(int M, int N, int G_, int c_) { nM = M / BM; nN = N / BM; nwg = nM * nN; G = G_; c = c_; }
    __host__ __device__ bool next(int i, Unit& u) const {
        const long L = (long)i * G + c; if (L >= nwg) return false;
        int wgid = (int)L; { const int q = nwg / NXCD, r = nwg % NXCD, xcd = wgid % NXCD, off = wgid / NXCD; wgid = (xcd < r ? xcd * (q + 1) : r * (q + 1) + (xcd - r) * q) + off; }
        const int nig = WGM * nN, gid = wgid / nig, fm = gid * WGM, gsz = (nM - fm) < WGM ? (nM - fm) : WGM;
        u.pm = fm + ((wgid % nig) % gsz); u.pn = (wgid % nig) / gsz; return true;
    }
    __device__ __forceinline__ void a_ready(const Unit&) const {}
    __device__ __forceinline__ void done(const Unit&) const {}
};
__device__ __forceinline__ unsigned cvt_pk_bf16(float lo, float hi) { unsigned r; asm volatile("v_cvt_pk_bf16_f32 %0, %1, %2" : "=v"(r) : "v"(lo), "v"(hi)); return r; }
__device__ __forceinline__ float sigmoid_f(float x) { return __builtin_amdgcn_rcpf(1.0f + __builtin_amdgcn_exp2f(-1.4426950408889634f * x)); }
struct EpiPlain {
    static constexpr bool PERM = true, AFTER_DRAIN = false;
    bf16_t* O; int ldc;
    __device__ __forceinline__ void operator()(const f32x4 (&acc)[2][2][4][2], const Unit& u, int wr, int wc, int fr, int fq) const {
        const int row0 = u.pm * BM + wr * 64 + fr, col0 = u.pn * BM + wc * 32 + 8 * fq;
#pragma unroll
        for (int ai = 0; ai < 2; ++ai)
#pragma unroll
            for (int m = 0; m < 4; ++m) { bf16_t* rowp = O + (size_t)(row0 + ai * HALF + m * 16) * ldc + col0;
#pragma unroll
                for (int bj = 0; bj < 2; ++bj) { const f32x4 v0 = acc[ai][bj][m][0], v1 = acc[ai][bj][m][1];
                    u32x4 w; w.x = cvt_pk_bf16(v0[0], v0[1]); w.y = cvt_pk_bf16(v0[2], v0[3]); w.z = cvt_pk_bf16(v1[0], v1[1]); w.w = cvt_pk_bf16(v1[2], v1[3]);
                    *(u32x4*)(rowp + bj * HALF) = w; } }
    }
};
struct EpiSwiGLU {
    static constexpr bool PERM = true, AFTER_DRAIN = false;
    bf16_t* O; int ldc;
    __device__ __forceinline__ void operator()(const f32x4 (&acc)[2][2][4][2], const Unit& u, int wr, int wc, int fr, int fq) const {
        const int row0 = u.pm * BM + wr * 64 + fr, col0 = u.pn * HALF + wc * 32 + 8 * fq;
#pragma unroll
        for (int ai = 0; ai < 2; ++ai)
#pragma unroll
            for (int m = 0; m < 4; ++m) { bf16_t* rowp = O + (size_t)(row0 + ai * HALF + m * 16) * ldc + col0;
                f32x4 r0, r1;
#pragma unroll
                for (int j = 0; j < 4; ++j) { const float g0 = acc[ai][0][m][0][j], g1 = acc[ai][0][m][1][j];
                    r0[j] = g0 * sigmoid_f(g0) * acc[ai][1][m][0][j]; r1[j] = g1 * sigmoid_f(g1) * acc[ai][1][m][1][j]; }
                u32x4 w; w.x = cvt_pk_bf16(r0[0], r0[1]); w.y = cvt_pk_bf16(r0[2], r0[3]); w.z = cvt_pk_bf16(r1[0], r1[1]); w.w = cvt_pk_bf16(r1[2], r1[3]);
                *(u32x4*)rowp = w; }
    }
};
struct EpiResid {
    static constexpr bool PERM = false, AFTER_DRAIN = false;
    const float* base; float* out; int ldc; float scale;
    __device__ __forceinline__ void operator()(const f32x4 (&acc)[2][2][4][2], const Unit& u, int wr, int wc, int fr, int fq) const {
        const int row0 = u.pm * BM + wr * 64 + fr, col0 = u.pn * BM + wc * 32 + 4 * fq;
#pragma unroll
        for (int ai = 0; ai < 2; ++ai)
#pragma unroll
            for (int m = 0; m < 4; ++m) { const size_t off = (size_t)(row0 + ai * HALF + m * 16) * ldc + col0;
#pragma unroll
                for (int bj = 0; bj < 2; ++bj)
#pragma unroll
                    for (int n = 0; n < 2; ++n) { const f32x4 b = *(const f32x4*)(base + off + bj * HALF + n * 16);
                        *(f32x4*)(out + off + bj * HALF + n * 16) = b + acc[ai][bj][m][n] * scale; } }
    }
};
struct EpiInProj {
    static constexpr bool PERM = true, AFTER_DRAIN = false;
    bf16_t* P; int ldp; int np; bf16_t* G; int ldg;
    __device__ __forceinline__ void operator()(const f32x4 (&acc)[2][2][4][2], const Unit& u, int wr, int wc, int fr, int fq) const {
        const int row0 = u.pm * BM + wr * 64 + fr; const bool isg = u.pn >= np;
        bf16_t* O = isg ? G : P; const int ldc = isg ? ldg : ldp; const int col0 = (isg ? u.pn - np : u.pn) * BM + wc * 32 + 8 * fq;
#pragma unroll
        for (int ai = 0; ai < 2; ++ai)
#pragma unroll
            for (int m = 0; m < 4; ++m) { bf16_t* rowp = O + (size_t)(row0 + ai * HALF + m * 16) * ldc + col0;
#pragma unroll
                for (int bj = 0; bj < 2; ++bj) { f32x4 v0 = acc[ai][bj][m][0], v1 = acc[ai][bj][m][1];
                    if (isg) {
#pragma unroll
                        for (int j = 0; j < 4; ++j) { v0[j] = sigmoid_f(v0[j]); v1[j] = sigmoid_f(v1[j]); } }
                    u32x4 w; w.x = cvt_pk_bf16(v0[0], v0[1]); w.y = cvt_pk_bf16(v0[2], v0[3]); w.z = cvt_pk_bf16(v1[0], v1[1]); w.w = cvt_pk_bf16(v1[2], v1[3]);
                    *(u32x4*)(rowp + bj * HALF) = w; } }
    }
};
template <int BR> struct EpiGate {
    static constexpr bool PERM = true, AFTER_DRAIN = false;
    const bf16_t* G; int ldg; int gcol0; float* GS; bf16_t* GSb; int ld;
    __device__ __forceinline__ void operator()(const f32x4 (&acc)[2][2][4][2], const Unit& u, int wr, int wc, int fr, int fq) const {
        const int row0 = u.pm * BM + wr * 64 + fr, col0 = u.pn * BM + wc * 32 + 8 * fq;
#pragma unroll
        for (int ai = 0; ai < 2; ++ai)
#pragma unroll
            for (int m = 0; m < 4; ++m) { const int row = row0 + ai * HALF + m * 16;
#pragma unroll
                for (int bj = 0; bj < 2; ++bj) { const int col = col0 + bj * HALF;
                    const u32x4 gw = *(const u32x4*)(G + (size_t)row * ldg + gcol0 + col);
                    f32x4 g0, g1;
                    g0[0] = __uint_as_float(gw.x << 16); g0[1] = __uint_as_float(gw.x & 0xffff0000u); g0[2] = __uint_as_float(gw.y << 16); g0[3] = __uint_as_float(gw.y & 0xffff0000u);
                    g1[0] = __uint_as_float(gw.z << 16); g1[1] = __uint_as_float(gw.z & 0xffff0000u); g1[2] = __uint_as_float(gw.w << 16); g1[3] = __uint_as_float(gw.w & 0xffff0000u);
                    f32x4 t0 = g0 * acc[ai][bj][m][0], t1 = g1 * acc[ai][bj][m][1];
                    float* gp = GS + (size_t)row * ld + col;
                    if (BR >= 1) { t0 = t0 + *(const f32x4*)gp; t1 = t1 + *(const f32x4*)(gp + 4); }
                    if (BR <= 1) { *(f32x4*)gp = t0; *(f32x4*)(gp + 4) = t1; }
                    else { u32x4 w; w.x = cvt_pk_bf16(t0[0], t0[1]); w.y = cvt_pk_bf16(t0[2], t0[3]); w.z = cvt_pk_bf16(t1[0], t1[1]); w.w = cvt_pk_bf16(t1[2], t1[3]);
                        *(u32x4*)(GSb + (size_t)row * ld + col) = w; } } }
    }
};
template <class Epi, class Sched, bool ALIGN_EPI = false, bool SP2 = false>
__device__ __forceinline__ void gemm_phase(PG8_LAS unsigned char* lds, const Gemm g, const Sched& S, const Epi& E) {
    int tid_ = threadIdx.x; asm volatile("" : "+v"(tid_));
    const int tid = tid_, wid = __builtin_amdgcn_readfirstlane(tid >> 6), lane = tid & 63, wr = wid >> 2, wc = wid & 3, fr = lane & 15, fq = lane >> 4;
    const int K = g.K, nt = K / BK;
    unsigned voffA[2], voffB[2];
#pragma unroll
    for (int i = 0; i < 2; ++i) { int R, C; stage_rc(tid * 16 + i * 8192, R, C); const int Rb = Epi::PERM ? ((R & ~31) + perm32(R & 31)) : R;
        voffA[i] = (unsigned)(R * K + C) * 2u; voffB[i] = (unsigned)(Rb * K + C) * 2u; }
    const size_t kstep = (size_t)(BK * 2);
    const size_t hstep = (size_t)HALF * K * 2;
    const size_t tstep = 2 * hstep;
    const unsigned ldsw = (unsigned)wid * 1024u;
    const int aoff = lds_byte(wr * 64 + fr, fq * 8), boff = lds_byte(wc * 32 + fr, fq * 8);
#define PG8_SA(b, h) (((b) * 2 + (h)) * HTB)
#define PG8_SB(b, h) ((4 + (b) * 2 + (h)) * HTB)
#define PG8_STAGE(bufoff, gbase, voff) do { _Pragma("unroll") for (int _i = 0; _i < 2; ++_i) \
        __builtin_amdgcn_global_load_lds((const unsigned*)((const char*)(gbase) + (voff)[_i]), (PG8_LAS unsigned*)(lds + (bufoff) + ldsw + _i * 8192), 16, 0, 0); } while (0)
#define PG8_LDA(dst, b, h) do { _Pragma("unroll") for (int m = 0; m < 4; ++m) _Pragma("unroll") for (int k = 0; k < 2; ++k) dst[m][k] = *(const PG8_LAS bf16x8*)(lds + PG8_SA(b, h) + aoff + m * 2048 + k * 1024); } while (0)
#define PG8_LDB(dst, b, h) do { _Pragma("unroll") for (int n = 0; n < 2; ++n) _Pragma("unroll") for (int k = 0; k < 2; ++k) dst[n][k] = *(const PG8_LAS bf16x8*)(lds + PG8_SB(b, h) + boff + n * 2048 + k * 1024); } while (0)
#define PG8_MMA(ai, bj, At, Bt) do { __builtin_amdgcn_s_setprio(1); _Pragma("unroll") for (int m = 0; m < 4; ++m) _Pragma("unroll") for (int n = 0; n < 2; ++n) _Pragma("unroll") for (int k = 0; k < 2; ++k) \
        acc[ai][bj][m][n] = __builtin_amdgcn_mfma_f32_16x16x32_bf16(Bt[n][k], At[m][k], acc[ai][bj][m][n], 0, 0, 0); __builtin_amdgcn_s_setprio(0); } while (0)
#define PG8_WAIT_V(n) asm volatile("s_waitcnt vmcnt(" #n ")" ::: "memory")
#define PG8_WAIT_L(n) asm volatile("s_waitcnt lgkmcnt(" #n ")" ::: "memory")
#define PG8_BAR __builtin_amdgcn_s_barrier()
#define PG8_SCHED __builtin_amdgcn_sched_barrier(0)
    Unit cur, nxt; int ui = 0;
    if (!S.next(0, cur)) return;
    f32x4 acc[2][2][4][2];
#pragma unroll
    for (int a = 0; a < 2; ++a)
#pragma unroll
        for (int b = 0; b < 2; ++b)
#pragma unroll
            for (int m = 0; m < 4; ++m)
#pragma unroll
                for (int n = 0; n < 2; ++n) acc[a][b][m][n] = (f32x4){0.f, 0.f, 0.f, 0.f};
    bf16x8 At[4][2], B0[2][2], B1[2][2];
    const char* cA = (const char*)g.A + (size_t)cur.pm * tstep; const char* cB = (const char*)g.Bt + (size_t)cur.pn * tstep;
    S.a_ready(cur);
    if constexpr (SP2) {
        PG8_STAGE(PG8_SB(0, 0), cB, voffB); PG8_STAGE(PG8_SB(0, 1), cB + hstep, voffB); PG8_STAGE(PG8_SA(0, 0), cA, voffA); PG8_STAGE(PG8_SA(0, 1), cA + hstep, voffA);
        if (wr == 1) PG8_BAR;
        PG8_WAIT_V(2); PG8_BAR;
        PG8_STAGE(PG8_SB(1, 0), cB + kstep, voffB); PG8_STAGE(PG8_SA(1, 0), cA + kstep, voffA); PG8_STAGE(PG8_SB(1, 1), cB + hstep + kstep, voffB);
        PG8_WAIT_V(6); PG8_BAR;
    } else {
        PG8_STAGE(PG8_SB(0, 0), cB, voffB); PG8_STAGE(PG8_SA(0, 0), cA, voffA); PG8_STAGE(PG8_SB(0, 1), cB + hstep, voffB); PG8_STAGE(PG8_SA(0, 1), cA + hstep, voffA);
        if (wr == 1) PG8_BAR;
        PG8_WAIT_V(4); PG8_BAR;
        PG8_STAGE(PG8_SB(1, 0), cB + kstep, voffB); PG8_STAGE(PG8_SA(1, 0), cA + kstep, voffA); PG8_STAGE(PG8_SB(1, 1), cB + hstep + kstep, voffB);
        PG8_WAIT_V(6); PG8_BAR;
    }
    for (;;) {
        const bool has_next = S.next(ui + 1, nxt);
        const char* nA = has_next ? (const char*)g.A + (size_t)nxt.pm * tstep : cA; const char* nB = has_next ? (const char*)g.Bt + (size_t)nxt.pn * tstep : cB;
        for (int t = 0; t < nt; t += 2) {
            const bool last = (t == nt - 2);
            const char* a1 = cA + (size_t)(t + 1) * kstep;
            const char* a2 = last ? nA : cA + (size_t)(t + 2) * kstep; const char* b2 = last ? nB : cB + (size_t)(t + 2) * kstep;
            const char* a3 = a2 + kstep; const char* b3 = b2 + kstep;
            if (last && has_next) S.a_ready(nxt);
            if constexpr (SP2) {
            PG8_LDB(B0, 0, 0); PG8_LDB(B1, 0, 1); PG8_SCHED; PG8_LDA(At, 0, 0); PG8_STAGE(PG8_SA(1, 1), a1 + hstep, voffA);
            PG8_WAIT_V(8); PG8_WAIT_L(0); PG8_BAR; PG8_MMA(0, 0, At, B0); PG8_MMA(0, 1, At, B1); PG8_BAR; PG8_SCHED;
            PG8_LDA(At, 0, 1); PG8_STAGE(PG8_SB(0, 0), b2, voffB); PG8_STAGE(PG8_SB(0, 1), b2 + hstep, voffB); PG8_STAGE(PG8_SA(0, 0), a2, voffA);
            PG8_WAIT_V(8); PG8_WAIT_L(0); PG8_BAR; PG8_MMA(1, 0, At, B0); PG8_MMA(1, 1, At, B1); PG8_BAR; PG8_SCHED;
            PG8_LDB(B0, 1, 0); PG8_LDB(B1, 1, 1); PG8_SCHED; PG8_LDA(At, 1, 0); PG8_STAGE(PG8_SA(0, 1), a2 + hstep, voffA);
            PG8_WAIT_V(8); PG8_WAIT_L(0); PG8_BAR; PG8_MMA(0, 0, At, B0); PG8_MMA(0, 1, At, B1); PG8_BAR; PG8_SCHED;
            PG8_LDA(At, 1, 1); PG8_STAGE(PG8_SB(1, 0), b3, voffB); PG8_STAGE(PG8_SB(1, 1), b3 + hstep, voffB); PG8_STAGE(PG8_SA(1, 0), a3, voffA);
            PG8_WAIT_V(8); PG8_WAIT_L(0); PG8_BAR; PG8_MMA(1, 0, At, B0); PG8_MMA(1, 1, At, B1); PG8_BAR; PG8_SCHED;
            } else {
            PG8_LDB(B0, 0, 0); PG8_SCHED; PG8_LDA(At, 0, 0); PG8_STAGE(PG8_SA(1, 1), a1 + hstep, voffA);
            PG8_WAIT_L(8); PG8_BAR; PG8_WAIT_L(0); PG8_MMA(0, 0, At, B0); PG8_BAR; PG8_SCHED;
            PG8_LDB(B1, 0, 1); PG8_STAGE(PG8_SB(0, 0), b2, voffB);
            PG8_BAR; PG8_WAIT_L(0); PG8_MMA(0, 1, At, B1); PG8_BAR;
            PG8_LDA(At, 0, 1); PG8_STAGE(PG8_SA(0, 0), a2, voffA);
            PG8_BAR; PG8_WAIT_L(0); PG8_MMA(1, 0, At, B0); PG8_BAR; PG8_SCHED;
            PG8_STAGE(PG8_SB(0, 1), b2 + hstep, voffB);
            PG8_WAIT_V(6); PG8_BAR; PG8_MMA(1, 1, At, B1); PG8_BAR;
            PG8_LDB(B0, 1, 0); PG8_SCHED; PG8_LDA(At, 1, 0); PG8_STAGE(PG8_SA(0, 1), a2 + hstep, voffA);
            PG8_WAIT_L(8); PG8_BAR; PG8_WAIT_L(0); PG8_MMA(0, 0, At, B0); PG8_BAR; PG8_SCHED;
            PG8_LDB(B1, 1, 1); PG8_STAGE(PG8_SB(1, 0), b3, voffB);
            PG8_BAR; PG8_WAIT_L(0); PG8_MMA(0, 1, At, B1); PG8_BAR;
            PG8_LDA(At, 1, 1); PG8_STAGE(PG8_SA(1, 0), a3, voffA);
            PG8_BAR; PG8_WAIT_L(0); PG8_MMA(1, 0, At, B0); PG8_BAR; PG8_SCHED;
            PG8_STAGE(PG8_SB(1, 1), b3 + hstep, voffB);
            PG8_WAIT_V(6); PG8_BAR; PG8_MMA(1, 1, At, B1); PG8_BAR;
            }
        }
        if constexpr (ALIGN_EPI) { if (wr == 0) PG8_BAR; }
        if constexpr (!Epi::AFTER_DRAIN) { E(acc, cur, wr, wc, fr, fq); S.done(cur); }
        if (!has_next) break;
#pragma unroll
        for (int a = 0; a < 2; ++a)
#pragma unroll
            for (int b = 0; b < 2; ++b)
#pragma unroll
                for (int m = 0; m < 4; ++m)
#pragma unroll
                    for (int n = 0; n < 2; ++n) acc[a][b][m][n] = (f32x4){0.f, 0.f, 0.f, 0.f};
        cur = nxt; cA = nA; cB = nB; ++ui;
        if constexpr (ALIGN_EPI) { if (wr == 1) PG8_BAR; }
    }
    PG8_WAIT_V(0);
    if constexpr (!ALIGN_EPI) { if (wr == 0) PG8_BAR; }
    PG8_BAR;
    if constexpr (Epi::AFTER_DRAIN) { E.fused(acc, cur, wr, wc, fr, fq, lds, wid, lane); S.done(cur); }
#undef PG8_SA
#undef PG8_SB
#undef PG8_STAGE
#undef PG8_LDA
#undef PG8_LDB
#undef PG8_MMA
#undef PG8_WAIT_V
#undef PG8_WAIT_L
#undef PG8_BAR
#undef PG8_SCHED
}
}
constexpr int NWAVES = 8;
constexpr int BATCH = 2, SEQ = 8192, DM = 4096, DFF = 11008, MTOK = BATCH * SEQ;
constexpr int MEMLEN = 256, MROWS = BATCH * MEMLEN;
constexpr float EPS = 1e-6f;
constexpr int NPC = 9984, NPT = NPC / 256;
constexpr int PC_CQ = 0, PC_CKV = 1536, PC_QD = 2048, PC_KD = 3584, PC_VD = 5120, PC_QI = 6656, PC_QM = 8704, PC_KR = 9728, PC_KI = 9792, PC_WI = 9856;
constexpr int NGC = 3 * DM;
constexpr int NIN = NPC + NGC;
constexpr int NGU = 2 * DFF;
constexpr float LOG2E = 1.4426950408889634f;
constexpr float QS_MLA = 0.07216878364870322f * LOG2E;
constexpr float QS_DSA = 0.08838834764831845f * LOG2E;
constexpr float QS_MEM = 0.0625f * LOG2E;
constexpr float LOG2_THETA = 18.931568569324174f;

constexpr size_t MiB = 1u << 20;
constexpr size_t WS_CTL = 0, CTL_ZERO_BYTES = 1 * MiB;
constexpr size_t WS_WGU = 1 * MiB;
constexpr size_t WS_WD = 173 * MiB;
constexpr size_t WS_SC = 1 * MiB;
constexpr size_t WS_WIN = 259 * MiB;
constexpr size_t WS_WUQ = 433 * MiB, WS_WUKV = 440 * MiB, WS_WMKV = 443 * MiB, WS_WOMLA = 459 * MiB, WS_WODSA = 471 * MiB, WS_WOMEM = 483 * MiB, WS_WOUT = 491 * MiB;
constexpr size_t WS_A = 523 * MiB;
constexpr size_t WS_BIG = 651 * MiB;
constexpr size_t WS_HMID = WS_BIG;
constexpr size_t WS_G = WS_BIG;
constexpr size_t WS_P = 1035 * MiB;
constexpr size_t WS_QMLARAW = 1035 * MiB, WS_KVRAW = 1107 * MiB, WS_QMLA = 1203 * MiB, WS_KMLA = 1275 * MiB;
constexpr size_t WS_GS = 1035 * MiB;
constexpr size_t WS_CQN = 1347 * MiB, WS_CKVN = 1395 * MiB, WS_QD = 1411 * MiB, WS_KD = 1459 * MiB, WS_VD = 1507 * MiB, WS_QI = 1555 * MiB, WS_KI = 1619 * MiB, WS_WI = 1621 * MiB, WS_KR = 1623 * MiB, WS_QM = 1625 * MiB;
constexpr size_t WS_YMLA = 1657 * MiB, WS_YDSA = 1705 * MiB, WS_YMEM = 1753 * MiB, WS_BM = 1785 * MiB, WS_MEMN = 1801 * MiB, WS_MKVRAW = 1805 * MiB, WS_MEMK = 1807 * MiB, WS_END = 1808 * MiB;
constexpr size_t SC_BATCH = (size_t)4096 * 8256;
static_assert(WS_SC + 2 * SC_BATCH * 4 <= WS_WIN, "scores fit the FFN weight region");
static_assert(WS_WGU + (size_t)NGU * DM * 2 <= WS_WD && WS_WD + (size_t)DM * DFF * 2 <= WS_WIN, "FFN weights");
static_assert(WS_WIN + (size_t)NIN * DM * 2 <= WS_WUQ, "win");
static_assert(WS_HMID + (size_t)MTOK * DFF * 2 <= WS_P && WS_G + (size_t)MTOK * NGC * 2 <= WS_P && WS_P + (size_t)MTOK * NPC * 2 <= WS_CQN, "big region");
static_assert(WS_GS + (size_t)MTOK * DM * 4 <= WS_CQN, "GS");
constexpr int CW_BAR = 4096, CW_QUEUE = 8192;

constexpr int RING_BYTES = 131072, MISC_OFF = RING_BYTES, LDS_BYTES = 147456;

#define GAS __attribute__((address_space(1)))
#define LAS __attribute__((address_space(3)))
#define DI __device__ __forceinline__
typedef unsigned short bf16;
typedef unsigned v4u __attribute__((ext_vector_type(4)));
typedef unsigned v2u __attribute__((ext_vector_type(2)));
typedef float f32x4 __attribute__((ext_vector_type(4)));
typedef float f32x16 __attribute__((ext_vector_type(16)));
typedef short bf16x8 __attribute__((ext_vector_type(8)));
typedef short s16x4 __attribute__((ext_vector_type(4)));
#define LDS_WAIT() asm volatile("s_waitcnt lgkmcnt(0)" ::: "memory")
DI float bf2f(bf16 v) { return __uint_as_float(((unsigned)v) << 16); }
DI unsigned f2bf(float f) { unsigned u = __float_as_uint(f); return (u + 0x7fffu + ((u >> 16) & 1u)) >> 16; }
DI unsigned pk2(float lo, float hi) { return f2bf(lo) | (f2bf(hi) << 16); }
DI float wave_sum(float v) {
#pragma unroll
    for (int o = 1; o < 64; o <<= 1) v += __shfl_xor(v, o);
    return v;
}
DI void sincos_rev(float ang, float& s, float& c) {
    double rev = (double)ang * 0.15915494309189535; rev -= __builtin_rint(rev);
    const float fr = (float)rev; s = __builtin_amdgcn_sinf(fr); c = __builtin_amdgcn_cosf(fr);
}
DI float inv_freq(int i, int half) { return __builtin_amdgcn_exp2f(-(float)i * (LOG2_THETA / (float)half)); }
#define XB_TMO      128
#define XB_XCNT(j)  (256  + 64 * (j))
#define XB_XSUB(j)  (1280 + 64 * (j))
#define XB_XGEN(j)  (2304 + 64 * (j))
#define XB_TOP      3328
#define XB_TOPGEN   3392
#define XCD_BAR_WORDS 3456
#define XB_SPIN_CAP (1u << 18)

__device__ __forceinline__ unsigned xb_ld(unsigned* p)              { return __hip_atomic_load(p, __ATOMIC_RELAXED, __HIP_MEMORY_SCOPE_AGENT); }
__device__ __forceinline__ unsigned xb_add(unsigned* p, unsigned v) { return __hip_atomic_fetch_add(p, v, __ATOMIC_RELAXED, __HIP_MEMORY_SCOPE_AGENT); }
__device__ __forceinline__ unsigned xb_xcc_id() { return (unsigned)__builtin_amdgcn_s_getreg((3 << 11) | 20) & 0xFu; }
#define XB_SPIN(cond, bar) do { unsigned _sp = 0; while (cond) { __builtin_amdgcn_s_sleep(1); \
    if ((++_sp & 255u) == 0u) { if (xb_ld(&(bar)[XB_TMO])) break; if (_sp > XB_SPIN_CAP) { atomicAdd(&(bar)[XB_TMO], 1u); break; } } } } while (0)

struct XcdBarrier {
    unsigned* bar; unsigned x;
    volatile LAS unsigned* st;
};

__device__ __forceinline__ XcdBarrier xcd_barrier_post(unsigned* bar, volatile LAS unsigned* st) {
    XcdBarrier b; b.bar = bar; b.x = xb_xcc_id(); b.st = st;
    if (threadIdx.x == 0) (void)xb_add(&bar[XB_XCNT(b.x)], 1u);
    return b;
}
__device__ __forceinline__ void xcd_barrier_complete(unsigned* bar, unsigned x, unsigned& nloc, unsigned& nx) {
    const unsigned G = gridDim.x * gridDim.y * gridDim.z;
    unsigned sum, cnt, mine, sp = 0u;
    for (;;) {
        sum = 0u; cnt = 0u; mine = 0u;
#pragma unroll
        for (unsigned j = 0; j < 16; ++j) { const unsigned c = xb_ld(&bar[XB_XCNT(j)]); sum += c; cnt += (c > 0u) ? 1u : 0u; mine = (j == x) ? c : mine; }
        if (sum == G) break;
        __builtin_amdgcn_s_sleep(1);
        if ((++sp & 255u) == 0u) { if (xb_ld(&bar[XB_TMO])) break; if (sp > XB_SPIN_CAP) { atomicAdd(&bar[XB_TMO], 1u); break; } }
    }
    nloc = mine > 0u ? mine : 1u; nx = cnt > 0u ? cnt : 1u;
}

__device__ __forceinline__ void xcd_barrier(const XcdBarrier& b) {
    asm volatile("s_waitcnt vmcnt(0)" ::: "memory");
    __syncthreads();
    if (threadIdx.x == 0) {
        unsigned* bar = b.bar;
        __builtin_amdgcn_s_waitcnt(0);
        unsigned nloc = b.st[0], nx = b.st[1];
        if (nloc == 0u) { xcd_barrier_complete(bar, b.x, nloc, nx); b.st[0] = nloc; b.st[1] = nx; }
        const unsigned old = xb_add(&bar[XB_XSUB(b.x)], 1u);
        const unsigned gen = old / nloc;
        if (old + 1u == (gen + 1u) * nloc) {
            __builtin_amdgcn_fence(__ATOMIC_RELEASE, "agent");
            asm volatile("s_waitcnt vmcnt(0)" ::: "memory");
            const unsigned og = xb_add(&bar[XB_TOP], 1u);
            const unsigned tg = og / nx;
            if (og + 1u == (tg + 1u) * nx) xb_add(&bar[XB_TOPGEN], 1u);
            else XB_SPIN(xb_ld(&bar[XB_TOPGEN]) == tg, bar);
            __builtin_amdgcn_fence(__ATOMIC_ACQUIRE, "agent");
            xb_add(&bar[XB_XGEN(b.x)], 1u);
            asm volatile("s_waitcnt vmcnt(0)" ::: "memory");
        } else {
            XB_SPIN(xb_ld(&bar[XB_XGEN(b.x)]) == gen, bar);
            __builtin_amdgcn_fence(__ATOMIC_ACQUIRE, "agent");
            asm volatile("s_waitcnt vmcnt(0)" ::: "memory");
        }
    }
    __syncthreads();
}
struct Ctx {
    LAS unsigned char* lds;
    int tid, lane, wave, G, gw, NGW;
};
DI Ctx make_ctx(LAS unsigned char* lds) {
    int t = threadIdx.x; asm volatile("" : "+v"(t));
    Ctx C; C.lds = lds; C.tid = t; C.lane = t & 63; C.wave = __builtin_amdgcn_readfirstlane(t >> 6);
    C.G = gridDim.x; C.gw = blockIdx.x * 8 + C.wave; C.NGW = C.G * 8; return C;
}

DI void conv_item(const float* W, int ldw, int col0, int k0, bf16* WT, int K, int drow0, bool zero, LAS float* scr, int lane) {
#pragma unroll 8
    for (int i = 0; i < 32; ++i) { const int kk = 2 * i + (lane >> 5); scr[kk * 33 + (lane & 31)] = zero ? 0.f : W[(size_t)(k0 + kk) * ldw + col0 + (lane & 31)]; }
    LDS_WAIT(); asm volatile("" ::: "memory");
    const int c = lane & 7;
#pragma unroll
    for (int j = 0; j < 4; ++j) { const int n = (lane >> 3) + 8 * j; const LAS float* s = scr + (8 * c) * 33 + n;
        v4u o; o.x = pk2(s[0 * 33], s[1 * 33]); o.y = pk2(s[2 * 33], s[3 * 33]); o.z = pk2(s[4 * 33], s[5 * 33]); o.w = pk2(s[6 * 33], s[7 * 33]);
        *(GAS v4u*)(WT + (size_t)(drow0 + n) * K + k0 + 8 * c) = o; }
    LDS_WAIT(); asm volatile("" ::: "memory");
}
DI int inproj_src(int d) {
    if (d < 2048) return d;
    if (d < 8704) return d + 64;
    if (d < 9728) return d + 160;
    if (d < 9792) return d - 7680;
    if (d < 9888) return d - 1024;
    return -1;
}
DI void conv_ffn(const Ctx& C, const float* wg, const float* wu, const float* wd, bf16* WGUt, bf16* WDt) {
    LAS float* scr = (LAS float*)(C.lds + C.wave * 16384);
    constexpr int I_GU = (DM / 64) * (NGU / 32), I_D = (DFF / 64) * (DM / 32);
    for (int it = C.gw; it < I_GU + I_D; it += C.NGW) {
        if (it < I_GU) { const int nblk = NGU / 32, kb = it / nblk, nb = it % nblk, n0 = nb * 32, pn = n0 >> 8, bj = (n0 >> 7) & 1, c = n0 & 127;
            conv_item(bj ? wu : wg, DFF, 128 * pn + c, 64 * kb, WGUt, DM, n0, false, scr, C.lane); }
        else { const int r = it - I_GU, nblk = DM / 32, kb = r / nblk, nb = r % nblk;
            conv_item(wd, DM, 32 * nb, 64 * kb, WDt, DFF, 32 * nb, false, scr, C.lane); }
    }
}
DI void conv_plain(const Ctx& C, const float* w, int K, int N, bf16* wt, int& base, int total_dummy) { (void)base; (void)total_dummy;
    LAS float* scr = (LAS float*)(C.lds + C.wave * 16384);
    const int nblk = N / 32, items = (K / 64) * nblk;
    for (int it = C.gw; it < items; it += C.NGW) { const int kb = it / nblk, nb = it % nblk; conv_item(w, N, 32 * nb, 64 * kb, wt, K, 32 * nb, false, scr, C.lane); }
}
DI void conv_win(const Ctx& C, const float* w_in, const float* w_gate, bf16* wt) {
    LAS float* scr = (LAS float*)(C.lds + C.wave * 16384);
    constexpr int nblk = NIN / 32, items = (DM / 64) * nblk;
    for (int it = C.gw; it < items; it += C.NGW) { const int kb = it / nblk, nb = it % nblk, n0 = 32 * nb;
        if (n0 < NPC) { const int sc = inproj_src(n0); conv_item(w_in, 9888, sc < 0 ? 0 : sc, 64 * kb, wt, DM, n0, sc < 0, scr, C.lane); }
        else { const int gi = n0 - NPC, br = gi / DM, col = gi % DM; conv_item(w_gate + (size_t)br * DM * DM, DM, col, 64 * kb, wt, DM, n0, false, scr, C.lane); } }
}
DI void rms_row4096(const float* xrow, const float* g, bf16* orow, int lane) {
    const GAS f32x4* xr = (const GAS f32x4*)xrow + lane; const GAS f32x4* gr = (const GAS f32x4*)g + lane;
    f32x4 v[16]; float s = 0.f;
#pragma unroll
    for (int j = 0; j < 16; ++j) { v[j] = xr[64 * j]; s += (v[j].x * v[j].x + v[j].y * v[j].y) + (v[j].z * v[j].z + v[j].w * v[j].w); }
    const float rstd = rsqrtf(wave_sum(s) * (1.f / 4096.f) + EPS);
    GAS v2u* o8 = (GAS v2u*)orow + lane;
#pragma unroll
    for (int j = 0; j < 16; ++j) { const f32x4 gg = gr[64 * j]; v2u o; o.x = pk2(v[j].x * rstd * gg.x, v[j].y * rstd * gg.y); o.y = pk2(v[j].z * rstd * gg.z, v[j].w * rstd * gg.w); o8[64 * j] = o; }
}
DI void rms_rows(const Ctx& C, const float* x, const float* g, bf16* o, int rows) {
    for (int m = C.gw; m < rows; m += C.NGW) rms_row4096(x + (size_t)m * DM, g, o + (size_t)m * DM, C.lane);
}

struct PP1 { const bf16* P; const int* pos; const float *g_cq, *g_ckv, *g_qd, *g_kd, *g_qm;
             bf16 *CQn, *CKVn, *Qd, *Kd, *Vd, *Qi, *Ki, *Kr, *Qm; float* Wi; };
DI void pp1_token(const PP1& A, int t, int lane) {
    const bf16* pr = A.P + (size_t)t * NPC;
    const float pos = (float)A.pos[t];
    float sn_d, cs_d, sn_i, cs_i;
    sincos_rev(pos * inv_freq(lane & 15, 16), sn_d, cs_d);
    sincos_rev(pos * inv_freq(lane & 7, 8), sn_i, cs_i);
    {
        float x[24]; float ss = 0.f;
#pragma unroll
        for (int k = 0; k < 24; ++k) { x[k] = bf2f(pr[PC_CQ + lane + 64 * k]); ss += x[k] * x[k]; }
        const float rstd = rsqrtf(wave_sum(ss) * (1.f / 1536.f) + EPS);
#pragma unroll
        for (int k = 0; k < 24; ++k) A.CQn[(size_t)t * 1536 + lane + 64 * k] = (bf16)f2bf(x[k] * rstd * A.g_cq[lane + 64 * k]);
    }
    {
        float x[8]; float ss = 0.f;
#pragma unroll
        for (int k = 0; k < 8; ++k) { x[k] = bf2f(pr[PC_CKV + lane + 64 * k]); ss += x[k] * x[k]; }
        const float rstd = rsqrtf(wave_sum(ss) * (1.f / 512.f) + EPS);
#pragma unroll
        for (int k = 0; k < 8; ++k) A.CKVn[(size_t)t * 512 + lane + 64 * k] = (bf16)f2bf(x[k] * rstd * A.g_ckv[lane + 64 * k]);
    }
#pragma unroll 1
    for (int qk = 0; qk < 2; ++qk) {
        const int pc = qk ? PC_KD : PC_QD; const float* g = qk ? A.g_kd : A.g_qd; bf16* O = qk ? A.Kd : A.Qd; const float sc = qk ? 1.0f : QS_DSA;
        const float g0 = g[lane], g1 = g[64 + lane];
#pragma unroll 4
        for (int h = 0; h < 12; ++h) {
            const float x0 = bf2f(pr[pc + h * 128 + lane]), x1 = bf2f(pr[pc + h * 128 + 64 + lane]);
            const float rstd = rsqrtf(wave_sum(x0 * x0 + x1 * x1) * (1.f / 128.f) + EPS);
            float y0 = x0 * rstd * g0; const float y1 = x1 * rstd * g1;
            const float pr0 = __shfl_xor(y0, 16);
            if (lane < 16) y0 = y0 * cs_d - pr0 * sn_d; else if (lane < 32) y0 = y0 * cs_d + pr0 * sn_d;
            O[(size_t)t * 1536 + h * 128 + lane] = (bf16)f2bf(y0 * sc); O[(size_t)t * 1536 + h * 128 + 64 + lane] = (bf16)f2bf(y1 * sc);
        }
    }
#pragma unroll
    for (int k = 0; k < 24; ++k) A.Vd[(size_t)t * 1536 + lane + 64 * k] = pr[PC_VD + lane + 64 * k];
#pragma unroll 4
    for (int h = 0; h < 32; ++h) {
        float x = bf2f(pr[PC_QI + h * 64 + lane]); const float px = __shfl_xor(x, 8);
        if (lane < 8) x = x * cs_i - px * sn_i; else if (lane < 16) x = x * cs_i + px * sn_i;
        A.Qi[(size_t)t * 2048 + h * 64 + lane] = (bf16)f2bf(x);
    }
    {
        float x = bf2f(pr[PC_KI + lane]); const float px = __shfl_xor(x, 8);
        if (lane < 8) x = x * cs_i - px * sn_i; else if (lane < 16) x = x * cs_i + px * sn_i;
        A.Ki[(size_t)t * 64 + lane] = (bf16)f2bf(x);
        if (lane < 32) A.Wi[(size_t)t * 32 + lane] = bf2f(pr[PC_WI + lane]);
        A.Kr[(size_t)t * 64 + lane] = pr[PC_KR + lane];
    }
#pragma unroll
    for (int h = 0; h < 4; ++h) {
        float x[4]; float ss = 0.f;
#pragma unroll
        for (int k = 0; k < 4; ++k) { x[k] = bf2f(pr[PC_QM + h * 256 + lane + 64 * k]); ss += x[k] * x[k]; }
        const float rstd = rsqrtf(wave_sum(ss) * (1.f / 256.f) + EPS) * QS_MEM;
#pragma unroll
        for (int k = 0; k < 4; ++k) A.Qm[(size_t)t * 1024 + h * 256 + lane + 64 * k] = (bf16)f2bf(x[k] * rstd * A.g_qm[lane + 64 * k]);
    }
}
struct PP2 { const bf16 *QmlaRaw, *KVraw, *Kr, *MKVraw; const int* pos; const float *g_q, *g_k, *g_km; bf16 *Qmla, *Kmla, *MemK; };
DI void pp2_token(const PP2& A, int t, int lane) {
    const float pos = (float)A.pos[t];
    float sn, cs; sincos_rev(pos * inv_freq(lane & 31, 32), sn, cs);
    const float gq0 = A.g_q[lane], gq1 = A.g_q[64 + lane], gq2 = A.g_q[128 + lane], gk0 = A.g_k[lane], gk1 = A.g_k[64 + lane], gk2 = A.g_k[128 + lane];
    const float kr = bf2f(A.Kr[(size_t)t * 64 + lane]);
#pragma unroll 2
    for (int h = 0; h < 12; ++h) {
        {   const bf16* q = A.QmlaRaw + (size_t)t * 2304 + h * 192;
            const float x0 = bf2f(q[lane]), x1 = bf2f(q[64 + lane]), x2 = bf2f(q[128 + lane]);
            const float rstd = rsqrtf(wave_sum(x0 * x0 + x1 * x1 + x2 * x2) * (1.f / 192.f) + EPS);
            float y0 = x0 * rstd * gq0; const float y1 = x1 * rstd * gq1, y2 = x2 * rstd * gq2;
            const float p0 = __shfl_xor(y0, 32); y0 = (lane < 32) ? y0 * cs - p0 * sn : y0 * cs + p0 * sn;
            bf16* o = A.Qmla + (size_t)t * 2304 + h * 192;
            o[lane] = (bf16)f2bf(y0 * QS_MLA); o[64 + lane] = (bf16)f2bf(y1 * QS_MLA); o[128 + lane] = (bf16)f2bf(y2 * QS_MLA); }
        {   const bf16* kv = A.KVraw + (size_t)t * 3072 + h * 256;
            const float x0 = kr, x1 = bf2f(kv[lane]), x2 = bf2f(kv[64 + lane]);
            const float rstd = rsqrtf(wave_sum(x0 * x0 + x1 * x1 + x2 * x2) * (1.f / 192.f) + EPS);
            float y0 = x0 * rstd * gk0; const float y1 = x1 * rstd * gk1, y2 = x2 * rstd * gk2;
            const float p0 = __shfl_xor(y0, 32); y0 = (lane < 32) ? y0 * cs - p0 * sn : y0 * cs + p0 * sn;
            bf16* o = A.Kmla + (size_t)t * 2304 + h * 192;
            o[lane] = (bf16)f2bf(y0); o[64 + lane] = (bf16)f2bf(y1); o[128 + lane] = (bf16)f2bf(y2); }
    }
}
DI void pp2_memrow(const PP2& A, int r, int lane) {
#pragma unroll
    for (int h = 0; h < 4; ++h) {
        float x[4]; float ss = 0.f;
#pragma unroll
        for (int k = 0; k < 4; ++k) { x[k] = bf2f(A.MKVraw[(size_t)r * 2048 + h * 256 + lane + 64 * k]); ss += x[k] * x[k]; }
        const float rstd = rsqrtf(wave_sum(ss) * (1.f / 256.f) + EPS);
#pragma unroll
        for (int k = 0; k < 4; ++k) A.MemK[(size_t)r * 1024 + h * 256 + lane + 64 * k] = (bf16)f2bf(x[k] * rstd * A.g_km[lane + 64 * k]);
    }
}

#define MFMA32(a, b, c) __builtin_amdgcn_mfma_f32_32x32x16_bf16((a), (b), (c), 0, 0, 0)
DI float half_swap_sum(float v) { auto rr = __builtin_amdgcn_permlane32_swap(__float_as_uint(v), __float_as_uint(v), false, false); return __uint_as_float(rr[0]) + __uint_as_float(rr[1]); }
DI float half_swap_max(float v) { auto rr = __builtin_amdgcn_permlane32_swap(__float_as_uint(v), __float_as_uint(v), false, false); return fmaxf(__uint_as_float(rr[0]), __uint_as_float(rr[1])); }
DI size_t sc_block_off(int b, int bi) { return (size_t)b * SC_BATCH + (size_t)4096 * (size_t)(bi * (bi + 1) / 2); }
DI void idx_item(int p, const bf16* Qi, const bf16* Ki, const float* Wi, float* Sc, int wave, int lane) {
    const int b = p >> 7, r = p & 127, hs = r & 1, k = r >> 1, r32 = lane & 31, hi = lane >> 5;
#pragma unroll 1
    for (int which = 0; which < 2; ++which) {
        const int bi = which ? 127 - k : k, nt32 = (bi + 1) * 2, ncol = (bi + 1) * 64;
        float* scb = Sc + sc_block_off(b, bi);
#pragma unroll 1
        for (int pass = 0; pass < 2; ++pass) {
            const int qa = 32 * hs + 4 * wave + 2 * pass, ta = b * SEQ + bi * 64 + qa;
            bf16x8 A0[4], A1[4]; f32x4 w0[4], w1[4];
#pragma unroll
            for (int d0 = 0; d0 < 4; ++d0) { A0[d0] = *(const bf16x8*)(Qi + (size_t)ta * 2048 + r32 * 64 + d0 * 16 + hi * 8); A1[d0] = *(const bf16x8*)(Qi + (size_t)(ta + 1) * 2048 + r32 * 64 + d0 * 16 + hi * 8); }
#pragma unroll
            for (int g = 0; g < 4; ++g) { w0[g] = *(const f32x4*)(Wi + (size_t)ta * 32 + 8 * g + 4 * hi); w1[g] = *(const f32x4*)(Wi + (size_t)(ta + 1) * 32 + 8 * g + 4 * hi); }
            float* o0 = scb + (size_t)qa * ncol + r32; float* o1 = o0 + ncol;
#pragma unroll 2
            for (int kt = 0; kt < nt32; ++kt) {
                const bf16* kp = Ki + (size_t)(b * SEQ + kt * 32 + r32) * 64 + hi * 8;
                bf16x8 B[4];
#pragma unroll
                for (int d0 = 0; d0 < 4; ++d0) B[d0] = *(const bf16x8*)(kp + d0 * 16);
                f32x16 c0, c1;
#pragma unroll
                for (int i = 0; i < 16; ++i) { c0[i] = 0.f; c1[i] = 0.f; }
#pragma unroll
                for (int d0 = 0; d0 < 4; ++d0) { c0 = MFMA32(A0[d0], B[d0], c0); c1 = MFMA32(A1[d0], B[d0], c1); }
                float s0 = 0.f, s1 = 0.f;
#pragma unroll
                for (int i = 0; i < 16; ++i) { s0 = fmaf(w0[i >> 2][i & 3], fmaxf(c0[i], 0.f), s0); s1 = fmaf(w1[i >> 2][i & 3], fmaxf(c1[i], 0.f), s1); }
                s0 = half_swap_sum(s0); s1 = half_swap_sum(s1);
                if (hi == 0) { o0[kt * 32] = s0; o1[kt * 32] = s1; }
            }
        }
    }
}
DI void select_row(const float* Sc, unsigned long long* BM64, int t, int lane, LAS unsigned long long* scr) {
    const int b = t / SEQ, s = t % SEQ, bi = s >> 6, n = (bi + 1) * 64;
    const float* row = Sc + sc_block_off(b, bi) + (size_t)(s & 63) * n;
    unsigned long long* out = BM64 + (size_t)t * 128;
    if (n <= 256) {
        const unsigned long long w0 = (lane < n / 64) ? ~0ull : 0ull;
        out[lane] = w0; out[64 + lane] = 0ull; return;
    }
    unsigned key[128];
#pragma unroll
    for (int i = 0; i < 128; ++i) { unsigned kk = 0u; if (64 * i < n) { const unsigned u = __float_as_uint(row[64 * i + lane]); kk = (u & 0x80000000u) ? ~u : (u | 0x80000000u); } key[i] = kk; }
    unsigned prefix = 0u;
#pragma unroll 1
    for (int bit = 31; bit >= 0; --bit) {
        const unsigned cand = prefix | (1u << bit); int cnt = 0;
#pragma unroll
        for (int i = 0; i < 128; ++i) cnt += (key[i] >= cand) ? 1 : 0;
#pragma unroll
        for (int o = 1; o < 64; o <<= 1) cnt += __shfl_xor(cnt, o);
        if (cnt >= 256) prefix = cand;
    }
    int cgt = 0;
#pragma unroll
    for (int i = 0; i < 128; ++i) cgt += (key[i] > prefix) ? 1 : 0;
#pragma unroll
    for (int o = 1; o < 64; o <<= 1) cgt += __shfl_xor(cgt, o);
    const int need = __builtin_amdgcn_readfirstlane(256 - cgt);
    int run = 0;
#pragma unroll
    for (int i = 0; i < 128; ++i) {
        const bool gt = key[i] > prefix, eq = key[i] == prefix;
        const unsigned long long eqb = __ballot(eq);
        const int rank = run + (int)__builtin_amdgcn_mbcnt_hi((unsigned)(eqb >> 32), __builtin_amdgcn_mbcnt_lo((unsigned)eqb, 0u));
        const unsigned long long take = __ballot(gt || (eq && rank < need));
        run += __popcll(eqb);
        if (lane == 0) scr[i] = take;
        if ((i & 7) == 7) __builtin_amdgcn_sched_barrier(0);
    }
    const unsigned long long mine0 = scr[lane], mine1 = scr[64 + lane];
    out[lane] = mine0; out[64 + lane] = mine1;
}
typedef short v4i16_t __attribute__((ext_vector_type(4)));
DI s16x4 vtr(const LAS unsigned char* p) { return __builtin_bit_cast(s16x4, __builtin_amdgcn_ds_read_tr16_b64_v4i16((LAS v4i16_t*)p)); }
DI unsigned cvtpk(float lo, float hi) { unsigned r; asm volatile("v_cvt_pk_bf16_f32 %0, %1, %2" : "=v"(r) : "v"(lo), "v"(hi)); return r; }
constexpr int VSTR = 320;
template <int DK> struct AttnLds { static constexpr int KSTR = DK * 2 + 16, KB = 64 * KSTR, VB = 64 * VSTR, K0 = 0, V0 = 2 * KB, TOTAL = 2 * KB + 2 * VB; };
static_assert(AttnLds<256>::TOTAL <= RING_BYTES, "attention LDS");

template <int DK, int MODE>
DI void attn_unit(LAS unsigned char* lds, const bf16* Qp, int LDQ, const bf16* Kp, int LDK, const bf16* Vp, int LDV, bf16* Op, int LDO, int NT, int chunk0, const unsigned* BMrow) {
    typedef AttnLds<DK> L;
    constexpr int ND = DK / 16, KCH = DK / 8, NKC = DK / 64;
    int tid_ = threadIdx.x; asm volatile("" : "+v"(tid_));
    const int tid = tid_, wid = __builtin_amdgcn_readfirstlane(tid >> 6), lane = tid & 63, r32 = lane & 31, hi = lane >> 5;
    const int mychunk = chunk0 + (wid >> 1);
    constexpr bool QLOOP = (DK > 192);
    bf16x8 qr[ND];
    const bf16* qw = Qp + (size_t)(wid * 32 + r32) * LDQ + hi * 8;
    if (!QLOOP) {
#pragma unroll
        for (int d0 = 0; d0 < ND; ++d0) qr[d0] = *(const bf16x8*)(qw + d0 * 16); }
    const unsigned* bmw = (MODE == 1) ? BMrow + (size_t)(wid * 32 + r32) * 256 : nullptr;
    int krow_[NKC], kcc_[NKC];
#pragma unroll
    for (int i = 0; i < NKC; ++i) { const int c = tid + 512 * i; krow_[i] = c / KCH; kcc_[i] = c % KCH; }
    const int vrow0 = tid >> 4, vcc = tid & 15;
    v4u kst[NKC], vst[2];
#define ATT_LOAD(j) do { const int key0_ = (j) * 64; \
        _Pragma("unroll") for (int i_ = 0; i_ < NKC; ++i_) kst[i_] = *(const v4u*)(Kp + (size_t)(key0_ + krow_[i_]) * LDK + kcc_[i_] * 8); \
        vst[0] = *(const v4u*)(Vp + (size_t)(key0_ + vrow0) * LDV + vcc * 8); vst[1] = *(const v4u*)(Vp + (size_t)(key0_ + 32 + vrow0) * LDV + vcc * 8); } while (0)
#define ATT_WRITE(buf) do { \
        _Pragma("unroll") for (int i_ = 0; i_ < NKC; ++i_) *(LAS v4u*)(lds + L::K0 + (buf) * L::KB + krow_[i_] * L::KSTR + kcc_[i_] * 16) = kst[i_]; \
        *(LAS v4u*)(lds + L::V0 + (buf) * L::VB + vrow0 * VSTR + vcc * 16) = vst[0]; *(LAS v4u*)(lds + L::V0 + (buf) * L::VB + (32 + vrow0) * VSTR + vcc * 16) = vst[1]; } while (0)
    float m_run = -1e30f, l_run = 0.f;
    f32x16 o[4];
#pragma unroll
    for (int d = 0; d < 4; ++d)
#pragma unroll
        for (int i = 0; i < 16; ++i) o[d][i] = 0.f;
    const int kbase = r32 * L::KSTR + hi * 16;
    const int q4 = (lane >> 2) & 3, p4 = lane & 3, blk = (lane >> 4) & 1;
    const int vbase = (4 * hi + q4) * VSTR + blk * 32 + p4 * 8;
    ATT_LOAD(0); ATT_WRITE(0);
    __syncthreads();
#pragma unroll 1
    for (int j = 0; j < NT; ++j) {
        const int cur = j & 1;
        const bool active = (MODE == 2) || (j <= mychunk);
        unsigned mw0 = 0xffffffffu, mw1 = 0xffffffffu;
        if (MODE == 1) { if (active) { const v2u mm = *(const v2u*)(bmw + 2 * j); mw0 = mm.x >> (4 * hi); mw1 = mm.y >> (4 * hi); } }
        if (j + 1 < NT) ATT_LOAD(j + 1);
        if (active) {
            f32x16 p0, p1;
#pragma unroll
            for (int i = 0; i < 16; ++i) { p0[i] = 0.f; p1[i] = 0.f; }
            const LAS unsigned char* kb = lds + L::K0 + cur * L::KB + kbase;
            const bf16* qwl = qw; if (QLOOP) asm volatile("" : "+v"(qwl));
#pragma unroll
            for (int d0 = 0; d0 < ND; ++d0) {
                const bf16x8 a0 = *(const LAS bf16x8*)(kb + d0 * 32), a1 = *(const LAS bf16x8*)(kb + 32 * L::KSTR + d0 * 32);
                const bf16x8 qf = QLOOP ? *(const bf16x8*)(qwl + d0 * 16) : qr[d0];
                p0 = MFMA32(a0, qf, p0); p1 = MFMA32(a1, qf, p1);
                if ((d0 & 3) == 3) __builtin_amdgcn_sched_barrier(0);
            }
            if (MODE == 1) {
#pragma unroll
                for (int i = 0; i < 16; ++i) { const unsigned bit = 1u << ((i & 3) + 8 * (i >> 2));
                    p0[i] = (mw0 & bit) ? p0[i] : -INFINITY; p1[i] = (mw1 & bit) ? p1[i] : -INFINITY; }
            }
            float tmax = p0[0];
#pragma unroll
            for (int i = 1; i < 16; ++i) tmax = fmaxf(tmax, p0[i]);
#pragma unroll
            for (int i = 0; i < 16; ++i) tmax = fmaxf(tmax, p1[i]);
            tmax = half_swap_max(tmax);
            const float m_new = fmaxf(m_run, tmax), alpha = __builtin_amdgcn_exp2f(m_run - m_new);
            m_run = m_new;
            float ps = 0.f;
#pragma unroll
            for (int i = 0; i < 16; ++i) { p0[i] = __builtin_amdgcn_exp2f(p0[i] - m_new); ps += p0[i]; }
#pragma unroll
            for (int i = 0; i < 16; ++i) { p1[i] = __builtin_amdgcn_exp2f(p1[i] - m_new); ps += p1[i]; }
            ps = half_swap_sum(ps);
            l_run = l_run * alpha + ps;
            if (__any(alpha < 1.0f)) {
#pragma unroll
                for (int d = 0; d < 4; ++d)
#pragma unroll
                    for (int i = 0; i < 16; ++i) o[d][i] *= alpha;
            }
            bf16x8 pb[4];
#pragma unroll
            for (int s = 0; s < 4; ++s) { v4u w;
                if (s < 2) { w.x = cvtpk(p0[8 * s + 0], p0[8 * s + 1]); w.y = cvtpk(p0[8 * s + 2], p0[8 * s + 3]); w.z = cvtpk(p0[8 * s + 4], p0[8 * s + 5]); w.w = cvtpk(p0[8 * s + 6], p0[8 * s + 7]); }
                else { const int s2 = s - 2; w.x = cvtpk(p1[8 * s2 + 0], p1[8 * s2 + 1]); w.y = cvtpk(p1[8 * s2 + 2], p1[8 * s2 + 3]); w.z = cvtpk(p1[8 * s2 + 4], p1[8 * s2 + 5]); w.w = cvtpk(p1[8 * s2 + 6], p1[8 * s2 + 7]); }
                pb[s] = __builtin_bit_cast(bf16x8, w); }
            const LAS unsigned char* vb = lds + L::V0 + cur * L::VB + vbase;
#pragma unroll
            for (int d0 = 0; d0 < 4; ++d0)
#pragma unroll
                for (int s = 0; s < 4; ++s) {
                    const s16x4 lo = vtr(vb + (16 * s) * VSTR + d0 * 64), hh = vtr(vb + (16 * s + 8) * VSTR + d0 * 64);
                    const bf16x8 va = (bf16x8){lo[0], lo[1], lo[2], lo[3], hh[0], hh[1], hh[2], hh[3]};
                    o[d0] = MFMA32(va, pb[s], o[d0]);
                    if (s == 3) __builtin_amdgcn_sched_barrier(0);
                }
        }
        if (j + 1 < NT) ATT_WRITE(cur ^ 1);
        __syncthreads();
    }
    const float rl = 1.0f / l_run;
    bf16* ow = Op + (size_t)(wid * 32 + r32) * LDO + 4 * hi;
#pragma unroll
    for (int d0 = 0; d0 < 4; ++d0)
#pragma unroll
        for (int g = 0; g < 4; ++g) { v2u w; w.x = cvtpk(o[d0][4 * g] * rl, o[d0][4 * g + 1] * rl); w.y = cvtpk(o[d0][4 * g + 2] * rl, o[d0][4 * g + 3] * rl);
            *(v2u*)(ow + 32 * d0 + 8 * g) = w; }
#undef ATT_LOAD
#undef ATT_WRITE
}
#ifndef MK_MULTI
#define MK_MULTI 0
#endif
#ifndef DBG_SKIP_MIXER
#define DBG_SKIP_MIXER 0
#endif
constexpr int NPH = 16;
#ifndef ATT_MASK
#define ATT_MASK 7
#endif
struct Args { const float* in[30]; float* out; unsigned char* ws; int ph_lo, ph_hi; };
static_assert(sizeof(Args) == 30 * 8 + 8 + 8 + 8, "no padding");

DI void ffn_up_phase(LAS unsigned char* lds, const bf16* A, const bf16* WGUt, bf16* Hmid, int G) {
    pg8::Gemm g{A, WGUt, MTOK, NGU, DM}; pg8::StaticOrder S; S.init(MTOK, NGU, G, (int)blockIdx.x);
    pg8::EpiSwiGLU E{Hmid, DFF};
    pg8::gemm_phase<pg8::EpiSwiGLU, pg8::StaticOrder, true, true>(lds, g, S, E);
}
DI void ffn_down_phase(LAS unsigned char* lds, const bf16* Hmid, const bf16* WDt, const float* base, float* out, int G) {
    pg8::Gemm g{Hmid, WDt, MTOK, DM, DFF}; pg8::StaticOrder S; S.init(MTOK, DM, G, (int)blockIdx.x);
    pg8::EpiResid E{base, out, DM, 0.5f};
    pg8::gemm_phase<pg8::EpiResid, pg8::StaticOrder, true, true>(lds, g, S, E);
}

__global__ void __launch_bounds__(NWAVES * 64, 2) mega_fwd(Args args) {
    extern __shared__ __attribute__((aligned(16))) unsigned char lds_raw[];
    LAS unsigned char* lds = (LAS unsigned char*)lds_raw;
    const int GRID = gridDim.x;
    const __attribute__((address_space(4))) unsigned char* ka = (const __attribute__((address_space(4))) unsigned char*)__builtin_amdgcn_kernarg_segment_ptr();
#define ARGQ(k) (*(void* const __attribute__((address_space(4)))*)(ka + 8 * (k)))
#define ARGP(k) ((const float*)ARGQ(k))
    unsigned char* ws = (unsigned char*)ARGQ(31);
    unsigned* ctl = (unsigned*)(ws + WS_CTL);
    volatile LAS unsigned* MISC = (volatile LAS unsigned*)(lds + MISC_OFF);
    for (int u = threadIdx.x; u < (LDS_BYTES - MISC_OFF) / 4; u += NWAVES * 64) ((LAS unsigned*)(lds + MISC_OFF))[u] = 0u;
    __syncthreads();
    const int lo = *(const __attribute__((address_space(4))) int*)(ka + 256), hi = *(const __attribute__((address_space(4))) int*)(ka + 260);
    XcdBarrier bar; bar.bar = ctl + CW_BAR; bar.x = 0; bar.st = nullptr;
    if (hi - lo > 1) bar = xcd_barrier_post(ctl + CW_BAR, MISC);
#ifndef PH_MASK
#define PH_MASK 0xffff
#endif
#define IN(k) ((((PH_MASK) >> (k)) & 1) && lo <= (k) && (k) < hi)
#define SEAM(k) do { if (IN(k) && IN((k) + 1)) xcd_barrier(bar); } while (0)
#ifndef REPEAT_MASK
#define REPEAT_MASK 0
#endif
#define NREP(k) (1 + (((REPEAT_MASK) >> (k)) & 1))
#define REPBAR(k) do { if (((REPEAT_MASK) >> (k)) & 1) xcd_barrier(bar); } while (0)

#define WGUt ((bf16*)(ws + WS_WGU))
#define WDt ((bf16*)(ws + WS_WD))
#define WINt ((bf16*)(ws + WS_WIN))
#define WUQt ((bf16*)(ws + WS_WUQ))
#define WUKVt ((bf16*)(ws + WS_WUKV))
#define WMKVt ((bf16*)(ws + WS_WMKV))
#define WOMLAt ((bf16*)(ws + WS_WOMLA))
#define WODSAt ((bf16*)(ws + WS_WODSA))
#define WOMEMt ((bf16*)(ws + WS_WOMEM))
#define WOUTt ((bf16*)(ws + WS_WOUT))
#define Abuf ((bf16*)(ws + WS_A))
#define Hmid ((bf16*)(ws + WS_HMID))
#define Gt ((bf16*)(ws + WS_G))
#define Pbuf ((bf16*)(ws + WS_P))
#define QmlaRaw ((bf16*)(ws + WS_QMLARAW))
#define KVraw ((bf16*)(ws + WS_KVRAW))
#define Qmla ((bf16*)(ws + WS_QMLA))
#define Kmla ((bf16*)(ws + WS_KMLA))
#define GS ((float*)(ws + WS_GS))
#define CQn ((bf16*)(ws + WS_CQN))
#define CKVn ((bf16*)(ws + WS_CKVN))
#define Qd ((bf16*)(ws + WS_QD))
#define Kd ((bf16*)(ws + WS_KD))
#define Vd ((bf16*)(ws + WS_VD))
#define Qi ((bf16*)(ws + WS_QI))
#define Ki ((bf16*)(ws + WS_KI))
#define Wi ((float*)(ws + WS_WI))
#define Kr ((bf16*)(ws + WS_KR))
#define Qm ((bf16*)(ws + WS_QM))
#define Ymla ((bf16*)(ws + WS_YMLA))
#define Ydsa ((bf16*)(ws + WS_YDSA))
#define Ymem ((bf16*)(ws + WS_YMEM))
#define BM ((unsigned*)(ws + WS_BM))
#define memn ((bf16*)(ws + WS_MEMN))
#define MKVraw ((bf16*)(ws + WS_MKVRAW))
#define MemK ((bf16*)(ws + WS_MEMK))
#define Sc ((float*)(ws + WS_SC))
#define X_IN (ARGP(0))
#define MEM_IN (ARGP(1))
#define POS_IN ((const int*)ARGP(2))
#define XRES ((float*)ARGQ(30))
    for (int rep_ = 0; rep_ < NREP(0); ++rep_) { if (rep_) REPBAR(0); if (IN(0)) { const Ctx C = make_ctx(lds);
        conv_ffn(C, ARGP(4), ARGP(5), ARGP(6), WGUt, WDt);
#if !DBG_SKIP_MIXER
        conv_win(C, ARGP(8), ARGP(24), WINt);
        int dummy = 0;
        conv_plain(C, ARGP(10), 1536, 2304, WUQt, dummy, 0);
        conv_plain(C, ARGP(12), 512, 3072, WUKVt, dummy, 0);
        conv_plain(C, ARGP(18), 4096, 2048, WMKVt, dummy, 0);
        conv_plain(C, ARGP(21), 1536, 4096, WOMLAt, dummy, 0);
        conv_plain(C, ARGP(22), 1536, 4096, WODSAt, dummy, 0);
        conv_plain(C, ARGP(23), 1024, 4096, WOMEMt, dummy, 0);
        conv_plain(C, ARGP(25), 4096, 4096, WOUTt, dummy, 0);
        rms_rows(C, MEM_IN, ARGP(17), memn, MROWS);
#endif
        rms_rows(C, X_IN, ARGP(3), Abuf, MTOK);
    }
    }
    SEAM(0);
    for (int rep_ = 0; rep_ < NREP(1); ++rep_) { if (rep_) REPBAR(1); if (IN(1)) ffn_up_phase(lds, Abuf, WGUt, Hmid, GRID);
    }
    SEAM(1);
    for (int rep_ = 0; rep_ < NREP(2); ++rep_) { if (rep_) REPBAR(2); if (IN(2)) ffn_down_phase(lds, Hmid, WDt, X_IN, XRES, GRID);
    }
    SEAM(2);
#if !DBG_SKIP_MIXER
    if (IN(3)) { const Ctx C = make_ctx(lds); rms_rows(C, XRES, ARGP(7), Abuf, MTOK); }
    SEAM(3);
    for (int rep_ = 0; rep_ < NREP(4); ++rep_) { if (rep_) REPBAR(4); if (IN(4)) {
        pg8::Gemm g{Abuf, WINt, MTOK, NIN, DM}; pg8::StaticOrder S; S.init(MTOK, NIN, GRID, (int)blockIdx.x);
        pg8::EpiInProj E{Pbuf, NPC, NPT, Gt, NGC};
        pg8::gemm_phase<pg8::EpiInProj, pg8::StaticOrder, true, true>(lds, g, S, E);
    }
    }
    SEAM(4);
    for (int rep_ = 0; rep_ < NREP(5); ++rep_) { if (rep_) REPBAR(5); if (IN(5)) { const Ctx C = make_ctx(lds);
        PP1 A{Pbuf, POS_IN, ARGP(9), ARGP(11), ARGP(15), ARGP(16), ARGP(19), CQn, CKVn, Qd, Kd, Vd, Qi, Ki, Kr, Qm, Wi};
        for (int t = C.gw; t < MTOK; t += C.NGW) pp1_token(A, t, C.lane);
    }
    }
    SEAM(5);
    for (int rep_ = 0; rep_ < NREP(6); ++rep_) { if (rep_) REPBAR(6); if (IN(6)) {
        { pg8::Gemm g{CQn, WUQt, MTOK, 2304, 1536}; pg8::StaticOrder S; S.init(MTOK, 2304, GRID, (int)blockIdx.x); pg8::EpiPlain E{QmlaRaw, 2304};
          pg8::gemm_phase<pg8::EpiPlain, pg8::StaticOrder, true, true>(lds, g, S, E); }
        { pg8::Gemm g{CKVn, WUKVt, MTOK, 3072, 512}; pg8::StaticOrder S; S.init(MTOK, 3072, GRID, (int)blockIdx.x); pg8::EpiPlain E{KVraw, 3072};
          pg8::gemm_phase<pg8::EpiPlain, pg8::StaticOrder, true, true>(lds, g, S, E); }
        { pg8::Gemm g{memn, WMKVt, MROWS, 2048, DM}; pg8::StaticOrder S; S.init(MROWS, 2048, GRID, (int)blockIdx.x); pg8::EpiPlain E{MKVraw, 2048};
          pg8::gemm_phase<pg8::EpiPlain, pg8::StaticOrder, true, true>(lds, g, S, E); }
    }
    }
    SEAM(6);
    for (int rep_ = 0; rep_ < NREP(7); ++rep_) { if (rep_) REPBAR(7); if (IN(7)) { const Ctx C = make_ctx(lds);
        PP2 A{QmlaRaw, KVraw, Kr, MKVraw, POS_IN, ARGP(13), ARGP(14), ARGP(20), Qmla, Kmla, MemK};
        for (int t = C.gw; t < MTOK; t += C.NGW) pp2_token(A, t, C.lane);
        for (int r = C.gw; r < MROWS; r += C.NGW) pp2_memrow(A, r, C.lane);
    }
    }
    SEAM(7);
    for (int rep_ = 0; rep_ < NREP(8); ++rep_) { if (rep_) REPBAR(8); if (IN(8)) { const Ctx C = make_ctx(lds); for (int p = blockIdx.x; p < 256; p += GRID) idx_item(p, Qi, Ki, Wi, Sc, C.wave, C.lane); }
    }
    SEAM(8);
    for (int rep_ = 0; rep_ < NREP(9); ++rep_) { if (rep_) REPBAR(9); if (IN(9)) { const Ctx C = make_ctx(lds); for (int t = C.gw; t < MTOK; t += C.NGW) select_row(Sc, (unsigned long long*)BM, t, C.lane, (LAS unsigned long long*)(lds + C.wave * 1024)); }
    }
    SEAM(9);
    for (int rep_ = 0; rep_ < NREP(10); ++rep_) { if (rep_) REPBAR(10); if (IN(10)) {
        for (;;) {
            if (threadIdx.x == 0) MISC[4] = __hip_atomic_fetch_add(ctl + CW_QUEUE + 64 * rep_, 1u, __ATOMIC_RELAXED, __HIP_MEMORY_SCOPE_AGENT);
            __syncthreads();
            const int u = __builtin_amdgcn_readfirstlane((int)MISC[4]);
            __syncthreads();
            if (u >= 2048) break;
            if (u < 1536) {
                const int qt = 31 - u / 48, r = u % 48, type = r / 24, bh = r % 24, b = bh / 12, h = bh % 12;
                const size_t row0 = (size_t)b * SEQ + 256 * qt, krow0 = (size_t)b * SEQ;
                if (type == 0) { if (ATT_MASK & 1) attn_unit<192, 0>(lds, Qmla + row0 * 2304 + h * 192, 2304, Kmla + krow0 * 2304 + h * 192, 2304, KVraw + krow0 * 3072 + h * 256 + 128, 3072,
                                                 Ymla + row0 * 1536 + h * 128, 1536, 4 * qt + 4, 4 * qt, nullptr); }
                else if (ATT_MASK & 2) attn_unit<128, 1>(lds, Qd + row0 * 1536 + h * 128, 1536, Kd + krow0 * 1536 + h * 128, 1536, Vd + krow0 * 1536 + h * 128, 1536,
                                       Ydsa + row0 * 1536 + h * 128, 1536, 4 * qt + 4, 4 * qt, BM + row0 * 256);
            } else {
                const int v = u - 1536, b = v >> 8, h = (v >> 6) & 3, qt = (v >> 1) & 31, dvh = v & 1;
                const size_t row0 = (size_t)b * SEQ + 256 * qt, krow0 = (size_t)b * MEMLEN;
                if (ATT_MASK & 4) attn_unit<256, 2>(lds, Qm + row0 * 1024 + h * 256, 1024, MemK + krow0 * 1024 + h * 256, 1024, MKVraw + krow0 * 2048 + 1024 + h * 256 + dvh * 128, 2048,
                                  Ymem + row0 * 1024 + h * 256 + dvh * 128, 1024, 4, 0, nullptr);
            }
        }
    }
    }
    SEAM(10);
    for (int rep_ = 0; rep_ < NREP(11); ++rep_) { if (rep_) REPBAR(11); if (IN(11)) {
        { pg8::Gemm g{Ymla, WOMLAt, MTOK, DM, 1536}; pg8::StaticOrder S; S.init(MTOK, DM, GRID, (int)blockIdx.x); pg8::EpiGate<0> E{Gt, NGC, 0, GS, Abuf, DM};
          pg8::gemm_phase<pg8::EpiGate<0>, pg8::StaticOrder, true, true>(lds, g, S, E); }
        { pg8::Gemm g{Ydsa, WODSAt, MTOK, DM, 1536}; pg8::StaticOrder S; S.init(MTOK, DM, GRID, (int)blockIdx.x); pg8::EpiGate<1> E{Gt, NGC, DM, GS, Abuf, DM};
          pg8::gemm_phase<pg8::EpiGate<1>, pg8::StaticOrder, true, true>(lds, g, S, E); }
        { pg8::Gemm g{Ymem, WOMEMt, MTOK, DM, 1024}; pg8::StaticOrder S; S.init(MTOK, DM, GRID, (int)blockIdx.x); pg8::EpiGate<2> E{Gt, NGC, 2 * DM, GS, Abuf, DM};
          pg8::gemm_phase<pg8::EpiGate<2>, pg8::StaticOrder, true, true>(lds, g, S, E); }
    }
    }
    SEAM(11);
    if (IN(12)) {
        pg8::Gemm g{Abuf, WOUTt, MTOK, DM, DM}; pg8::StaticOrder S; S.init(MTOK, DM, GRID, (int)blockIdx.x); pg8::EpiResid E{XRES, XRES, DM, 1.0f};
        pg8::gemm_phase<pg8::EpiResid, pg8::StaticOrder, true, true>(lds, g, S, E);
    }
    SEAM(12);
#endif
    if (IN(13)) { const Ctx C = make_ctx(lds); conv_ffn(C, ARGP(27), ARGP(28), ARGP(29), WGUt, WDt); rms_rows(C, XRES, ARGP(26), Abuf, MTOK); }
    SEAM(13);
    if (IN(14)) ffn_up_phase(lds, Abuf, WGUt, Hmid, GRID);
    SEAM(14);
    if (IN(15)) ffn_down_phase(lds, Hmid, WDt, XRES, XRES, GRID);
#undef IN
#undef SEAM
}

#undef WGUt
#undef WDt
#undef WINt
#undef WUQt
#undef WUKVt
#undef WMKVt
#undef WOMLAt
#undef WODSAt
#undef WOMEMt
#undef WOUTt
#undef Abuf
#undef Hmid
#undef Gt
#undef Pbuf
#undef QmlaRaw
#undef KVraw
#undef Qmla
#undef Kmla
#undef GS
#undef CQn
#undef CKVn
#undef Qd
#undef Kd
#undef Vd
#undef Qi
#undef Ki
#undef Wi
#undef Kr
#undef Qm
#undef Ymla
#undef Ydsa
#undef Ymem
#undef BM
#undef memn
#undef MKVraw
#undef MemK
#undef Sc
#undef X_IN
#undef MEM_IN
#undef POS_IN
#undef XRES
#undef ARGQ
#undef ARGP
extern "C" void kernel_launch(void* const* d_in, const int* in_sizes, int n_in, void* d_out, int out_size, void* d_ws, size_t ws_size, hipStream_t stream) {
    static int grid = 0;
    if (grid == 0) {
        if (n_in != 30 || in_sizes[0] != MTOK * DM || out_size != MTOK * DM || ws_size < WS_END) {
            fprintf(stderr, "kernel_launch: built for 30 inputs, x/out of %d floats, >= %zu bytes of workspace; got n_in %d, in0 %d, out %d, ws %zu; nothing launched\n", MTOK * DM, (size_t)WS_END, n_in, n_in > 0 ? in_sizes[0] : -1, out_size, ws_size);
            grid = -1; return; }
        int dev = 0, cus = 0, per_cu = 0;
        if (hipGetDevice(&dev) != hipSuccess || hipDeviceGetAttribute(&cus, hipDeviceAttributeMultiprocessorCount, dev) != hipSuccess) { fprintf(stderr, "kernel_launch: device query failed\n"); grid = -1; return; }
        if (hipFuncSetAttribute((const void*)mega_fwd, hipFuncAttributeMaxDynamicSharedMemorySize, LDS_BYTES) != hipSuccess) { fprintf(stderr, "kernel_launch: hipFuncSetAttribute failed\n"); grid = -1; return; }
        if (hipOccupancyMaxActiveBlocksPerMultiprocessor(&per_cu, (const void*)mega_fwd, NWAVES * 64, LDS_BYTES) != hipSuccess || per_cu < 1)
            fprintf(stderr, "kernel_launch: note: occupancy query reports %d workgroups per CU\n", per_cu);
        (void)hipGetLastError();
        grid = cus;
    }
    if (grid < 0) return;
    if (hipMemsetAsync((char*)d_ws + WS_CTL, 0, CTL_ZERO_BYTES, stream) != hipSuccess) { fprintf(stderr, "kernel_launch: memset failed\n"); return; }
    Args a{};
    for (int i = 0; i < 30; ++i) a.in[i] = (const float*)d_in[i];
    a.out = (float*)d_out; a.ws = (unsigned char*)d_ws;
#if MK_MULTI
    for (int k = 0; k < NPH; ++k) { a.ph_lo = k; a.ph_hi = k + 1; hipLaunchKernelGGL(mega_fwd, dim3(grid), dim3(NWAVES * 64), LDS_BYTES, stream, a); }
#else
    a.ph_lo = 0; a.ph_hi = NPH;
    hipLaunchKernelGGL(mega_fwd, dim3(grid), dim3(NWAVES * 64), LDS_BYTES, stream, a);
#endif
    const hipError_t le = hipPeekAtLastError();
    if (le != hipSuccess) fprintf(stderr, "kernel_launch: launch failed: %s\n", hipGetErrorName(le));
}
```

```cpp
#include <hip/hip_runtime.h>
#include <cstdio>
#include <cstdint>
namespace pg8 {
#define PG8_LAS __attribute__((address_space(3)))
typedef unsigned short bf16_t;
typedef short bf16x8 __attribute__((ext_vector_type(8)));
typedef float f32x4 __attribute__((ext_vector_type(4)));
typedef unsigned u32x4 __attribute__((ext_vector_type(4)));
constexpr int BM = 256, BK = 64, HALF = 128, HTB = HALF * BK * 2  , STAGE_BYTES = 8 * HTB, NXCD = 8, WGM = 8;

__host__ __device__ __forceinline__ int lds_byte(int r, int c) { const int st = (r >> 4) * 2 + (c >> 5), rr = r & 15, cc = c & 31, ob = rr * 64 + cc * 2; return st * 1024 + (ob ^ (((ob >> 9) & 1) << 5)); }
__host__ __device__ __forceinline__ void stage_rc(int b, int& R, int& C) { const int st = b / 1024, sb = b % 1024, swz = sb ^ (((sb >> 9) & 1) << 5); R = (st >> 1) * 16 + swz / 64; C = (st & 1) * 32 + (swz % 64) / 2; }
__host__ __device__ __forceinline__ int perm32(int rho) { const int n = rho >> 4, i = rho & 15; return 8 * (i >> 2) + 4 * n + (i & 3); }

struct Unit { int pm, pn; };
struct Gemm { const bf16_t* A; const bf16_t* Bt; int M, N, K; };

struct StaticOrder {
    int nM, nN, nwg, G, c;
    __host__ __device__ void init(int M, int N, int G_, int c_) { nM = M / BM; nN = N / BM; nwg = nM * nN; G = G_; c = c_; }
    __host__ __device__ bool next(int i, Unit& u) const {
        const long L = (long)i * G + c; if (L >= nwg) return false;
        int wgid = (int)L; { const int q = nwg / NXCD, r = nwg % NXCD, xcd = wgid % NXCD, off = wgid / NXCD; wgid = (xcd < r ? xcd * (q + 1) : r * (q + 1) + (xcd - r) * q) + off; }
        const int nig = WGM * nN, gid = wgid / nig, fm = gid * WGM, gsz = (nM - fm) < WGM ? (nM - fm) : WGM;
        u.pm = fm + ((wgid % nig) % gsz); u.pn = (wgid % nig) / gsz; return true;
    }
    __device__ __forceinline__ void a_ready(const Unit&) const {}
    __device__ __forceinline__ void done(const Unit&) const {}
};
__device__ __forceinline__ unsigned cvt_pk_bf16(float lo, float hi) { unsigned r; asm volatile("v_cvt_pk_bf16_f32 %0, %1, %2" : "=v"(r) : "v"(lo), "v"(hi)); return r; }
__device__ __forceinline__ float sigmoid_f(float x) { return __builtin_amdgcn_rcpf(1.0f + __builtin_amdgcn_exp2f(-1.4426950408889634f * x)); }
struct EpiPlain {
    static constexpr bool PERM = true, AFTER_DRAIN = false;
    bf16_t* O; int ldc;
    __device__ __forceinline__ void operator()(const f32x4 (&acc)[2][2][4][2], const Unit& u, int wr, int wc, int fr, int fq) const {
        const int row0 = u.pm * BM + wr * 64 + fr, col0 = u.pn * BM + wc * 32 + 8 * fq;
#pragma unroll
        for (int ai = 0; ai < 2; ++ai)
#pragma unroll
            for (int m = 0; m < 4; ++m) { bf16_t* rowp = O + (size_t)(row0 + ai * HALF + m * 16) * ldc + col0;
#pragma unroll
                for (int bj = 0; bj < 2; ++bj) { const f32x4 v0 = acc[ai][bj][m][0], v1 = acc[ai][bj][m][1];
                    u32x4 w; w.x = cvt_pk_bf16(v0[0], v0[1]); w.y = cvt_pk_bf16(v0[2], v0[3]); w.z = cvt_pk_bf16(v1[0], v1[1]); w.w = cvt_pk_bf16(v1[2], v1[3]);
                    *(u32x4*)(rowp + bj * HALF) = w; } }
    }
};
struct EpiSwiGLU {
    static constexpr bool PERM = true, AFTER_DRAIN = false;
    bf16_t* O; int ldc;
    __device__ __forceinline__ void operator()(const f32x4 (&acc)[2][2][4][2], const Unit& u, int wr, int wc, int fr, int fq) const {
        const int row0 = u.pm * BM + wr * 64 + fr, col0 = u.pn * HALF + wc * 32 + 8 * fq;
#pragma unroll
        for (int ai = 0; ai < 2; ++ai)
#pragma unroll
            for (int m = 0; m < 4; ++m) { bf16_t* rowp = O + (size_t)(row0 + ai * HALF + m * 16) * ldc + col0;
                f32x4 r0, r1;
#pragma unroll
                for (int j = 0; j < 4; ++j) { const float g0 = acc[ai][0][m][0][j], g1 = acc[ai][0][m][1][j];
                    r0[j] = g0 * sigmoid_f(g0) * acc[ai][1][m][0][j]; r1[j] = g1 * sigmoid_f(g1) * acc[ai][1][m][1][j]; }
                u32x4 w; w.x = cvt_pk_bf16(r0[0], r0[1]); w.y = cvt_pk_bf16(r0[2], r0[3]); w.z = cvt_pk_bf16(r1[0], r1[1]); w.w = cvt_pk_bf16(r1[2], r1[3]);
                *(u32x4*)rowp = w; }
    }
};
struct EpiResid {
    static constexpr bool PERM = false, AFTER_DRAIN = false;
    const float* base; float* out; int ldc; float scale;
    __device__ __forceinline__ void operator()(const f32x4 (&acc)[2][2][4][2], const Unit& u, int wr, int wc, int fr, int fq) const {
        const int row0 = u.pm * BM + wr * 64 + fr, col0 = u.pn * BM + wc * 32 + 4 * fq;
#pragma unroll
        for (int ai = 0; ai < 2; ++ai)
#pragma unroll
            for (int m = 0; m < 4; ++m) { const size_t off = (size_t)(row0 + ai * HALF + m * 16) * ldc + col0;
#pragma unroll
                for (int bj = 0; bj < 2; ++bj)
#pragma unroll
                    for (int n = 0; n < 2; ++n) { const f32x4 b = *(const f32x4*)(base + off + bj * HALF + n * 16);
                        *(f32x4*)(out + off + bj * HALF + n * 16) = b + acc[ai][bj][m][n] * scale; } }
    }
};
struct EpiInProj {
    static constexpr bool PERM = true, AFTER_DRAIN = false;
    bf16_t* P; int ldp; int np; bf16_t* G; int ldg;
    __device__ __forceinline__ void operator()(const f32x4 (&acc)[2][2][4][2], const Unit& u, int wr, int wc, int fr, int fq) const {
        const int row0 = u.pm * BM + wr * 64 + fr; const bool isg = u.pn >= np;
        bf16_t* O = isg ? G : P; const int ldc = isg ? ldg : ldp; const int col0 = (isg ? u.pn - np : u.pn) * BM + wc * 32 + 8 * fq;
#pragma unroll
        for (int ai = 0; ai < 2; ++ai)
#pragma unroll
            for (int m = 0; m < 4; ++m) { bf16_t* rowp = O + (size_t)(row0 + ai * HALF + m * 16) * ldc + col0;
#pragma unroll
                for (int bj = 0; bj < 2; ++bj) { f32x4 v0 = acc[ai][bj][m][0], v1 = acc[ai][bj][m][1];
                    if (isg) {
#pragma unroll
                        for (int j = 0; j < 4; ++j) { v0[j] = sigmoid_f(v0[j]); v1[j] = sigmoid_f(v1[j]); } }
                    u32x4 w; w.x = cvt_pk_bf16(v0[0], v0[1]); w.y = cvt_pk_bf16(v0[2], v0[3]); w.z = cvt_pk_bf16(v1[0], v1[1]); w.w = cvt_pk_bf16(v1[2], v1[3]);
                    *(u32x4*)(rowp + bj * HALF) = w; } }
    }
};
template <int BR> struct EpiGate {
    static constexpr bool PERM = true, AFTER_DRAIN = false;
    const bf16_t* G; int ldg; int gcol0; float* GS; bf16_t* GSb; int ld;
    __device__ __forceinline__ void operator()(const f32x4 (&acc)[2][2][4][2], const Unit& u, int wr, int wc, int fr, int fq) const {
        const int row0 = u.pm * BM + wr * 64 + fr, col0 = u.pn * BM + wc * 32 + 8 * fq;
#pragma unroll
        for (int ai = 0; ai < 2; ++ai)
#pragma unroll
            for (int m = 0; m < 4; ++m) { const int row = row0 + ai * HALF + m * 16;
#pragma unroll
                for (int bj = 0; bj < 2; ++bj) { const int col = col0 + bj * HALF;
                    const u32x4 gw = *(const u32x4*)(G + (size_t)row * ldg + gcol0 + col);
                    f32x4 g0, g1;
                    g0[0] = __uint_as_float(gw.x << 16); g0[1] = __uint_as_float(gw.x & 0xffff0000u); g0[2] = __uint_as_float(gw.y << 16); g0[3] = __uint_as_float(gw.y & 0xffff0000u);
                    g1[0] = __uint_as_float(gw.z << 16); g1[1] = __uint_as_float(gw.z & 0xffff0000u); g1[2] = __uint_as_float(gw.w << 16); g1[3] = __uint_as_float(gw.w & 0xffff0000u);
                    f32x4 t0 = g0 * acc[ai][bj][m][0], t1 = g1 * acc[ai][bj][m][1];
                    float* gp = GS + (size_t)row * ld + col;
                    if (BR >= 1) { t0 = t0 + *(const f32x4*)gp; t1 = t1 + *(const f32x4*)(gp + 4); }
                    if (BR <= 1) { *(f32x4*)gp = t0; *(f32x4*)(gp + 4) = t1; }
                    else { u32x4 w; w.x = cvt_pk_bf16(t0[0], t0[1]); w.y = cvt_pk_bf16(t0[2], t0[3]); w.z = cvt_pk_bf16(t1[0], t1[1]); w.w = cvt_pk_bf16(t1[2], t1[3]);
                        *(u32x4*)(GSb + (size_t)row * ld + col) = w; } } }
    }
};
template <class Epi, class Sched, bool ALIGN_EPI = false, bool SP2 = false>
__device__ __forceinline__ void gemm_phase(PG8_LAS unsigned char* lds, const Gemm g, const Sched& S, const Epi& E) {
    int tid_ = threadIdx.x; asm volatile("" : "+v"(tid_));
    const int tid = tid_, wid = __builtin_amdgcn_readfirstlane(tid >> 6), lane = tid & 63, wr = wid >> 2, wc = wid & 3, fr = lane & 15, fq = lane >> 4;
    const int K = g.K, nt = K / BK;
    unsigned voffA[2], voffB[2];
#pragma unroll
    for (int i = 0; i < 2; ++i) { int R, C; stage_rc(tid * 16 + i * 8192, R, C); const int Rb = Epi::PERM ? ((R & ~31) + perm32(R & 31)) : R;
        voffA[i] = (unsigned)(R * K + C) * 2u; voffB[i] = (unsigned)(Rb * K + C) * 2u; }
    const size_t kstep = (size_t)(BK * 2);
    const size_t hstep = (size_t)HALF * K * 2;
    const size_t tstep = 2 * hstep;
    const unsigned ldsw = (unsigned)wid * 1024u;
    const int aoff = lds_byte(wr * 64 + fr, fq * 8), boff = lds_byte(wc * 32 + fr, fq * 8);
#define PG8_SA(b, h) (((b) * 2 + (h)) * HTB)
#define PG8_SB(b, h) ((4 + (b) * 2 + (h)) * HTB)
#define PG8_STAGE(bufoff, gbase, voff) do { _Pragma("unroll") for (int _i = 0; _i < 2; ++_i) \
        __builtin_amdgcn_global_load_lds((const unsigned*)((const char*)(gbase) + (voff)[_i]), (PG8_LAS unsigned*)(lds + (bufoff) + ldsw + _i * 8192), 16, 0, 0); } while (0)
#define PG8_LDA(dst, b, h) do { _Pragma("unroll") for (int m = 0; m < 4; ++m) _Pragma("unroll") for (int k = 0; k < 2; ++k) dst[m][k] = *(const PG8_LAS bf16x8*)(lds + PG8_SA(b, h) + aoff + m * 2048 + k * 1024); } while (0)
#define PG8_LDB(dst, b, h) do { _Pragma("unroll") for (int n = 0; n < 2; ++n) _Pragma("unroll") for (int k = 0; k < 2; ++k) dst[n][k] = *(const PG8_LAS bf16x8*)(lds + PG8_SB(b, h) + boff + n * 2048 + k * 1024); } while (0)
#define PG8_MMA(ai, bj, At, Bt) do { __builtin_amdgcn_s_setprio(1); _Pragma("unroll") for (int m = 0; m < 4; ++m) _Pragma("unroll") for (int n = 0; n < 2; ++n) _Pragma("unroll") for (int k = 0; k < 2; ++k) \
        acc[ai][bj][m][n] = __builtin_amdgcn_mfma_f32_16x16x32_bf16(Bt[n][k], At[m][k], acc[ai][bj][m][n], 0, 0, 0); __builtin_amdgcn_s_setprio(0); } while (0)
#define PG8_WAIT_V(n) asm volatile("s_waitcnt vmcnt(" #n ")" ::: "memory")
#define PG8_WAIT_L(n) asm volatile("s_waitcnt lgkmcnt(" #n ")" ::: "memory")
#define PG8_BAR __builtin_amdgcn_s_barrier()
#define PG8_SCHED __builtin_amdgcn_sched_barrier(0)
    Unit cur, nxt; int ui = 0;
    if (!S.next(0, cur)) return;
    f32x4 acc[2][2][4][2];
#pragma unroll
    for (int a = 0; a < 2; ++a)
#pragma unroll
        for (int b = 0; b < 2; ++b)
#pragma unroll
            for (int m = 0; m < 4; ++m)
#pragma unroll
                for (int n = 0; n < 2; ++n) acc[a][b][m][n] = (f32x4){0.f, 0.f, 0.f, 0.f};
    bf16x8 At[4][2], B0[2][2], B1[2][2];
    const char* cA = (const char*)g.A + (size_t)cur.pm * tstep; const char* cB = (const char*)g.Bt + (size_t)cur.pn * tstep;
    S.a_ready(cur);
    if constexpr (SP2) {
        PG8_STAGE(PG8_SB(0, 0), cB, voffB); PG8_STAGE(PG8_SB(0, 1), cB + hstep, voffB); PG8_STAGE(PG8_SA(0, 0), cA, voffA); PG8_STAGE(PG8_SA(0, 1), cA + hstep, voffA);
        if (wr == 1) PG8_BAR;
        PG8_WAIT_V(2); PG8_BAR;
        PG8_STAGE(PG8_SB(1, 0), cB + kstep, voffB); PG8_STAGE(PG8_SA(1, 0), cA + kstep, voffA); PG8_STAGE(PG8_SB(1, 1), cB + hstep + kstep, voffB);
        PG8_WAIT_V(6); PG8_BAR;
    } else {
        PG8_STAGE(PG8_SB(0, 0), cB, voffB); PG8_STAGE(PG8_SA(0, 0), cA, voffA); PG8_STAGE(PG8_SB(0, 1), cB + hstep, voffB); PG8_STAGE(PG8_SA(0, 1), cA + hstep, voffA);
        if (wr == 1) PG8_BAR;
        PG8_WAIT_V(4); PG8_BAR;
        PG8_STAGE(PG8_SB(1, 0), cB + kstep, voffB); PG8_STAGE(PG8_SA(1, 0), cA + kstep, voffA); PG8_STAGE(PG8_SB(1, 1), cB + hstep + kstep, voffB);
        PG8_WAIT_V(6); PG8_BAR;
    }
    for (;;) {
        const bool has_next = S.next(ui + 1, nxt);
        const char* nA = has_next ? (const char*)g.A + (size_t)nxt.pm * tstep : cA; const char* nB = has_next ? (const char*)g.Bt + (size_t)nxt.pn * tstep : cB;
        for (int t = 0; t < nt; t += 2) {
            const bool last = (t == nt - 2);
            const char* a1 = cA + (size_t)(t + 1) * kstep;
            const char* a2 = last ? nA : cA + (size_t)(t + 2) * kstep; const char* b2 = last ? nB : cB + (size_t)(t + 2) * kstep;
            const char* a3 = a2 + kstep; const char* b3 = b2 + kstep;
            if (last && has_next) S.a_ready(nxt);
            if constexpr (SP2) {
            PG8_LDB(B0, 0, 0); PG8_LDB(B1, 0, 1); PG8_SCHED; PG8_LDA(At, 0, 0); PG8_STAGE(PG8_SA(1, 1), a1 + hstep, voffA);
            PG8_WAIT_V(8); PG8_WAIT_L(0); PG8_BAR; PG8_MMA(0, 0, At, B0); PG8_MMA(0, 1, At, B1); PG8_BAR; PG8_SCHED;
            PG8_LDA(At, 0, 1); PG8_STAGE(PG8_SB(0, 0), b2, voffB); PG8_STAGE(PG8_SB(0, 1), b2 + hstep, voffB); PG8_STAGE(PG8_SA(0, 0), a2, voffA);
            PG8_WAIT_V(8); PG8_WAIT_L(0); PG8_BAR; PG8_MMA(1, 0, At, B0); PG8_MMA(1, 1, At, B1); PG8_BAR; PG8_SCHED;
            PG8_LDB(B0, 1, 0); PG8_LDB(B1, 1, 1); PG8_SCHED; PG8_LDA(At, 1, 0); PG8_STAGE(PG8_SA(0, 1), a2 + hstep, voffA);
            PG8_WAIT_V(8); PG8_WAIT_L(0); PG8_BAR; PG8_MMA(0, 0, At, B0); PG8_MMA(0, 1, At, B1); PG8_BAR; PG8_SCHED;
            PG8_LDA(At, 1, 1); PG8_STAGE(PG8_SB(1, 0), b3, voffB); PG8_STAGE(PG8_SB(1, 1), b3 + hstep, voffB); PG8_STAGE(PG8_SA(1, 0), a3, voffA);
            PG8_WAIT_V(8); PG8_WAIT_L(0); PG8_BAR; PG8_MMA(1, 0, At, B0); PG8_MMA(1, 1, At, B1); PG8_BAR; PG8_SCHED;
            } else {
            PG8_LDB(B0, 0, 0); PG8_SCHED; PG8_LDA(At, 0, 0); PG8_STAGE(PG8_SA(1, 1), a1 + hstep, voffA);
            PG8_WAIT_L(8); PG8_BAR; PG8_WAIT_L(0); PG8_MMA(0, 0, At, B0); PG8_BAR; PG8_SCHED;
            PG8_LDB(B1, 0, 1); PG8_STAGE(PG8_SB(0, 0), b2, voffB);
            PG8_BAR; PG8_WAIT_L(0); PG8_MMA(0, 1, At, B1); PG8_BAR;
            PG8_LDA(At, 0, 1); PG8_STAGE(PG8_SA(0, 0), a2, voffA);
            PG8_BAR; PG8_WAIT_L(0); PG8_MMA(1, 0, At, B0); PG8_BAR; PG8_SCHED;
            PG8_STAGE(PG8_SB(0, 1), b2 + hstep, voffB);
            PG8_WAIT_V(6); PG8_BAR; PG8_MMA(1, 1, At, B1); PG8_BAR;
            PG8_LDB(B0, 1, 0); PG8_SCHED; PG8_LDA(At, 1, 0); PG8_STAGE(PG8_SA(0, 1), a2 + hstep, voffA);
            PG8_WAIT_L(8); PG8_BAR; PG8_WAIT_L(0); PG8_MMA(0, 0, At, B0); PG8_BAR; PG8_SCHED;
            PG8_LDB(B1, 1, 1); PG8_STAGE(PG8_SB(1, 0), b3, voffB);
            PG8_BAR; PG8_WAIT_L(0); PG8_MMA(0, 1, At, B1); PG8_BAR;
            PG8_LDA(At, 1, 1); PG8_STAGE(PG8_SA(1, 0), a3, voffA);
            PG8_BAR; PG8_WAIT_L(0); PG8_MMA(1, 0, At, B0); PG8_BAR; PG8_SCHED;
            PG8_STAGE(PG8_SB(1, 1), b3 + hstep, voffB);
            PG8_WAIT_V(6); PG8_BAR; PG8_MMA(1, 1, At, B1); PG8_BAR;
            }
        }
        if constexpr (ALIGN_EPI) { if (wr == 0) PG8_BAR; }
        if constexpr (!Epi::AFTER_DRAIN) { E(acc, cur, wr, wc, fr, fq); S.done(cur); }
        if (!has_next) break;
#pragma unroll
        for (int a = 0; a < 2; ++a)
#pragma unroll
            for (int b = 0; b < 2; ++b)
#pragma unroll
                for (int m = 0; m < 4; ++m)
#pragma unroll
                    for (int n = 0; n < 2; ++n) acc[a][b][m][n] = (f32x4){0.f, 0.f, 0.f, 0.f};
        cur = nxt; cA = nA; cB = nB; ++ui;
        if constexpr (ALIGN_EPI) { if (wr == 1) PG8_BAR; }
    }
    PG8_WAIT_V(0);
    if constexpr (!ALIGN_EPI) { if (wr == 0) PG8_BAR; }
    PG8_BAR;
    if constexpr (Epi::AFTER_DRAIN) { E.fused(acc, cur, wr, wc, fr, fq, lds, wid, lane); S.done(cur); }
#undef PG8_SA
#undef PG8_SB
#undef PG8_STAGE
#undef PG8_LDA
#undef PG8_LDB
#undef PG8_MMA
#undef PG8_WAIT_V
#undef PG8_WAIT_L
#undef PG8_BAR
#undef PG8_SCHED
}
}
constexpr int NWAVES = 8;
constexpr int BATCH = 2, SEQ = 8192, DM = 4096, DFF = 11008, MTOK = BATCH * SEQ;
constexpr int MEMLEN = 256, MROWS = BATCH * MEMLEN;
constexpr float EPS = 1e-6f;
constexpr int NPC = 9984, NPT = NPC / 256;
constexpr int PC_CQ = 0, PC_CKV = 1536, PC_QD = 2048, PC_KD = 3584, PC_VD = 5120, PC_QI = 6656, PC_QM = 8704, PC_KR = 9728, PC_KI = 9792, PC_WI = 9856;
constexpr int NGC = 3 * DM;
constexpr int NIN = NPC + NGC;
constexpr int NGU = 2 * DFF;
constexpr float LOG2E = 1.4426950408889634f;
constexpr float QS_MLA = 0.07216878364870322f * LOG2E;
constexpr float QS_DSA = 0.08838834764831845f * LOG2E;
constexpr float QS_MEM = 0.0625f * LOG2E;
constexpr float LOG2_THETA = 18.931568569324174f;

constexpr size_t MiB = 1u << 20;
constexpr size_t WS_CTL = 0, CTL_ZERO_BYTES = 1 * MiB;
constexpr size_t WS_WGU = 1 * MiB;
constexpr size_t WS_WD = 173 * MiB;
constexpr size_t WS_SC = 1 * MiB;
constexpr size_t WS_WIN = 259 * MiB;
constexpr size_t WS_WUQ = 433 * MiB, WS_WUKV = 440 * MiB, WS_WMKV = 443 * MiB, WS_WOMLA = 459 * MiB, WS_WODSA = 471 * MiB, WS_WOMEM = 483 * MiB, WS_WOUT = 491 * MiB;
constexpr size_t WS_A = 523 * MiB;
constexpr size_t WS_BIG = 651 * MiB;
constexpr size_t WS_HMID = WS_BIG;
constexpr size_t WS_G = WS_BIG;
constexpr size_t WS_P = 1035 * MiB;
constexpr size_t WS_QMLARAW = 1035 * MiB, WS_KVRAW = 1107 * MiB, WS_QMLA = 1203 * MiB, WS_KMLA = 1275 * MiB;
constexpr size_t WS_GS = 1035 * MiB;
constexpr size_t WS_CQN = 1347 * MiB, WS_CKVN = 1395 * MiB, WS_QD = 1411 * MiB, WS_KD = 1459 * MiB, WS_VD = 1507 * MiB, WS_QI = 1555 * MiB, WS_KI = 1619 * MiB, WS_WI = 1621 * MiB, WS_KR = 1623 * MiB, WS_QM = 1625 * MiB;
constexpr size_t WS_YMLA = 1657 * MiB, WS_YDSA = 1705 * MiB, WS_YMEM = 1753 * MiB, WS_BM = 1785 * MiB, WS_MEMN = 1801 * MiB, WS_MKVRAW = 1805 * MiB, WS_MEMK = 1807 * MiB, WS_END = 1808 * MiB;
constexpr size_t SC_BATCH = (size_t)4096 * 8256;
static_assert(WS_SC + 2 * SC_BATCH * 4 <= WS_WIN, "scores fit the FFN weight region");
static_assert(WS_WGU + (size_t)NGU * DM * 2 <= WS_WD && WS_WD + (size_t)DM * DFF * 2 <= WS_WIN, "FFN weights");
static_assert(WS_WIN + (size_t)NIN * DM * 2 <= WS_WUQ, "win");
static_assert(WS_HMID + (size_t)MTOK * DFF * 2 <= WS_P && WS_G + (size_t)MTOK * NGC * 2 <= WS_P && WS_P + (size_t)MTOK * NPC * 2 <= WS_CQN, "big region");
static_assert(WS_GS + (size_t)MTOK * DM * 4 <= WS_CQN, "GS");
constexpr int CW_BAR = 4096, CW_QUEUE = 8192;

constexpr int RING_BYTES = 131072, MISC_OFF = RING_BYTES, LDS_BYTES = 147456;

#define GAS __attribute__((address_space(1)))
#define LAS __attribute__((address_space(3)))
#define DI __device__ __forceinline__
typedef unsigned short bf16;
typedef unsigned v4u __attribute__((ext_vector_type(4)));
typedef unsigned v2u __attribute__((ext_vector_type(2)));
typedef float f32x4 __attribute__((ext_vector_type(4)));
typedef float f32x16 __attribute__((ext_vector_type(16)));
typedef short bf16x8 __attribute__((ext_vector_type(8)));
typedef short s16x4 __attribute__((ext_vector_type(4)));
#define LDS_WAIT() asm volatile("s_waitcnt lgkmcnt(0)" ::: "memory")
DI float bf2f(bf16 v) { return __uint_as_float(((unsigned)v) << 16); }
DI unsigned f2bf(float f) { unsigned u = __float_as_uint(f); return (u + 0x7fffu + ((u >> 16) & 1u)) >> 16; }
DI unsigned pk2(float lo, float hi) { return f2bf(lo) | (f2bf(hi) << 16); }
DI float wave_sum(float v) {
#pragma unroll
    for (int o = 1; o < 64; o <<= 1) v += __shfl_xor(v, o);
    return v;
}
DI void sincos_rev(float ang, float& s, float& c) {
    double rev = (double)ang * 0.15915494309189535; rev -= __builtin_rint(rev);
    const float fr = (float)rev; s = __builtin_amdgcn_sinf(fr); c = __builtin_amdgcn_cosf(fr);
}
DI float inv_freq(int i, int half) { return __builtin_amdgcn_exp2f(-(float)i * (LOG2_THETA / (float)half)); }
#define XB_TMO      128
#define XB_XCNT(j)  (256  + 64 * (j))
#define XB_XSUB(j)  (1280 + 64 * (j))
#define XB_XGEN(j)  (2304 + 64 * (j))
#define XB_TOP      3328
#define XB_TOPGEN   3392
#define XCD_BAR_WORDS 3456
#define XB_SPIN_CAP (1u << 18)

__device__ __forceinline__ unsigned xb_ld(unsigned* p)              { return __hip_atomic_load(p, __ATOMIC_RELAXED, __HIP_MEMORY_SCOPE_AGENT); }
__device__ __forceinline__ unsigned xb_add(unsigned* p, unsigned v) { return __hip_atomic_fetch_add(p, v, __ATOMIC_RELAXED, __HIP_MEMORY_SCOPE_AGENT); }
__device__ __forceinline__ unsigned xb_xcc_id() { return (unsigned)__builtin_amdgcn_s_getreg((3 << 11) | 20) & 0xFu; }
#define XB_SPIN(cond, bar) do { unsigned _sp = 0; while (cond) { __builtin_amdgcn_s_sleep(1); \
    if ((++_sp & 255u) == 0u) { if (xb_ld(&(bar)[XB_TMO])) break; if (_sp > XB_SPIN_CAP) { atomicAdd(&(bar)[XB_TMO], 1u); break; } } } } while (0)

struct XcdBarrier {
    unsigned* bar; unsigned x;
    volatile LAS unsigned* st;
};

__device__ __forceinline__ XcdBarrier xcd_barrier_post(unsigned* bar, volatile LAS unsigned* st) {
    XcdBarrier b; b.bar = bar; b.x = xb_xcc_id(); b.st = st;
    if (threadIdx.x == 0) (void)xb_add(&bar[XB_XCNT(b.x)], 1u);
    return b;
}
__device__ __forceinline__ void xcd_barrier_complete(unsigned* bar, unsigned x, unsigned& nloc, unsigned& nx) {
    const unsigned G = gridDim.x * gridDim.y * gridDim.z;
    unsigned sum, cnt, mine, sp = 0u;
    for (;;) {
        sum = 0u; cnt = 0u; mine = 0u;
#pragma unroll
        for (unsigned j = 0; j < 16; ++j) { const unsigned c = xb_ld(&bar[XB_XCNT(j)]); sum += c; cnt += (c > 0u) ? 1u : 0u; mine = (j == x) ? c : mine; }
        if (sum == G) break;
        __builtin_amdgcn_s_sleep(1);
        if ((++sp & 255u) == 0u) { if (xb_ld(&bar[XB_TMO])) break; if (sp > XB_SPIN_CAP) { atomicAdd(&bar[XB_TMO], 1u); break; } }
    }
    nloc = mine > 0u ? mine : 1u; nx = cnt > 0u ? cnt : 1u;
}

__device__ __forceinline__ void xcd_barrier(const XcdBarrier& b) {
    asm volatile("s_waitcnt vmcnt(0)" ::: "memory");
    __syncthreads();
    if (threadIdx.x == 0) {
        unsigned* bar = b.bar;
        __builtin_amdgcn_s_waitcnt(0);
        unsigned nloc = b.st[0], nx = b.st[1];
        if (nloc == 0u) { xcd_barrier_complete(bar, b.x, nloc, nx); b.st[0] = nloc; b.st[1] = nx; }
        const unsigned old = xb_add(&bar[XB_XSUB(b.x)], 1u);
        const unsigned gen = old / nloc;
        if (old + 1u == (gen + 1u) * nloc) {
            __builtin_amdgcn_fence(__ATOMIC_RELEASE, "agent");
            asm volatile("s_waitcnt vmcnt(0)" ::: "memory");
            const unsigned og = xb_add(&bar[XB_TOP], 1u);
            const unsigned tg = og / nx;
            if (og + 1u == (tg + 1u) * nx) xb_add(&bar[XB_TOPGEN], 1u);
            else XB_SPIN(xb_ld(&bar[XB_TOPGEN]) == tg, bar);
            __builtin_amdgcn_fence(__ATOMIC_ACQUIRE, "agent");
            xb_add(&bar[XB_XGEN(b.x)], 1u);
            asm volatile("s_waitcnt vmcnt(0)" ::: "memory");
        } else {
            XB_SPIN(xb_ld(&bar[XB_XGEN(b.x)]) == gen, bar);
            __builtin_amdgcn_fence(__ATOMIC_ACQUIRE, "agent");
            asm volatile("s_waitcnt vmcnt(0)" ::: "memory");
        }
    }
    __syncthreads();
}
struct Ctx {
    LAS unsigned char* lds;
    int tid, lane, wave, G, gw, NGW;
};
DI Ctx make_ctx(LAS unsigned char* lds) {
    int t = threadIdx.x; asm volatile("" : "+v"(t));
    Ctx C; C.lds = lds; C.tid = t; C.lane = t & 63; C.wave = __builtin_amdgcn_readfirstlane(t >> 6);
    C.G = gridDim.x; C.gw = blockIdx.x * 8 + C.wave; C.NGW = C.G * 8; return C;
}

DI void conv_item(const float* W, int ldw, int col0, int k0, bf16* WT, int K, int drow0, bool zero, LAS float* scr, int lane) {
#pragma unroll 8
    for (int i = 0; i < 32; ++i) { const int kk = 2 * i + (lane >> 5); scr[kk * 33 + (lane & 31)] = zero ? 0.f : W[(size_t)(k0 + kk) * ldw + col0 + (lane & 31)]; }
    LDS_WAIT(); asm volatile("" ::: "memory");
    const int c = lane & 7;
#pragma unroll
    for (int j = 0; j < 4; ++j) { const int n = (lane >> 3) + 8 * j; const LAS float* s = scr + (8 * c) * 33 + n;
        v4u o; o.x = pk2(s[0 * 33], s[1 * 33]); o.y = pk2(s[2 * 33], s[3 * 33]); o.z = pk2(s[4 * 33], s[5 * 33]); o.w = pk2(s[6 * 33], s[7 * 33]);
        *(GAS v4u*)(WT + (size_t)(drow0 + n) * K + k0 + 8 * c) = o; }
    LDS_WAIT(); asm volatile("" ::: "memory");
}
DI int inproj_src(int d) {
    if (d < 2048) return d;
    if (d < 8704) return d + 64;
    if (d < 9728) return d + 160;
    if (d < 9792) return d - 7680;
    if (d < 9888) return d - 1024;
    return -1;
}
DI void conv_ffn(const Ctx& C, const float* wg, const float* wu, const float* wd, bf16* WGUt, bf16* WDt) {
    LAS float* scr = (LAS float*)(C.lds + C.wave * 16384);
    constexpr int I_GU = (DM / 64) * (NGU / 32), I_D = (DFF / 64) * (DM / 32);
    for (int it = C.gw; it < I_GU + I_D; it += C.NGW) {
        if (it < I_GU) { const int nblk = NGU / 32, kb = it / nblk, nb = it % nblk, n0 = nb * 32, pn = n0 >> 8, bj = (n0 >> 7) & 1, c = n0 & 127;
            conv_item(bj ? wu : wg, DFF, 128 * pn + c, 64 * kb, WGUt, DM, n0, false, scr, C.lane); }
        else { const int r = it - I_GU, nblk = DM / 32, kb = r / nblk, nb = r % nblk;
            conv_item(wd, DM, 32 * nb, 64 * kb, WDt, DFF, 32 * nb, false, scr, C.lane); }
    }
}
DI void conv_plain(const Ctx& C, const float* w, int K, int N, bf16* wt, int& base, int total_dummy) { (void)base; (void)total_dummy;
    LAS float* scr = (LAS float*)(C.lds + C.wave * 16384);
    const int nblk = N / 32, items = (K / 64) * nblk;
    for (int it = C.gw; it < items; it += C.NGW) { const int kb = it / nblk, nb = it % nblk; conv_item(w, N, 32 * nb, 64 * kb, wt, K, 32 * nb, false, scr, C.lane); }
}
DI void conv_win(const Ctx& C, const float* w_in, const float* w_gate, bf16* wt) {
    LAS float* scr = (LAS float*)(C.lds + C.wave * 16384);
    constexpr int nblk = NIN / 32, items = (DM / 64) * nblk;
    for (int it = C.gw; it < items; it += C.NGW) { const int kb = it / nblk, nb = it % nblk, n0 = 32 * nb;
        if (n0 < NPC) { const int sc = inproj_src(n0); conv_item(w_in, 9888, sc < 0 ? 0 : sc, 64 * kb, wt, DM, n0, sc < 0, scr, C.lane); }
        else { const int gi = n0 - NPC, br = gi / DM, col = gi % DM; conv_item(w_gate + (size_t)br * DM * DM, DM, col, 64 * kb, wt, DM, n0, false, scr, C.lane); } }
}
DI void rms_row4096(const float* xrow, const float* g, bf16* orow, int lane) {
    const GAS f32x4* xr = (const GAS f32x4*)xrow + lane; const GAS f32x4* gr = (const GAS f32x4*)g + lane;
    f32x4 v[16]; float s = 0.f;
#pragma unroll
    for (int j = 0; j < 16; ++j) { v[j] = xr[64 * j]; s += (v[j].x * v[j].x + v[j].y * v[j].y) + (v[j].z * v[j].z + v[j].w * v[j].w); }
    const float rstd = rsqrtf(wave_sum(s) * (1.f / 4096.f) + EPS);
    GAS v2u* o8 = (GAS v2u*)orow + lane;
#pragma unroll
    for (int j = 0; j < 16; ++j) { const f32x4 gg = gr[64 * j]; v2u o; o.x = pk2(v[j].x * rstd * gg.x, v[j].y * rstd * gg.y); o.y = pk2(v[j].z * rstd * gg.z, v[j].w * rstd * gg.w); o8[64 * j] = o; }
}
DI void rms_rows(const Ctx& C, const float* x, const float* g, bf16* o, int rows) {
    for (int m = C.gw; m < rows; m += C.NGW) rms_row4096(x + (size_t)m * DM, g, o + (size_t)m * DM, C.lane);
}

struct PP1 { const bf16* P; const int* pos; const float *g_cq, *g_ckv, *g_qd, *g_kd, *g_qm;
             bf16 *CQn, *CKVn, *Qd, *Kd, *Vd, *Qi, *Ki, *Kr, *Qm; float* Wi; };
DI void pp1_token(const PP1& A, int t, int lane) {
    const bf16* pr = A.P + (size_t)t * NPC;
    const float pos = (float)A.pos[t];
    float sn_d, cs_d, sn_i, cs_i;
    sincos_rev(pos * inv_freq(lane & 15, 16), sn_d, cs_d);
    sincos_rev(pos * inv_freq(lane & 7, 8), sn_i, cs_i);
    {
        float x[24]; float ss = 0.f;
#pragma unroll
        for (int k = 0; k < 24; ++k) { x[k] = bf2f(pr[PC_CQ + lane + 64 * k]); ss += x[k] * x[k]; }
        const float rstd = rsqrtf(wave_sum(ss) * (1.f / 1536.f) + EPS);
#pragma unroll
        for (int k = 0; k < 24; ++k) A.CQn[(size_t)t * 1536 + lane + 64 * k] = (bf16)f2bf(x[k] * rstd * A.g_cq[lane + 64 * k]);
    }
    {
        float x[8]; float ss = 0.f;
#pragma unroll
        for (int k = 0; k < 8; ++k) { x[k] = bf2f(pr[PC_CKV + lane + 64 * k]); ss += x[k] * x[k]; }
        const float rstd = rsqrtf(wave_sum(ss) * (1.f / 512.f) + EPS);
#pragma unroll
        for (int k = 0; k < 8; ++k) A.CKVn[(size_t)t * 512 + lane + 64 * k] = (bf16)f2bf(x[k] * rstd * A.g_ckv[lane + 64 * k]);
    }
#pragma unroll 1
    for (int qk = 0; qk < 2; ++qk) {
        const int pc = qk ? PC_KD : PC_QD; const float* g = qk ? A.g_kd : A.g_qd; bf16* O = qk ? A.Kd : A.Qd; const float sc = qk ? 1.0f : QS_DSA;
        const float g0 = g[lane], g1 = g[64 + lane];
#pragma unroll 4
        for (int h = 0; h < 12; ++h) {
            const float x0 = bf2f(pr[pc + h * 128 + lane]), x1 = bf2f(pr[pc + h * 128 + 64 + lane]);
            const float rstd = rsqrtf(wave_sum(x0 * x0 + x1 * x1) * (1.f / 128.f) + EPS);
            float y0 = x0 * rstd * g0; const float y1 = x1 * rstd * g1;
            const float pr0 = __shfl_xor(y0, 16);
            if (lane < 16) y0 = y0 * cs_d - pr0 * sn_d; else if (lane < 32) y0 = y0 * cs_d + pr0 * sn_d;
            O[(size_t)t * 1536 + h * 128 + lane] = (bf16)f2bf(y0 * sc); O[(size_t)t * 1536 + h * 128 + 64 + lane] = (bf16)f2bf(y1 * sc);
        }
    }
#pragma unroll
    for (int k = 0; k < 24; ++k) A.Vd[(size_t)t * 1536 + lane + 64 * k] = pr[PC_VD + lane + 64 * k];
#pragma unroll 4
    for (int h = 0; h < 32; ++h) {
        float x = bf2f(pr[PC_QI + h * 64 + lane]); const float px = __shfl_xor(x, 8);
        if (lane < 8) x = x * cs_i - px * sn_i; else if (lane < 16) x = x * cs_i + px * sn_i;
        A.Qi[(size_t)t * 2048 + h * 64 + lane] = (bf16)f2bf(x);
    }
    {
        float x = bf2f(pr[PC_KI + lane]); const float px = __shfl_xor(x, 8);
        if (lane < 8) x = x * cs_i - px * sn_i; else if (lane < 16) x = x * cs_i + px * sn_i;
        A.Ki[(size_t)t * 64 + lane] = (bf16)f2bf(x);
        if (lane < 32) A.Wi[(size_t)t * 32 + lane] = bf2f(pr[PC_WI + lane]);
        A.Kr[(size_t)t * 64 + lane] = pr[PC_KR + lane];
    }
#pragma unroll
    for (int h = 0; h < 4; ++h) {
        float x[4]; float ss = 0.f;
#pragma unroll
        for (int k = 0; k < 4; ++k) { x[k] = bf2f(pr[PC_QM + h * 256 + lane + 64 * k]); ss += x[k] * x[k]; }
        const float rstd = rsqrtf(wave_sum(ss) * (1.f / 256.f) + EPS) * QS_MEM;
#pragma unroll
        for (int k = 0; k < 4; ++k) A.Qm[(size_t)t * 1024 + h * 256 + lane + 64 * k] = (bf16)f2bf(x[k] * rstd * A.g_qm[lane + 64 * k]);
    }
}
struct PP2 { const bf16 *QmlaRaw, *KVraw, *Kr, *MKVraw; const int* pos; const float *g_q, *g_k, *g_km; bf16 *Qmla, *Kmla, *MemK; };
DI void pp2_token(const PP2& A, int t, int lane) {
    const float pos = (float)A.pos[t];
    float sn, cs; sincos_rev(pos * inv_freq(lane & 31, 32), sn, cs);
    const float gq0 = A.g_q[lane], gq1 = A.g_q[64 + lane], gq2 = A.g_q[128 + lane], gk0 = A.g_k[lane], gk1 = A.g_k[64 + lane], gk2 = A.g_k[128 + lane];
    const float kr = bf2f(A.Kr[(size_t)t * 64 + lane]);
#pragma unroll 2
    for (int h = 0; h < 12; ++h) {
        {   const bf16* q = A.QmlaRaw + (size_t)t * 2304 + h * 192;
            const float x0 = bf2f(q[lane]), x1 = bf2f(q[64 + lane]), x2 = bf2f(q[128 + lane]);
            const float rstd = rsqrtf(wave_sum(x0 * x0 + x1 * x1 + x2 * x2) * (1.f / 192.f) + EPS);
            float y0 = x0 * rstd * gq0; const float y1 = x1 * rstd * gq1, y2 = x2 * rstd * gq2;
            const float p0 = __shfl_xor(y0, 32); y0 = (lane < 32) ? y0 * cs - p0 * sn : y0 * cs + p0 * sn;
            bf16* o = A.Qmla + (size_t)t * 2304 + h * 192;
            o[lane] = (bf16)f2bf(y0 * QS_MLA); o[64 + lane] = (bf16)f2bf(y1 * QS_MLA); o[128 + lane] = (bf16)f2bf(y2 * QS_MLA); }
        {   const bf16* kv = A.KVraw + (size_t)t * 3072 + h * 256;
            const float x0 = kr, x1 = bf2f(kv[lane]), x2 = bf2f(kv[64 + lane]);
            const float rstd = rsqrtf(wave_sum(x0 * x0 + x1 * x1 + x2 * x2) * (1.f / 192.f) + EPS);
            float y0 = x0 * rstd * gk0; const float y1 = x1 * rstd * gk1, y2 = x2 * rstd * gk2;
            const float p0 = __shfl_xor(y0, 32); y0 = (lane < 32) ? y0 * cs - p0 * sn : y0 * cs + p0 * sn;
            bf16* o = A.Kmla + (size_t)t * 2304 + h * 192;
            o[lane] = (bf16)f2bf(y0); o[64 + lane] = (bf16)f2bf(y1); o[128 + lane] = (bf16)f2bf(y2); }
    }
}
DI void pp2_memrow(const PP2& A, int r, int lane) {
#pragma unroll
    for (int h = 0; h < 4; ++h) {
        float x[4]; float ss = 0.f;
#pragma unroll
        for (int k = 0; k < 4; ++k) { x[k] = bf2f(A.MKVraw[(size_t)r * 2048 + h * 256 + lane + 64 * k]); ss += x[k] * x[k]; }
        const float rstd = rsqrtf(wave_sum(ss) * (1.f / 256.f) + EPS);
#pragma unroll
        for (int k = 0; k < 4; ++k) A.MemK[(size_t)r * 1024 + h * 256 + lane + 64 * k] = (bf16)f2bf(x[k] * rstd * A.g_km[lane + 64 * k]);
    }
}

#define MFMA32(a, b, c) __builtin_amdgcn_mfma_f32_32x32x16_bf16((a), (b), (c), 0, 0, 0)
DI float half_swap_sum(float v) { auto rr = __builtin_amdgcn_permlane32_swap(__float_as_uint(v), __float_as_uint(v), false, false); return __uint_as_float(rr[0]) + __uint_as_float(rr[1]); }
DI float half_swap_max(float v) { auto rr = __builtin_amdgcn_permlane32_swap(__float_as_uint(v), __float_as_uint(v), false, false); return fmaxf(__uint_as_float(rr[0]), __uint_as_float(rr[1])); }
DI size_t sc_block_off(int b, int bi) { return (size_t)b * SC_BATCH + (size_t)4096 * (size_t)(bi * (bi + 1) / 2); }
DI void idx_item(int p, const bf16* Qi, const bf16* Ki, const float* Wi, float* Sc, int wave, int lane) {
    const int b = p >> 7, r = p & 127, hs = r & 1, k = r >> 1, r32 = lane & 31, hi = lane >> 5;
#pragma unroll 1
    for (int which = 0; which < 2; ++which) {
        const int bi = which ? 127 - k : k, nt32 = (bi + 1) * 2, ncol = (bi + 1) * 64;
        float* scb = Sc + sc_block_off(b, bi);
#pragma unroll 1
        for (int pass = 0; pass < 2; ++pass) {
            const int qa = 32 * hs + 4 * wave + 2 * pass, ta = b * SEQ + bi * 64 + qa;
            bf16x8 A0[4], A1[4]; f32x4 w0[4], w1[4];
#pragma unroll
            for (int d0 = 0; d0 < 4; ++d0) { A0[d0] = *(const bf16x8*)(Qi + (size_t)ta * 2048 + r32 * 64 + d0 * 16 + hi * 8); A1[d0] = *(const bf16x8*)(Qi + (size_t)(ta + 1) * 2048 + r32 * 64 + d0 * 16 + hi * 8); }
#pragma unroll
            for (int g = 0; g < 4; ++g) { w0[g] = *(const f32x4*)(Wi + (size_t)ta * 32 + 8 * g + 4 * hi); w1[g] = *(const f32x4*)(Wi + (size_t)(ta + 1) * 32 + 8 * g + 4 * hi); }
            float* o0 = scb + (size_t)qa * ncol + r32; float* o1 = o0 + ncol;
#pragma unroll 2
            for (int kt = 0; kt < nt32; ++kt) {
                const bf16* kp = Ki + (size_t)(b * SEQ + kt * 32 + r32) * 64 + hi * 8;
                bf16x8 B[4];
#pragma unroll
                for (int d0 = 0; d0 < 4; ++d0) B[d0] = *(const bf16x8*)(kp + d0 * 16);
                f32x16 c0, c1;
#pragma unroll
                for (int i = 0; i < 16; ++i) { c0[i] = 0.f; c1[i] = 0.f; }
#pragma unroll
                for (int d0 = 0; d0 < 4; ++d0) { c0 = MFMA32(A0[d0], B[d0], c0); c1 = MFMA32(A1[d0], B[d0], c1); }
                float s0 = 0.f, s1 = 0.f;
#pragma unroll
                for (int i = 0; i < 16; ++i) { s0 = fmaf(w0[i >> 2][i & 3], fmaxf(c0[i], 0.f), s0); s1 = fmaf(w1[i >> 2][i & 3], fmaxf(c1[i], 0.f), s1); }
                s0 = half_swap_sum(s0); s1 = half_swap_sum(s1);
                if (hi == 0) { o0[kt * 32] = s0; o1[kt * 32] = s1; }
            }
        }
    }
}
DI void select_row(const float* Sc, unsigned long long* BM64, int t, int lane, LAS unsigned* hist, LAS unsigned long long* scr) {
    const int b = t / SEQ, s = t % SEQ, bi = s >> 6, n = (bi + 1) * 64;
    const float* row = Sc + sc_block_off(b, bi) + (size_t)(s & 63) * n;
    unsigned long long* out = BM64 + (size_t)t * 128;
    if (n <= 256) {
        out[lane] = (lane < n / 64) ? ~0ull : 0ull; out[64 + lane] = 0ull; return;
    }
    const int NG = (n + 1023) >> 10;
    unsigned key[128];
#pragma unroll
    for (int g = 0; g < 8; ++g) {
        if (g < NG) {
#pragma unroll
            for (int r = 0; r < 16; ++r) { const int i = 16 * g + r; unsigned kk = 0u; if (64 * i < n) { const unsigned u = __float_as_uint(row[64 * i + lane]); kk = (u & 0x80000000u) ? ~u : (u | 0x80000000u); } key[i] = kk; }
        } else {
#pragma unroll
            for (int r = 0; r < 16; ++r) key[16 * g + r] = 0u;
        }
    }
    unsigned prefix = 0u; int remaining = 256;
#pragma unroll 1
    for (int pass = 0; pass < 4; ++pass) {
        const int shift = 24 - 8 * pass;
        *(LAS v4u*)(hist + 4 * lane) = (v4u){0u, 0u, 0u, 0u};
#pragma unroll
        for (int g = 0; g < 8; ++g) {
            if (g < NG) {
#pragma unroll
                for (int r = 0; r < 16; ++r) { const unsigned k = key[16 * g + r];
                    const bool ok = (pass == 0) || ((k >> ((shift + 8) & 31)) == prefix);
                    if (ok) __hip_atomic_fetch_add(hist + ((k >> shift) & 255u), 1u, __ATOMIC_RELAXED, __HIP_MEMORY_SCOPE_WORKGROUP); }
            }
        }
        LDS_WAIT();
        const v4u bb = *(LAS v4u*)(hist + 4 * lane);
        const int lane_sum = (int)(bb.x + bb.y + bb.z + bb.w);
        int S = lane_sum;
#pragma unroll
        for (int o = 1; o < 64; o <<= 1) { const int tv = __shfl_down(S, o); if (lane + o < 64) S += tv; }
        const int above = S - lane_sum;
        const bool mine = (above < remaining) && (remaining <= S);
        const int c3 = above + (int)bb.w, c2 = c3 + (int)bb.z, c1 = c2 + (int)bb.y;
        int d, cab;
        if (remaining <= c3) { d = 3; cab = above; } else if (remaining <= c2) { d = 2; cab = c3; } else if (remaining <= c1) { d = 1; cab = c2; } else { d = 0; cab = c1; }
        const unsigned long long mb = __ballot(mine);
        const int src = __builtin_amdgcn_readfirstlane((int)__ffsll((long long)mb) - 1) & 63;
        const int D = __builtin_amdgcn_readlane(4 * lane + d, src), CAB = __builtin_amdgcn_readlane(cab, src);
        prefix = (prefix << 8) | (unsigned)D; remaining -= CAB;
        LDS_WAIT();
    }
    const int need = remaining;
    int run = 0;
#pragma unroll
    for (int g = 0; g < 8; ++g) {
        if (g < NG) {
#pragma unroll
            for (int r = 0; r < 16; ++r) { const int i = 16 * g + r;
                const bool gt = key[i] > prefix, eq = key[i] == prefix;
                const unsigned long long eqb = __ballot(eq);
                const int rank = run + (int)__builtin_amdgcn_mbcnt_hi((unsigned)(eqb >> 32), __builtin_amdgcn_mbcnt_lo((unsigned)eqb, 0u));
                const unsigned long long take = __ballot(gt || (eq && rank < need));
                run += __popcll(eqb);
                if (lane == 0) scr[i] = take;
                if ((r & 7) == 7) __builtin_amdgcn_sched_barrier(0); }
        } else { if (lane < 16) scr[16 * g + lane] = 0ull; }
    }
    LDS_WAIT();
    const unsigned long long mine0 = scr[lane], mine1 = scr[64 + lane];
    out[lane] = mine0; out[64 + lane] = mine1;
    LDS_WAIT();
}
typedef short v4i16_t __attribute__((ext_vector_type(4)));
DI s16x4 vtr(const LAS unsigned char* p) { return __builtin_bit_cast(s16x4, __builtin_amdgcn_ds_read_tr16_b64_v4i16((LAS v4i16_t*)p)); }
DI unsigned cvtpk(float lo, float hi) { unsigned r; asm volatile("v_cvt_pk_bf16_f32 %0, %1, %2" : "=v"(r) : "v"(lo), "v"(hi)); return r; }
constexpr int VSTR = 320;
template <int DK> struct AttnLds { static constexpr int KSTR = DK * 2 + 16, KB = 64 * KSTR, VB = 64 * VSTR, K0 = 0, V0 = 2 * KB, TOTAL = 2 * KB + 2 * VB; };
static_assert(AttnLds<256>::TOTAL <= RING_BYTES, "attention LDS");

template <int DK, int MODE>
DI void attn_unit(LAS unsigned char* lds, const bf16* Qp, int LDQ, const bf16* Kp, int LDK, const bf16* Vp, int LDV, bf16* Op, int LDO, int NT, int chunk0, const unsigned* BMrow) {
    typedef AttnLds<DK> L;
    constexpr int ND = DK / 16, KCH = DK / 8, NKC = DK / 64;
    int tid_ = threadIdx.x; asm volatile("" : "+v"(tid_));
    const int tid = tid_, wid = __builtin_amdgcn_readfirstlane(tid >> 6), lane = tid & 63, r32 = lane & 31, hi = lane >> 5;
    const int mychunk = chunk0 + (wid >> 1);
    constexpr bool QLOOP = (DK > 192);
    bf16x8 qr[ND];
    const bf16* qw = Qp + (size_t)(wid * 32 + r32) * LDQ + hi * 8;
    if (!QLOOP) {
#pragma unroll
        for (int d0 = 0; d0 < ND; ++d0) qr[d0] = *(const bf16x8*)(qw + d0 * 16); }
    const unsigned* bmw = (MODE == 1) ? BMrow + (size_t)(wid * 32 + r32) * 256 : nullptr;
    int krow_[NKC], kcc_[NKC];
#pragma unroll
    for (int i = 0; i < NKC; ++i) { const int c = tid + 512 * i; krow_[i] = c / KCH; kcc_[i] = c % KCH; }
    const int vrow0 = tid >> 4, vcc = tid & 15;
    v4u kst[NKC], vst[2];
#define ATT_LOAD(j) do { const int key0_ = (j) * 64; \
        _Pragma("unroll") for (int i_ = 0; i_ < NKC; ++i_) kst[i_] = *(const v4u*)(Kp + (size_t)(key0_ + krow_[i_]) * LDK + kcc_[i_] * 8); \
        vst[0] = *(const v4u*)(Vp + (size_t)(key0_ + vrow0) * LDV + vcc * 8); vst[1] = *(const v4u*)(Vp + (size_t)(key0_ + 32 + vrow0) * LDV + vcc * 8); } while (0)
#define ATT_WRITE(buf) do { \
        _Pragma("unroll") for (int i_ = 0; i_ < NKC; ++i_) *(LAS v4u*)(lds + L::K0 + (buf) * L::KB + krow_[i_] * L::KSTR + kcc_[i_] * 16) = kst[i_]; \
        *(LAS v4u*)(lds + L::V0 + (buf) * L::VB + vrow0 * VSTR + vcc * 16) = vst[0]; *(LAS v4u*)(lds + L::V0 + (buf) * L::VB + (32 + vrow0) * VSTR + vcc * 16) = vst[1]; } while (0)
    float m_run = -1e30f, l_run = 0.f;
    f32x16 o[4];
#pragma unroll
    for (int d = 0; d < 4; ++d)
#pragma unroll
        for (int i = 0; i < 16; ++i) o[d][i] = 0.f;
    const int kbase = r32 * L::KSTR + hi * 16;
    const int q4 = (lane >> 2) & 3, p4 = lane & 3, blk = (lane >> 4) & 1;
    const int vbase = (4 * hi + q4) * VSTR + blk * 32 + p4 * 8;
    ATT_LOAD(0); ATT_WRITE(0);
    __syncthreads();
#pragma unroll 1
    for (int j = 0; j < NT; ++j) {
        const int cur = j & 1;
        const bool active = (MODE == 2) || (j <= mychunk);
        unsigned mw0 = 0xffffffffu, mw1 = 0xffffffffu;
        if (MODE == 1) { if (active) { const v2u mm = *(const v2u*)(bmw + 2 * j); mw0 = mm.x >> (4 * hi); mw1 = mm.y >> (4 * hi); } }
        if (j + 1 < NT) ATT_LOAD(j + 1);
        if (active) {
            f32x16 p0, p1;
#pragma unroll
            for (int i = 0; i < 16; ++i) { p0[i] = 0.f; p1[i] = 0.f; }
            const LAS unsigned char* kb = lds + L::K0 + cur * L::KB + kbase;
            const bf16* qwl = qw; if (QLOOP) asm volatile("" : "+v"(qwl));
#pragma unroll
            for (int d0 = 0; d0 < ND; ++d0) {
                const bf16x8 a0 = *(const LAS bf16x8*)(kb + d0 * 32), a1 = *(const LAS bf16x8*)(kb + 32 * L::KSTR + d0 * 32);
                const bf16x8 qf = QLOOP ? *(const bf16x8*)(qwl + d0 * 16) : qr[d0];
                p0 = MFMA32(a0, qf, p0); p1 = MFMA32(a1, qf, p1);
                if ((d0 & 3) == 3) __builtin_amdgcn_sched_barrier(0);
            }
            if (MODE == 1) {
#pragma unroll
                for (int i = 0; i < 16; ++i) { const unsigned bit = 1u << ((i & 3) + 8 * (i >> 2));
                    p0[i] = (mw0 & bit) ? p0[i] : -INFINITY; p1[i] = (mw1 & bit) ? p1[i] : -INFINITY; }
            }
            float tmax = p0[0];
#pragma unroll
            for (int i = 1; i < 16; ++i) tmax = fmaxf(tmax, p0[i]);
#pragma unroll
            for (int i = 0; i < 16; ++i) tmax = fmaxf(tmax, p1[i]);
            tmax = half_swap_max(tmax);
            const float m_new = fmaxf(m_run, tmax), alpha = __builtin_amdgcn_exp2f(m_run - m_new);
            m_run = m_new;
            float ps = 0.f;
#pragma unroll
            for (int i = 0; i < 16; ++i) { p0[i] = __builtin_amdgcn_exp2f(p0[i] - m_new); ps += p0[i]; }
#pragma unroll
            for (int i = 0; i < 16; ++i) { p1[i] = __builtin_amdgcn_exp2f(p1[i] - m_new); ps += p1[i]; }
            ps = half_swap_sum(ps);
            l_run = l_run * alpha + ps;
            if (__any(alpha < 1.0f)) {
#pragma unroll
                for (int d = 0; d < 4; ++d)
#pragma unroll
                    for (int i = 0; i < 16; ++i) o[d][i] *= alpha;
            }
            bf16x8 pb[4];
#pragma unroll
            for (int s = 0; s < 4; ++s) { v4u w;
                if (s < 2) { w.x = cvtpk(p0[8 * s + 0], p0[8 * s + 1]); w.y = cvtpk(p0[8 * s + 2], p0[8 * s + 3]); w.z = cvtpk(p0[8 * s + 4], p0[8 * s + 5]); w.w = cvtpk(p0[8 * s + 6], p0[8 * s + 7]); }
                else { const int s2 = s - 2; w.x = cvtpk(p1[8 * s2 + 0], p1[8 * s2 + 1]); w.y = cvtpk(p1[8 * s2 + 2], p1[8 * s2 + 3]); w.z = cvtpk(p1[8 * s2 + 4], p1[8 * s2 + 5]); w.w = cvtpk(p1[8 * s2 + 6], p1[8 * s2 + 7]); }
                pb[s] = __builtin_bit_cast(bf16x8, w); }
            const LAS unsigned char* vb = lds + L::V0 + cur * L::VB + vbase;
#pragma unroll
            for (int d0 = 0; d0 < 4; ++d0)
#pragma unroll
                for (int s = 0; s < 4; ++s) {
                    const s16x4 lo = vtr(vb + (16 * s) * VSTR + d0 * 64), hh = vtr(vb + (16 * s + 8) * VSTR + d0 * 64);
                    const bf16x8 va = (bf16x8){lo[0], lo[1], lo[2], lo[3], hh[0], hh[1], hh[2], hh[3]};
                    o[d0] = MFMA32(va, pb[s], o[d0]);
                    if (s == 3) __builtin_amdgcn_sched_barrier(0);
                }
        }
        if (j + 1 < NT) ATT_WRITE(cur ^ 1);
        __syncthreads();
    }
    const float rl = 1.0f / l_run;
    bf16* ow = Op + (size_t)(wid * 32 + r32) * LDO + 4 * hi;
#pragma unroll
    for (int d0 = 0; d0 < 4; ++d0)
#pragma unroll
        for (int g = 0; g < 4; ++g) { v2u w; w.x = cvtpk(o[d0][4 * g] * rl, o[d0][4 * g + 1] * rl); w.y = cvtpk(o[d0][4 * g + 2] * rl, o[d0][4 * g + 3] * rl);
            *(v2u*)(ow + 32 * d0 + 8 * g) = w; }
#undef ATT_LOAD
#undef ATT_WRITE
}
#ifndef MK_MULTI
#define MK_MULTI 0
#endif
#ifndef DBG_SKIP_MIXER
#define DBG_SKIP_MIXER 0
#endif
constexpr int NPH = 16;
#ifndef ATT_MASK
#define ATT_MASK 7
#endif
struct Args { const float* in[30]; float* out; unsigned char* ws; int ph_lo, ph_hi; };
static_assert(sizeof(Args) == 30 * 8 + 8 + 8 + 8, "no padding");

DI void ffn_up_phase(LAS unsigned char* lds, const bf16* A, const bf16* WGUt, bf16* Hmid, int G) {
    pg8::Gemm g{A, WGUt, MTOK, NGU, DM}; pg8::StaticOrder S; S.init(MTOK, NGU, G, (int)blockIdx.x);
    pg8::EpiSwiGLU E{Hmid, DFF};
    pg8::gemm_phase<pg8::EpiSwiGLU, pg8::StaticOrder, true, true>(lds, g, S, E);
}
DI void ffn_down_phase(LAS unsigned char* lds, const bf16* Hmid, const bf16* WDt, const float* base, float* out, int G) {
    pg8::Gemm g{Hmid, WDt, MTOK, DM, DFF}; pg8::StaticOrder S; S.init(MTOK, DM, G, (int)blockIdx.x);
    pg8::EpiResid E{base, out, DM, 0.5f};
    pg8::gemm_phase<pg8::EpiResid, pg8::StaticOrder, true, true>(lds, g, S, E);
}

__global__ void __launch_bounds__(NWAVES * 64, 2) mega_fwd(Args args) {
    extern __shared__ __attribute__((aligned(16))) unsigned char lds_raw[];
    LAS unsigned char* lds = (LAS unsigned char*)lds_raw;
    const int GRID = gridDim.x;
    const __attribute__((address_space(4))) unsigned char* ka = (const __attribute__((address_space(4))) unsigned char*)__builtin_amdgcn_kernarg_segment_ptr();
#define ARGQ(k) (*(void* const __attribute__((address_space(4)))*)(ka + 8 * (k)))
#define ARGP(k) ((const float*)ARGQ(k))
    unsigned char* ws = (unsigned char*)ARGQ(31);
    unsigned* ctl = (unsigned*)(ws + WS_CTL);
    volatile LAS unsigned* MISC = (volatile LAS unsigned*)(lds + MISC_OFF);
    for (int u = threadIdx.x; u < (LDS_BYTES - MISC_OFF) / 4; u += NWAVES * 64) ((LAS unsigned*)(lds + MISC_OFF))[u] = 0u;
    __syncthreads();
    const int lo = *(const __attribute__((address_space(4))) int*)(ka + 256), hi = *(const __attribute__((address_space(4))) int*)(ka + 260);
    XcdBarrier bar; bar.bar = ctl + CW_BAR; bar.x = 0; bar.st = nullptr;
    if (hi - lo > 1) bar = xcd_barrier_post(ctl + CW_BAR, MISC);
#ifndef PH_MASK
#define PH_MASK 0xffff
#endif
#define IN(k) ((((PH_MASK) >> (k)) & 1) && lo <= (k) && (k) < hi)
#define SEAM(k) do { if (IN(k) && IN((k) + 1)) xcd_barrier(bar); } while (0)
#ifndef REPEAT_MASK
#define REPEAT_MASK 0
#endif
#define NREP(k) (1 + (((REPEAT_MASK) >> (k)) & 1))
#define REPBAR(k) do { if (((REPEAT_MASK) >> (k)) & 1) xcd_barrier(bar); } while (0)

#define WGUt ((bf16*)(ws + WS_WGU))
#define WDt ((bf16*)(ws + WS_WD))
#define WINt ((bf16*)(ws + WS_WIN))
#define WUQt ((bf16*)(ws + WS_WUQ))
#define WUKVt ((bf16*)(ws + WS_WUKV))
#define WMKVt ((bf16*)(ws + WS_WMKV))
#define WOMLAt ((bf16*)(ws + WS_WOMLA))
#define WODSAt ((bf16*)(ws + WS_WODSA))
#define WOMEMt ((bf16*)(ws + WS_WOMEM))
#define WOUTt ((bf16*)(ws + WS_WOUT))
#define Abuf ((bf16*)(ws + WS_A))
#define Hmid ((bf16*)(ws + WS_HMID))
#define Gt ((bf16*)(ws + WS_G))
#define Pbuf ((bf16*)(ws + WS_P))
#define QmlaRaw ((bf16*)(ws + WS_QMLARAW))
#define KVraw ((bf16*)(ws + WS_KVRAW))
#define Qmla ((bf16*)(ws + WS_QMLA))
#define Kmla ((bf16*)(ws + WS_KMLA))
#define GS ((float*)(ws + WS_GS))
#define CQn ((bf16*)(ws + WS_CQN))
#define CKVn ((bf16*)(ws + WS_CKVN))
#define Qd ((bf16*)(ws + WS_QD))
#define Kd ((bf16*)(ws + WS_KD))
#define Vd ((bf16*)(ws + WS_VD))
#define Qi ((bf16*)(ws + WS_QI))
#define Ki ((bf16*)(ws + WS_KI))
#define Wi ((float*)(ws + WS_WI))
#define Kr ((bf16*)(ws + WS_KR))
#define Qm ((bf16*)(ws + WS_QM))
#define Ymla ((bf16*)(ws + WS_YMLA))
#define Ydsa ((bf16*)(ws + WS_YDSA))
#define Ymem ((bf16*)(ws + WS_YMEM))
#define BM ((unsigned*)(ws + WS_BM))
#define memn ((bf16*)(ws + WS_MEMN))
#define MKVraw ((bf16*)(ws + WS_MKVRAW))
#define MemK ((bf16*)(ws + WS_MEMK))
#define Sc ((float*)(ws + WS_SC))
#define X_IN (ARGP(0))
#define MEM_IN (ARGP(1))
#define POS_IN ((const int*)ARGP(2))
#define XRES ((float*)ARGQ(30))
    for (int rep_ = 0; rep_ < NREP(0); ++rep_) { if (rep_) REPBAR(0); if (IN(0)) { const Ctx C = make_ctx(lds);
        conv_ffn(C, ARGP(4), ARGP(5), ARGP(6), WGUt, WDt);
#if !DBG_SKIP_MIXER
        conv_win(C, ARGP(8), ARGP(24), WINt);
        int dummy = 0;
        conv_plain(C, ARGP(10), 1536, 2304, WUQt, dummy, 0);
        conv_plain(C, ARGP(12), 512, 3072, WUKVt, dummy, 0);
        conv_plain(C, ARGP(18), 4096, 2048, WMKVt, dummy, 0);
        conv_plain(C, ARGP(21), 1536, 4096, WOMLAt, dummy, 0);
        conv_plain(C, ARGP(22), 1536, 4096, WODSAt, dummy, 0);
        conv_plain(C, ARGP(23), 1024, 4096, WOMEMt, dummy, 0);
        conv_plain(C, ARGP(25), 4096, 4096, WOUTt, dummy, 0);
        rms_rows(C, MEM_IN, ARGP(17), memn, MROWS);
#endif
        rms_rows(C, X_IN, ARGP(3), Abuf, MTOK);
    }
    }
    SEAM(0);
    for (int rep_ = 0; rep_ < NREP(1); ++rep_) { if (rep_) REPBAR(1); if (IN(1)) ffn_up_phase(lds, Abuf, WGUt, Hmid, GRID);
    }
    SEAM(1);
    for (int rep_ = 0; rep_ < NREP(2); ++rep_) { if (rep_) REPBAR(2); if (IN(2)) ffn_down_phase(lds, Hmid, WDt, X_IN, XRES, GRID);
    }
    SEAM(2);
#if !DBG_SKIP_MIXER
    if (IN(3)) { const Ctx C = make_ctx(lds); rms_rows(C, XRES, ARGP(7), Abuf, MTOK); }
    SEAM(3);
    for (int rep_ = 0; rep_ < NREP(4); ++rep_) { if (rep_) REPBAR(4); if (IN(4)) {
        pg8::Gemm g{Abuf, WINt, MTOK, NIN, DM}; pg8::StaticOrder S; S.init(MTOK, NIN, GRID, (int)blockIdx.x);
        pg8::EpiInProj E{Pbuf, NPC, NPT, Gt, NGC};
        pg8::gemm_phase<pg8::EpiInProj, pg8::StaticOrder, true, true>(lds, g, S, E);
    }
    }
    SEAM(4);
    for (int rep_ = 0; rep_ < NREP(5); ++rep_) { if (rep_) REPBAR(5); if (IN(5)) { const Ctx C = make_ctx(lds);
        PP1 A{Pbuf, POS_IN, ARGP(9), ARGP(11), ARGP(15), ARGP(16), ARGP(19), CQn, CKVn, Qd, Kd, Vd, Qi, Ki, Kr, Qm, Wi};
        for (int t = C.gw; t < MTOK; t += C.NGW) pp1_token(A, t, C.lane);
    }
    }
    SEAM(5);
    for (int rep_ = 0; rep_ < NREP(6); ++rep_) { if (rep_) REPBAR(6); if (IN(6)) {
        { pg8::Gemm g{CQn, WUQt, MTOK, 2304, 1536}; pg8::StaticOrder S; S.init(MTOK, 2304, GRID, (int)blockIdx.x); pg8::EpiPlain E{QmlaRaw, 2304};
          pg8::gemm_phase<pg8::EpiPlain, pg8::StaticOrder, true, true>(lds, g, S, E); }
        { pg8::Gemm g{CKVn, WUKVt, MTOK, 3072, 512}; pg8::StaticOrder S; S.init(MTOK, 3072, GRID, (int)blockIdx.x); pg8::EpiPlain E{KVraw, 3072};
          pg8::gemm_phase<pg8::EpiPlain, pg8::StaticOrder, true, true>(lds, g, S, E); }
        { pg8::Gemm g{memn, WMKVt, MROWS, 2048, DM}; pg8::StaticOrder S; S.init(MROWS, 2048, GRID, (int)blockIdx.x); pg8::EpiPlain E{MKVraw, 2048};
          pg8::gemm_phase<pg8::EpiPlain, pg8::StaticOrder, true, true>(lds, g, S, E); }
    }
    }
    SEAM(6);
    for (int rep_ = 0; rep_ < NREP(7); ++rep_) { if (rep_) REPBAR(7); if (IN(7)) { const Ctx C = make_ctx(lds);
        PP2 A{QmlaRaw, KVraw, Kr, MKVraw, POS_IN, ARGP(13), ARGP(14), ARGP(20), Qmla, Kmla, MemK};
        for (int t = C.gw; t < MTOK; t += C.NGW) pp2_token(A, t, C.lane);
        for (int r = C.gw; r < MROWS; r += C.NGW) pp2_memrow(A, r, C.lane);
    }
    }
    SEAM(7);
    for (int rep_ = 0; rep_ < NREP(8); ++rep_) { if (rep_) REPBAR(8); if (IN(8)) { const Ctx C = make_ctx(lds); for (int p = blockIdx.x; p < 256; p += GRID) idx_item(p, Qi, Ki, Wi, Sc, C.wave, C.lane); }
    }
    SEAM(8);
    for (int rep_ = 0; rep_ < NREP(9); ++rep_) { if (rep_) REPBAR(9); if (IN(9)) { const Ctx C = make_ctx(lds); for (int t = C.gw; t < MTOK; t += C.NGW) select_row(Sc, (unsigned long long*)BM, t, C.lane, (LAS unsigned*)(lds + C.wave * 2048), (LAS unsigned long long*)(lds + C.wave * 2048 + 1024)); }
    }
    SEAM(9);
    for (int rep_ = 0; rep_ < NREP(10); ++rep_) { if (rep_) REPBAR(10); if (IN(10)) {
        for (;;) {
            if (threadIdx.x == 0) MISC[4] = __hip_atomic_fetch_add(ctl + CW_QUEUE + 64 * rep_, 1u, __ATOMIC_RELAXED, __HIP_MEMORY_SCOPE_AGENT);
            __syncthreads();
            const int u = __builtin_amdgcn_readfirstlane((int)MISC[4]);
            __syncthreads();
            if (u >= 2048) break;
            if (u < 1536) {
                const int qt = 31 - u / 48, r = u % 48, type = r / 24, bh = r % 24, b = bh / 12, h = bh % 12;
                const size_t row0 = (size_t)b * SEQ + 256 * qt, krow0 = (size_t)b * SEQ;
                if (type == 0) { if (ATT_MASK & 1) attn_unit<192, 0>(lds, Qmla + row0 * 2304 + h * 192, 2304, Kmla + krow0 * 2304 + h * 192, 2304, KVraw + krow0 * 3072 + h * 256 + 128, 3072,
                                                 Ymla + row0 * 1536 + h * 128, 1536, 4 * qt + 4, 4 * qt, nullptr); }
                else if (ATT_MASK & 2) attn_unit<128, 1>(lds, Qd + row0 * 1536 + h * 128, 1536, Kd + krow0 * 1536 + h * 128, 1536, Vd + krow0 * 1536 + h * 128, 1536,
                                       Ydsa + row0 * 1536 + h * 128, 1536, 4 * qt + 4, 4 * qt, BM + row0 * 256);
            } else {
                const int v = u - 1536, b = v >> 8, h = (v >> 6) & 3, qt = (v >> 1) & 31, dvh = v & 1;
                const size_t row0 = (size_t)b * SEQ + 256 * qt, krow0 = (size_t)b * MEMLEN;
                if (ATT_MASK & 4) attn_unit<256, 2>(lds, Qm + row0 * 1024 + h * 256, 1024, MemK + krow0 * 1024 + h * 256, 1024, MKVraw + krow0 * 2048 + 1024 + h * 256 + dvh * 128, 2048,
                                  Ymem + row0 * 1024 + h * 256 + dvh * 128, 1024, 4, 0, nullptr);
            }
        }
    }
    }
    SEAM(10);
    for (int rep_ = 0; rep_ < NREP(11); ++rep_) { if (rep_) REPBAR(11); if (IN(11)) {
        { pg8::Gemm g{Ymla, WOMLAt, MTOK, DM, 1536}; pg8::StaticOrder S; S.init(MTOK, DM, GRID, (int)blockIdx.x); pg8::EpiGate<0> E{Gt, NGC, 0, GS, Abuf, DM};
          pg8::gemm_phase<pg8::EpiGate<0>, pg8::StaticOrder, true, true>(lds, g, S, E); }
        { pg8::Gemm g{Ydsa, WODSAt, MTOK, DM, 1536}; pg8::StaticOrder S; S.init(MTOK, DM, GRID, (int)blockIdx.x); pg8::EpiGate<1> E{Gt, NGC, DM, GS, Abuf, DM};
          pg8::gemm_phase<pg8::EpiGate<1>, pg8::StaticOrder, true, true>(lds, g, S, E); }
        { pg8::Gemm g{Ymem, WOMEMt, MTOK, DM, 1024}; pg8::StaticOrder S; S.init(MTOK, DM, GRID, (int)blockIdx.x); pg8::EpiGate<2> E{Gt, NGC, 2 * DM, GS, Abuf, DM};
          pg8::gemm_phase<pg8::EpiGate<2>, pg8::StaticOrder, true, true>(lds, g, S, E); }
    }
    }
    SEAM(11);
    if (IN(12)) {
        pg8::Gemm g{Abuf, WOUTt, MTOK, DM, DM}; pg8::StaticOrder S; S.init(MTOK, DM, GRID, (int)blockIdx.x); pg8::EpiResid E{XRES, XRES, DM, 1.0f};
        pg8::gemm_phase<pg8::EpiResid, pg8::StaticOrder, true, true>(lds, g, S, E);
    }
    SEAM(12);
#endif
    if (IN(13)) { const Ctx C = make_ctx(lds); conv_ffn(C, ARGP(27), ARGP(28), ARGP(29), WGUt, WDt); rms_rows(C, XRES, ARGP(26), Abuf, MTOK); }
    SEAM(13);
    if (IN(14)) ffn_up_phase(lds, Abuf, WGUt, Hmid, GRID);
    SEAM(14);
    if (IN(15)) ffn_down_phase(lds, Hmid, WDt, XRES, XRES, GRID);
#undef IN
#undef SEAM
}

#undef WGUt
#undef WDt
#undef WINt
#undef WUQt
#undef WUKVt
#undef WMKVt
#undef WOMLAt
#undef WODSAt
#undef WOMEMt
#undef WOUTt
#undef Abuf
#undef Hmid
#undef Gt
#undef Pbuf
#undef QmlaRaw
#undef KVraw
#undef Qmla
#undef Kmla
#undef GS
#undef CQn
#undef CKVn
#undef Qd
#undef Kd
#undef Vd
#undef Qi
#undef Ki
#undef Wi
#undef Kr
#undef Qm
#undef Ymla
#undef Ydsa
#undef Ymem
#undef BM
#undef memn
#undef MKVraw
#undef MemK
#undef Sc
#undef X_IN
#undef MEM_IN
#undef POS_IN
#undef XRES
#undef ARGQ
#undef ARGP
extern "C" void kernel_launch(void* const* d_in, const int* in_sizes, int n_in, void* d_out, int out_size, void* d_ws, size_t ws_size, hipStream_t stream) {
    static int grid = 0;
    if (grid == 0) {
        if (n_in != 30 || in_sizes[0] != MTOK * DM || out_size != MTOK * DM || ws_size < WS_END) {
            fprintf(stderr, "kernel_launch: built for 30 inputs, x/out of %d floats, >= %zu bytes of workspace; got n_in %d, in0 %d, out %d, ws %zu; nothing launched\n", MTOK * DM, (size_t)WS_END, n_in, n_in > 0 ? in_sizes[0] : -1, out_size, ws_size);
            grid = -1; return; }
        int dev = 0, cus = 0, per_cu = 0;
        if (hipGetDevice(&dev) != hipSuccess || hipDeviceGetAttribute(&cus, hipDeviceAttributeMultiprocessorCount, dev) != hipSuccess) { fprintf(stderr, "kernel_launch: device query failed\n"); grid = -1; return; }
        if (hipFuncSetAttribute((const void*)mega_fwd, hipFuncAttributeMaxDynamicSharedMemorySize, LDS_BYTES) != hipSuccess) { fprintf(stderr, "kernel_launch: hipFuncSetAttribute failed\n"); grid = -1; return; }
        if (hipOccupancyMaxActiveBlocksPerMultiprocessor(&per_cu, (const void*)mega_fwd, NWAVES * 64, LDS_BYTES) != hipSuccess || per_cu < 1)
            fprintf(stderr, "kernel_launch: note: occupancy query reports %d workgroups per CU\n", per_cu);
        (void)hipGetLastError();
        grid = cus;
    }
    if (grid < 0) return;
    if (hipMemsetAsync((char*)d_ws + WS_CTL, 0, CTL_ZERO_BYTES, stream) != hipSuccess) { fprintf(stderr, "kernel_launch: memset failed\n"); return; }
    Args a{};
    for (int i = 0; i < 30; ++i) a.in[i] = (const float*)d_in[i];
    a.out = (float*)d_out; a.ws = (unsigned char*)d_ws;
#if MK_MULTI
    for (int k = 0; k < NPH; ++k) { a.ph_lo = k; a.ph_hi = k + 1; hipLaunchKernelGGL(mega_fwd, dim3(grid), dim3(NWAVES * 64), LDS_BYTES, stream, a); }
#else
    a.ph_lo = 0; a.ph_hi = NPH;
    hipLaunchKernelGGL(mega_fwd, dim3(grid), dim3(NWAVES * 64), LDS_BYTES, stream, a);
#endif
    const hipError_t le = hipPeekAtLastError();
    if (le != hipSuccess) fprintf(stderr, "kernel_launch: launch failed: %s\n", hipGetErrorName(le));
}
```

```cpp
#include <hip/hip_runtime.h>
#include <cstdio>
#include <cstdint>
namespace pg8 {
#define PG8_LAS __attribute__((address_space(3)))
typedef unsigned short bf16_t;
typedef short bf16x8 __attribute__((ext_vector_type(8)));
typedef float f32x4 __attribute__((ext_vector_type(4)));
typedef unsigned u32x4 __attribute__((ext_vector_type(4)));
constexpr int BM = 256, BK = 64, HALF = 128, HTB = HALF * BK * 2  , STAGE_BYTES = 8 * HTB, NXCD = 8, WGM = 8;

__host__ __device__ __forceinline__ int lds_byte(int r, int c) { const int st = (r >> 4) * 2 + (c >> 5), rr = r & 15, cc = c & 31, ob = rr * 64 + cc * 2; return st * 1024 + (ob ^ (((ob >> 9) & 1) << 5)); }
__host__ __device__ __forceinline__ void stage_rc(int b, int& R, int& C) { const int st = b / 1024, sb = b % 1024, swz = sb ^ (((sb >> 9) & 1) << 5); R = (st >> 1) * 16 + swz / 64; C = (st & 1) * 32 + (swz % 64) / 2; }
__host__ __device__ __forceinline__ int perm32(int rho) { const int n = rho >> 4, i = rho & 15; return 8 * (i >> 2) + 4 * n + (i & 3); }

struct Unit { int pm, pn; };
struct Gemm { const bf16_t* A; const bf16_t* Bt; int M, N, K; };

struct StaticOrder {
    int nM, nN, nwg, G, c;
    __host__ __device__ void init(int M, int N, int G_, int c_) { nM = M / BM; nN = N / BM; nwg = nM * nN; G = G_; c = c_; }
    __host__ __device__ bool next(int i, Unit& u) const {
        const long L = (long)i * G + c; if (L >= nwg) return false;
        int wgid = (int)L; { const int q = nwg / NXCD, r = nwg % NXCD, xcd = wgid % NXCD, off = wgid / NXCD; wgid = (xcd < r ? xcd * (q + 1) : r * (q + 1) + (xcd - r) * q) + off; }
        const int nig = WGM * nN, gid = wgid / nig, fm = gid * WGM, gsz = (nM - fm) < WGM ? (nM - fm) : WGM;
        u.pm = fm + ((wgid % nig) % gsz); u.pn = (wgid % nig) / gsz; return true;
    }
    __device__ __forceinline__ void a_ready(const Unit&) const {}
    __device__ __forceinline__ void done(const Unit&) const {}
};
__device__ __forceinline__ unsigned cvt_pk_bf16(float lo, float hi) { unsigned r; asm volatile("v_cvt_pk_bf16_f32 %0, %1, %2" : "=v"(r) : "v"(lo), "v"(hi)); return r; }
__device__ __forceinline__ float sigmoid_f(float x) { return __builtin_amdgcn_rcpf(1.0f + __builtin_amdgcn_exp2f(-1.4426950408889634f * x)); }
struct EpiPlain {
    static constexpr bool PERM = true, AFTER_DRAIN = false;
    bf16_t* O; int ldc;
    __device__ __forceinline__ void operator()(const f32x4 (&acc)[2][2][4][2], const Unit& u, int wr, int wc, int fr, int fq) const {
        const int row0 = u.pm * BM + wr * 64 + fr, col0 = u.pn * BM + wc * 32 + 8 * fq;
#pragma unroll
        for (int ai = 0; ai < 2; ++ai)
#pragma unroll
            for (int m = 0; m < 4; ++m) { bf16_t* rowp = O + (size_t)(row0 + ai * HALF + m * 16) * ldc + col0;
#pragma unroll
                for (int bj = 0; bj < 2; ++bj) { const f32x4 v0 = acc[ai][bj][m][0], v1 = acc[ai][bj][m][1];
                    u32x4 w; w.x = cvt_pk_bf16(v0[0], v0[1]); w.y = cvt_pk_bf16(v0[2], v0[3]); w.z = cvt_pk_bf16(v1[0], v1[1]); w.w = cvt_pk_bf16(v1[2], v1[3]);
                    *(u32x4*)(rowp + bj * HALF) = w; } }
    }
};
struct EpiSwiGLU {
    static constexpr bool PERM = true, AFTER_DRAIN = false;
    bf16_t* O; int ldc;
    __device__ __forceinline__ void operator()(const f32x4 (&acc)[2][2][4][2], const Unit& u, int wr, int wc, int fr, int fq) const {
        const int row0 = u.pm * BM + wr * 64 + fr, col0 = u.pn * HALF + wc * 32 + 8 * fq;
#pragma unroll
        for (int ai = 0; ai < 2; ++ai)
#pragma unroll
            for (int m = 0; m < 4; ++m) { bf16_t* rowp = O + (size_t)(row0 + ai * HALF + m * 16) * ldc + col0;
                f32x4 r0, r1;
#pragma unroll
                for (int j = 0; j < 4; ++j) { const float g0 = acc[ai][0][m][0][j], g1 = acc[ai][0][m][1][j];
                    r0[j] = g0 * sigmoid_f(g0) * acc[ai][1][m][0][j]; r1[j] = g1 * sigmoid_f(g1) * acc[ai][1][m][1][j]; }
                u32x4 w; w.x = cvt_pk_bf16(r0[0], r0[1]); w.y = cvt_pk_bf16(r0[2], r0[3]); w.z = cvt_pk_bf16(r1[0], r1[1]); w.w = cvt_pk_bf16(r1[2], r1[3]);
                *(u32x4*)rowp = w; }
    }
};
struct EpiResid {
    static constexpr bool PERM = false, AFTER_DRAIN = false;
    const float* base; float* out; int ldc; float scale;
    __device__ __forceinline__ void operator()(const f32x4 (&acc)[2][2][4][2], const Unit& u, int wr, int wc, int fr, int fq) const {
        const int row0 = u.pm * BM + wr * 64 + fr, col0 = u.pn * BM + wc * 32 + 4 * fq;
#pragma unroll
        for (int ai = 0; ai < 2; ++ai)
#pragma unroll
            for (int m = 0; m < 4; ++m) { const size_t off = (size_t)(row0 + ai * HALF + m * 16) * ldc + col0;
#pragma unroll
                for (int bj = 0; bj < 2; ++bj)
#pragma unroll
                    for (int n = 0; n < 2; ++n) { const f32x4 b = *(const f32x4*)(base + off + bj * HALF + n * 16);
                        *(f32x4*)(out + off + bj * HALF + n * 16) = b + acc[ai][bj][m][n] * scale; } }
    }
};
struct EpiInProj {
    static constexpr bool PERM = true, AFTER_DRAIN = false;
    bf16_t* P; int ldp; int np; bf16_t* G; int ldg;
    __device__ __forceinline__ void operator()(const f32x4 (&acc)[2][2][4][2], const Unit& u, int wr, int wc, int fr, int fq) const {
        const int row0 = u.pm * BM + wr * 64 + fr; const bool isg = u.pn >= np;
        bf16_t* O = isg ? G : P; const int ldc = isg ? ldg : ldp; const int col0 = (isg ? u.pn - np : u.pn) * BM + wc * 32 + 8 * fq;
#pragma unroll
        for (int ai = 0; ai < 2; ++ai)
#pragma unroll
            for (int m = 0; m < 4; ++m) { bf16_t* rowp = O + (size_t)(row0 + ai * HALF + m * 16) * ldc + col0;
#pragma unroll
                for (int bj = 0; bj < 2; ++bj) { f32x4 v0 = acc[ai][bj][m][0], v1 = acc[ai][bj][m][1];
                    if (isg) {
#pragma unroll
                        for (int j = 0; j < 4; ++j) { v0[j] = sigmoid_f(v0[j]); v1[j] = sigmoid_f(v1[j]); } }
                    u32x4 w; w.x = cvt_pk_bf16(v0[0], v0[1]); w.y = cvt_pk_bf16(v0[2], v0[3]); w.z = cvt_pk_bf16(v1[0], v1[1]); w.w = cvt_pk_bf16(v1[2], v1[3]);
                    *(u32x4*)(rowp + bj * HALF) = w; } }
    }
};
template <int BR> struct EpiGate {
    static constexpr bool PERM = true, AFTER_DRAIN = false;
    const bf16_t* G; int ldg; int gcol0; float* GS; bf16_t* GSb; int ld;
    __device__ __forceinline__ void operator()(const f32x4 (&acc)[2][2][4][2], const Unit& u, int wr, int wc, int fr, int fq) const {
        const int row0 = u.pm * BM + wr * 64 + fr, col0 = u.pn * BM + wc * 32 + 8 * fq;
#pragma unroll
        for (int ai = 0; ai < 2; ++ai)
#pragma unroll
            for (int m = 0; m < 4; ++m) { const int row = row0 + ai * HALF + m * 16;
#pragma unroll
                for (int bj = 0; bj < 2; ++bj) { const int col = col0 + bj * HALF;
                    const u32x4 gw = *(const u32x4*)(G + (size_t)row * ldg + gcol0 + col);
                    f32x4 g0, g1;
                    g0[0] = __uint_as_float(gw.x << 16); g0[1] = __uint_as_float(gw.x & 0xffff0000u); g0[2] = __uint_as_float(gw.y << 16); g0[3] = __uint_as_float(gw.y & 0xffff0000u);
                    g1[0] = __uint_as_float(gw.z << 16); g1[1] = __uint_as_float(gw.z & 0xffff0000u); g1[2] = __uint_as_float(gw.w << 16); g1[3] = __uint_as_float(gw.w & 0xffff0000u);
                    f32x4 t0 = g0 * acc[ai][bj][m][0], t1 = g1 * acc[ai][bj][m][1];
                    float* gp = GS + (size_t)row * ld + col;
                    if (BR >= 1) { t0 = t0 + *(const f32x4*)gp; t1 = t1 + *(const f32x4*)(gp + 4); }
                    if (BR <= 1) { *(f32x4*)gp = t0; *(f32x4*)(gp + 4) = t1; }
                    else { u32x4 w; w.x = cvt_pk_bf16(t0[0], t0[1]); w.y = cvt_pk_bf16(t0[2], t0[3]); w.z = cvt_pk_bf16(t1[0], t1[1]); w.w = cvt_pk_bf16(t1[2], t1[3]);
                        *(u32x4*)(GSb + (size_t)row * ld + col) = w; } } }
    }
};
template <class Epi, class Sched, bool ALIGN_EPI = false, bool SP2 = false>
__device__ __forceinline__ void gemm_phase(PG8_LAS unsigned char* lds, const Gemm g, const Sched& S, const Epi& E) {
    int tid_ = threadIdx.x; asm volatile("" : "+v"(tid_));
    const int tid = tid_, wid = __builtin_amdgcn_readfirstlane(tid >> 6), lane = tid & 63, wr = wid >> 2, wc = wid & 3, fr = lane & 15, fq = lane >> 4;
    const int K = g.K, nt = K / BK;
    unsigned voffA[2], voffB[2];
#pragma unroll
    for (int i = 0; i < 2; ++i) { int R, C; stage_rc(tid * 16 + i * 8192, R, C); const int Rb = Epi::PERM ? ((R & ~31) + perm32(R & 31)) : R;
        voffA[i] = (unsigned)(R * K + C) * 2u; voffB[i] = (unsigned)(Rb * K + C) * 2u; }
    const size_t kstep = (size_t)(BK * 2);
    const size_t hstep = (size_t)HALF * K * 2;
    const size_t tstep = 2 * hstep;
    const unsigned ldsw = (unsigned)wid * 1024u;
    const int aoff = lds_byte(wr * 64 + fr, fq * 8), boff = lds_byte(wc * 32 + fr, fq * 8);
#define PG8_SA(b, h) (((b) * 2 + (h)) * HTB)
#define PG8_SB(b, h) ((4 + (b) * 2 + (h)) * HTB)
#define PG8_STAGE(bufoff, gbase, voff) do { _Pragma("unroll") for (int _i = 0; _i < 2; ++_i) \
        __builtin_amdgcn_global_load_lds((const unsigned*)((const char*)(gbase) + (voff)[_i]), (PG8_LAS unsigned*)(lds + (bufoff) + ldsw + _i * 8192), 16, 0, 0); } while (0)
#define PG8_LDA(dst, b, h) do { _Pragma("unroll") for (int m = 0; m < 4; ++m) _Pragma("unroll") for (int k = 0; k < 2; ++k) dst[m][k] = *(const PG8_LAS bf16x8*)(lds + PG8_SA(b, h) + aoff + m * 2048 + k * 1024); } while (0)
#define PG8_LDB(dst, b, h) do { _Pragma("unroll") for (int n = 0; n < 2; ++n) _Pragma("unroll") for (int k = 0; k < 2; ++k) dst[n][k] = *(const PG8_LAS bf16x8*)(lds + PG8_SB(b, h) + boff + n * 2048 + k * 1024); } while (0)
#define PG8_MMA(ai, bj, At, Bt) do { __builtin_amdgcn_s_setprio(1); _Pragma("unroll") for (int m = 0; m < 4; ++m) _Pragma("unroll") for (int n = 0; n < 2; ++n) _Pragma("unroll") for (int k = 0; k < 2; ++k) \
        acc[ai][bj][m][n] = __builtin_amdgcn_mfma_f32_16x16x32_bf16(Bt[n][k], At[m][k], acc[ai][bj][m][n], 0, 0, 0); __builtin_amdgcn_s_setprio(0); } while (0)
#define PG8_WAIT_V(n) asm volatile("s_waitcnt vmcnt(" #n ")" ::: "memory")
#define PG8_WAIT_L(n) asm volatile("s_waitcnt lgkmcnt(" #n ")" ::: "memory")
#define PG8_BAR __builtin_amdgcn_s_barrier()
#define PG8_SCHED __builtin_amdgcn_sched_barrier(0)
    Unit cur, nxt; int ui = 0;
    if (!S.next(0, cur)) return;
    f32x4 acc[2][2][4][2];
#pragma unroll
    for (int a = 0; a < 2; ++a)
#pragma unroll
        for (int b = 0; b < 2; ++b)
#pragma unroll
            for (int m = 0; m < 4; ++m)
#pragma unroll
                for (int n = 0; n < 2; ++n) acc[a][b][m][n] = (f32x4){0.f, 0.f, 0.f, 0.f};
    bf16x8 At[4][2], B0[2][2], B1[2][2];
    const char* cA = (const char*)g.A + (size_t)cur.pm * tstep; const char* cB = (const char*)g.Bt + (size_t)cur.pn * tstep;
    S.a_ready(cur);
    if constexpr (SP2) {
        PG8_STAGE(PG8_SB(0, 0), cB, voffB); PG8_STAGE(PG8_SB(0, 1), cB + hstep, voffB); PG8_STAGE(PG8_SA(0, 0), cA, voffA); PG8_STAGE(PG8_SA(0, 1), cA + hstep, voffA);
        if (wr == 1) PG8_BAR;
        PG8_WAIT_V(2); PG8_BAR;
        PG8_STAGE(PG8_SB(1, 0), cB + kstep, voffB); PG8_STAGE(PG8_SA(1, 0), cA + kstep, voffA); PG8_STAGE(PG8_SB(1, 1), cB + hstep + kstep, voffB);
        PG8_WAIT_V(6); PG8_BAR;
    } else {
        PG8_STAGE(PG8_SB(0, 0), cB, voffB); PG8_STAGE(PG8_SA(0, 0), cA, voffA); PG8_STAGE(PG8_SB(0, 1), cB + hstep, voffB); PG8_STAGE(PG8_SA(0, 1), cA + hstep, voffA);
        if (wr == 1) PG8_BAR;
        PG8_WAIT_V(4); PG8_BAR;
        PG8_STAGE(PG8_SB(1, 0), cB + kstep, voffB); PG8_STAGE(PG8_SA(1, 0), cA + kstep, voffA); PG8_STAGE(PG8_SB(1, 1), cB + hstep + kstep, voffB);
        PG8_WAIT_V(6); PG8_BAR;
    }
    for (;;) {
        const bool has_next = S.next(ui + 1, nxt);
        const char* nA = has_next ? (const char*)g.A + (size_t)nxt.pm * tstep : cA; const char* nB = has_next ? (const char*)g.Bt + (size_t)nxt.pn * tstep : cB;
        for (int t = 0; t < nt; t += 2) {
            const bool last = (t == nt - 2);
            const char* a1 = cA + (size_t)(t + 1) * kstep;
            const char* a2 = last ? nA : cA + (size_t)(t + 2) * kstep; const char* b2 = last ? nB : cB + (size_t)(t + 2) * kstep;
            const char* a3 = a2 + kstep; const char* b3 = b2 + kstep;
            if (last && has_next) S.a_ready(nxt);
            if constexpr (SP2) {
            PG8_LDB(B0, 0, 0); PG8_LDB(B1, 0, 1); PG8_SCHED; PG8_LDA(At, 0, 0); PG8_STAGE(PG8_SA(1, 1), a1 + hstep, voffA);
            PG8_WAIT_V(8); PG8_WAIT_L(0); PG8_BAR; PG8_MMA(0, 0, At, B0); PG8_MMA(0, 1, At, B1); PG8_BAR; PG8_SCHED;
            PG8_LDA(At, 0, 1); PG8_STAGE(PG8_SB(0, 0), b2, voffB); PG8_STAGE(PG8_SB(0, 1), b2 + hstep, voffB); PG8_STAGE(PG8_SA(0, 0), a2, voffA);
            PG8_WAIT_V(8); PG8_WAIT_L(0); PG8_BAR; PG8_MMA(1, 0, At, B0); PG8_MMA(1, 1, At, B1); PG8_BAR; PG8_SCHED;
            PG8_LDB(B0, 1, 0); PG8_LDB(B1, 1, 1); PG8_SCHED; PG8_LDA(At, 1, 0); PG8_STAGE(PG8_SA(0, 1), a2 + hstep, voffA);
            PG8_WAIT_V(8); PG8_WAIT_L(0); PG8_BAR; PG8_MMA(0, 0, At, B0); PG8_MMA(0, 1, At, B1); PG8_BAR; PG8_SCHED;
            PG8_LDA(At, 1, 1); PG8_STAGE(PG8_SB(1, 0), b3, voffB); PG8_STAGE(PG8_SB(1, 1), b3 + hstep, voffB); PG8_STAGE(PG8_SA(1, 0), a3, voffA);
            PG8_WAIT_V(8); PG8_WAIT_L(0); PG8_BAR; PG8_MMA(1, 0, At, B0); PG8_MMA(1, 1, At, B1); PG8_BAR; PG8_SCHED;
            } else {
            PG8_LDB(B0, 0, 0); PG8_SCHED; PG8_LDA(At, 0, 0); PG8_STAGE(PG8_SA(1, 1), a1 + hstep, voffA);
            PG8_WAIT_L(8); PG8_BAR; PG8_WAIT_L(0); PG8_MMA(0, 0, At, B0); PG8_BAR; PG8_SCHED;
            PG8_LDB(B1, 0, 1); PG8_STAGE(PG8_SB(0, 0), b2, voffB);
            PG8_BAR; PG8_WAIT_L(0); PG8_MMA(0, 1, At, B1); PG8_BAR;
            PG8_LDA(At, 0, 1); PG8_STAGE(PG8_SA(0, 0), a2, voffA);
            PG8_BAR; PG8_WAIT_L(0); PG8_MMA(1, 0, At, B0); PG8_BAR; PG8_SCHED;
            PG8_STAGE(PG8_SB(0, 1), b2 + hstep, voffB);
            PG8_WAIT_V(6); PG8_BAR; PG8_MMA(1, 1, At, B1); PG8_BAR;
            PG8_LDB(B0, 1, 0); PG8_SCHED; PG8_LDA(At, 1, 0); PG8_STAGE(PG8_SA(0, 1), a2 + hstep, voffA);
            PG8_WAIT_L(8); PG8_BAR; PG8_WAIT_L(0); PG8_MMA(0, 0, At, B0); PG8_BAR; PG8_SCHED;
            PG8_LDB(B1, 1, 1); PG8_STAGE(PG8_SB(1, 0), b3, voffB);
            PG8_BAR; PG8_WAIT_L(0); PG8_MMA(0, 1, At, B1); PG8_BAR;
            PG8_LDA(At, 1, 1); PG8_STAGE(PG8_SA(1, 0), a3, voffA);
            PG8_BAR; PG8_WAIT_L(0); PG8_MMA(1, 0, At, B0); PG8_BAR; PG8_SCHED;
            PG8_STAGE(PG8_SB(1, 1), b3 + hstep, voffB);
            PG8_WAIT_V(6); PG8_BAR; PG8_MMA(1, 1, At, B1); PG8_BAR;
            }
        }
        if constexpr (ALIGN_EPI) { if (wr == 0) PG8_BAR; }
        if constexpr (!Epi::AFTER_DRAIN) { E(acc, cur, wr, wc, fr, fq); S.done(cur); }
        if (!has_next) break;
#pragma unroll
        for (int a = 0; a < 2; ++a)
#pragma unroll
            for (int b = 0; b < 2; ++b)
#pragma unroll
                for (int m = 0; m < 4; ++m)
#pragma unroll
                    for (int n = 0; n < 2; ++n) acc[a][b][m][n] = (f32x4){0.f, 0.f, 0.f, 0.f};
        cur = nxt; cA = nA; cB = nB; ++ui;
        if constexpr (ALIGN_EPI) { if (wr == 1) PG8_BAR; }
    }
    PG8_WAIT_V(0);
    if constexpr (!ALIGN_EPI) { if (wr == 0) PG8_BAR; }
    PG8_BAR;
    if constexpr (Epi::AFTER_DRAIN) { E.fused(acc, cur, wr, wc, fr, fq, lds, wid, lane); S.done(cur); }
#undef PG8_SA
#undef PG8_SB
#undef PG8_STAGE
#undef PG8_LDA
#undef PG8_LDB
#undef PG8_MMA
#undef PG8_WAIT_V
#undef PG8_WAIT_L
#undef PG8_BAR
#undef PG8_SCHED
}
}
constexpr int NWAVES = 8;
constexpr int BATCH = 2, SEQ = 8192, DM = 4096, DFF = 11008, MTOK = BATCH * SEQ;
constexpr int MEMLEN = 256, MROWS = BATCH * MEMLEN;
constexpr float EPS = 1e-6f;
constexpr int NPC = 9984, NPT = NPC / 256;
constexpr int PC_CQ = 0, PC_CKV = 1536, PC_QD = 2048, PC_KD = 3584, PC_VD = 5120, PC_QI = 6656, PC_QM = 8704, PC_KR = 9728, PC_KI = 9792, PC_WI = 9856;
constexpr int NGC = 3 * DM;
constexpr int NIN = NPC + NGC;
constexpr int NGU = 2 * DFF;
constexpr float LOG2E = 1.4426950408889634f;
constexpr float QS_MLA = 0.07216878364870322f * LOG2E;
constexpr float QS_DSA = 0.08838834764831845f * LOG2E;
constexpr float QS_MEM = 0.0625f * LOG2E;
constexpr float LOG2_THETA = 18.931568569324174f;

constexpr size_t MiB = 1u << 20;
constexpr size_t WS_CTL = 0, CTL_ZERO_BYTES = 1 * MiB;
constexpr size_t WS_WGU = 1 * MiB;
constexpr size_t WS_WD = 173 * MiB;
constexpr size_t WS_SC = 1 * MiB;
constexpr size_t WS_WIN = 259 * MiB;
constexpr size_t WS_WUQ = 433 * MiB, WS_WUKV = 440 * MiB, WS_WMKV = 443 * MiB, WS_WOMLA = 459 * MiB, WS_WODSA = 471 * MiB, WS_WOMEM = 483 * MiB, WS_WOUT = 491 * MiB;
constexpr size_t WS_A = 523 * MiB;
constexpr size_t WS_BIG = 651 * MiB;
constexpr size_t WS_HMID = WS_BIG;
constexpr size_t WS_G = WS_BIG;
constexpr size_t WS_P = 1035 * MiB;
constexpr size_t WS_QMLARAW = 1035 * MiB, WS_KVRAW = 1107 * MiB, WS_QMLA = 1203 * MiB, WS_KMLA = 1275 * MiB;
constexpr size_t WS_GS = 1035 * MiB;
constexpr size_t WS_CQN = 1347 * MiB, WS_CKVN = 1395 * MiB, WS_QD = 1411 * MiB, WS_KD = 1459 * MiB, WS_VD = 1507 * MiB, WS_QI = 1555 * MiB, WS_KI = 1619 * MiB, WS_WI = 1621 * MiB, WS_KR = 1623 * MiB, WS_QM = 1625 * MiB;
constexpr size_t WS_YMLA = 1657 * MiB, WS_YDSA = 1705 * MiB, WS_YMEM = 1753 * MiB, WS_BM = 1785 * MiB, WS_MEMN = 1801 * MiB, WS_MKVRAW = 1805 * MiB, WS_MEMK = 1807 * MiB, WS_END = 1808 * MiB;
constexpr size_t SC_BATCH = (size_t)4096 * 8256;
static_assert(WS_SC + 2 * SC_BATCH * 4 <= WS_WIN, "scores fit the FFN weight region");
static_assert(WS_WGU + (size_t)NGU * DM * 2 <= WS_WD && WS_WD + (size_t)DM * DFF * 2 <= WS_WIN, "FFN weights");
static_assert(WS_WIN + (size_t)NIN * DM * 2 <= WS_WUQ, "win");
static_assert(WS_HMID + (size_t)MTOK * DFF * 2 <= WS_P && WS_G + (size_t)MTOK * NGC * 2 <= WS_P && WS_P + (size_t)MTOK * NPC * 2 <= WS_CQN, "big region");
static_assert(WS_GS + (size_t)MTOK * DM * 4 <= WS_CQN, "GS");
constexpr int CW_BAR = 4096, CW_QUEUE = 8192;

constexpr int RING_BYTES = 131072, MISC_OFF = RING_BYTES, LDS_BYTES = 147456;

#define GAS __attribute__((address_space(1)))
#define LAS __attribute__((address_space(3)))
#define DI __device__ __forceinline__
typedef unsigned short bf16;
typedef unsigned v4u __attribute__((ext_vector_type(4)));
typedef unsigned v2u __attribute__((ext_vector_type(2)));
typedef float f32x4 __attribute__((ext_vector_type(4)));
typedef float f32x16 __attribute__((ext_vector_type(16)));
typedef short bf16x8 __attribute__((ext_vector_type(8)));
typedef short s16x4 __attribute__((ext_vector_type(4)));
#define LDS_WAIT() asm volatile("s_waitcnt lgkmcnt(0)" ::: "memory")
DI float bf2f(bf16 v) { return __uint_as_float(((unsigned)v) << 16); }
DI unsigned f2bf(float f) { unsigned u = __float_as_uint(f); return (u + 0x7fffu + ((u >> 16) & 1u)) >> 16; }
DI unsigned pk2(float lo, float hi) { return f2bf(lo) | (f2bf(hi) << 16); }
DI float wave_sum(float v) {
#pragma unroll
    for (int o = 1; o < 64; o <<= 1) v += __shfl_xor(v, o);
    return v;
}
DI void sincos_rev(float ang, float& s, float& c) {
    double rev = (double)ang * 0.15915494309189535; rev -= __builtin_rint(rev);
    const float fr = (float)rev; s = __builtin_amdgcn_sinf(fr); c = __builtin_amdgcn_cosf(fr);
}
DI float inv_freq(int i, int half) { return __builtin_amdgcn_exp2f(-(float)i * (LOG2_THETA / (float)half)); }
#define XB_TMO      128
#define XB_XCNT(j)  (256  + 64 * (j))
#define XB_XSUB(j)  (1280 + 64 * (j))
#define XB_XGEN(j)  (2304 + 64 * (j))
#define XB_TOP      3328
#define XB_TOPGEN   3392
#define XCD_BAR_WORDS 3456
#define XB_SPIN_CAP (1u << 18)

__device__ __forceinline__ unsigned xb_ld(unsigned* p)              { return __hip_atomic_load(p, __ATOMIC_RELAXED, __HIP_MEMORY_SCOPE_AGENT); }
__device__ __forceinline__ unsigned xb_add(unsigned* p, unsigned v) { return __hip_atomic_fetch_add(p, v, __ATOMIC_RELAXED, __HIP_MEMORY_SCOPE_AGENT); }
__device__ __forceinline__ unsigned xb_xcc_id() { return (unsigned)__builtin_amdgcn_s_getreg((3 << 11) | 20) & 0xFu; }
#define XB_SPIN(cond, bar) do { unsigned _sp = 0; while (cond) { __builtin_amdgcn_s_sleep(1); \
    if ((++_sp & 255u) == 0u) { if (xb_ld(&(bar)[XB_TMO])) break; if (_sp > XB_SPIN_CAP) { atomicAdd(&(bar)[XB_TMO], 1u); break; } } } } while (0)

struct XcdBarrier {
    unsigned* bar; unsigned x;
    volatile LAS unsigned* st;
};

__device__ __forceinline__ XcdBarrier xcd_barrier_post(unsigned* bar, volatile LAS unsigned* st) {
    XcdBarrier b; b.bar = bar; b.x = xb_xcc_id(); b.st = st;
    if (threadIdx.x == 0) (void)xb_add(&bar[XB_XCNT(b.x)], 1u);
    return b;
}
__device__ __forceinline__ void xcd_barrier_complete(unsigned* bar, unsigned x, unsigned& nloc, unsigned& nx) {
    const unsigned G = gridDim.x * gridDim.y * gridDim.z;
    unsigned sum, cnt, mine, sp = 0u;
    for (;;) {
        sum = 0u; cnt = 0u; mine = 0u;
#pragma unroll
        for (unsigned j = 0; j < 16; ++j) { const unsigned c = xb_ld(&bar[XB_XCNT(j)]); sum += c; cnt += (c > 0u) ? 1u : 0u; mine = (j == x) ? c : mine; }
        if (sum == G) break;
        __builtin_amdgcn_s_sleep(1);
        if ((++sp & 255u) == 0u) { if (xb_ld(&bar[XB_TMO])) break; if (sp > XB_SPIN_CAP) { atomicAdd(&bar[XB_TMO], 1u); break; } }
    }
    nloc = mine > 0u ? mine : 1u; nx = cnt > 0u ? cnt : 1u;
}

__device__ __forceinline__ void xcd_barrier(const XcdBarrier& b) {
    asm volatile("s_waitcnt vmcnt(0)" ::: "memory");
    __syncthreads();
    if (threadIdx.x == 0) {
        unsigned* bar = b.bar;
        __builtin_amdgcn_s_waitcnt(0);
        unsigned nloc = b.st[0], nx = b.st[1];
        if (nloc == 0u) { xcd_barrier_complete(bar, b.x, nloc, nx); b.st[0] = nloc; b.st[1] = nx; }
        const unsigned old = xb_add(&bar[XB_XSUB(b.x)], 1u);
        const unsigned gen = old / nloc;
        if (old + 1u == (gen + 1u) * nloc) {
            __builtin_amdgcn_fence(__ATOMIC_RELEASE, "agent");
            asm volatile("s_waitcnt vmcnt(0)" ::: "memory");
            const unsigned og = xb_add(&bar[XB_TOP], 1u);
            const unsigned tg = og / nx;
            if (og + 1u == (tg + 1u) * nx) xb_add(&bar[XB_TOPGEN], 1u);
            else XB_SPIN(xb_ld(&bar[XB_TOPGEN]) == tg, bar);
            __builtin_amdgcn_fence(__ATOMIC_ACQUIRE, "agent");
            xb_add(&bar[XB_XGEN(b.x)], 1u);
            asm volatile("s_waitcnt vmcnt(0)" ::: "memory");
        } else {
            XB_SPIN(xb_ld(&bar[XB_XGEN(b.x)]) == gen, bar);
            __builtin_amdgcn_fence(__ATOMIC_ACQUIRE, "agent");
            asm volatile("s_waitcnt vmcnt(0)" ::: "memory");
        }
    }
    __syncthreads();
}
struct Ctx {
    LAS unsigned char* lds;
    int tid, lane, wave, G, gw, NGW;
};
DI Ctx make_ctx(LAS unsigned char* lds) {
    int t = threadIdx.x; asm volatile("" : "+v"(t));
    Ctx C; C.lds = lds; C.tid = t; C.lane = t & 63; C.wave = __builtin_amdgcn_readfirstlane(t >> 6);
    C.G = gridDim.x; C.gw = blockIdx.x * 8 + C.wave; C.NGW = C.G * 8; return C;
}

DI void conv_item(const float* W, int ldw, int col0, int k0, bf16* WT, int K, int drow0, bool zero, LAS float* scr, int lane) {
#pragma unroll 8
    for (int i = 0; i < 32; ++i) { const int kk = 2 * i + (lane >> 5); scr[kk * 33 + (lane & 31)] = zero ? 0.f : W[(size_t)(k0 + kk) * ldw + col0 + (lane & 31)]; }
    LDS_WAIT(); asm volatile("" ::: "memory");
    const int c = lane & 7;
#pragma unroll
    for (int j = 0; j < 4; ++j) { const int n = (lane >> 3) + 8 * j; const LAS float* s = scr + (8 * c) * 33 + n;
        v4u o; o.x = pk2(s[0 * 33], s[1 * 33]); o.y = pk2(s[2 * 33], s[3 * 33]); o.z = pk2(s[4 * 33], s[5 * 33]); o.w = pk2(s[6 * 33], s[7 * 33]);
        *(GAS v4u*)(WT + (size_t)(drow0 + n) * K + k0 + 8 * c) = o; }
    LDS_WAIT(); asm volatile("" ::: "memory");
}
DI int inproj_src(int d) {
    if (d < 2048) return d;
    if (d < 8704) return d + 64;
    if (d < 9728) return d + 160;
    if (d < 9792) return d - 7680;
    if (d < 9888) return d - 1024;
    return -1;
}
DI void conv_ffn(const Ctx& C, const float* wg, const float* wu, const float* wd, bf16* WGUt, bf16* WDt) {
    LAS float* scr = (LAS float*)(C.lds + C.wave * 16384);
    constexpr int I_GU = (DM / 64) * (NGU / 32), I_D = (DFF / 64) * (DM / 32);
    for (int it = C.gw; it < I_GU + I_D; it += C.NGW) {
        if (it < I_GU) { const int nblk = NGU / 32, kb = it / nblk, nb = it % nblk, n0 = nb * 32, pn = n0 >> 8, bj = (n0 >> 7) & 1, c = n0 & 127;
            conv_item(bj ? wu : wg, DFF, 128 * pn + c, 64 * kb, WGUt, DM, n0, false, scr, C.lane); }
        else { const int r = it - I_GU, nblk = DM / 32, kb = r / nblk, nb = r % nblk;
            conv_item(wd, DM, 32 * nb, 64 * kb, WDt, DFF, 32 * nb, false, scr, C.lane); }
    }
}
DI void conv_plain(const Ctx& C, const float* w, int K, int N, bf16* wt, int& base, int total_dummy) { (void)base; (void)total_dummy;
    LAS float* scr = (LAS float*)(C.lds + C.wave * 16384);
    const int nblk = N / 32, items = (K / 64) * nblk;
    for (int it = C.gw; it < items; it += C.NGW) { const int kb = it / nblk, nb = it % nblk; conv_item(w, N, 32 * nb, 64 * kb, wt, K, 32 * nb, false, scr, C.lane); }
}
DI void conv_win(const Ctx& C, const float* w_in, const float* w_gate, bf16* wt) {
    LAS float* scr = (LAS float*)(C.lds + C.wave * 16384);
    constexpr int nblk = NIN / 32, items = (DM / 64) * nblk;
    for (int it = C.gw; it < items; it += C.NGW) { const int kb = it / nblk, nb = it % nblk, n0 = 32 * nb;
        if (n0 < NPC) { const int sc = inproj_src(n0); conv_item(w_in, 9888, sc < 0 ? 0 : sc, 64 * kb, wt, DM, n0, sc < 0, scr, C.lane); }
        else { const int gi = n0 - NPC, br = gi / DM, col = gi % DM; conv_item(w_gate + (size_t)br * DM * DM, DM, col, 64 * kb, wt, DM, n0, false, scr, C.lane); } }
}
DI void rms_row4096(const float* xrow, const float* g, bf16* orow, int lane) {
    const GAS f32x4* xr = (const GAS f32x4*)xrow + lane; const GAS f32x4* gr = (const GAS f32x4*)g + lane;
    f32x4 v[16]; float s = 0.f;
#pragma unroll
    for (int j = 0; j < 16; ++j) { v[j] = xr[64 * j]; s += (v[j].x * v[j].x + v[j].y * v[j].y) + (v[j].z * v[j].z + v[j].w * v[j].w); }
    const float rstd = rsqrtf(wave_sum(s) * (1.f / 4096.f) + EPS);
    GAS v2u* o8 = (GAS v2u*)orow + lane;
#pragma unroll
    for (int j = 0; j < 16; ++j) { const f32x4 gg = gr[64 * j]; v2u o; o.x = pk2(v[j].x * rstd * gg.x, v[j].y * rstd * gg.y); o.y = pk2(v[j].z * rstd * gg.z, v[j].w * rstd * gg.w); o8[64 * j] = o; }
}
DI void rms_rows(const Ctx& C, const float* x, const float* g, bf16* o, int rows) {
    for (int m = C.gw; m < rows; m += C.NGW) rms_row4096(x + (size_t)m * DM, g, o + (size_t)m * DM, C.lane);
}

struct PP1 { const bf16* P; const int* pos; const float *g_cq, *g_ckv, *g_qd, *g_kd, *g_qm;
             bf16 *CQn, *CKVn, *Qd, *Kd, *Vd, *Qi, *Ki, *Kr, *Qm; float* Wi; };
DI void pp1_token(const PP1& A, int t, int lane) {
    const bf16* pr = A.P + (size_t)t * NPC;
    const float pos = (float)A.pos[t];
    float sn_d, cs_d, sn_i, cs_i;
    sincos_rev(pos * inv_freq(lane & 15, 16), sn_d, cs_d);
    sincos_rev(pos * inv_freq(lane & 7, 8), sn_i, cs_i);
    {
        float x[24]; float ss = 0.f;
#pragma unroll
        for (int k = 0; k < 24; ++k) { x[k] = bf2f(pr[PC_CQ + lane + 64 * k]); ss += x[k] * x[k]; }
        const float rstd = rsqrtf(wave_sum(ss) * (1.f / 1536.f) + EPS);
#pragma unroll
        for (int k = 0; k < 24; ++k) A.CQn[(size_t)t * 1536 + lane + 64 * k] = (bf16)f2bf(x[k] * rstd * A.g_cq[lane + 64 * k]);
    }
    {
        float x[8]; float ss = 0.f;
#pragma unroll
        for (int k = 0; k < 8; ++k) { x[k] = bf2f(pr[PC_CKV + lane + 64 * k]); ss += x[k] * x[k]; }
        const float rstd = rsqrtf(wave_sum(ss) * (1.f / 512.f) + EPS);
#pragma unroll
        for (int k = 0; k < 8; ++k) A.CKVn[(size_t)t * 512 + lane + 64 * k] = (bf16)f2bf(x[k] * rstd * A.g_ckv[lane + 64 * k]);
    }
#pragma unroll 1
    for (int qk = 0; qk < 2; ++qk) {
        const int pc = qk ? PC_KD : PC_QD; const float* g = qk ? A.g_kd : A.g_qd; bf16* O = qk ? A.Kd : A.Qd; const float sc = qk ? 1.0f : QS_DSA;
        const float g0 = g[lane], g1 = g[64 + lane];
#pragma unroll 4
        for (int h = 0; h < 12; ++h) {
            const float x0 = bf2f(pr[pc + h * 128 + lane]), x1 = bf2f(pr[pc + h * 128 + 64 + lane]);
            const float rstd = rsqrtf(wave_sum(x0 * x0 + x1 * x1) * (1.f / 128.f) + EPS);
            float y0 = x0 * rstd * g0; const float y1 = x1 * rstd * g1;
            const float pr0 = __shfl_xor(y0, 16);
            if (lane < 16) y0 = y0 * cs_d - pr0 * sn_d; else if (lane < 32) y0 = y0 * cs_d + pr0 * sn_d;
            O[(size_t)t * 1536 + h * 128 + lane] = (bf16)f2bf(y0 * sc); O[(size_t)t * 1536 + h * 128 + 64 + lane] = (bf16)f2bf(y1 * sc);
        }
    }
#pragma unroll
    for (int k = 0; k < 24; ++k) A.Vd[(size_t)t * 1536 + lane + 64 * k] = pr[PC_VD + lane + 64 * k];
#pragma unroll 4
    for (int h = 0; h < 32; ++h) {
        float x = bf2f(pr[PC_QI + h * 64 + lane]); const float px = __shfl_xor(x, 8);
        if (lane < 8) x = x * cs_i - px * sn_i; else if (lane < 16) x = x * cs_i + px * sn_i;
        A.Qi[(size_t)t * 2048 + h * 64 + lane] = (bf16)f2bf(x);
    }
    {
        float x = bf2f(pr[PC_KI + lane]); const float px = __shfl_xor(x, 8);
        if (lane < 8) x = x * cs_i - px * sn_i; else if (lane < 16) x = x * cs_i + px * sn_i;
        A.Ki[(size_t)t * 64 + lane] = (bf16)f2bf(x);
        if (lane < 32) A.Wi[(size_t)t * 32 + lane] = bf2f(pr[PC_WI + lane]);
        A.Kr[(size_t)t * 64 + lane] = pr[PC_KR + lane];
    }
#pragma unroll
    for (int h = 0; h < 4; ++h) {
        float x[4]; float ss = 0.f;
#pragma unroll
        for (int k = 0; k < 4; ++k) { x[k] = bf2f(pr[PC_QM + h * 256 + lane + 64 * k]); ss += x[k] * x[k]; }
        const float rstd = rsqrtf(wave_sum(ss) * (1.f / 256.f) + EPS) * QS_MEM;
#pragma unroll
        for (int k = 0; k < 4; ++k) A.Qm[(size_t)t * 1024 + h * 256 + lane + 64 * k] = (bf16)f2bf(x[k] * rstd * A.g_qm[lane + 64 * k]);
    }
}
struct PP2 { const bf16 *QmlaRaw, *KVraw, *Kr, *MKVraw; const int* pos; const float *g_q, *g_k, *g_km; bf16 *Qmla, *Kmla, *MemK; };
DI void pp2_token(const PP2& A, int t, int lane) {
    const float pos = (float)A.pos[t];
    float sn, cs; sincos_rev(pos * inv_freq(lane & 31, 32), sn, cs);
    const float gq0 = A.g_q[lane], gq1 = A.g_q[64 + lane], gq2 = A.g_q[128 + lane], gk0 = A.g_k[lane], gk1 = A.g_k[64 + lane], gk2 = A.g_k[128 + lane];
    const float kr = bf2f(A.Kr[(size_t)t * 64 + lane]);
#pragma unroll 2
    for (int h = 0; h < 12; ++h) {
        {   const bf16* q = A.QmlaRaw + (size_t)t * 2304 + h * 192;
            const float x0 = bf2f(q[lane]), x1 = bf2f(q[64 + lane]), x2 = bf2f(q[128 + lane]);
            const float rstd = rsqrtf(wave_sum(x0 * x0 + x1 * x1 + x2 * x2) * (1.f / 192.f) + EPS);
            float y0 = x0 * rstd * gq0; const float y1 = x1 * rstd * gq1, y2 = x2 * rstd * gq2;
            const float p0 = __shfl_xor(y0, 32); y0 = (lane < 32) ? y0 * cs - p0 * sn : y0 * cs + p0 * sn;
            bf16* o = A.Qmla + (size_t)t * 2304 + h * 192;
            o[lane] = (bf16)f2bf(y0 * QS_MLA); o[64 + lane] = (bf16)f2bf(y1 * QS_MLA); o[128 + lane] = (bf16)f2bf(y2 * QS_MLA); }
        {   const bf16* kv = A.KVraw + (size_t)t * 3072 + h * 256;
            const float x0 = kr, x1 = bf2f(kv[lane]), x2 = bf2f(kv[64 + lane]);
            const float rstd = rsqrtf(wave_sum(x0 * x0 + x1 * x1 + x2 * x2) * (1.f / 192.f) + EPS);
            float y0 = x0 * rstd * gk0; const float y1 = x1 * rstd * gk1, y2 = x2 * rstd * gk2;
            const float p0 = __shfl_xor(y0, 32); y0 = (lane < 32) ? y0 * cs - p0 * sn : y0 * cs + p0 * sn;
            bf16* o = A.Kmla + (size_t)t * 2304 + h * 192;
            o[lane] = (bf16)f2bf(y0); o[64 + lane] = (bf16)f2bf(y1); o[128 + lane] = (bf16)f2bf(y2); }
    }
}
DI void pp2_memrow(const PP2& A, int r, int lane) {
#pragma unroll
    for (int h = 0; h < 4; ++h) {
        float x[4]; float ss = 0.f;
#pragma unroll
        for (int k = 0; k < 4; ++k) { x[k] = bf2f(A.MKVraw[(size_t)r * 2048 + h * 256 + lane + 64 * k]); ss += x[k] * x[k]; }
        const float rstd = rsqrtf(wave_sum(ss) * (1.f / 256.f) + EPS);
#pragma unroll
        for (int k = 0; k < 4; ++k) A.MemK[(size_t)r * 1024 + h * 256 + lane + 64 * k] = (bf16)f2bf(x[k] * rstd * A.g_km[lane + 64 * k]);
    }
}

#define MFMA32(a, b, c) __builtin_amdgcn_mfma_f32_32x32x16_bf16((a), (b), (c), 0, 0, 0)
DI float half_swap_sum(float v) { auto rr = __builtin_amdgcn_permlane32_swap(__float_as_uint(v), __float_as_uint(v), false, false); return __uint_as_float(rr[0]) + __uint_as_float(rr[1]); }
DI float half_swap_max(float v) { auto rr = __builtin_amdgcn_permlane32_swap(__float_as_uint(v), __float_as_uint(v), false, false); return fmaxf(__uint_as_float(rr[0]), __uint_as_float(rr[1])); }
DI size_t sc_block_off(int b, int bi) { return (size_t)b * SC_BATCH + (size_t)4096 * (size_t)(bi * (bi + 1) / 2); }
DI void idx_item(int p, const bf16* Qi, const bf16* Ki, const float* Wi, float* Sc, int wave, int lane) {
    const int b = p >> 7, r = p & 127, hs = r & 1, k = r >> 1, r32 = lane & 31, hi = lane >> 5;
#pragma unroll 1
    for (int which = 0; which < 2; ++which) {
        const int bi = which ? 127 - k : k, nt32 = (bi + 1) * 2, ncol = (bi + 1) * 64;
        float* scb = Sc + sc_block_off(b, bi);
#pragma unroll 1
        for (int pass = 0; pass < 2; ++pass) {
            const int qa = 32 * hs + 4 * wave + 2 * pass, ta = b * SEQ + bi * 64 + qa;
            bf16x8 A0[4], A1[4]; f32x4 w0[4], w1[4];
#pragma unroll
            for (int d0 = 0; d0 < 4; ++d0) { A0[d0] = *(const bf16x8*)(Qi + (size_t)ta * 2048 + r32 * 64 + d0 * 16 + hi * 8); A1[d0] = *(const bf16x8*)(Qi + (size_t)(ta + 1) * 2048 + r32 * 64 + d0 * 16 + hi * 8); }
#pragma unroll
            for (int g = 0; g < 4; ++g) { w0[g] = *(const f32x4*)(Wi + (size_t)ta * 32 + 8 * g + 4 * hi); w1[g] = *(const f32x4*)(Wi + (size_t)(ta + 1) * 32 + 8 * g + 4 * hi); }
            float* o0 = scb + (size_t)qa * ncol + r32; float* o1 = o0 + ncol;
            const bf16* kp = Ki + (size_t)(b * SEQ + r32) * 64 + hi * 8;
#define IDX_LOADB(B, kt_) do { _Pragma("unroll") for (int d0_ = 0; d0_ < 4; ++d0_) B[d0_] = *(const bf16x8*)(kp + (size_t)(kt_) * 2048 + d0_ * 16); } while (0)
#define IDX_MMA(c0_, c1_, B) do { _Pragma("unroll") for (int i_ = 0; i_ < 16; ++i_) { c0_[i_] = 0.f; c1_[i_] = 0.f; } \
        _Pragma("unroll") for (int d0_ = 0; d0_ < 4; ++d0_) { c0_ = MFMA32(A0[d0_], B[d0_], c0_); c1_ = MFMA32(A1[d0_], B[d0_], c1_); } } while (0)
#define IDX_EPI(c0_, c1_, kt_) do { float s0_ = 0.f, s1_ = 0.f; \
        _Pragma("unroll") for (int i_ = 0; i_ < 16; ++i_) { s0_ = fmaf(w0[i_ >> 2][i_ & 3], fmaxf(c0_[i_], 0.f), s0_); s1_ = fmaf(w1[i_ >> 2][i_ & 3], fmaxf(c1_[i_], 0.f), s1_); } \
        s0_ = half_swap_sum(s0_); s1_ = half_swap_sum(s1_); if (hi == 0) { o0[(kt_) * 32] = s0_; o1[(kt_) * 32] = s1_; } } while (0)
            bf16x8 BA[4], BB[4]; f32x16 cA0, cA1, cB0, cB1;
            IDX_LOADB(BA, 0); IDX_LOADB(BB, 1);
            IDX_MMA(cA0, cA1, BA);
#pragma unroll 1
            for (int kt = 0; kt < nt32; kt += 2) {
                const bool more = kt + 2 < nt32;
                IDX_MMA(cB0, cB1, BB);
                if (more) IDX_LOADB(BA, kt + 2);
                IDX_EPI(cA0, cA1, kt);
                if (more) { IDX_MMA(cA0, cA1, BA); IDX_LOADB(BB, kt + 3); }
                IDX_EPI(cB0, cB1, kt + 1);
            }
#undef IDX_LOADB
#undef IDX_MMA
#undef IDX_EPI
        }
    }
}
DI int suffix_scan64(int v, int lane) {
#pragma unroll
    for (int o = 1; o < 64; o <<= 1) { const int tv = __shfl_down(v, o); if (lane + o < 64) v += tv; }
    return v;
}
template <int NBITS, bool FIRST>
DI int radix_pass(const unsigned (&key)[128], int NG, int shift, unsigned& prefix, int& remaining, LAS unsigned* hist, int lane) {
    constexpr int NB = 1 << NBITS, PER = NB / 64;
#pragma unroll
    for (int q = 0; q < PER / 4; ++q) *(LAS v4u*)(hist + PER * lane + 4 * q) = (v4u){0u, 0u, 0u, 0u};
#pragma unroll
    for (int g = 0; g < 8; ++g) {
        if (g < NG) {
#pragma unroll
            for (int r = 0; r < 16; ++r) { const unsigned k = key[16 * g + r];
                const bool ok = FIRST || ((k >> (shift + NBITS)) == prefix);
                if (ok) __hip_atomic_fetch_add(hist + ((k >> shift) & (unsigned)(NB - 1)), 1u, __ATOMIC_RELAXED, __HIP_MEMORY_SCOPE_WORKGROUP); }
        }
    }
    LDS_WAIT();
    int lane_sum = 0;
#pragma unroll
    for (int q = 0; q < PER / 4; ++q) { const v4u bb = *(LAS v4u*)(hist + PER * lane + 4 * q); lane_sum += (int)(bb.x + bb.y + bb.z + bb.w); }
    const int S = suffix_scan64(lane_sum, lane), above = S - lane_sum;
    const int src = __builtin_amdgcn_readfirstlane((int)__ffsll((long long)__ballot((above < remaining) && (remaining <= S))) - 1) & 63;
    const int rem2 = remaining - __builtin_amdgcn_readlane(above, src);
    const int bv = (lane < PER) ? (int)hist[PER * src + lane] : 0;
    const int S2 = suffix_scan64(bv, lane), above2 = S2 - bv;
    const int src2 = __builtin_amdgcn_readfirstlane((int)__ffsll((long long)__ballot((above2 < rem2) && (rem2 <= S2))) - 1) & 63;
    prefix = (prefix << NBITS) | (unsigned)(PER * src + src2);
    remaining = rem2 - __builtin_amdgcn_readlane(above2, src2);
    const int cnt = __builtin_amdgcn_readlane(bv, src2);
    LDS_WAIT();
    return cnt;
}
DI void select_row(const float* Sc, unsigned long long* BM64, int t, int lane, LAS unsigned* hist, LAS unsigned long long* scr) {
    const int b = t / SEQ, s = t % SEQ, bi = s >> 6, n = (bi + 1) * 64;
    const float* row = Sc + sc_block_off(b, bi) + (size_t)(s & 63) * n;
    unsigned long long* out = BM64 + (size_t)t * 128;
    if (n <= 256) {
        out[lane] = (lane < n / 64) ? ~0ull : 0ull; out[64 + lane] = 0ull; return;
    }
    const int NG = (n + 1023) >> 10;
    unsigned key[128];
#pragma unroll
    for (int g = 0; g < 8; ++g) {
        if (g < NG) {
#pragma unroll
            for (int r = 0; r < 16; ++r) { const int i = 16 * g + r; unsigned kk = 0u; if (64 * i < n) { const unsigned u = __float_as_uint(row[64 * i + lane]); kk = (u & 0x80000000u) ? ~u : (u | 0x80000000u); } key[i] = kk; }
        } else {
#pragma unroll
            for (int r = 0; r < 16; ++r) key[16 * g + r] = 0u;
        }
    }
    unsigned prefix = 0u; int remaining = 256;
    radix_pass<12, true>(key, NG, 20, prefix, remaining, hist, lane);
    radix_pass<10, false>(key, NG, 10, prefix, remaining, hist, lane);
    const int cnt_eq = radix_pass<10, false>(key, NG, 0, prefix, remaining, hist, lane);
    const int need = remaining;
    if (cnt_eq == need) {
#pragma unroll
        for (int g = 0; g < 8; ++g) {
            if (g < NG) {
#pragma unroll
                for (int r = 0; r < 16; ++r) { const int i = 16 * g + r; const unsigned long long take = __ballot(key[i] >= prefix); if (lane == 0) scr[i] = take; }
            } else { if (lane < 16) scr[16 * g + lane] = 0ull; }
        }
    } else {
        int run = 0;
#pragma unroll
        for (int g = 0; g < 8; ++g) {
            if (g < NG) {
#pragma unroll
                for (int r = 0; r < 16; ++r) { const int i = 16 * g + r;
                    const bool gt = key[i] > prefix, eq = key[i] == prefix;
                    const unsigned long long eqb = __ballot(eq);
                    const int rank = run + (int)__builtin_amdgcn_mbcnt_hi((unsigned)(eqb >> 32), __builtin_amdgcn_mbcnt_lo((unsigned)eqb, 0u));
                    const unsigned long long take = __ballot(gt || (eq && rank < need));
                    run += __popcll(eqb);
                    if (lane == 0) scr[i] = take;
                    if ((r & 7) == 7) __builtin_amdgcn_sched_barrier(0); }
            } else { if (lane < 16) scr[16 * g + lane] = 0ull; }
        }
    }
    LDS_WAIT();
    const unsigned long long mine0 = scr[lane], mine1 = scr[64 + lane];
    out[lane] = mine0; out[64 + lane] = mine1;
    LDS_WAIT();
}
typedef short v4i16_t __attribute__((ext_vector_type(4)));
DI s16x4 vtr(const LAS unsigned char* p) { return __builtin_bit_cast(s16x4, __builtin_amdgcn_ds_read_tr16_b64_v4i16((LAS v4i16_t*)p)); }
DI unsigned cvtpk(float lo, float hi) { unsigned r; asm volatile("v_cvt_pk_bf16_f32 %0, %1, %2" : "=v"(r) : "v"(lo), "v"(hi)); return r; }
constexpr int VSTR = 320;
template <int DK> struct AttnLds { static constexpr int KSTR = DK * 2 + 16, KB = 64 * KSTR, VB = 64 * VSTR, K0 = 0, V0 = 2 * KB, TOTAL = 2 * KB + 2 * VB; };
static_assert(AttnLds<256>::TOTAL <= RING_BYTES, "attention LDS");

template <int DK, int MODE>
DI void attn_unit(LAS unsigned char* lds, const bf16* Qp, int LDQ, const bf16* Kp, int LDK, const bf16* Vp, int LDV, bf16* Op, int LDO, int NT, int chunk0, const unsigned* BMrow) {
    typedef AttnLds<DK> L;
    constexpr int ND = DK / 16, KCH = DK / 8, NKC = DK / 64;
    int tid_ = threadIdx.x; asm volatile("" : "+v"(tid_));
    const int tid = tid_, wid = __builtin_amdgcn_readfirstlane(tid >> 6), lane = tid & 63, r32 = lane & 31, hi = lane >> 5;
    const int mychunk = chunk0 + (wid >> 1);
    constexpr bool QLOOP = (DK > 192);
    bf16x8 qr[ND];
    const bf16* qw = Qp + (size_t)(wid * 32 + r32) * LDQ + hi * 8;
    if (!QLOOP) {
#pragma unroll
        for (int d0 = 0; d0 < ND; ++d0) qr[d0] = *(const bf16x8*)(qw + d0 * 16); }
    const unsigned* bmw = (MODE == 1) ? BMrow + (size_t)(wid * 32 + r32) * 256 : nullptr;
    int krow_[NKC], kcc_[NKC];
#pragma unroll
    for (int i = 0; i < NKC; ++i) { const int c = tid + 512 * i; krow_[i] = c / KCH; kcc_[i] = c % KCH; }
    const int vrow0 = tid >> 4, vcc = tid & 15;
    v4u kst[NKC], vst[2];
#define ATT_LOAD(j) do { const int key0_ = (j) * 64; \
        _Pragma("unroll") for (int i_ = 0; i_ < NKC; ++i_) kst[i_] = *(const v4u*)(Kp + (size_t)(key0_ + krow_[i_]) * LDK + kcc_[i_] * 8); \
        vst[0] = *(const v4u*)(Vp + (size_t)(key0_ + vrow0) * LDV + vcc * 8); vst[1] = *(const v4u*)(Vp + (size_t)(key0_ + 32 + vrow0) * LDV + vcc * 8); } while (0)
#define ATT_WRITE(buf) do { \
        _Pragma("unroll") for (int i_ = 0; i_ < NKC; ++i_) *(LAS v4u*)(lds + L::K0 + (buf) * L::KB + krow_[i_] * L::KSTR + kcc_[i_] * 16) = kst[i_]; \
        *(LAS v4u*)(lds + L::V0 + (buf) * L::VB + vrow0 * VSTR + vcc * 16) = vst[0]; *(LAS v4u*)(lds + L::V0 + (buf) * L::VB + (32 + vrow0) * VSTR + vcc * 16) = vst[1]; } while (0)
    float m_run = -1e30f, l_run = 0.f;
    f32x16 o[4];
#pragma unroll
    for (int d = 0; d < 4; ++d)
#pragma unroll
        for (int i = 0; i < 16; ++i) o[d][i] = 0.f;
    const int kbase = r32 * L::KSTR + hi * 16;
    const int q4 = (lane >> 2) & 3, p4 = lane & 3, blk = (lane >> 4) & 1;
    const int vbase = (4 * hi + q4) * VSTR + blk * 32 + p4 * 8;
    ATT_LOAD(0); ATT_WRITE(0);
    __syncthreads();
#pragma unroll 1
    for (int j = 0; j < NT; ++j) {
        const int cur = j & 1;
        const bool active = (MODE == 2) || (j <= mychunk);
        unsigned mw0 = 0xffffffffu, mw1 = 0xffffffffu;
        if (MODE == 1) { if (active) { const v2u mm = *(const v2u*)(bmw + 2 * j); mw0 = mm.x >> (4 * hi); mw1 = mm.y >> (4 * hi); } }
        if (j + 1 < NT) ATT_LOAD(j + 1);
        if (active) {
            f32x16 p0, p1;
#pragma unroll
            for (int i = 0; i < 16; ++i) { p0[i] = 0.f; p1[i] = 0.f; }
            const LAS unsigned char* kb = lds + L::K0 + cur * L::KB + kbase;
            const bf16* qwl = qw; if (QLOOP) asm volatile("" : "+v"(qwl));
#pragma unroll
            for (int d0 = 0; d0 < ND; ++d0) {
                const bf16x8 a0 = *(const LAS bf16x8*)(kb + d0 * 32), a1 = *(const LAS bf16x8*)(kb + 32 * L::KSTR + d0 * 32);
                const bf16x8 qf = QLOOP ? *(const bf16x8*)(qwl + d0 * 16) : qr[d0];
                p0 = MFMA32(a0, qf, p0); p1 = MFMA32(a1, qf, p1);
                if ((d0 & 3) == 3) __builtin_amdgcn_sched_barrier(0);
            }
            if (MODE == 1) {
#pragma unroll
                for (int i = 0; i < 16; ++i) { const unsigned bit = 1u << ((i & 3) + 8 * (i >> 2));
                    p0[i] = (mw0 & bit) ? p0[i] : -INFINITY; p1[i] = (mw1 & bit) ? p1[i] : -INFINITY; }
            }
            float tmax = p0[0];
#pragma unroll
            for (int i = 1; i < 16; ++i) tmax = fmaxf(tmax, p0[i]);
#pragma unroll
            for (int i = 0; i < 16; ++i) tmax = fmaxf(tmax, p1[i]);
            tmax = half_swap_max(tmax);
            const float m_new = fmaxf(m_run, tmax), alpha = __builtin_amdgcn_exp2f(m_run - m_new);
            m_run = m_new;
            float ps = 0.f;
#pragma unroll
            for (int i = 0; i < 16; ++i) { p0[i] = __builtin_amdgcn_exp2f(p0[i] - m_new); ps += p0[i]; }
#pragma unroll
            for (int i = 0; i < 16; ++i) { p1[i] = __builtin_amdgcn_exp2f(p1[i] - m_new); ps += p1[i]; }
            ps = half_swap_sum(ps);
            l_run = l_run * alpha + ps;
            if (__any(alpha < 1.0f)) {
#pragma unroll
                for (int d = 0; d < 4; ++d)
#pragma unroll
                    for (int i = 0; i < 16; ++i) o[d][i] *= alpha;
            }
            bf16x8 pb[4];
#pragma unroll
            for (int s = 0; s < 4; ++s) { v4u w;
                if (s < 2) { w.x = cvtpk(p0[8 * s + 0], p0[8 * s + 1]); w.y = cvtpk(p0[8 * s + 2], p0[8 * s + 3]); w.z = cvtpk(p0[8 * s + 4], p0[8 * s + 5]); w.w = cvtpk(p0[8 * s + 6], p0[8 * s + 7]); }
                else { const int s2 = s - 2; w.x = cvtpk(p1[8 * s2 + 0], p1[8 * s2 + 1]); w.y = cvtpk(p1[8 * s2 + 2], p1[8 * s2 + 3]); w.z = cvtpk(p1[8 * s2 + 4], p1[8 * s2 + 5]); w.w = cvtpk(p1[8 * s2 + 6], p1[8 * s2 + 7]); }
                pb[s] = __builtin_bit_cast(bf16x8, w); }
            const LAS unsigned char* vb = lds + L::V0 + cur * L::VB + vbase;
#pragma unroll
            for (int d0 = 0; d0 < 4; ++d0)
#pragma unroll
                for (int s = 0; s < 4; ++s) {
                    const s16x4 lo = vtr(vb + (16 * s) * VSTR + d0 * 64), hh = vtr(vb + (16 * s + 8) * VSTR + d0 * 64);
                    const bf16x8 va = (bf16x8){lo[0], lo[1], lo[2], lo[3], hh[0], hh[1], hh[2], hh[3]};
                    o[d0] = MFMA32(va, pb[s], o[d0]);
                    if (s == 3) __builtin_amdgcn_sched_barrier(0);
                }
        }
        if (j + 1 < NT) ATT_WRITE(cur ^ 1);
        __syncthreads();
    }
    const float rl = 1.0f / l_run;
    bf16* ow = Op + (size_t)(wid * 32 + r32) * LDO + 4 * hi;
#pragma unroll
    for (int d0 = 0; d0 < 4; ++d0)
#pragma unroll
        for (int g = 0; g < 4; ++g) { v2u w; w.x = cvtpk(o[d0][4 * g] * rl, o[d0][4 * g + 1] * rl); w.y = cvtpk(o[d0][4 * g + 2] * rl, o[d0][4 * g + 3] * rl);
            *(v2u*)(ow + 32 * d0 + 8 * g) = w; }
#undef ATT_LOAD
#undef ATT_WRITE
}
#ifndef MK_MULTI
#define MK_MULTI 0
#endif
#ifndef DBG_SKIP_MIXER
#define DBG_SKIP_MIXER 0
#endif
constexpr int NPH = 16;
#ifndef ATT_MASK
#define ATT_MASK 7
#endif
struct Args { const float* in[30]; float* out; unsigned char* ws; int ph_lo, ph_hi; };
static_assert(sizeof(Args) == 30 * 8 + 8 + 8 + 8, "no padding");

DI void ffn_up_phase(LAS unsigned char* lds, const bf16* A, const bf16* WGUt, bf16* Hmid, int G) {
    pg8::Gemm g{A, WGUt, MTOK, NGU, DM}; pg8::StaticOrder S; S.init(MTOK, NGU, G, (int)blockIdx.x);
    pg8::EpiSwiGLU E{Hmid, DFF};
    pg8::gemm_phase<pg8::EpiSwiGLU, pg8::StaticOrder, true, true>(lds, g, S, E);
}
DI void ffn_down_phase(LAS unsigned char* lds, const bf16* Hmid, const bf16* WDt, const float* base, float* out, int G) {
    pg8::Gemm g{Hmid, WDt, MTOK, DM, DFF}; pg8::StaticOrder S; S.init(MTOK, DM, G, (int)blockIdx.x);
    pg8::EpiResid E{base, out, DM, 0.5f};
    pg8::gemm_phase<pg8::EpiResid, pg8::StaticOrder, true, true>(lds, g, S, E);
}

__global__ void __launch_bounds__(NWAVES * 64, 2) mega_fwd(Args args) {
    extern __shared__ __attribute__((aligned(16))) unsigned char lds_raw[];
    LAS unsigned char* lds = (LAS unsigned char*)lds_raw;
    const int GRID = gridDim.x;
    const __attribute__((address_space(4))) unsigned char* ka = (const __attribute__((address_space(4))) unsigned char*)__builtin_amdgcn_kernarg_segment_ptr();
#define ARGQ(k) (*(void* const __attribute__((address_space(4)))*)(ka + 8 * (k)))
#define ARGP(k) ((const float*)ARGQ(k))
    unsigned char* ws = (unsigned char*)ARGQ(31);
    unsigned* ctl = (unsigned*)(ws + WS_CTL);
    volatile LAS unsigned* MISC = (volatile LAS unsigned*)(lds + MISC_OFF);
    for (int u = threadIdx.x; u < (LDS_BYTES - MISC_OFF) / 4; u += NWAVES * 64) ((LAS unsigned*)(lds + MISC_OFF))[u] = 0u;
    __syncthreads();
    const int lo = *(const __attribute__((address_space(4))) int*)(ka + 256), hi = *(const __attribute__((address_space(4))) int*)(ka + 260);
    XcdBarrier bar; bar.bar = ctl + CW_BAR; bar.x = 0; bar.st = nullptr;
    if (hi - lo > 1) bar = xcd_barrier_post(ctl + CW_BAR, MISC);
#ifndef PH_MASK
#define PH_MASK 0xffff
#endif
#define IN(k) ((((PH_MASK) >> (k)) & 1) && lo <= (k) && (k) < hi)
#define SEAM(k) do { if (IN(k) && IN((k) + 1)) xcd_barrier(bar); } while (0)
#ifndef REPEAT_MASK
#define REPEAT_MASK 0
#endif
#define NREP(k) (1 + (((REPEAT_MASK) >> (k)) & 1))
#define REPBAR(k) do { if (((REPEAT_MASK) >> (k)) & 1) xcd_barrier(bar); } while (0)

#define WGUt ((bf16*)(ws + WS_WGU))
#define WDt ((bf16*)(ws + WS_WD))
#define WINt ((bf16*)(ws + WS_WIN))
#define WUQt ((bf16*)(ws + WS_WUQ))
#define WUKVt ((bf16*)(ws + WS_WUKV))
#define WMKVt ((bf16*)(ws + WS_WMKV))
#define WOMLAt ((bf16*)(ws + WS_WOMLA))
#define WODSAt ((bf16*)(ws + WS_WODSA))
#define WOMEMt ((bf16*)(ws + WS_WOMEM))
#define WOUTt ((bf16*)(ws + WS_WOUT))
#define Abuf ((bf16*)(ws + WS_A))
#define Hmid ((bf16*)(ws + WS_HMID))
#define Gt ((bf16*)(ws + WS_G))
#define Pbuf ((bf16*)(ws + WS_P))
#define QmlaRaw ((bf16*)(ws + WS_QMLARAW))
#define KVraw ((bf16*)(ws + WS_KVRAW))
#define Qmla ((bf16*)(ws + WS_QMLA))
#define Kmla ((bf16*)(ws + WS_KMLA))
#define GS ((float*)(ws + WS_GS))
#define CQn ((bf16*)(ws + WS_CQN))
#define CKVn ((bf16*)(ws + WS_CKVN))
#define Qd ((bf16*)(ws + WS_QD))
#define Kd ((bf16*)(ws + WS_KD))
#define Vd ((bf16*)(ws + WS_VD))
#define Qi ((bf16*)(ws + WS_QI))
#define Ki ((bf16*)(ws + WS_KI))
#define Wi ((float*)(ws + WS_WI))
#define Kr ((bf16*)(ws + WS_KR))
#define Qm ((bf16*)(ws + WS_QM))
#define Ymla ((bf16*)(ws + WS_YMLA))
#define Ydsa ((bf16*)(ws + WS_YDSA))
#define Ymem ((bf16*)(ws + WS_YMEM))
#define BM ((unsigned*)(ws + WS_BM))
#define memn ((bf16*)(ws + WS_MEMN))
#define MKVraw ((bf16*)(ws + WS_MKVRAW))
#define MemK ((bf16*)(ws + WS_MEMK))
#define Sc ((float*)(ws + WS_SC))
#define X_IN (ARGP(0))
#define MEM_IN (ARGP(1))
#define POS_IN ((const int*)ARGP(2))
#define XRES ((float*)ARGQ(30))
    for (int rep_ = 0; rep_ < NREP(0); ++rep_) { if (rep_) REPBAR(0); if (IN(0)) { const Ctx C = make_ctx(lds);
        conv_ffn(C, ARGP(4), ARGP(5), ARGP(6), WGUt, WDt);
#if !DBG_SKIP_MIXER
        conv_win(C, ARGP(8), ARGP(24), WINt);
        int dummy = 0;
        conv_plain(C, ARGP(10), 1536, 2304, WUQt, dummy, 0);
        conv_plain(C, ARGP(12), 512, 3072, WUKVt, dummy, 0);
        conv_plain(C, ARGP(18), 4096, 2048, WMKVt, dummy, 0);
        conv_plain(C, ARGP(21), 1536, 4096, WOMLAt, dummy, 0);
        conv_plain(C, ARGP(22), 1536, 4096, WODSAt, dummy, 0);
        conv_plain(C, ARGP(23), 1024, 4096, WOMEMt, dummy, 0);
        conv_plain(C, ARGP(25), 4096, 4096, WOUTt, dummy, 0);
        rms_rows(C, MEM_IN, ARGP(17), memn, MROWS);
#endif
        rms_rows(C, X_IN, ARGP(3), Abuf, MTOK);
    }
    }
    SEAM(0);
    for (int rep_ = 0; rep_ < NREP(1); ++rep_) { if (rep_) REPBAR(1); if (IN(1)) ffn_up_phase(lds, Abuf, WGUt, Hmid, GRID);
    }
    SEAM(1);
    for (int rep_ = 0; rep_ < NREP(2); ++rep_) { if (rep_) REPBAR(2); if (IN(2)) ffn_down_phase(lds, Hmid, WDt, X_IN, XRES, GRID);
    }
    SEAM(2);
#if !DBG_SKIP_MIXER
    if (IN(3)) { const Ctx C = make_ctx(lds); rms_rows(C, XRES, ARGP(7), Abuf, MTOK); }
    SEAM(3);
    for (int rep_ = 0; rep_ < NREP(4); ++rep_) { if (rep_) REPBAR(4); if (IN(4)) {
        pg8::Gemm g{Abuf, WINt, MTOK, NIN, DM}; pg8::StaticOrder S; S.init(MTOK, NIN, GRID, (int)blockIdx.x);
        pg8::EpiInProj E{Pbuf, NPC, NPT, Gt, NGC};
        pg8::gemm_phase<pg8::EpiInProj, pg8::StaticOrder, true, true>(lds, g, S, E);
    }
    }
    SEAM(4);
    for (int rep_ = 0; rep_ < NREP(5); ++rep_) { if (rep_) REPBAR(5); if (IN(5)) { const Ctx C = make_ctx(lds);
        PP1 A{Pbuf, POS_IN, ARGP(9), ARGP(11), ARGP(15), ARGP(16), ARGP(19), CQn, CKVn, Qd, Kd, Vd, Qi, Ki, Kr, Qm, Wi};
        for (int t = C.gw; t < MTOK; t += C.NGW) pp1_token(A, t, C.lane);
    }
    }
    SEAM(5);
    for (int rep_ = 0; rep_ < NREP(6); ++rep_) { if (rep_) REPBAR(6); if (IN(6)) {
        { pg8::Gemm g{CQn, WUQt, MTOK, 2304, 1536}; pg8::StaticOrder S; S.init(MTOK, 2304, GRID, (int)blockIdx.x); pg8::EpiPlain E{QmlaRaw, 2304};
          pg8::gemm_phase<pg8::EpiPlain, pg8::StaticOrder, true, true>(lds, g, S, E); }
        { pg8::Gemm g{CKVn, WUKVt, MTOK, 3072, 512}; pg8::StaticOrder S; S.init(MTOK, 3072, GRID, (int)blockIdx.x); pg8::EpiPlain E{KVraw, 3072};
          pg8::gemm_phase<pg8::EpiPlain, pg8::StaticOrder, true, true>(lds, g, S, E); }
        { pg8::Gemm g{memn, WMKVt, MROWS, 2048, DM}; pg8::StaticOrder S; S.init(MROWS, 2048, GRID, (int)blockIdx.x); pg8::EpiPlain E{MKVraw, 2048};
          pg8::gemm_phase<pg8::EpiPlain, pg8::StaticOrder, true, true>(lds, g, S, E); }
    }
    }
    SEAM(6);
    for (int rep_ = 0; rep_ < NREP(7); ++rep_) { if (rep_) REPBAR(7); if (IN(7)) { const Ctx C = make_ctx(lds);
        PP2 A{QmlaRaw, KVraw, Kr, MKVraw, POS_IN, ARGP(13), ARGP(14), ARGP(20), Qmla, Kmla, MemK};
        for (int t = C.gw; t < MTOK; t += C.NGW) pp2_token(A, t, C.lane);
        for (int r = C.gw; r < MROWS; r += C.NGW) pp2_memrow(A, r, C.lane);
    }
    }
    SEAM(7);
    for (int rep_ = 0; rep_ < NREP(8); ++rep_) { if (rep_) REPBAR(8); if (IN(8)) { const Ctx C = make_ctx(lds); for (int p = blockIdx.x; p < 256; p += GRID) idx_item(p, Qi, Ki, Wi, Sc, C.wave, C.lane); }
    }
    SEAM(8);
    for (int rep_ = 0; rep_ < NREP(9); ++rep_) { if (rep_) REPBAR(9); if (IN(9)) { const Ctx C = make_ctx(lds); for (int t = C.gw; t < MTOK; t += C.NGW) select_row(Sc, (unsigned long long*)BM, t, C.lane, (LAS unsigned*)(lds + C.wave * 16384), (LAS unsigned long long*)(lds + MISC_OFF + 64 + C.wave * 1024)); }
    }
    SEAM(9);
    for (int rep_ = 0; rep_ < NREP(10); ++rep_) { if (rep_) REPBAR(10); if (IN(10)) {
        for (;;) {
            if (threadIdx.x == 0) MISC[4] = __hip_atomic_fetch_add(ctl + CW_QUEUE + 64 * rep_, 1u, __ATOMIC_RELAXED, __HIP_MEMORY_SCOPE_AGENT);
            __syncthreads();
            const int u = __builtin_amdgcn_readfirstlane((int)MISC[4]);
            __syncthreads();
            if (u >= 2048) break;
            if (u < 1536) {
                const int qt = 31 - u / 48, r = u % 48, type = r / 24, bh = r % 24, b = bh / 12, h = bh % 12;
                const size_t row0 = (size_t)b * SEQ + 256 * qt, krow0 = (size_t)b * SEQ;
                if (type == 0) { if (ATT_MASK & 1) attn_unit<192, 0>(lds, Qmla + row0 * 2304 + h * 192, 2304, Kmla + krow0 * 2304 + h * 192, 2304, KVraw + krow0 * 3072 + h * 256 + 128, 3072,
                                                 Ymla + row0 * 1536 + h * 128, 1536, 4 * qt + 4, 4 * qt, nullptr); }
                else if (ATT_MASK & 2) attn_unit<128, 1>(lds, Qd + row0 * 1536 + h * 128, 1536, Kd + krow0 * 1536 + h * 128, 1536, Vd + krow0 * 1536 + h * 128, 1536,
                                       Ydsa + row0 * 1536 + h * 128, 1536, 4 * qt + 4, 4 * qt, BM + row0 * 256);
            } else {
                const int v = u - 1536, b = v >> 8, h = (v >> 6) & 3, qt = (v >> 1) & 31, dvh = v & 1;
                const size_t row0 = (size_t)b * SEQ + 256 * qt, krow0 = (size_t)b * MEMLEN;
                if (ATT_MASK & 4) attn_unit<256, 2>(lds, Qm + row0 * 1024 + h * 256, 1024, MemK + krow0 * 1024 + h * 256, 1024, MKVraw + krow0 * 2048 + 1024 + h * 256 + dvh * 128, 2048,
                                  Ymem + row0 * 1024 + h * 256 + dvh * 128, 1024, 4, 0, nullptr);
            }
        }
    }
    }
    SEAM(10);
    for (int rep_ = 0; rep_ < NREP(11); ++rep_) { if (rep_) REPBAR(11); if (IN(11)) {
        { pg8::Gemm g{Ymla, WOMLAt, MTOK, DM, 1536}; pg8::StaticOrder S; S.init(MTOK, DM, GRID, (int)blockIdx.x); pg8::EpiGate<0> E{Gt, NGC, 0, GS, Abuf, DM};
          pg8::gemm_phase<pg8::EpiGate<0>, pg8::StaticOrder, true, true>(lds, g, S, E); }
        { pg8::Gemm g{Ydsa, WODSAt, MTOK, DM, 1536}; pg8::StaticOrder S; S.init(MTOK, DM, GRID, (int)blockIdx.x); pg8::EpiGate<1> E{Gt, NGC, DM, GS, Abuf, DM};
          pg8::gemm_phase<pg8::EpiGate<1>, pg8::StaticOrder, true, true>(lds, g, S, E); }
        { pg8::Gemm g{Ymem, WOMEMt, MTOK, DM, 1024}; pg8::StaticOrder S; S.init(MTOK, DM, GRID, (int)blockIdx.x); pg8::EpiGate<2> E{Gt, NGC, 2 * DM, GS, Abuf, DM};
          pg8::gemm_phase<pg8::EpiGate<2>, pg8::StaticOrder, true, true>(lds, g, S, E); }
    }
    }
    SEAM(11);
    if (IN(12)) {
        pg8::Gemm g{Abuf, WOUTt, MTOK, DM, DM}; pg8::StaticOrder S; S.init(MTOK, DM, GRID, (int)blockIdx.x); pg8::EpiResid E{XRES, XRES, DM, 1.0f};
        pg8::gemm_phase<pg8::EpiResid, pg8::StaticOrder, true, true>(lds, g, S, E);
    }
    SEAM(12);
#endif
    if (IN(13)) { const Ctx C = make_ctx(lds); conv_ffn(C, ARGP(27), ARGP(28), ARGP(29), WGUt, WDt); rms_rows(C, XRES, ARGP(26), Abuf, MTOK); }
    SEAM(13);
    if (IN(14)) ffn_up_phase(lds, Abuf, WGUt, Hmid, GRID);
    SEAM(14);
    if (IN(15)) ffn_down_phase(lds, Hmid, WDt, XRES, XRES, GRID);
#undef IN
#undef SEAM
}

#undef WGUt
#undef WDt
#undef WINt
#undef WUQt
#undef WUKVt
#undef WMKVt
#undef WOMLAt
#undef WODSAt
#undef WOMEMt
#undef WOUTt
#undef Abuf
#undef Hmid
#undef Gt
#undef Pbuf
#undef QmlaRaw
#undef KVraw
#undef Qmla
#undef Kmla
#undef GS
#undef CQn
#undef CKVn
#undef Qd
#undef Kd
#undef Vd
#undef Qi
#undef Ki
#undef Wi
#undef Kr
#undef Qm
#undef Ymla
#undef Ydsa
#undef Ymem
#undef BM
#undef memn
#undef MKVraw
#undef MemK
#undef Sc
#undef X_IN
#undef MEM_IN
#undef POS_IN
#undef XRES
#undef ARGQ
#undef ARGP
extern "C" void kernel_launch(void* const* d_in, const int* in_sizes, int n_in, void* d_out, int out_size, void* d_ws, size_t ws_size, hipStream_t stream) {
    static int grid = 0;
    if (grid == 0) {
        if (n_in != 30 || in_sizes[0] != MTOK * DM || out_size != MTOK * DM || ws_size < WS_END) {
            fprintf(stderr, "kernel_launch: built for 30 inputs, x/out of %d floats, >= %zu bytes of workspace; got n_in %d, in0 %d, out %d, ws %zu; nothing launched\n", MTOK * DM, (size_t)WS_END, n_in, n_in > 0 ? in_sizes[0] : -1, out_size, ws_size);
            grid = -1; return; }
        int dev = 0, cus = 0, per_cu = 0;
        if (hipGetDevice(&dev) != hipSuccess || hipDeviceGetAttribute(&cus, hipDeviceAttributeMultiprocessorCount, dev) != hipSuccess) { fprintf(stderr, "kernel_launch: device query failed\n"); grid = -1; return; }
        if (hipFuncSetAttribute((const void*)mega_fwd, hipFuncAttributeMaxDynamicSharedMemorySize, LDS_BYTES) != hipSuccess) { fprintf(stderr, "kernel_launch: hipFuncSetAttribute failed\n"); grid = -1; return; }
        if (hipOccupancyMaxActiveBlocksPerMultiprocessor(&per_cu, (const void*)mega_fwd, NWAVES * 64, LDS_BYTES) != hipSuccess || per_cu < 1)
            fprintf(stderr, "kernel_launch: note: occupancy query reports %d workgroups per CU\n", per_cu);
        (void)hipGetLastError();
        grid = cus;
    }
    if (grid < 0) return;
    if (hipMemsetAsync((char*)d_ws + WS_CTL, 0, CTL_ZERO_BYTES, stream) != hipSuccess) { fprintf(stderr, "kernel_launch: memset failed\n"); return; }
    Args a{};
    for (int i = 0; i < 30; ++i) a.in[i] = (const float*)d_in[i];
    a.out = (float*)d_out; a.ws = (unsigned char*)d_ws;
#if MK_MULTI
    for (int k = 0; k < NPH; ++k) { a.ph_lo = k; a.ph_hi = k + 1; hipLaunchKernelGGL(mega_fwd, dim3(grid), dim3(NWAVES * 64), LDS_BYTES, stream, a); }
#else
    a.ph_lo = 0; a.ph_hi = NPH;
    hipLaunchKernelGGL(mega_fwd, dim3(grid), dim3(NWAVES * 64), LDS_BYTES, stream, a);
#endif
    const hipError_t le = hipPeekAtLastError();
    if (le != hipSuccess) fprintf(stderr, "kernel_launch: launch failed: %s\n", hipGetErrorName(le));
}
```

```cpp
#include <hip/hip_runtime.h>
#include <cstdio>
#include <cstdint>
namespace pg8 {
#define PG8_LAS __attribute__((address_space(3)))
typedef unsigned short bf16_t;
typedef short bf16x8 __attribute__((ext_vector_type(8)));
typedef float f32x4 __attribute__((ext_vector_type(4)));
typedef unsigned u32x4 __attribute__((ext_vector_type(4)));
constexpr int BM = 256, BK = 64, HALF = 128, HTB = HALF * BK * 2  , STAGE_BYTES = 8 * HTB, NXCD = 8, WGM = 8;

__host__ __device__ __forceinline__ int lds_byte(int r, int c) { const int st = (r >> 4) * 2 + (c >> 5), rr = r & 15, cc = c & 31, ob = rr * 64 + cc * 2; return st * 1024 + (ob ^ (((ob >> 9) & 1) << 5)); }
__host__ __device__ __forceinline__ void stage_rc(int b, int& R, int& C) { const int st = b / 1024, sb = b % 1024, swz = sb ^ (((sb >> 9) & 1) << 5); R = (st >> 1) * 16 + swz / 64; C = (st & 1) * 32 + (swz % 64) / 2; }
__host__ __device__ __forceinline__ int perm32(int rho) { const int n = rho >> 4, i = rho & 15; return 8 * (i >> 2) + 4 * n + (i & 3); }

struct Unit { int pm, pn; };
struct Gemm { const bf16_t* A; const bf16_t* Bt; int M, N, K; };

struct StaticOrder {
    int nM, nN, nwg, G, c;
    __host__ __device__ void init(int M, int N, int G_, int c_) { nM = M / BM; nN = N / BM; nwg = nM * nN; G = G_; c = c_; }
    __host__ __device__ bool next(int i, Unit& u) const {
        const long L = (long)i * G + c; if (L >= nwg) return false;
        int wgid = (int)L; { const int q = nwg / NXCD, r = nwg % NXCD, xcd = wgid % NXCD, off = wgid / NXCD; wgid = (xcd < r ? xcd * (q + 1) : r * (q + 1) + (xcd - r) * q) + off; }
        const int nig = WGM * nN, gid = wgid / nig, fm = gid * WGM, gsz = (nM - fm) < WGM ? (nM - fm) : WGM;
        u.pm = fm + ((wgid % nig) % gsz); u.pn = (wgid % nig) / gsz; return true;
    }
    __device__ __forceinline__ void a_ready(const Unit&) const {}
    __device__ __forceinline__ void done(const Unit&) const {}
};
__device__ __forceinline__ unsigned cvt_pk_bf16(float lo, float hi) { unsigned r; asm volatile("v_cvt_pk_bf16_f32 %0, %1, %2" : "=v"(r) : "v"(lo), "v"(hi)); return r; }
__device__ __forceinline__ float sigmoid_f(float x) { return __builtin_amdgcn_rcpf(1.0f + __builtin_amdgcn_exp2f(-1.4426950408889634f * x)); }
struct EpiPlain {
    static constexpr bool PERM = true, AFTER_DRAIN = false;
    bf16_t* O; int ldc;
    __device__ __forceinline__ void operator()(const f32x4 (&acc)[2][2][4][2], const Unit& u, int wr, int wc, int fr, int fq) const {
        const int row0 = u.pm * BM + wr * 64 + fr, col0 = u.pn * BM + wc * 32 + 8 * fq;
#pragma unroll
        for (int ai = 0; ai < 2; ++ai)
#pragma unroll
            for (int m = 0; m < 4; ++m) { bf16_t* rowp = O + (size_t)(row0 + ai * HALF + m * 16) * ldc + col0;
#pragma unroll
                for (int bj = 0; bj < 2; ++bj) { const f32x4 v0 = acc[ai][bj][m][0], v1 = acc[ai][bj][m][1];
                    u32x4 w; w.x = cvt_pk_bf16(v0[0], v0[1]); w.y = cvt_pk_bf16(v0[2], v0[3]); w.z = cvt_pk_bf16(v1[0], v1[1]); w.w = cvt_pk_bf16(v1[2], v1[3]);
                    *(u32x4*)(rowp + bj * HALF) = w; } }
    }
};
struct EpiSwiGLU {
    static constexpr bool PERM = true, AFTER_DRAIN = false;
    bf16_t* O; int ldc;
    __device__ __forceinline__ void operator()(const f32x4 (&acc)[2][2][4][2], const Unit& u, int wr, int wc, int fr, int fq) const {
        const int row0 = u.pm * BM + wr * 64 + fr, col0 = u.pn * HALF + wc * 32 + 8 * fq;
#pragma unroll
        for (int ai = 0; ai < 2; ++ai)
#pragma unroll
            for (int m = 0; m < 4; ++m) { bf16_t* rowp = O + (size_t)(row0 + ai * HALF + m * 16) * ldc + col0;
                f32x4 r0, r1;
#pragma unroll
                for (int j = 0; j < 4; ++j) { const float g0 = acc[ai][0][m][0][j], g1 = acc[ai][0][m][1][j];
                    r0[j] = g0 * sigmoid_f(g0) * acc[ai][1][m][0][j]; r1[j] = g1 * sigmoid_f(g1) * acc[ai][1][m][1][j]; }
                u32x4 w; w.x = cvt_pk_bf16(r0[0], r0[1]); w.y = cvt_pk_bf16(r0[2], r0[3]); w.z = cvt_pk_bf16(r1[0], r1[1]); w.w = cvt_pk_bf16(r1[2], r1[3]);
                *(u32x4*)rowp = w; }
    }
};
struct EpiResid {
    static constexpr bool PERM = false, AFTER_DRAIN = false;
    const float* base; float* out; int ldc; float scale;
    __device__ __forceinline__ void operator()(const f32x4 (&acc)[2][2][4][2], const Unit& u, int wr, int wc, int fr, int fq) const {
        const int row0 = u.pm * BM + wr * 64 + fr, col0 = u.pn * BM + wc * 32 + 4 * fq;
#pragma unroll
        for (int ai = 0; ai < 2; ++ai)
#pragma unroll
            for (int m = 0; m < 4; ++m) { const size_t off = (size_t)(row0 + ai * HALF + m * 16) * ldc + col0;
#pragma unroll
                for (int bj = 0; bj < 2; ++bj)
#pragma unroll
                    for (int n = 0; n < 2; ++n) { const f32x4 b = *(const f32x4*)(base + off + bj * HALF + n * 16);
                        *(f32x4*)(out + off + bj * HALF + n * 16) = b + acc[ai][bj][m][n] * scale; } }
    }
};
struct EpiInProj {
    static constexpr bool PERM = true, AFTER_DRAIN = false;
    bf16_t* P; int ldp; int np; bf16_t* G; int ldg;
    __device__ __forceinline__ void operator()(const f32x4 (&acc)[2][2][4][2], const Unit& u, int wr, int wc, int fr, int fq) const {
        const int row0 = u.pm * BM + wr * 64 + fr; const bool isg = u.pn >= np;
        bf16_t* O = isg ? G : P; const int ldc = isg ? ldg : ldp; const int col0 = (isg ? u.pn - np : u.pn) * BM + wc * 32 + 8 * fq;
#pragma unroll
        for (int ai = 0; ai < 2; ++ai)
#pragma unroll
            for (int m = 0; m < 4; ++m) { bf16_t* rowp = O + (size_t)(row0 + ai * HALF + m * 16) * ldc + col0;
#pragma unroll
                for (int bj = 0; bj < 2; ++bj) { f32x4 v0 = acc[ai][bj][m][0], v1 = acc[ai][bj][m][1];
                    if (isg) {
#pragma unroll
                        for (int j = 0; j < 4; ++j) { v0[j] = sigmoid_f(v0[j]); v1[j] = sigmoid_f(v1[j]); } }
                    u32x4 w; w.x = cvt_pk_bf16(v0[0], v0[1]); w.y = cvt_pk_bf16(v0[2], v0[3]); w.z = cvt_pk_bf16(v1[0], v1[1]); w.w = cvt_pk_bf16(v1[2], v1[3]);
                    *(u32x4*)(rowp + bj * HALF) = w; } }
    }
};
template <int BR> struct EpiGate {
    static constexpr bool PERM = true, AFTER_DRAIN = false;
    const bf16_t* G; int ldg; int gcol0; float* GS; bf16_t* GSb; int ld;
    __device__ __forceinline__ void operator()(const f32x4 (&acc)[2][2][4][2], const Unit& u, int wr, int wc, int fr, int fq) const {
        const int row0 = u.pm * BM + wr * 64 + fr, col0 = u.pn * BM + wc * 32 + 8 * fq;
#pragma unroll
        for (int ai = 0; ai < 2; ++ai)
#pragma unroll
            for (int m = 0; m < 4; ++m) { const int row = row0 + ai * HALF + m * 16;
#pragma unroll
                for (int bj = 0; bj < 2; ++bj) { const int col = col0 + bj * HALF;
                    const u32x4 gw = *(const u32x4*)(G + (size_t)row * ldg + gcol0 + col);
                    f32x4 g0, g1;
                    g0[0] = __uint_as_float(gw.x << 16); g0[1] = __uint_as_float(gw.x & 0xffff0000u); g0[2] = __uint_as_float(gw.y << 16); g0[3] = __uint_as_float(gw.y & 0xffff0000u);
                    g1[0] = __uint_as_float(gw.z << 16); g1[1] = __uint_as_float(gw.z & 0xffff0000u); g1[2] = __uint_as_float(gw.w << 16); g1[3] = __uint_as_float(gw.w & 0xffff0000u);
                    f32x4 t0 = g0 * acc[ai][bj][m][0], t1 = g1 * acc[ai][bj][m][1];
                    float* gp = GS + (size_t)row * ld + col;
                    if (BR >= 1) { t0 = t0 + *(const f32x4*)gp; t1 = t1 + *(const f32x4*)(gp + 4); }
                    if (BR <= 1) { *(f32x4*)gp = t0; *(f32x4*)(gp + 4) = t1; }
                    else { u32x4 w; w.x = cvt_pk_bf16(t0[0], t0[1]); w.y = cvt_pk_bf16(t0[2], t0[3]); w.z = cvt_pk_bf16(t1[0], t1[1]); w.w = cvt_pk_bf16(t1[2], t1[3]);
                        *(u32x4*)(GSb + (size_t)row * ld + col) = w; } } }
    }
};
template <class Epi, class Sched, bool ALIGN_EPI = false, bool SP2 = false>
__device__ __forceinline__ void gemm_phase(PG8_LAS unsigned char* lds, const Gemm g, const Sched& S, const Epi& E) {
    int tid_ = threadIdx.x; asm volatile("" : "+v"(tid_));
    const int tid = tid_, wid = __builtin_amdgcn_readfirstlane(tid >> 6), lane = tid & 63, wr = wid >> 2, wc = wid & 3, fr = lane & 15, fq = lane >> 4;
    const int K = g.K, nt = K / BK;
    unsigned voffA[2], voffB[2];
#pragma unroll
    for (int i = 0; i < 2; ++i) { int R, C; stage_rc(tid * 16 + i * 8192, R, C); const int Rb = Epi::PERM ? ((R & ~31) + perm32(R & 31)) : R;
        voffA[i] = (unsigned)(R * K + C) * 2u; voffB[i] = (unsigned)(Rb * K + C) * 2u; }
    const size_t kstep = (size_t)(BK * 2);
    const size_t hstep = (size_t)HALF * K * 2;
    const size_t tstep = 2 * hstep;
    const unsigned ldsw = (unsigned)wid * 1024u;
    const int aoff = lds_byte(wr * 64 + fr, fq * 8), boff = lds_byte(wc * 32 + fr, fq * 8);
#define PG8_SA(b, h) (((b) * 2 + (h)) * HTB)
#define PG8_SB(b, h) ((4 + (b) * 2 + (h)) * HTB)
#define PG8_STAGE(bufoff, gbase, voff) do { _Pragma("unroll") for (int _i = 0; _i < 2; ++_i) \
        __builtin_amdgcn_global_load_lds((const unsigned*)((const char*)(gbase) + (voff)[_i]), (PG8_LAS unsigned*)(lds + (bufoff) + ldsw + _i * 8192), 16, 0, 0); } while (0)
#define PG8_LDA(dst, b, h) do { _Pragma("unroll") for (int m = 0; m < 4; ++m) _Pragma("unroll") for (int k = 0; k < 2; ++k) dst[m][k] = *(const PG8_LAS bf16x8*)(lds + PG8_SA(b, h) + aoff + m * 2048 + k * 1024); } while (0)
#define PG8_LDB(dst, b, h) do { _Pragma("unroll") for (int n = 0; n < 2; ++n) _Pragma("unroll") for (int k = 0; k < 2; ++k) dst[n][k] = *(const PG8_LAS bf16x8*)(lds + PG8_SB(b, h) + boff + n * 2048 + k * 1024); } while (0)
#define PG8_MMA(ai, bj, At, Bt) do { __builtin_amdgcn_s_setprio(1); _Pragma("unroll") for (int m = 0; m < 4; ++m) _Pragma("unroll") for (int n = 0; n < 2; ++n) _Pragma("unroll") for (int k = 0; k < 2; ++k) \
        acc[ai][bj][m][n] = __builtin_amdgcn_mfma_f32_16x16x32_bf16(Bt[n][k], At[m][k], acc[ai][bj][m][n], 0, 0, 0); __builtin_amdgcn_s_setprio(0); } while (0)
#define PG8_WAIT_V(n) asm volatile("s_waitcnt vmcnt(" #n ")" ::: "memory")
#define PG8_WAIT_L(n) asm volatile("s_waitcnt lgkmcnt(" #n ")" ::: "memory")
#define PG8_BAR __builtin_amdgcn_s_barrier()
#define PG8_SCHED __builtin_amdgcn_sched_barrier(0)
    Unit cur, nxt; int ui = 0;
    if (!S.next(0, cur)) return;
    f32x4 acc[2][2][4][2];
#pragma unroll
    for (int a = 0; a < 2; ++a)
#pragma unroll
        for (int b = 0; b < 2; ++b)
#pragma unroll
            for (int m = 0; m < 4; ++m)
#pragma unroll
                for (int n = 0; n < 2; ++n) acc[a][b][m][n] = (f32x4){0.f, 0.f, 0.f, 0.f};
    bf16x8 At[4][2], B0[2][2], B1[2][2];
    const char* cA = (const char*)g.A + (size_t)cur.pm * tstep; const char* cB = (const char*)g.Bt + (size_t)cur.pn * tstep;
    S.a_ready(cur);
    if constexpr (SP2) {
        PG8_STAGE(PG8_SB(0, 0), cB, voffB); PG8_STAGE(PG8_SB(0, 1), cB + hstep, voffB); PG8_STAGE(PG8_SA(0, 0), cA, voffA); PG8_STAGE(PG8_SA(0, 1), cA + hstep, voffA);
        if (wr == 1) PG8_BAR;
        PG8_WAIT_V(2); PG8_BAR;
        PG8_STAGE(PG8_SB(1, 0), cB + kstep, voffB); PG8_STAGE(PG8_SA(1, 0), cA + kstep, voffA); PG8_STAGE(PG8_SB(1, 1), cB + hstep + kstep, voffB);
        PG8_WAIT_V(6); PG8_BAR;
    } else {
        PG8_STAGE(PG8_SB(0, 0), cB, voffB); PG8_STAGE(PG8_SA(0, 0), cA, voffA); PG8_STAGE(PG8_SB(0, 1), cB + hstep, voffB); PG8_STAGE(PG8_SA(0, 1), cA + hstep, voffA);
        if (wr == 1) PG8_BAR;
        PG8_WAIT_V(4); PG8_BAR;
        PG8_STAGE(PG8_SB(1, 0), cB + kstep, voffB); PG8_STAGE(PG8_SA(1, 0), cA + kstep, voffA); PG8_STAGE(PG8_SB(1, 1), cB + hstep + kstep, voffB);
        PG8_WAIT_V(6); PG8_BAR;
    }
    for (;;) {
        const bool has_next = S.next(ui + 1, nxt);
        const char* nA = has_next ? (const char*)g.A + (size_t)nxt.pm * tstep : cA; const char* nB = has_next ? (const char*)g.Bt + (size_t)nxt.pn * tstep : cB;
        for (int t = 0; t < nt; t += 2) {
            const bool last = (t == nt - 2);
            const char* a1 = cA + (size_t)(t + 1) * kstep;
            const char* a2 = last ? nA : cA + (size_t)(t + 2) * kstep; const char* b2 = last ? nB : cB + (size_t)(t + 2) * kstep;
            const char* a3 = a2 + kstep; const char* b3 = b2 + kstep;
            if (last && has_next) S.a_ready(nxt);
            if constexpr (SP2) {
            PG8_LDB(B0, 0, 0); PG8_LDB(B1, 0, 1); PG8_SCHED; PG8_LDA(At, 0, 0); PG8_STAGE(PG8_SA(1, 1), a1 + hstep, voffA);
            PG8_WAIT_V(8); PG8_WAIT_L(0); PG8_BAR; PG8_MMA(0, 0, At, B0); PG8_MMA(0, 1, At, B1); PG8_BAR; PG8_SCHED;
            PG8_LDA(At, 0, 1); PG8_STAGE(PG8_SB(0, 0), b2, voffB); PG8_STAGE(PG8_SB(0, 1), b2 + hstep, voffB); PG8_STAGE(PG8_SA(0, 0), a2, voffA);
            PG8_WAIT_V(8); PG8_WAIT_L(0); PG8_BAR; PG8_MMA(1, 0, At, B0); PG8_MMA(1, 1, At, B1); PG8_BAR; PG8_SCHED;
            PG8_LDB(B0, 1, 0); PG8_LDB(B1, 1, 1); PG8_SCHED; PG8_LDA(At, 1, 0); PG8_STAGE(PG8_SA(0, 1), a2 + hstep, voffA);
            PG8_WAIT_V(8); PG8_WAIT_L(0); PG8_BAR; PG8_MMA(0, 0, At, B0); PG8_MMA(0, 1, At, B1); PG8_BAR; PG8_SCHED;
            PG8_LDA(At, 1, 1); PG8_STAGE(PG8_SB(1, 0), b3, voffB); PG8_STAGE(PG8_SB(1, 1), b3 + hstep, voffB); PG8_STAGE(PG8_SA(1, 0), a3, voffA);
            PG8_WAIT_V(8); PG8_WAIT_L(0); PG8_BAR; PG8_MMA(1, 0, At, B0); PG8_MMA(1, 1, At, B1); PG8_BAR; PG8_SCHED;
            } else {
            PG8_LDB(B0, 0, 0); PG8_SCHED; PG8_LDA(At, 0, 0); PG8_STAGE(PG8_SA(1, 1), a1 + hstep, voffA);
            PG8_WAIT_L(8); PG8_BAR; PG8_WAIT_L(0); PG8_MMA(0, 0, At, B0); PG8_BAR; PG8_SCHED;
            PG8_LDB(B1, 0, 1); PG8_STAGE(PG8_SB(0, 0), b2, voffB);
            PG8_BAR; PG8_WAIT_L(0); PG8_MMA(0, 1, At, B1); PG8_BAR;
            PG8_LDA(At, 0, 1); PG8_STAGE(PG8_SA(0, 0), a2, voffA);
            PG8_BAR; PG8_WAIT_L(0); PG8_MMA(1, 0, At, B0); PG8_BAR; PG8_SCHED;
            PG8_STAGE(PG8_SB(0, 1), b2 + hstep, voffB);
            PG8_WAIT_V(6); PG8_BAR; PG8_MMA(1, 1, At, B1); PG8_BAR;
            PG8_LDB(B0, 1, 0); PG8_SCHED; PG8_LDA(At, 1, 0); PG8_STAGE(PG8_SA(0, 1), a2 + hstep, voffA);
            PG8_WAIT_L(8); PG8_BAR; PG8_WAIT_L(0); PG8_MMA(0, 0, At, B0); PG8_BAR; PG8_SCHED;
            PG8_LDB(B1, 1, 1); PG8_STAGE(PG8_SB(1, 0), b3, voffB);
            PG8_BAR; PG8_WAIT_L(0); PG8_MMA(0, 1, At, B1); PG8_BAR;
            PG8_LDA(At, 1, 1); PG8_STAGE(PG8_SA(1, 0), a3, voffA);
            PG8_BAR; PG8_WAIT_L(0); PG8_MMA(1, 0, At, B0); PG8_BAR; PG8_SCHED;
            PG8_STAGE(PG8_SB(1, 1), b3 + hstep, voffB);
            PG8_WAIT_V(6); PG8_BAR; PG8_MMA(1, 1, At, B1); PG8_BAR;
            }
        }
        if constexpr (ALIGN_EPI) { if (wr == 0) PG8_BAR; }
        if constexpr (!Epi::AFTER_DRAIN) { E(acc, cur, wr, wc, fr, fq); S.done(cur); }
        if (!has_next) break;
#pragma unroll
        for (int a = 0; a < 2; ++a)
#pragma unroll
            for (int b = 0; b < 2; ++b)
#pragma unroll
                for (int m = 0; m < 4; ++m)
#pragma unroll
                    for (int n = 0; n < 2; ++n) acc[a][b][m][n] = (f32x4){0.f, 0.f, 0.f, 0.f};
        cur = nxt; cA = nA; cB = nB; ++ui;
        if constexpr (ALIGN_EPI) { if (wr == 1) PG8_BAR; }
    }
    PG8_WAIT_V(0);
    if constexpr (!ALIGN_EPI) { if (wr == 0) PG8_BAR; }
    PG8_BAR;
    if constexpr (Epi::AFTER_DRAIN) { E.fused(acc, cur, wr, wc, fr, fq, lds, wid, lane); S.done(cur); }
#undef PG8_SA
#undef PG8_SB
#undef PG8_STAGE
#undef PG8_LDA
#undef PG8_LDB
#undef PG8_MMA
#undef PG8_WAIT_V
#undef PG8_WAIT_L
#undef PG8_BAR
#undef PG8_SCHED
}
}
constexpr int NWAVES = 8;
constexpr int BATCH = 2, SEQ = 8192, DM = 4096, DFF = 11008, MTOK = BATCH * SEQ;
constexpr int MEMLEN = 256, MROWS = BATCH * MEMLEN;
constexpr float EPS = 1e-6f;
constexpr int NPC = 9984, NPT = NPC / 256;
constexpr int PC_CQ = 0, PC_CKV = 1536, PC_QD = 2048, PC_KD = 3584, PC_VD = 5120, PC_QI = 6656, PC_QM = 8704, PC_KR = 9728, PC_KI = 9792, PC_WI = 9856;
constexpr int NGC = 3 * DM;
constexpr int NIN = NPC + NGC;
constexpr int NGU = 2 * DFF;
constexpr float LOG2E = 1.4426950408889634f;
constexpr float QS_MLA = 0.07216878364870322f * LOG2E;
constexpr float QS_DSA = 0.08838834764831845f * LOG2E;
constexpr float QS_MEM = 0.0625f * LOG2E;
constexpr float LOG2_THETA = 18.931568569324174f;

constexpr size_t MiB = 1u << 20;
constexpr size_t WS_CTL = 0, CTL_ZERO_BYTES = 1 * MiB;
constexpr size_t WS_WGU = 1 * MiB;
constexpr size_t WS_WD = 173 * MiB;
constexpr size_t WS_SC = 1 * MiB;
constexpr size_t WS_WIN = 259 * MiB;
constexpr size_t WS_WUQ = 433 * MiB, WS_WUKV = 440 * MiB, WS_WMKV = 443 * MiB, WS_WOMLA = 459 * MiB, WS_WODSA = 471 * MiB, WS_WOMEM = 483 * MiB, WS_WOUT = 491 * MiB;
constexpr size_t WS_A = 523 * MiB;
constexpr size_t WS_BIG = 651 * MiB;
constexpr size_t WS_HMID = WS_BIG;
constexpr size_t WS_G = WS_BIG;
constexpr size_t WS_P = 1035 * MiB;
constexpr size_t WS_QMLARAW = 1035 * MiB, WS_KVRAW = 1107 * MiB, WS_QMLA = 1203 * MiB, WS_KMLA = 1275 * MiB;
constexpr size_t WS_GS = 1035 * MiB;
constexpr size_t WS_CQN = 1347 * MiB, WS_CKVN = 1395 * MiB, WS_QD = 1411 * MiB, WS_KD = 1459 * MiB, WS_VD = 1507 * MiB, WS_QI = 1555 * MiB, WS_KI = 1619 * MiB, WS_WI = 1621 * MiB, WS_KR = 1623 * MiB, WS_QM = 1625 * MiB;
constexpr size_t WS_YMLA = 1657 * MiB, WS_YDSA = 1705 * MiB, WS_YMEM = 1753 * MiB, WS_BM = 1785 * MiB, WS_MEMN = 1801 * MiB, WS_MKVRAW = 1805 * MiB, WS_MEMK = 1807 * MiB, WS_END = 1808 * MiB;
constexpr size_t SC_BATCH = (size_t)4096 * 8256;
static_assert(WS_SC + 2 * SC_BATCH * 4 <= WS_WIN, "scores fit the FFN weight region");
static_assert(WS_WGU + (size_t)NGU * DM * 2 <= WS_WD && WS_WD + (size_t)DM * DFF * 2 <= WS_WIN, "FFN weights");
static_assert(WS_WIN + (size_t)NIN * DM * 2 <= WS_WUQ, "win");
static_assert(WS_HMID + (size_t)MTOK * DFF * 2 <= WS_P && WS_G + (size_t)MTOK * NGC * 2 <= WS_P && WS_P + (size_t)MTOK * NPC * 2 <= WS_CQN, "big region");
static_assert(WS_GS + (size_t)MTOK * DM * 4 <= WS_CQN, "GS");
constexpr int CW_BAR = 4096, CW_QUEUE = 8192;

constexpr int RING_BYTES = 131072, MISC_OFF = RING_BYTES, LDS_BYTES = 147456;

#define GAS __attribute__((address_space(1)))
#define LAS __attribute__((address_space(3)))
#define DI __device__ __forceinline__
typedef unsigned short bf16;
typedef unsigned v4u __attribute__((ext_vector_type(4)));
typedef unsigned v2u __attribute__((ext_vector_type(2)));
typedef float f32x4 __attribute__((ext_vector_type(4)));
typedef float f32x16 __attribute__((ext_vector_type(16)));
typedef short bf16x8 __attribute__((ext_vector_type(8)));
typedef short s16x4 __attribute__((ext_vector_type(4)));
#define LDS_WAIT() asm volatile("s_waitcnt lgkmcnt(0)" ::: "memory")
DI float bf2f(bf16 v) { return __uint_as_float(((unsigned)v) << 16); }
DI unsigned f2bf(float f) { unsigned u = __float_as_uint(f); return (u + 0x7fffu + ((u >> 16) & 1u)) >> 16; }
DI unsigned pk2(float lo, float hi) { return f2bf(lo) | (f2bf(hi) << 16); }
DI float wave_sum(float v) {
#pragma unroll
    for (int o = 1; o < 64; o <<= 1) v += __shfl_xor(v, o);
    return v;
}
DI void sincos_rev(float ang, float& s, float& c) {
    double rev = (double)ang * 0.15915494309189535; rev -= __builtin_rint(rev);
    const float fr = (float)rev; s = __builtin_amdgcn_sinf(fr); c = __builtin_amdgcn_cosf(fr);
}
DI float inv_freq(int i, int half) { return __builtin_amdgcn_exp2f(-(float)i * (LOG2_THETA / (float)half)); }
#define XB_TMO      128
#define XB_XCNT(j)  (256  + 64 * (j))
#define XB_XSUB(j)  (1280 + 64 * (j))
#define XB_XGEN(j)  (2304 + 64 * (j))
#define XB_TOP      3328
#define XB_TOPGEN   3392
#define XCD_BAR_WORDS 3456
#define XB_SPIN_CAP (1u << 18)

__device__ __forceinline__ unsigned xb_ld(unsigned* p)              { return __hip_atomic_load(p, __ATOMIC_RELAXED, __HIP_MEMORY_SCOPE_AGENT); }
__device__ __forceinline__ unsigned xb_add(unsigned* p, unsigned v) { return __hip_atomic_fetch_add(p, v, __ATOMIC_RELAXED, __HIP_MEMORY_SCOPE_AGENT); }
__device__ __forceinline__ unsigned xb_xcc_id() { return (unsigned)__builtin_amdgcn_s_getreg((3 << 11) | 20) & 0xFu; }
#define XB_SPIN(cond, bar) do { unsigned _sp = 0; while (cond) { __builtin_amdgcn_s_sleep(1); \
    if ((++_sp & 255u) == 0u) { if (xb_ld(&(bar)[XB_TMO])) break; if (_sp > XB_SPIN_CAP) { atomicAdd(&(bar)[XB_TMO], 1u); break; } } } } while (0)

struct XcdBarrier {
    unsigned* bar; unsigned x;
    volatile LAS unsigned* st;
};

__device__ __forceinline__ XcdBarrier xcd_barrier_post(unsigned* bar, volatile LAS unsigned* st) {
    XcdBarrier b; b.bar = bar; b.x = xb_xcc_id(); b.st = st;
    if (threadIdx.x == 0) (void)xb_add(&bar[XB_XCNT(b.x)], 1u);
    return b;
}
__device__ __forceinline__ void xcd_barrier_complete(unsigned* bar, unsigned x, unsigned& nloc, unsigned& nx) {
    const unsigned G = gridDim.x * gridDim.y * gridDim.z;
    unsigned sum, cnt, mine, sp = 0u;
    for (;;) {
        sum = 0u; cnt = 0u; mine = 0u;
#pragma unroll
        for (unsigned j = 0; j < 16; ++j) { const unsigned c = xb_ld(&bar[XB_XCNT(j)]); sum += c; cnt += (c > 0u) ? 1u : 0u; mine = (j == x) ? c : mine; }
        if (sum == G) break;
        __builtin_amdgcn_s_sleep(1);
        if ((++sp & 255u) == 0u) { if (xb_ld(&bar[XB_TMO])) break; if (sp > XB_SPIN_CAP) { atomicAdd(&bar[XB_TMO], 1u); break; } }
    }
    nloc = mine > 0u ? mine : 1u; nx = cnt > 0u ? cnt : 1u;
}

__device__ __forceinline__ void xcd_barrier(const XcdBarrier& b) {
    asm volatile("s_waitcnt vmcnt(0)" ::: "memory");
    __syncthreads();
    if (threadIdx.x == 0) {
        unsigned* bar = b.bar;
        __builtin_amdgcn_s_waitcnt(0);
        unsigned nloc = b.st[0], nx = b.st[1];
        if (nloc == 0u) { xcd_barrier_complete(bar, b.x, nloc, nx); b.st[0] = nloc; b.st[1] = nx; }
        const unsigned old = xb_add(&bar[XB_XSUB(b.x)], 1u);
        const unsigned gen = old / nloc;
        if (old + 1u == (gen + 1u) * nloc) {
            __builtin_amdgcn_fence(__ATOMIC_RELEASE, "agent");
            asm volatile("s_waitcnt vmcnt(0)" ::: "memory");
            const unsigned og = xb_add(&bar[XB_TOP], 1u);
            const unsigned tg = og / nx;
            if (og + 1u == (tg + 1u) * nx) xb_add(&bar[XB_TOPGEN], 1u);
            else XB_SPIN(xb_ld(&bar[XB_TOPGEN]) == tg, bar);
            __builtin_amdgcn_fence(__ATOMIC_ACQUIRE, "agent");
            xb_add(&bar[XB_XGEN(b.x)], 1u);
            asm volatile("s_waitcnt vmcnt(0)" ::: "memory");
        } else {
            XB_SPIN(xb_ld(&bar[XB_XGEN(b.x)]) == gen, bar);
            __builtin_amdgcn_fence(__ATOMIC_ACQUIRE, "agent");
            asm volatile("s_waitcnt vmcnt(0)" ::: "memory");
        }
    }
    __syncthreads();
}
struct Ctx {
    LAS unsigned char* lds;
    int tid, lane, wave, G, gw, NGW;
};
DI Ctx make_ctx(LAS unsigned char* lds) {
    int t = threadIdx.x; asm volatile("" : "+v"(t));
    Ctx C; C.lds = lds; C.tid = t; C.lane = t & 63; C.wave = __builtin_amdgcn_readfirstlane(t >> 6);
    C.G = gridDim.x; C.gw = blockIdx.x * 8 + C.wave; C.NGW = C.G * 8; return C;
}

DI void conv_item(const float* W, int ldw, int col0, int k0, bf16* WT, int K, int drow0, bool zero, LAS float* scr, int lane) {
#pragma unroll 8
    for (int i = 0; i < 32; ++i) { const int kk = 2 * i + (lane >> 5); scr[kk * 33 + (lane & 31)] = zero ? 0.f : W[(size_t)(k0 + kk) * ldw + col0 + (lane & 31)]; }
    LDS_WAIT(); asm volatile("" ::: "memory");
    const int c = lane & 7;
#pragma unroll
    for (int j = 0; j < 4; ++j) { const int n = (lane >> 3) + 8 * j; const LAS float* s = scr + (8 * c) * 33 + n;
        v4u o; o.x = pk2(s[0 * 33], s[1 * 33]); o.y = pk2(s[2 * 33], s[3 * 33]); o.z = pk2(s[4 * 33], s[5 * 33]); o.w = pk2(s[6 * 33], s[7 * 33]);
        *(GAS v4u*)(WT + (size_t)(drow0 + n) * K + k0 + 8 * c) = o; }
    LDS_WAIT(); asm volatile("" ::: "memory");
}
DI int inproj_src(int d) {
    if (d < 2048) return d;
    if (d < 8704) return d + 64;
    if (d < 9728) return d + 160;
    if (d < 9792) return d - 7680;
    if (d < 9888) return d - 1024;
    return -1;
}
DI void conv_ffn(const Ctx& C, const float* wg, const float* wu, const float* wd, bf16* WGUt, bf16* WDt) {
    LAS float* scr = (LAS float*)(C.lds + C.wave * 16384);
    constexpr int I_GU = (DM / 64) * (NGU / 32), I_D = (DFF / 64) * (DM / 32);
    for (int it = C.gw; it < I_GU + I_D; it += C.NGW) {
        if (it < I_GU) { const int nblk = NGU / 32, kb = it / nblk, nb = it % nblk, n0 = nb * 32, pn = n0 >> 8, bj = (n0 >> 7) & 1, c = n0 & 127;
            conv_item(bj ? wu : wg, DFF, 128 * pn + c, 64 * kb, WGUt, DM, n0, false, scr, C.lane); }
        else { const int r = it - I_GU, nblk = DM / 32, kb = r / nblk, nb = r % nblk;
            conv_item(wd, DM, 32 * nb, 64 * kb, WDt, DFF, 32 * nb, false, scr, C.lane); }
    }
}
DI void conv_plain(const Ctx& C, const float* w, int K, int N, bf16* wt, int& base, int total_dummy) { (void)base; (void)total_dummy;
    LAS float* scr = (LAS float*)(C.lds + C.wave * 16384);
    const int nblk = N / 32, items = (K / 64) * nblk;
    for (int it = C.gw; it < items; it += C.NGW) { const int kb = it / nblk, nb = it % nblk; conv_item(w, N, 32 * nb, 64 * kb, wt, K, 32 * nb, false, scr, C.lane); }
}
DI void conv_win(const Ctx& C, const float* w_in, const float* w_gate, bf16* wt) {
    LAS float* scr = (LAS float*)(C.lds + C.wave * 16384);
    constexpr int nblk = NIN / 32, items = (DM / 64) * nblk;
    for (int it = C.gw; it < items; it += C.NGW) { const int kb = it / nblk, nb = it % nblk, n0 = 32 * nb;
        if (n0 < NPC) { const int sc = inproj_src(n0); conv_item(w_in, 9888, sc < 0 ? 0 : sc, 64 * kb, wt, DM, n0, sc < 0, scr, C.lane); }
        else { const int gi = n0 - NPC, br = gi / DM, col = gi % DM; conv_item(w_gate + (size_t)br * DM * DM, DM, col, 64 * kb, wt, DM, n0, false, scr, C.lane); } }
}
DI void rms_row4096(const float* xrow, const float* g, bf16* orow, int lane) {
    const GAS f32x4* xr = (const GAS f32x4*)xrow + lane; const GAS f32x4* gr = (const GAS f32x4*)g + lane;
    f32x4 v[16]; float s = 0.f;
#pragma unroll
    for (int j = 0; j < 16; ++j) { v[j] = xr[64 * j]; s += (v[j].x * v[j].x + v[j].y * v[j].y) + (v[j].z * v[j].z + v[j].w * v[j].w); }
    const float rstd = rsqrtf(wave_sum(s) * (1.f / 4096.f) + EPS);
    GAS v2u* o8 = (GAS v2u*)orow + lane;
#pragma unroll
    for (int j = 0; j < 16; ++j) { const f32x4 gg = gr[64 * j]; v2u o; o.x = pk2(v[j].x * rstd * gg.x, v[j].y * rstd * gg.y); o.y = pk2(v[j].z * rstd * gg.z, v[j].w * rstd * gg.w); o8[64 * j] = o; }
}
DI void rms_rows(const Ctx& C, const float* x, const float* g, bf16* o, int rows) {
    for (int m = C.gw; m < rows; m += C.NGW) rms_row4096(x + (size_t)m * DM, g, o + (size_t)m * DM, C.lane);
}

struct PP1 { const bf16* P; const int* pos; const float *g_cq, *g_ckv, *g_qd, *g_kd, *g_qm;
             bf16 *CQn, *CKVn, *Qd, *Kd, *Vd, *Qi, *Ki, *Kr, *Qm; float* Wi; };
DI void pp1_token(const PP1& A, int t, int lane) {
    const bf16* pr = A.P + (size_t)t * NPC;
    const float pos = (float)A.pos[t];
    float sn_d, cs_d, sn_i, cs_i;
    sincos_rev(pos * inv_freq(lane & 15, 16), sn_d, cs_d);
    sincos_rev(pos * inv_freq(lane & 7, 8), sn_i, cs_i);
    {
        float x[24]; float ss = 0.f;
#pragma unroll
        for (int k = 0; k < 24; ++k) { x[k] = bf2f(pr[PC_CQ + lane + 64 * k]); ss += x[k] * x[k]; }
        const float rstd = rsqrtf(wave_sum(ss) * (1.f / 1536.f) + EPS);
#pragma unroll
        for (int k = 0; k < 24; ++k) A.CQn[(size_t)t * 1536 + lane + 64 * k] = (bf16)f2bf(x[k] * rstd * A.g_cq[lane + 64 * k]);
    }
    {
        float x[8]; float ss = 0.f;
#pragma unroll
        for (int k = 0; k < 8; ++k) { x[k] = bf2f(pr[PC_CKV + lane + 64 * k]); ss += x[k] * x[k]; }
        const float rstd = rsqrtf(wave_sum(ss) * (1.f / 512.f) + EPS);
#pragma unroll
        for (int k = 0; k < 8; ++k) A.CKVn[(size_t)t * 512 + lane + 64 * k] = (bf16)f2bf(x[k] * rstd * A.g_ckv[lane + 64 * k]);
    }
#pragma unroll 1
    for (int qk = 0; qk < 2; ++qk) {
        const int pc = qk ? PC_KD : PC_QD; const float* g = qk ? A.g_kd : A.g_qd; bf16* O = qk ? A.Kd : A.Qd; const float sc = qk ? 1.0f : QS_DSA;
        const float g0 = g[lane], g1 = g[64 + lane];
#pragma unroll 4
        for (int h = 0; h < 12; ++h) {
            const float x0 = bf2f(pr[pc + h * 128 + lane]), x1 = bf2f(pr[pc + h * 128 + 64 + lane]);
            const float rstd = rsqrtf(wave_sum(x0 * x0 + x1 * x1) * (1.f / 128.f) + EPS);
            float y0 = x0 * rstd * g0; const float y1 = x1 * rstd * g1;
            const float pr0 = __shfl_xor(y0, 16);
            if (lane < 16) y0 = y0 * cs_d - pr0 * sn_d; else if (lane < 32) y0 = y0 * cs_d + pr0 * sn_d;
            O[(size_t)t * 1536 + h * 128 + lane] = (bf16)f2bf(y0 * sc); O[(size_t)t * 1536 + h * 128 + 64 + lane] = (bf16)f2bf(y1 * sc);
        }
    }
#pragma unroll
    for (int k = 0; k < 24; ++k) A.Vd[(size_t)t * 1536 + lane + 64 * k] = pr[PC_VD + lane + 64 * k];
#pragma unroll 4
    for (int h = 0; h < 32; ++h) {
        float x = bf2f(pr[PC_QI + h * 64 + lane]); const float px = __shfl_xor(x, 8);
        if (lane < 8) x = x * cs_i - px * sn_i; else if (lane < 16) x = x * cs_i + px * sn_i;
        A.Qi[(size_t)t * 2048 + h * 64 + lane] = (bf16)f2bf(x);
    }
    {
        float x = bf2f(pr[PC_KI + lane]); const float px = __shfl_xor(x, 8);
        if (lane < 8) x = x * cs_i - px * sn_i; else if (lane < 16) x = x * cs_i + px * sn_i;
        A.Ki[(size_t)t * 64 + lane] = (bf16)f2bf(x);
        if (lane < 32) A.Wi[(size_t)t * 32 + lane] = bf2f(pr[PC_WI + lane]);
        A.Kr[(size_t)t * 64 + lane] = pr[PC_KR + lane];
    }
#pragma unroll
    for (int h = 0; h < 4; ++h) {
        float x[4]; float ss = 0.f;
#pragma unroll
        for (int k = 0; k < 4; ++k) { x[k] = bf2f(pr[PC_QM + h * 256 + lane + 64 * k]); ss += x[k] * x[k]; }
        const float rstd = rsqrtf(wave_sum(ss) * (1.f / 256.f) + EPS) * QS_MEM;
#pragma unroll
        for (int k = 0; k < 4; ++k) A.Qm[(size_t)t * 1024 + h * 256 + lane + 64 * k] = (bf16)f2bf(x[k] * rstd * A.g_qm[lane + 64 * k]);
    }
}
struct PP2 { const bf16 *QmlaRaw, *KVraw, *Kr, *MKVraw; const int* pos; const float *g_q, *g_k, *g_km; bf16 *Qmla, *Kmla, *MemK; };
DI void pp2_token(const PP2& A, int t, int lane) {
    const float pos = (float)A.pos[t];
    float sn, cs; sincos_rev(pos * inv_freq(lane & 31, 32), sn, cs);
    const float gq0 = A.g_q[lane], gq1 = A.g_q[64 + lane], gq2 = A.g_q[128 + lane], gk0 = A.g_k[lane], gk1 = A.g_k[64 + lane], gk2 = A.g_k[128 + lane];
    const float kr = bf2f(A.Kr[(size_t)t * 64 + lane]);
#pragma unroll 2
    for (int h = 0; h < 12; ++h) {
        {   const bf16* q = A.QmlaRaw + (size_t)t * 2304 + h * 192;
            const float x0 = bf2f(q[lane]), x1 = bf2f(q[64 + lane]), x2 = bf2f(q[128 + lane]);
            const float rstd = rsqrtf(wave_sum(x0 * x0 + x1 * x1 + x2 * x2) * (1.f / 192.f) + EPS);
            float y0 = x0 * rstd * gq0; const float y1 = x1 * rstd * gq1, y2 = x2 * rstd * gq2;
            const float p0 = __shfl_xor(y0, 32); y0 = (lane < 32) ? y0 * cs - p0 * sn : y0 * cs + p0 * sn;
            bf16* o = A.Qmla + (size_t)t * 2304 + h * 192;
            o[lane] = (bf16)f2bf(y0 * QS_MLA); o[64 + lane] = (bf16)f2bf(y1 * QS_MLA); o[128 + lane] = (bf16)f2bf(y2 * QS_MLA); }
        {   const bf16* kv = A.KVraw + (size_t)t * 3072 + h * 256;
            const float x0 = kr, x1 = bf2f(kv[lane]), x2 = bf2f(kv[64 + lane]);
            const float rstd = rsqrtf(wave_sum(x0 * x0 + x1 * x1 + x2 * x2) * (1.f / 192.f) + EPS);
            float y0 = x0 * rstd * gk0; const float y1 = x1 * rstd * gk1, y2 = x2 * rstd * gk2;
            const float p0 = __shfl_xor(y0, 32); y0 = (lane < 32) ? y0 * cs - p0 * sn : y0 * cs + p0 * sn;
            bf16* o = A.Kmla + (size_t)t * 2304 + h * 192;
            o[lane] = (bf16)f2bf(y0); o[64 + lane] = (bf16)f2bf(y1); o[128 + lane] = (bf16)f2bf(y2); }
    }
}
DI void pp2_memrow(const PP2& A, int r, int lane) {
#pragma unroll
    for (int h = 0; h < 4; ++h) {
        float x[4]; float ss = 0.f;
#pragma unroll
        for (int k = 0; k < 4; ++k) { x[k] = bf2f(A.MKVraw[(size_t)r * 2048 + h * 256 + lane + 64 * k]); ss += x[k] * x[k]; }
        const float rstd = rsqrtf(wave_sum(ss) * (1.f / 256.f) + EPS);
#pragma unroll
        for (int k = 0; k < 4; ++k) A.MemK[(size_t)r * 1024 + h * 256 + lane + 64 * k] = (bf16)f2bf(x[k] * rstd * A.g_km[lane + 64 * k]);
    }
}

#define MFMA32(a, b, c) __builtin_amdgcn_mfma_f32_32x32x16_bf16((a), (b), (c), 0, 0, 0)
DI float half_swap_sum(float v) { auto rr = __builtin_amdgcn_permlane32_swap(__float_as_uint(v), __float_as_uint(v), false, false); return __uint_as_float(rr[0]) + __uint_as_float(rr[1]); }
DI float half_swap_max(float v) { auto rr = __builtin_amdgcn_permlane32_swap(__float_as_uint(v), __float_as_uint(v), false, false); return fmaxf(__uint_as_float(rr[0]), __uint_as_float(rr[1])); }
DI size_t sc_block_off(int b, int bi) { return (size_t)b * SC_BATCH + (size_t)4096 * (size_t)(bi * (bi + 1) / 2); }
DI void idx_item(int p, const bf16* Qi, const bf16* Ki, const float* Wi, float* Sc, int wave, int lane) {
    const int b = p >> 7, r = p & 127, hs = r & 1, k = r >> 1, r32 = lane & 31, hi = lane >> 5;
#pragma unroll 1
    for (int which = 0; which < 2; ++which) {
        const int bi = which ? 127 - k : k, nt32 = (bi + 1) * 2, ncol = (bi + 1) * 64;
        float* scb = Sc + sc_block_off(b, bi);
#pragma unroll 1
        for (int pass = 0; pass < 2; ++pass) {
            const int qa = 32 * hs + 4 * wave + 2 * pass, ta = b * SEQ + bi * 64 + qa;
            bf16x8 A0[4], A1[4]; f32x4 w0[4], w1[4];
#pragma unroll
            for (int d0 = 0; d0 < 4; ++d0) { A0[d0] = *(const bf16x8*)(Qi + (size_t)ta * 2048 + r32 * 64 + d0 * 16 + hi * 8); A1[d0] = *(const bf16x8*)(Qi + (size_t)(ta + 1) * 2048 + r32 * 64 + d0 * 16 + hi * 8); }
#pragma unroll
            for (int g = 0; g < 4; ++g) { w0[g] = *(const f32x4*)(Wi + (size_t)ta * 32 + 8 * g + 4 * hi); w1[g] = *(const f32x4*)(Wi + (size_t)(ta + 1) * 32 + 8 * g + 4 * hi); }
            float* o0 = scb + (size_t)qa * ncol + r32; float* o1 = o0 + ncol;
            const bf16* kp = Ki + (size_t)(b * SEQ + r32) * 64 + hi * 8;
#define IDX_LOADB(B, kt_) do { _Pragma("unroll") for (int d0_ = 0; d0_ < 4; ++d0_) B[d0_] = *(const bf16x8*)(kp + (size_t)(kt_) * 2048 + d0_ * 16); } while (0)
#define IDX_MMA(c0_, c1_, B) do { _Pragma("unroll") for (int i_ = 0; i_ < 16; ++i_) { c0_[i_] = 0.f; c1_[i_] = 0.f; } \
        _Pragma("unroll") for (int d0_ = 0; d0_ < 4; ++d0_) { c0_ = MFMA32(A0[d0_], B[d0_], c0_); c1_ = MFMA32(A1[d0_], B[d0_], c1_); } } while (0)
#define IDX_EPI(c0_, c1_, kt_) do { float s0_ = 0.f, s1_ = 0.f; \
        _Pragma("unroll") for (int i_ = 0; i_ < 16; ++i_) { s0_ = fmaf(w0[i_ >> 2][i_ & 3], fmaxf(c0_[i_], 0.f), s0_); s1_ = fmaf(w1[i_ >> 2][i_ & 3], fmaxf(c1_[i_], 0.f), s1_); } \
        s0_ = half_swap_sum(s0_); s1_ = half_swap_sum(s1_); if (hi == 0) { o0[(kt_) * 32] = s0_; o1[(kt_) * 32] = s1_; } } while (0)
            bf16x8 BA[4], BB[4]; f32x16 cA0, cA1, cB0, cB1;
            IDX_LOADB(BA, 0); IDX_LOADB(BB, 1);
            IDX_MMA(cA0, cA1, BA);
#pragma unroll 1
            for (int kt = 0; kt < nt32; kt += 2) {
                const bool more = kt + 2 < nt32;
                IDX_MMA(cB0, cB1, BB);
                if (more) IDX_LOADB(BA, kt + 2);
                IDX_EPI(cA0, cA1, kt);
                if (more) { IDX_MMA(cA0, cA1, BA); IDX_LOADB(BB, kt + 3); }
                IDX_EPI(cB0, cB1, kt + 1);
            }
#undef IDX_LOADB
#undef IDX_MMA
#undef IDX_EPI
        }
    }
}
DI int suffix_scan64(int v, int lane) {
#pragma unroll
    for (int o = 1; o < 64; o <<= 1) { const int tv = __shfl_down(v, o); if (lane + o < 64) v += tv; }
    return v;
}
template <int NBITS, bool FIRST>
DI int radix_pass(const unsigned (&key)[128], int NG, int shift, unsigned& prefix, int& remaining, LAS unsigned* hist, int lane) {
    constexpr int NB = 1 << NBITS, PER = NB / 64;
#pragma unroll
    for (int q = 0; q < PER / 4; ++q) *(LAS v4u*)(hist + PER * lane + 4 * q) = (v4u){0u, 0u, 0u, 0u};
#pragma unroll
    for (int g = 0; g < 8; ++g) {
        if (g < NG) {
#pragma unroll
            for (int r = 0; r < 16; ++r) { const unsigned k = key[16 * g + r];
                const bool ok = FIRST || ((k >> (shift + NBITS)) == prefix);
                if (ok) __hip_atomic_fetch_add(hist + ((k >> shift) & (unsigned)(NB - 1)), 1u, __ATOMIC_RELAXED, __HIP_MEMORY_SCOPE_WORKGROUP); }
        }
    }
    LDS_WAIT();
    int lane_sum = 0;
#pragma unroll
    for (int q = 0; q < PER / 4; ++q) { const v4u bb = *(LAS v4u*)(hist + PER * lane + 4 * q); lane_sum += (int)(bb.x + bb.y + bb.z + bb.w); }
    const int S = suffix_scan64(lane_sum, lane), above = S - lane_sum;
    const int src = __builtin_amdgcn_readfirstlane((int)__ffsll((long long)__ballot((above < remaining) && (remaining <= S))) - 1) & 63;
    const int rem2 = remaining - __builtin_amdgcn_readlane(above, src);
    const int bv = (lane < PER) ? (int)hist[PER * src + lane] : 0;
    const int S2 = suffix_scan64(bv, lane), above2 = S2 - bv;
    const int src2 = __builtin_amdgcn_readfirstlane((int)__ffsll((long long)__ballot((above2 < rem2) && (rem2 <= S2))) - 1) & 63;
    prefix = (prefix << NBITS) | (unsigned)(PER * src + src2);
    remaining = rem2 - __builtin_amdgcn_readlane(above2, src2);
    const int cnt = __builtin_amdgcn_readlane(bv, src2);
    LDS_WAIT();
    return cnt;
}
DI void select_row(const float* Sc, unsigned long long* BM64, int t, int lane, LAS unsigned* hist, LAS unsigned long long* scr) {
    const int b = t / SEQ, s = t % SEQ, bi = s >> 6, n = (bi + 1) * 64;
    const float* row = Sc + sc_block_off(b, bi) + (size_t)(s & 63) * n;
    unsigned long long* out = BM64 + (size_t)t * 128;
    if (n <= 256) {
        out[lane] = (lane < n / 64) ? ~0ull : 0ull; out[64 + lane] = 0ull; return;
    }
    const int NG = (n + 1023) >> 10;
    unsigned key[128];
#pragma unroll
    for (int g = 0; g < 8; ++g) {
        if (g < NG) {
#pragma unroll
            for (int r = 0; r < 16; ++r) { const int i = 16 * g + r;
                const unsigned u = __float_as_uint(row[64 * i + lane]); const unsigned kk = (u & 0x80000000u) ? ~u : (u | 0x80000000u); key[i] = (64 * i < n) ? kk : 0u; }
        } else {
#pragma unroll
            for (int r = 0; r < 16; ++r) key[16 * g + r] = 0u;
        }
    }
    unsigned prefix = 0u; int remaining = 256;
    radix_pass<12, true>(key, NG, 20, prefix, remaining, hist, lane);
    radix_pass<10, false>(key, NG, 10, prefix, remaining, hist, lane);
    const int cnt_eq = radix_pass<10, false>(key, NG, 0, prefix, remaining, hist, lane);
    const int need = remaining;
    if (cnt_eq == need) {
#pragma unroll
        for (int g = 0; g < 8; ++g) {
            if (g < NG) {
#pragma unroll
                for (int r = 0; r < 16; ++r) { const int i = 16 * g + r; const unsigned long long take = __ballot(key[i] >= prefix); if (lane == 0) scr[i] = take; }
            } else { if (lane < 16) scr[16 * g + lane] = 0ull; }
        }
    } else {
        int run = 0;
#pragma unroll
        for (int g = 0; g < 8; ++g) {
            if (g < NG) {
#pragma unroll
                for (int r = 0; r < 16; ++r) { const int i = 16 * g + r;
                    const bool gt = key[i] > prefix, eq = key[i] == prefix;
                    const unsigned long long eqb = __ballot(eq);
                    const int rank = run + (int)__builtin_amdgcn_mbcnt_hi((unsigned)(eqb >> 32), __builtin_amdgcn_mbcnt_lo((unsigned)eqb, 0u));
                    const unsigned long long take = __ballot(gt || (eq && rank < need));
                    run += __popcll(eqb);
                    if (lane == 0) scr[i] = take;
                    if ((r & 7) == 7) __builtin_amdgcn_sched_barrier(0); }
            } else { if (lane < 16) scr[16 * g + lane] = 0ull; }
        }
    }
    LDS_WAIT();
    const unsigned long long mine0 = scr[lane], mine1 = scr[64 + lane];
    out[lane] = mine0; out[64 + lane] = mine1;
    LDS_WAIT();
}
typedef short v4i16_t __attribute__((ext_vector_type(4)));
DI s16x4 vtr(const LAS unsigned char* p) { return __builtin_bit_cast(s16x4, __builtin_amdgcn_ds_read_tr16_b64_v4i16((LAS v4i16_t*)p)); }
DI unsigned cvtpk(float lo, float hi) { unsigned r; asm volatile("v_cvt_pk_bf16_f32 %0, %1, %2" : "=v"(r) : "v"(lo), "v"(hi)); return r; }
constexpr int VSTR = 320;
template <int DK> struct AttnLds { static constexpr int KSTR = DK * 2 + 16, KB = 64 * KSTR, VB = 64 * VSTR, K0 = 0, V0 = 2 * KB, TOTAL = 2 * KB + 2 * VB; };
static_assert(AttnLds<256>::TOTAL <= RING_BYTES, "attention LDS");

template <int DK, int MODE>
DI void attn_unit(LAS unsigned char* lds, const bf16* Qp, int LDQ, const bf16* Kp, int LDK, const bf16* Vp, int LDV, bf16* Op, int LDO, int NT, int chunk0, const unsigned* BMrow) {
    typedef AttnLds<DK> L;
    constexpr int ND = DK / 16, KCH = DK / 8, NKC = DK / 64;
    int tid_ = threadIdx.x; asm volatile("" : "+v"(tid_));
    const int tid = tid_, wid = __builtin_amdgcn_readfirstlane(tid >> 6), lane = tid & 63, r32 = lane & 31, hi = lane >> 5;
    const int mychunk = chunk0 + (wid >> 1);
    constexpr bool QLOOP = (DK > 192);
    bf16x8 qr[ND];
    const bf16* qw = Qp + (size_t)(wid * 32 + r32) * LDQ + hi * 8;
    if (!QLOOP) {
#pragma unroll
        for (int d0 = 0; d0 < ND; ++d0) qr[d0] = *(const bf16x8*)(qw + d0 * 16); }
    const unsigned* bmw = (MODE == 1) ? BMrow + (size_t)(wid * 32 + r32) * 256 : nullptr;
    int krow_[NKC], kcc_[NKC];
#pragma unroll
    for (int i = 0; i < NKC; ++i) { const int c = tid + 512 * i; krow_[i] = c / KCH; kcc_[i] = c % KCH; }
    const int vrow0 = tid >> 4, vcc = tid & 15;
    v4u kst[NKC], vst[2];
#define ATT_LOAD(j) do { const int key0_ = (j) * 64; \
        _Pragma("unroll") for (int i_ = 0; i_ < NKC; ++i_) kst[i_] = *(const v4u*)(Kp + (size_t)(key0_ + krow_[i_]) * LDK + kcc_[i_] * 8); \
        vst[0] = *(const v4u*)(Vp + (size_t)(key0_ + vrow0) * LDV + vcc * 8); vst[1] = *(const v4u*)(Vp + (size_t)(key0_ + 32 + vrow0) * LDV + vcc * 8); } while (0)
#define ATT_WRITE(buf) do { \
        _Pragma("unroll") for (int i_ = 0; i_ < NKC; ++i_) *(LAS v4u*)(lds + L::K0 + (buf) * L::KB + krow_[i_] * L::KSTR + kcc_[i_] * 16) = kst[i_]; \
        *(LAS v4u*)(lds + L::V0 + (buf) * L::VB + vrow0 * VSTR + vcc * 16) = vst[0]; *(LAS v4u*)(lds + L::V0 + (buf) * L::VB + (32 + vrow0) * VSTR + vcc * 16) = vst[1]; } while (0)
    float m_run = -1e30f, l_run = 0.f;
    f32x16 o[4];
#pragma unroll
    for (int d = 0; d < 4; ++d)
#pragma unroll
        for (int i = 0; i < 16; ++i) o[d][i] = 0.f;
    const int kbase = r32 * L::KSTR + hi * 16;
    const int q4 = (lane >> 2) & 3, p4 = lane & 3, blk = (lane >> 4) & 1;
    const int vbase = (4 * hi + q4) * VSTR + blk * 32 + p4 * 8;
    ATT_LOAD(0); ATT_WRITE(0);
    __syncthreads();
#pragma unroll 1
    for (int j = 0; j < NT; ++j) {
        const int cur = j & 1;
        const bool active = (MODE == 2) || (j <= mychunk);
        unsigned mw0 = 0xffffffffu, mw1 = 0xffffffffu;
        if (MODE == 1) { if (active) { const v2u mm = *(const v2u*)(bmw + 2 * j); mw0 = mm.x >> (4 * hi); mw1 = mm.y >> (4 * hi); } }
        if (j + 1 < NT) ATT_LOAD(j + 1);
        if (active) {
            f32x16 p0, p1;
#pragma unroll
            for (int i = 0; i < 16; ++i) { p0[i] = 0.f; p1[i] = 0.f; }
            const LAS unsigned char* kb = lds + L::K0 + cur * L::KB + kbase;
            const bf16* qwl = qw; if (QLOOP) asm volatile("" : "+v"(qwl));
#pragma unroll
            for (int d0 = 0; d0 < ND; ++d0) {
                const bf16x8 a0 = *(const LAS bf16x8*)(kb + d0 * 32), a1 = *(const LAS bf16x8*)(kb + 32 * L::KSTR + d0 * 32);
                const bf16x8 qf = QLOOP ? *(const bf16x8*)(qwl + d0 * 16) : qr[d0];
                p0 = MFMA32(a0, qf, p0); p1 = MFMA32(a1, qf, p1);
                if ((d0 & 3) == 3) __builtin_amdgcn_sched_barrier(0);
            }
            if (MODE == 1) {
#pragma unroll
                for (int i = 0; i < 16; ++i) { const unsigned bit = 1u << ((i & 3) + 8 * (i >> 2));
                    p0[i] = (mw0 & bit) ? p0[i] : -INFINITY; p1[i] = (mw1 & bit) ? p1[i] : -INFINITY; }
            }
            float tmax = p0[0];
#pragma unroll
            for (int i = 1; i < 16; ++i) tmax = fmaxf(tmax, p0[i]);
#pragma unroll
            for (int i = 0; i < 16; ++i) tmax = fmaxf(tmax, p1[i]);
            tmax = half_swap_max(tmax);
            const float m_new = fmaxf(m_run, tmax), alpha = __builtin_amdgcn_exp2f(m_run - m_new);
            m_run = m_new;
            float ps = 0.f;
#pragma unroll
            for (int i = 0; i < 16; ++i) { p0[i] = __builtin_amdgcn_exp2f(p0[i] - m_new); ps += p0[i]; }
#pragma unroll
            for (int i = 0; i < 16; ++i) { p1[i] = __builtin_amdgcn_exp2f(p1[i] - m_new); ps += p1[i]; }
            ps = half_swap_sum(ps);
            l_run = l_run * alpha + ps;
            if (__any(alpha < 1.0f)) {
#pragma unroll
                for (int d = 0; d < 4; ++d)
#pragma unroll
                    for (int i = 0; i < 16; ++i) o[d][i] *= alpha;
            }
            bf16x8 pb[4];
#pragma unroll
            for (int s = 0; s < 4; ++s) { v4u w;
                if (s < 2) { w.x = cvtpk(p0[8 * s + 0], p0[8 * s + 1]); w.y = cvtpk(p0[8 * s + 2], p0[8 * s + 3]); w.z = cvtpk(p0[8 * s + 4], p0[8 * s + 5]); w.w = cvtpk(p0[8 * s + 6], p0[8 * s + 7]); }
                else { const int s2 = s - 2; w.x = cvtpk(p1[8 * s2 + 0], p1[8 * s2 + 1]); w.y = cvtpk(p1[8 * s2 + 2], p1[8 * s2 + 3]); w.z = cvtpk(p1[8 * s2 + 4], p1[8 * s2 + 5]); w.w = cvtpk(p1[8 * s2 + 6], p1[8 * s2 + 7]); }
                pb[s] = __builtin_bit_cast(bf16x8, w); }
            const LAS unsigned char* vb = lds + L::V0 + cur * L::VB + vbase;
#pragma unroll
            for (int d0 = 0; d0 < 4; ++d0)
#pragma unroll
                for (int s = 0; s < 4; ++s) {
                    const s16x4 lo = vtr(vb + (16 * s) * VSTR + d0 * 64), hh = vtr(vb + (16 * s + 8) * VSTR + d0 * 64);
                    const bf16x8 va = (bf16x8){lo[0], lo[1], lo[2], lo[3], hh[0], hh[1], hh[2], hh[3]};
                    o[d0] = MFMA32(va, pb[s], o[d0]);
                    if (s == 3) __builtin_amdgcn_sched_barrier(0);
                }
        }
        if (j + 1 < NT) ATT_WRITE(cur ^ 1);
        __syncthreads();
    }
    const float rl = 1.0f / l_run;
    bf16* ow = Op + (size_t)(wid * 32 + r32) * LDO + 4 * hi;
#pragma unroll
    for (int d0 = 0; d0 < 4; ++d0)
#pragma unroll
        for (int g = 0; g < 4; ++g) { v2u w; w.x = cvtpk(o[d0][4 * g] * rl, o[d0][4 * g + 1] * rl); w.y = cvtpk(o[d0][4 * g + 2] * rl, o[d0][4 * g + 3] * rl);
            *(v2u*)(ow + 32 * d0 + 8 * g) = w; }
#undef ATT_LOAD
#undef ATT_WRITE
}
#ifndef MK_MULTI
#define MK_MULTI 0
#endif
#ifndef DBG_SKIP_MIXER
#define DBG_SKIP_MIXER 0
#endif
constexpr int NPH = 16;
#ifndef ATT_MASK
#define ATT_MASK 7
#endif
struct Args { const float* in[30]; float* out; unsigned char* ws; int ph_lo, ph_hi; };
static_assert(sizeof(Args) == 30 * 8 + 8 + 8 + 8, "no padding");

DI void ffn_up_phase(LAS unsigned char* lds, const bf16* A, const bf16* WGUt, bf16* Hmid, int G) {
    pg8::Gemm g{A, WGUt, MTOK, NGU, DM}; pg8::StaticOrder S; S.init(MTOK, NGU, G, (int)blockIdx.x);
    pg8::EpiSwiGLU E{Hmid, DFF};
    pg8::gemm_phase<pg8::EpiSwiGLU, pg8::StaticOrder, true, true>(lds, g, S, E);
}
DI void ffn_down_phase(LAS unsigned char* lds, const bf16* Hmid, const bf16* WDt, const float* base, float* out, int G) {
    pg8::Gemm g{Hmid, WDt, MTOK, DM, DFF}; pg8::StaticOrder S; S.init(MTOK, DM, G, (int)blockIdx.x);
    pg8::EpiResid E{base, out, DM, 0.5f};
    pg8::gemm_phase<pg8::EpiResid, pg8::StaticOrder, true, true>(lds, g, S, E);
}

__global__ void __launch_bounds__(NWAVES * 64, 2) mega_fwd(Args args) {
    extern __shared__ __attribute__((aligned(16))) unsigned char lds_raw[];
    LAS unsigned char* lds = (LAS unsigned char*)lds_raw;
    const int GRID = gridDim.x;
    const __attribute__((address_space(4))) unsigned char* ka = (const __attribute__((address_space(4))) unsigned char*)__builtin_amdgcn_kernarg_segment_ptr();
#define ARGQ(k) (*(void* const __attribute__((address_space(4)))*)(ka + 8 * (k)))
#define ARGP(k) ((const float*)ARGQ(k))
    unsigned char* ws = (unsigned char*)ARGQ(31);
    unsigned* ctl = (unsigned*)(ws + WS_CTL);
    volatile LAS unsigned* MISC = (volatile LAS unsigned*)(lds + MISC_OFF);
    for (int u = threadIdx.x; u < (LDS_BYTES - MISC_OFF) / 4; u += NWAVES * 64) ((LAS unsigned*)(lds + MISC_OFF))[u] = 0u;
    __syncthreads();
    const int lo = *(const __attribute__((address_space(4))) int*)(ka + 256), hi = *(const __attribute__((address_space(4))) int*)(ka + 260);
    XcdBarrier bar; bar.bar = ctl + CW_BAR; bar.x = 0; bar.st = nullptr;
    if (hi - lo > 1) bar = xcd_barrier_post(ctl + CW_BAR, MISC);
#ifndef PH_MASK
#define PH_MASK 0xffff
#endif
#define IN(k) ((((PH_MASK) >> (k)) & 1) && lo <= (k) && (k) < hi)
#define SEAM(k) do { if (IN(k) && IN((k) + 1)) xcd_barrier(bar); } while (0)
#ifndef REPEAT_MASK
#define REPEAT_MASK 0
#endif
#define NREP(k) (1 + (((REPEAT_MASK) >> (k)) & 1))
#define REPBAR(k) do { if (((REPEAT_MASK) >> (k)) & 1) xcd_barrier(bar); } while (0)

#define WGUt ((bf16*)(ws + WS_WGU))
#define WDt ((bf16*)(ws + WS_WD))
#define WINt ((bf16*)(ws + WS_WIN))
#define WUQt ((bf16*)(ws + WS_WUQ))
#define WUKVt ((bf16*)(ws + WS_WUKV))
#define WMKVt ((bf16*)(ws + WS_WMKV))
#define WOMLAt ((bf16*)(ws + WS_WOMLA))
#define WODSAt ((bf16*)(ws + WS_WODSA))
#define WOMEMt ((bf16*)(ws + WS_WOMEM))
#define WOUTt ((bf16*)(ws + WS_WOUT))
#define Abuf ((bf16*)(ws + WS_A))
#define Hmid ((bf16*)(ws + WS_HMID))
#define Gt ((bf16*)(ws + WS_G))
#define Pbuf ((bf16*)(ws + WS_P))
#define QmlaRaw ((bf16*)(ws + WS_QMLARAW))
#define KVraw ((bf16*)(ws + WS_KVRAW))
#define Qmla ((bf16*)(ws + WS_QMLA))
#define Kmla ((bf16*)(ws + WS_KMLA))
#define GS ((float*)(ws + WS_GS))
#define CQn ((bf16*)(ws + WS_CQN))
#define CKVn ((bf16*)(ws + WS_CKVN))
#define Qd ((bf16*)(ws + WS_QD))
#define Kd ((bf16*)(ws + WS_KD))
#define Vd ((bf16*)(ws + WS_VD))
#define Qi ((bf16*)(ws + WS_QI))
#define Ki ((bf16*)(ws + WS_KI))
#define Wi ((float*)(ws + WS_WI))
#define Kr ((bf16*)(ws + WS_KR))
#define Qm ((bf16*)(ws + WS_QM))
#define Ymla ((bf16*)(ws + WS_YMLA))
#define Ydsa ((bf16*)(ws + WS_YDSA))
#define Ymem ((bf16*)(ws + WS_YMEM))
#define BM ((unsigned*)(ws + WS_BM))
#define memn ((bf16*)(ws + WS_MEMN))
#define MKVraw ((bf16*)(ws + WS_MKVRAW))
#define MemK ((bf16*)(ws + WS_MEMK))
#define Sc ((float*)(ws + WS_SC))
#define X_IN (ARGP(0))
#define MEM_IN (ARGP(1))
#define POS_IN ((const int*)ARGP(2))
#define XRES ((float*)ARGQ(30))
    for (int rep_ = 0; rep_ < NREP(0); ++rep_) { if (rep_) REPBAR(0); if (IN(0)) { const Ctx C = make_ctx(lds);
        conv_ffn(C, ARGP(4), ARGP(5), ARGP(6), WGUt, WDt);
#if !DBG_SKIP_MIXER
        conv_win(C, ARGP(8), ARGP(24), WINt);
        int dummy = 0;
        conv_plain(C, ARGP(10), 1536, 2304, WUQt, dummy, 0);
        conv_plain(C, ARGP(12), 512, 3072, WUKVt, dummy, 0);
        conv_plain(C, ARGP(18), 4096, 2048, WMKVt, dummy, 0);
        conv_plain(C, ARGP(21), 1536, 4096, WOMLAt, dummy, 0);
        conv_plain(C, ARGP(22), 1536, 4096, WODSAt, dummy, 0);
        conv_plain(C, ARGP(23), 1024, 4096, WOMEMt, dummy, 0);
        conv_plain(C, ARGP(25), 4096, 4096, WOUTt, dummy, 0);
        rms_rows(C, MEM_IN, ARGP(17), memn, MROWS);
#endif
        rms_rows(C, X_IN, ARGP(3), Abuf, MTOK);
    }
    }
    SEAM(0);
    for (int rep_ = 0; rep_ < NREP(1); ++rep_) { if (rep_) REPBAR(1); if (IN(1)) ffn_up_phase(lds, Abuf, WGUt, Hmid, GRID);
    }
    SEAM(1);
    for (int rep_ = 0; rep_ < NREP(2); ++rep_) { if (rep_) REPBAR(2); if (IN(2)) ffn_down_phase(lds, Hmid, WDt, X_IN, XRES, GRID);
    }
    SEAM(2);
#if !DBG_SKIP_MIXER
    if (IN(3)) { const Ctx C = make_ctx(lds); rms_rows(C, XRES, ARGP(7), Abuf, MTOK); }
    SEAM(3);
    for (int rep_ = 0; rep_ < NREP(4); ++rep_) { if (rep_) REPBAR(4); if (IN(4)) {
        pg8::Gemm g{Abuf, WINt, MTOK, NIN, DM}; pg8::StaticOrder S; S.init(MTOK, NIN, GRID, (int)blockIdx.x);
        pg8::EpiInProj E{Pbuf, NPC, NPT, Gt, NGC};
        pg8::gemm_phase<pg8::EpiInProj, pg8::StaticOrder, true, true>(lds, g, S, E);
    }
    }
    SEAM(4);
    for (int rep_ = 0; rep_ < NREP(5); ++rep_) { if (rep_) REPBAR(5); if (IN(5)) { const Ctx C = make_ctx(lds);
        PP1 A{Pbuf, POS_IN, ARGP(9), ARGP(11), ARGP(15), ARGP(16), ARGP(19), CQn, CKVn, Qd, Kd, Vd, Qi, Ki, Kr, Qm, Wi};
        for (int t = C.gw; t < MTOK; t += C.NGW) pp1_token(A, t, C.lane);
    }
    }
    SEAM(5);
    for (int rep_ = 0; rep_ < NREP(6); ++rep_) { if (rep_) REPBAR(6); if (IN(6)) {
        { pg8::Gemm g{CQn, WUQt, MTOK, 2304, 1536}; pg8::StaticOrder S; S.init(MTOK, 2304, GRID, (int)blockIdx.x); pg8::EpiPlain E{QmlaRaw, 2304};
          pg8::gemm_phase<pg8::EpiPlain, pg8::StaticOrder, true, true>(lds, g, S, E); }
        { pg8::Gemm g{CKVn, WUKVt, MTOK, 3072, 512}; pg8::StaticOrder S; S.init(MTOK, 3072, GRID, (int)blockIdx.x); pg8::EpiPlain E{KVraw, 3072};
          pg8::gemm_phase<pg8::EpiPlain, pg8::StaticOrder, true, true>(lds, g, S, E); }
        { pg8::Gemm g{memn, WMKVt, MROWS, 2048, DM}; pg8::StaticOrder S; S.init(MROWS, 2048, GRID, (int)blockIdx.x); pg8::EpiPlain E{MKVraw, 2048};
          pg8::gemm_phase<pg8::EpiPlain, pg8::StaticOrder, true, true>(lds, g, S, E); }
    }
    }
    SEAM(6);
    for (int rep_ = 0; rep_ < NREP(7); ++rep_) { if (rep_) REPBAR(7); if (IN(7)) { const Ctx C = make_ctx(lds);
        PP2 A{QmlaRaw, KVraw, Kr, MKVraw, POS_IN, ARGP(13), ARGP(14), ARGP(20), Qmla, Kmla, MemK};
        for (int t = C.gw; t < MTOK; t += C.NGW) pp2_token(A, t, C.lane);
        for (int r = C.gw; r < MROWS; r += C.NGW) pp2_memrow(A, r, C.lane);
    }
    }
    SEAM(7);
    for (int rep_ = 0; rep_ < NREP(8); ++rep_) { if (rep_) REPBAR(8); if (IN(8)) { const Ctx C = make_ctx(lds); for (int p = blockIdx.x; p < 256; p += GRID) idx_item(p, Qi, Ki, Wi, Sc, C.wave, C.lane); }
    }
    SEAM(8);
    for (int rep_ = 0; rep_ < NREP(9); ++rep_) { if (rep_) REPBAR(9); if (IN(9)) { const Ctx C = make_ctx(lds); for (int t = C.gw; t < MTOK; t += C.NGW) select_row(Sc, (unsigned long long*)BM, t, C.lane, (LAS unsigned*)(lds + C.wave * 16384), (LAS unsigned long long*)(lds + MISC_OFF + 64 + C.wave * 1024)); }
    }
    SEAM(9);
    for (int rep_ = 0; rep_ < NREP(10); ++rep_) { if (rep_) REPBAR(10); if (IN(10)) {
        for (;;) {
            if (threadIdx.x == 0) MISC[4] = __hip_atomic_fetch_add(ctl + CW_QUEUE + 64 * rep_, 1u, __ATOMIC_RELAXED, __HIP_MEMORY_SCOPE_AGENT);
            __syncthreads();
            const int u = __builtin_amdgcn_readfirstlane((int)MISC[4]);
            __syncthreads();
            if (u >= 2048) break;
            if (u < 1536) {
                const int qt = 31 - u / 48, r = u % 48, type = r / 24, bh = r % 24, b = bh / 12, h = bh % 12;
                const size_t row0 = (size_t)b * SEQ + 256 * qt, krow0 = (size_t)b * SEQ;
                if (type == 0) { if (ATT_MASK & 1) attn_unit<192, 0>(lds, Qmla + row0 * 2304 + h * 192, 2304, Kmla + krow0 * 2304 + h * 192, 2304, KVraw + krow0 * 3072 + h * 256 + 128, 3072,
                                                 Ymla + row0 * 1536 + h * 128, 1536, 4 * qt + 4, 4 * qt, nullptr); }
                else if (ATT_MASK & 2) attn_unit<128, 1>(lds, Qd + row0 * 1536 + h * 128, 1536, Kd + krow0 * 1536 + h * 128, 1536, Vd + krow0 * 1536 + h * 128, 1536,
                                       Ydsa + row0 * 1536 + h * 128, 1536, 4 * qt + 4, 4 * qt, BM + row0 * 256);
            } else {
                const int v = u - 1536, b = v >> 8, h = (v >> 6) & 3, qt = (v >> 1) & 31, dvh = v & 1;
                const size_t row0 = (size_t)b * SEQ + 256 * qt, krow0 = (size_t)b * MEMLEN;
                if (ATT_MASK & 4) attn_unit<256, 2>(lds, Qm + row0 * 1024 + h * 256, 1024, MemK + krow0 * 1024 + h * 256, 1024, MKVraw + krow0 * 2048 + 1024 + h * 256 + dvh * 128, 2048,
                                  Ymem + row0 * 1024 + h * 256 + dvh * 128, 1024, 4, 0, nullptr);
            }
        }
    }
    }
    SEAM(10);
    for (int rep_ = 0; rep_ < NREP(11); ++rep_) { if (rep_) REPBAR(11); if (IN(11)) {
        { pg8::Gemm g{Ymla, WOMLAt, MTOK, DM, 1536}; pg8::StaticOrder S; S.init(MTOK, DM, GRID, (int)blockIdx.x); pg8::EpiGate<0> E{Gt, NGC, 0, GS, Abuf, DM};
          pg8::gemm_phase<pg8::EpiGate<0>, pg8::StaticOrder, true, true>(lds, g, S, E); }
        { pg8::Gemm g{Ydsa, WODSAt, MTOK, DM, 1536}; pg8::StaticOrder S; S.init(MTOK, DM, GRID, (int)blockIdx.x); pg8::EpiGate<1> E{Gt, NGC, DM, GS, Abuf, DM};
          pg8::gemm_phase<pg8::EpiGate<1>, pg8::StaticOrder, true, true>(lds, g, S, E); }
        { pg8::Gemm g{Ymem, WOMEMt, MTOK, DM, 1024}; pg8::StaticOrder S; S.init(MTOK, DM, GRID, (int)blockIdx.x); pg8::EpiGate<2> E{Gt, NGC, 2 * DM, GS, Abuf, DM};
          pg8::gemm_phase<pg8::EpiGate<2>, pg8::StaticOrder, true, true>(lds, g, S, E); }
    }
    }
    SEAM(11);
    if (IN(12)) {
        pg8::Gemm g{Abuf, WOUTt, MTOK, DM, DM}; pg8::StaticOrder S; S.init(MTOK, DM, GRID, (int)blockIdx.x); pg8::EpiResid E{XRES, XRES, DM, 1.0f};
        pg8::gemm_phase<pg8::EpiResid, pg8::StaticOrder, true, true>(lds, g, S, E);
    }
    SEAM(12);
#endif
    if (IN(13)) { const Ctx C = make_ctx(lds); conv_ffn(C, ARGP(27), ARGP(28), ARGP(29), WGUt, WDt); rms_rows(C, XRES, ARGP(26), Abuf, MTOK); }
    SEAM(13);
    if (IN(14)) ffn_up_phase(lds, Abuf, WGUt, Hmid, GRID);
    SEAM(14);
    if (IN(15)) ffn_down_phase(lds, Hmid, WDt, XRES, XRES, GRID);
#undef IN
#undef SEAM
}

#undef WGUt
#undef WDt
#undef WINt
#undef WUQt
#undef WUKVt
#undef WMKVt
#undef WOMLAt
#undef WODSAt
#undef WOMEMt
#undef WOUTt
#undef Abuf
#undef Hmid
#undef Gt
#undef Pbuf
#undef QmlaRaw
#undef KVraw
#undef Qmla
#undef Kmla
#undef GS
#undef CQn
#undef CKVn
#undef Qd
#undef Kd
#undef Vd
#undef Qi
#undef Ki
#undef Wi
#undef Kr
#undef Qm
#undef Ymla
#undef Ydsa
#undef Ymem
#undef BM
#undef memn
#undef MKVraw
#undef MemK
#undef Sc
#undef X_IN
#undef MEM_IN
#undef POS_IN
#undef XRES
#undef ARGQ
#undef ARGP
extern "C" void kernel_launch(void* const* d_in, const int* in_sizes, int n_in, void* d_out, int out_size, void* d_ws, size_t ws_size, hipStream_t stream) {
    static int grid = 0;
    if (grid == 0) {
        if (n_in != 30 || in_sizes[0] != MTOK * DM || out_size != MTOK * DM || ws_size < WS_END) {
            fprintf(stderr, "kernel_launch: built for 30 inputs, x/out of %d floats, >= %zu bytes of workspace; got n_in %d, in0 %d, out %d, ws %zu; nothing launched\n", MTOK * DM, (size_t)WS_END, n_in, n_in > 0 ? in_sizes[0] : -1, out_size, ws_size);
            grid = -1; return; }
        int dev = 0, cus = 0, per_cu = 0;
        if (hipGetDevice(&dev) != hipSuccess || hipDeviceGetAttribute(&cus, hipDeviceAttributeMultiprocessorCount, dev) != hipSuccess) { fprintf(stderr, "kernel_launch: device query failed\n"); grid = -1; return; }
        if (hipFuncSetAttribute((const void*)mega_fwd, hipFuncAttributeMaxDynamicSharedMemorySize, LDS_BYTES) != hipSuccess) { fprintf(stderr, "kernel_launch: hipFuncSetAttribute failed\n"); grid = -1; return; }
        if (hipOccupancyMaxActiveBlocksPerMultiprocessor(&per_cu, (const void*)mega_fwd, NWAVES * 64, LDS_BYTES) != hipSuccess || per_cu < 1)
            fprintf(stderr, "kernel_launch: note: occupancy query reports %d workgroups per CU\n", per_cu);
        (void)hipGetLastError();
        grid = cus;
    }
    if (grid < 0) return;
    if (hipMemsetAsync((char*)d_ws + WS_CTL, 0, CTL_ZERO_BYTES, stream) != hipSuccess) { fprintf(stderr, "kernel_launch: memset failed\n"); return; }
    Args a{};
    for (int i = 0; i < 30; ++i) a.in[i] = (const float*)d_in[i];
    a.out = (float*)d_out; a.ws = (unsigned char*)d_ws;
#if MK_MULTI
    for (int k = 0; k < NPH; ++k) { a.ph_lo = k; a.ph_hi = k + 1; hipLaunchKernelGGL(mega_fwd, dim3(grid), dim3(NWAVES * 64), LDS_BYTES, stream, a); }
#else
    a.ph_lo = 0; a.ph_hi = NPH;
    hipLaunchKernelGGL(mega_fwd, dim3(grid), dim3(NWAVES * 64), LDS_BYTES, stream, a);
#endif
    const hipError_t le = hipPeekAtLastError();
    if (le != hipSuccess) fprintf(stderr, "kernel_launch: launch failed: %s\n", hipGetErrorName(le));
}
```

```cpp
#include <hip/hip_runtime.h>
#include <cstdio>
#include <cstdint>
namespace pg8 {
#define PG8_LAS __attribute__((address_space(3)))
typedef unsigned short bf16_t;
typedef short bf16x8 __attribute__((ext_vector_type(8)));
typedef float f32x4 __attribute__((ext_vector_type(4)));
typedef unsigned u32x4 __attribute__((ext_vector_type(4)));
constexpr int BM = 256, BK = 64, HALF = 128, HTB = HALF * BK * 2  , STAGE_BYTES = 8 * HTB, NXCD = 8, WGM = 8;

__host__ __device__ __forceinline__ int lds_byte(int r, int c) { const int st = (r >> 4) * 2 + (c >> 5), rr = r & 15, cc = c & 31, ob = rr * 64 + cc * 2; return st * 1024 + (ob ^ (((ob >> 9) & 1) << 5)); }
__host__ __device__ __forceinline__ void stage_rc(int b, int& R, int& C) { const int st = b / 1024, sb = b % 1024, swz = sb ^ (((sb >> 9) & 1) << 5); R = (st >> 1) * 16 + swz / 64; C = (st & 1) * 32 + (swz % 64) / 2; }
__host__ __device__ __forceinline__ int perm32(int rho) { const int n = rho >> 4, i = rho & 15; return 8 * (i >> 2) + 4 * n + (i & 3); }

struct Unit { int pm, pn; };
struct Gemm { const bf16_t* A; const bf16_t* Bt; int M, N, K; };

struct StaticOrder {
    int nM, nN, nwg, G, c;
    __host__ __device__ void init(int M, int N, int G_, int c_) { nM = M / BM; nN = N / BM; nwg = nM * nN; G = G_; c = c_; }
    __host__ __device__ bool next(int i, Unit& u) const {
        const long L = (long)i * G + c; if (L >= nwg) return false;
        int wgid = (int)L; { const int q = nwg / NXCD, r = nwg % NXCD, xcd = wgid % NXCD, off = wgid / NXCD; wgid = (xcd < r ? xcd * (q + 1) : r * (q + 1) + (xcd - r) * q) + off; }
        const int nig = WGM * nN, gid = wgid / nig, fm = gid * WGM, gsz = (nM - fm) < WGM ? (nM - fm) : WGM;
        u.pm = fm + ((wgid % nig) % gsz); u.pn = (wgid % nig) / gsz; return true;
    }
    __device__ __forceinline__ void a_ready(const Unit&) const {}
    __device__ __forceinline__ void done(const Unit&) const {}
};
__device__ __forceinline__ unsigned cvt_pk_bf16(float lo, float hi) { unsigned r; asm volatile("v_cvt_pk_bf16_f32 %0, %1, %2" : "=v"(r) : "v"(lo), "v"(hi)); return r; }
#define DI_PG __device__ __forceinline__
#ifndef GATES_U8
#define GATES_U8 1
#endif
__device__ __forceinline__ unsigned pk_fp8x4(float a, float b, float c, float d) { int p = __builtin_amdgcn_cvt_pk_fp8_f32(a, b, 0, false); p = __builtin_amdgcn_cvt_pk_fp8_f32(c, d, p, true); return (unsigned)p; }
__device__ __forceinline__ float sigmoid_f(float x) { return __builtin_amdgcn_rcpf(1.0f + __builtin_amdgcn_exp2f(-1.4426950408889634f * x)); }
struct EpiPlain {
    static constexpr bool PERM = true, AFTER_DRAIN = false;
    bf16_t* O; int ldc;
    __device__ __forceinline__ void operator()(const f32x4 (&acc)[2][2][4][2], const Unit& u, int wr, int wc, int fr, int fq) const {
        const int row0 = u.pm * BM + wr * 64 + fr, col0 = u.pn * BM + wc * 32 + 8 * fq;
#pragma unroll
        for (int ai = 0; ai < 2; ++ai)
#pragma unroll
            for (int m = 0; m < 4; ++m) { bf16_t* rowp = O + (size_t)(row0 + ai * HALF + m * 16) * ldc + col0;
#pragma unroll
                for (int bj = 0; bj < 2; ++bj) { const f32x4 v0 = acc[ai][bj][m][0], v1 = acc[ai][bj][m][1];
                    u32x4 w; w.x = cvt_pk_bf16(v0[0], v0[1]); w.y = cvt_pk_bf16(v0[2], v0[3]); w.z = cvt_pk_bf16(v1[0], v1[1]); w.w = cvt_pk_bf16(v1[2], v1[3]);
                    *(u32x4*)(rowp + bj * HALF) = w; } }
    }
};
struct EpiPlain8 {
    static constexpr bool PERM = true, AFTER_DRAIN = false, FP8 = true;
    bf16_t* O; int ldc; float scale;
    __device__ __forceinline__ void operator()(const f32x4 (&acc)[2][2][4][2], const Unit& u, int wr, int wc, int fr, int fq) const {
        const int row0 = u.pm * BM + wr * 64 + fr, col0 = u.pn * BM + wc * 32 + 8 * fq;
#pragma unroll
        for (int ai = 0; ai < 2; ++ai)
#pragma unroll
            for (int m = 0; m < 4; ++m) { bf16_t* rowp = O + (size_t)(row0 + ai * HALF + m * 16) * ldc + col0;
#pragma unroll
                for (int bj = 0; bj < 2; ++bj) { const f32x4 v0 = acc[ai][bj][m][0] * scale, v1 = acc[ai][bj][m][1] * scale;
                    u32x4 w; w.x = cvt_pk_bf16(v0[0], v0[1]); w.y = cvt_pk_bf16(v0[2], v0[3]); w.z = cvt_pk_bf16(v1[0], v1[1]); w.w = cvt_pk_bf16(v1[2], v1[3]);
                    *(u32x4*)(rowp + bj * HALF) = w; } }
    }
};
struct EpiPlain8R {
    static constexpr bool PERM = true, AFTER_DRAIN = false, FP8 = true;
    bf16_t* O; int ldc; float scale; bf16_t* O2; int ld2; int pn0, pn1;
    __device__ __forceinline__ void operator()(const f32x4 (&acc)[2][2][4][2], const Unit& u, int wr, int wc, int fr, int fq) const {
        const bool alt = u.pn >= pn0 && u.pn < pn1;
        bf16_t* const B = alt ? O2 : O; const int ld = alt ? ld2 : ldc;
        const int row0 = u.pm * BM + wr * 64 + fr, col0 = (alt ? u.pn - pn0 : u.pn) * BM + wc * 32 + 8 * fq;
#pragma unroll
        for (int ai = 0; ai < 2; ++ai)
#pragma unroll
            for (int m = 0; m < 4; ++m) { bf16_t* rowp = B + (size_t)(row0 + ai * HALF + m * 16) * ld + col0;
#pragma unroll
                for (int bj = 0; bj < 2; ++bj) { const f32x4 v0 = acc[ai][bj][m][0] * scale, v1 = acc[ai][bj][m][1] * scale;
                    u32x4 w; w.x = cvt_pk_bf16(v0[0], v0[1]); w.y = cvt_pk_bf16(v0[2], v0[3]); w.z = cvt_pk_bf16(v1[0], v1[1]); w.w = cvt_pk_bf16(v1[2], v1[3]);
                    *(u32x4*)(rowp + bj * HALF) = w; } }
    }
};
template <int F8, bool I8_ = false> struct EpiSwiGLU {
    static constexpr bool PERM = true, AFTER_DRAIN = false, I8 = I8_;
    unsigned char* O; int ldc; float oscale; const float* rowscale; unsigned char* O8; int pm_split;
    __device__ __forceinline__ void operator()(const f32x4 (&acc)[2][2][4][2], const Unit& u, int wr, int wc, int fr, int fq) const {
        const int row0 = u.pm * BM + wr * 64 + fr, col0 = u.pn * HALF + wc * 32 + 8 * fq;
        const bool f8 = (F8 == 1) || (F8 == 2 && u.pm < pm_split); unsigned char* const OF8 = (F8 == 2) ? O8 : O;
        float rsv[8];
        if constexpr (I8_) {
#pragma unroll
            for (int q = 0; q < 8; ++q) rsv[q] = rowscale[row0 + (q >> 2) * HALF + (q & 3) * 16]; }
#pragma unroll
        for (int ai = 0; ai < 2; ++ai)
#pragma unroll
            for (int m = 0; m < 4; ++m) { const size_t eoff = (size_t)(row0 + ai * HALF + m * 16) * ldc + col0;
                f32x4 r0, r1;
                if constexpr (I8_) {
                    const float rs = rsv[ai * 4 + m], c = -1.4426950408889634f * rs, k = f8 ? rs * rs * oscale : rs * rs;
#pragma unroll
                    for (int j = 0; j < 4; ++j) {
                        const float g0 = (float)__float_as_int(acc[ai][0][m][0][j]), g1 = (float)__float_as_int(acc[ai][0][m][1][j]), u0 = (float)__float_as_int(acc[ai][1][m][0][j]), u1 = (float)__float_as_int(acc[ai][1][m][1][j]);
                        r0[j] = (g0 * u0) * __builtin_amdgcn_rcpf(1.0f + __builtin_amdgcn_exp2f(g0 * c)) * k; r1[j] = (g1 * u1) * __builtin_amdgcn_rcpf(1.0f + __builtin_amdgcn_exp2f(g1 * c)) * k; }
                } else {
#pragma unroll
                    for (int j = 0; j < 4; ++j) { const float g0 = acc[ai][0][m][0][j], g1 = acc[ai][0][m][1][j], u0 = acc[ai][1][m][0][j], u1 = acc[ai][1][m][1][j];
                        r0[j] = g0 * sigmoid_f(g0) * u0; r1[j] = g1 * sigmoid_f(g1) * u1; }
                }
                if (f8) {
#pragma unroll
                    for (int j = 0; j < 4; ++j) { const float os = I8_ ? 1.0f : oscale; r0[j] = __builtin_amdgcn_fmed3f(r0[j] * os, -448.f, 448.f); r1[j] = __builtin_amdgcn_fmed3f(r1[j] * os, -448.f, 448.f); }
                    typedef unsigned u32x2_ __attribute__((ext_vector_type(2)));
                    u32x2_ w; w.x = pk_fp8x4(r0[0], r0[1], r0[2], r0[3]); w.y = pk_fp8x4(r1[0], r1[1], r1[2], r1[3]);
                    *(u32x2_*)(OF8 + eoff) = w;
                } else {
                    u32x4 w; w.x = cvt_pk_bf16(r0[0], r0[1]); w.y = cvt_pk_bf16(r0[2], r0[3]); w.z = cvt_pk_bf16(r1[0], r1[1]); w.w = cvt_pk_bf16(r1[2], r1[3]);
                    *(u32x4*)((bf16_t*)O + eoff) = w; } }
    }
};
struct EpiResid {
    static constexpr bool PERM = true, AFTER_DRAIN = false;
    const float* base; float* out; int ldc; float scale;
    __device__ __forceinline__ void operator()(const f32x4 (&acc)[2][2][4][2], const Unit& u, int wr, int wc, int fr, int fq) const {
        const int row0 = u.pm * BM + wr * 64 + fr, col0 = u.pn * BM + wc * 32 + 8 * fq;
        f32x4 cur[8], nxt[8];
#define RESID_OFF(q_, j_) ((size_t)(row0 + ((q_) >> 2) * HALF + ((q_) & 3) * 16) * ldc + col0 + ((j_) >> 1) * HALF + ((j_) & 1) * 4)
#pragma unroll
        for (int e = 0; e < 8; ++e) cur[e] = *(const f32x4*)(base + RESID_OFF(e >> 2, e & 3));
#pragma unroll
        for (int b = 0; b < 4; ++b) {
            if (b + 1 < 4) {
#pragma unroll
                for (int e = 0; e < 8; ++e) nxt[e] = *(const f32x4*)(base + RESID_OFF(2 * (b + 1) + (e >> 2), e & 3)); }
#pragma unroll
            for (int e = 0; e < 8; ++e) { const int q = 2 * b + (e >> 2), j = e & 3;
                *(f32x4*)(out + RESID_OFF(q, j)) = cur[e] + acc[q >> 2][j >> 1][q & 3][j & 1] * scale; }
#pragma unroll
            for (int e = 0; e < 8; ++e) cur[e] = nxt[e];
        }
#undef RESID_OFF
    }
};
struct EpiResid8 {
    static constexpr bool PERM = true, AFTER_DRAIN = false, FP8 = true;
    const float* base; float* out; int ldc; float scale;
    __device__ __forceinline__ void operator()(const f32x4 (&acc)[2][2][4][2], const Unit& u, int wr, int wc, int fr, int fq) const {
        const int row0 = u.pm * BM + wr * 64 + fr, col0 = u.pn * BM + wc * 32 + 8 * fq;
        f32x4 cur[8], nxt[8];
#define RESID_OFF(q_, j_) ((size_t)(row0 + ((q_) >> 2) * HALF + ((q_) & 3) * 16) * ldc + col0 + ((j_) >> 1) * HALF + ((j_) & 1) * 4)
#pragma unroll
        for (int e = 0; e < 8; ++e) cur[e] = *(const f32x4*)(base + RESID_OFF(e >> 2, e & 3));
#pragma unroll
        for (int b = 0; b < 4; ++b) {
            if (b + 1 < 4) {
#pragma unroll
                for (int e = 0; e < 8; ++e) nxt[e] = *(const f32x4*)(base + RESID_OFF(2 * (b + 1) + (e >> 2), e & 3)); }
#pragma unroll
            for (int e = 0; e < 8; ++e) { const int q = 2 * b + (e >> 2), j = e & 3;
                *(f32x4*)(out + RESID_OFF(q, j)) = cur[e] + acc[q >> 2][j >> 1][q & 3][j & 1] * scale; }
#pragma unroll
            for (int e = 0; e < 8; ++e) cur[e] = nxt[e];
        }
#undef RESID_OFF
    }
};
struct EpiResid8A {
    static constexpr bool PERM = true, AFTER_DRAIN = false, FP8 = true;
    const float* base; const bf16_t* add; float* out; int ldc; float scale;
    __device__ __forceinline__ void operator()(const f32x4 (&acc)[2][2][4][2], const Unit& u, int wr, int wc, int fr, int fq) const {
        int fr_ = fr; asm volatile("" : "+v"(fr_));
        const int row0 = u.pm * BM + wr * 64 + fr_, col0 = u.pn * BM + wc * 32 + 8 * fq;
        typedef unsigned u32x2a_ __attribute__((ext_vector_type(2)));
        f32x4 cur[4], nxt[4]; u32x2a_ cd[4], nd[4];
#define RESID_OFF(q_, j_) ((size_t)(row0 + ((q_) >> 2) * HALF + ((q_) & 3) * 16) * ldc + col0 + ((j_) >> 1) * HALF + ((j_) & 1) * 4)
#pragma unroll
        for (int e = 0; e < 4; ++e) { cur[e] = *(const f32x4*)(base + RESID_OFF(0, e)); cd[e] = *(const u32x2a_*)(add + RESID_OFF(0, e)); }
#pragma unroll
        for (int q = 0; q < 8; ++q) {
            if (q + 1 < 8) {
#pragma unroll
                for (int e = 0; e < 4; ++e) { nxt[e] = *(const f32x4*)(base + RESID_OFF(q + 1, e)); nd[e] = *(const u32x2a_*)(add + RESID_OFF(q + 1, e)); } }
#pragma unroll
            for (int e = 0; e < 4; ++e) {
                f32x4 a; a[0] = __uint_as_float(cd[e].x << 16); a[1] = __uint_as_float(cd[e].x & 0xffff0000u); a[2] = __uint_as_float(cd[e].y << 16); a[3] = __uint_as_float(cd[e].y & 0xffff0000u);
                *(f32x4*)(out + RESID_OFF(q, e)) = (cur[e] + a) + acc[q >> 2][e >> 1][q & 3][e & 1] * scale; }
#pragma unroll
            for (int e = 0; e < 4; ++e) { cur[e] = nxt[e]; cd[e] = nd[e]; }
        }
#undef RESID_OFF
    }
};
struct EpiResid8B {
    static constexpr bool PERM = true, AFTER_DRAIN = false, FP8 = true;
    const bf16_t* base; float* out; int ldc; float scale;
    __device__ __forceinline__ void operator()(const f32x4 (&acc)[2][2][4][2], const Unit& u, int wr, int wc, int fr, int fq) const {
        int fr_ = fr; asm volatile("" : "+v"(fr_));
        const int row0 = u.pm * BM + wr * 64 + fr_, col0 = u.pn * BM + wc * 32 + 8 * fq;
        typedef unsigned u32x2b_ __attribute__((ext_vector_type(2)));
        u32x2b_ cd[8], nd[8];
#define RESID_OFF(q_, j_) ((size_t)(row0 + ((q_) >> 2) * HALF + ((q_) & 3) * 16) * ldc + col0 + ((j_) >> 1) * HALF + ((j_) & 1) * 4)
#pragma unroll
        for (int e = 0; e < 8; ++e) cd[e] = *(const u32x2b_*)(base + RESID_OFF(e >> 2, e & 3));
#pragma unroll
        for (int b = 0; b < 4; ++b) {
            if (b + 1 < 4) {
#pragma unroll
                for (int e = 0; e < 8; ++e) nd[e] = *(const u32x2b_*)(base + RESID_OFF(2 * (b + 1) + (e >> 2), e & 3)); }
#pragma unroll
            for (int e = 0; e < 8; ++e) { const int q = 2 * b + (e >> 2), j = e & 3;
                f32x4 a; a[0] = __uint_as_float(cd[e].x << 16); a[1] = __uint_as_float(cd[e].x & 0xffff0000u); a[2] = __uint_as_float(cd[e].y << 16); a[3] = __uint_as_float(cd[e].y & 0xffff0000u);
                *(f32x4*)(out + RESID_OFF(q, j)) = a + acc[q >> 2][j >> 1][q & 3][j & 1] * scale; }
#pragma unroll
            for (int e = 0; e < 8; ++e) cd[e] = nd[e];
        }
#undef RESID_OFF
    }
};
struct EpiInProj {
    static constexpr bool PERM = true, AFTER_DRAIN = false;
    bf16_t* P; int ldp; int np; bf16_t* G; int ldg;
    __device__ __forceinline__ void operator()(const f32x4 (&acc)[2][2][4][2], const Unit& u, int wr, int wc, int fr, int fq) const {
        const int row0 = u.pm * BM + wr * 64 + fr; const bool isg = u.pn >= np;
        bf16_t* O = isg ? G : P; const int ldc = isg ? ldg : ldp; const int col0 = (isg ? u.pn - np : u.pn) * BM + wc * 32 + 8 * fq;
#pragma unroll
        for (int ai = 0; ai < 2; ++ai)
#pragma unroll
            for (int m = 0; m < 4; ++m) { bf16_t* rowp = O + (size_t)(row0 + ai * HALF + m * 16) * ldc + col0;
#pragma unroll
                for (int bj = 0; bj < 2; ++bj) { f32x4 v0 = acc[ai][bj][m][0], v1 = acc[ai][bj][m][1];
                    if (isg) {
#pragma unroll
                        for (int j = 0; j < 4; ++j) { v0[j] = fmaxf(sigmoid_f(v0[j]), 5.9604645e-8f); v1[j] = fmaxf(sigmoid_f(v1[j]), 5.9604645e-8f); } }
                    u32x4 w; w.x = cvt_pk_bf16(v0[0], v0[1]); w.y = cvt_pk_bf16(v0[2], v0[3]); w.z = cvt_pk_bf16(v1[0], v1[1]); w.w = cvt_pk_bf16(v1[2], v1[3]);
                    *(u32x4*)(rowp + bj * HALF) = w; } }
    }
};
#if GATES_U8
struct EpiGates8 {
    static constexpr bool PERM = true, AFTER_DRAIN = false, FP8 = true;
    unsigned char* G; int ldg; float inv_wscale;
    __device__ __forceinline__ void operator()(const f32x4 (&acc)[2][2][4][2], const Unit& u, int wr, int wc, int fr, int fq) const {
        int fr_ = fr; asm volatile("" : "+v"(fr_));
        const int row0 = u.pm * BM + wr * 64 + fr_, col0 = u.pn * BM + wc * 32 + 8 * fq;
#pragma unroll
        for (int ai = 0; ai < 2; ++ai)
#pragma unroll
            for (int m = 0; m < 4; ++m) { unsigned char* rowp = G + (size_t)(row0 + ai * HALF + m * 16) * ldg + col0;
#pragma unroll
                for (int bj = 0; bj < 2; ++bj) { const f32x4 v0 = acc[ai][bj][m][0], v1 = acc[ai][bj][m][1];
                    unsigned w0 = 0u, w1 = 0u;
#pragma unroll
                    for (int j = 0; j < 4; ++j) {
                        w0 = __builtin_amdgcn_cvt_pk_u8_f32(fmaxf(__builtin_fmaf(sigmoid_f(v0[j] * inv_wscale), 255.0f, 0.5f), 1.0f), j, w0);
                        w1 = __builtin_amdgcn_cvt_pk_u8_f32(fmaxf(__builtin_fmaf(sigmoid_f(v1[j] * inv_wscale), 255.0f, 0.5f), 1.0f), j, w1); }
                    typedef unsigned u32x2g_ __attribute__((ext_vector_type(2)));
                    u32x2g_ w; w.x = w0; w.y = w1;
                    *(u32x2g_*)(rowp + bj * HALF) = w; } }
    }
};
#else
struct EpiGates8 {
    static constexpr bool PERM = true, AFTER_DRAIN = false, FP8 = true;
    bf16_t* G; int ldg; float inv_wscale;
    __device__ __forceinline__ void operator()(const f32x4 (&acc)[2][2][4][2], const Unit& u, int wr, int wc, int fr, int fq) const {
        int fr_ = fr; asm volatile("" : "+v"(fr_));
        const int row0 = u.pm * BM + wr * 64 + fr_, col0 = u.pn * BM + wc * 32 + 8 * fq;
#pragma unroll
        for (int ai = 0; ai < 2; ++ai)
#pragma unroll
            for (int m = 0; m < 4; ++m) { bf16_t* rowp = G + (size_t)(row0 + ai * HALF + m * 16) * ldg + col0;
#pragma unroll
                for (int bj = 0; bj < 2; ++bj) { f32x4 v0 = acc[ai][bj][m][0], v1 = acc[ai][bj][m][1];
#pragma unroll
                    for (int j = 0; j < 4; ++j) { v0[j] = fmaxf(sigmoid_f(v0[j] * inv_wscale), 5.9604645e-8f); v1[j] = fmaxf(sigmoid_f(v1[j] * inv_wscale), 5.9604645e-8f); }
                    u32x4 w; w.x = cvt_pk_bf16(v0[0], v0[1]); w.y = cvt_pk_bf16(v0[2], v0[3]); w.z = cvt_pk_bf16(v1[0], v1[1]); w.w = cvt_pk_bf16(v1[2], v1[3]);
                    *(u32x4*)(rowp + bj * HALF) = w; } }
    }
};
#endif
DI_PG void unpack_bf16x8(const u32x4 gw, f32x4& g0, f32x4& g1) {
    g0[0] = __uint_as_float(gw.x << 16); g0[1] = __uint_as_float(gw.x & 0xffff0000u); g0[2] = __uint_as_float(gw.y << 16); g0[3] = __uint_as_float(gw.y & 0xffff0000u);
    g1[0] = __uint_as_float(gw.z << 16); g1[1] = __uint_as_float(gw.z & 0xffff0000u); g1[2] = __uint_as_float(gw.w << 16); g1[3] = __uint_as_float(gw.w & 0xffff0000u);
}
#if GATES_U8
typedef unsigned u32x2c_ __attribute__((ext_vector_type(2)));
DI_PG void unpack_u8x8(const u32x2c_ gw, f32x4& g0, f32x4& g1) {
    g0[0] = (float)(gw.x & 255u); g0[1] = (float)((gw.x >> 8) & 255u); g0[2] = (float)((gw.x >> 16) & 255u); g0[3] = (float)(gw.x >> 24);
    g1[0] = (float)(gw.y & 255u); g1[1] = (float)((gw.y >> 8) & 255u); g1[2] = (float)((gw.y >> 16) & 255u); g1[3] = (float)(gw.y >> 24);
}
#endif
struct EpiGateCat {
    static constexpr bool PERM = true, AFTER_DRAIN = false, FP8 = true; static constexpr int MIDK = 12;
#if GATES_U8
    const unsigned char* G;
#else
    const bf16_t* G;
#endif
    int ldg; int gstride; unsigned char* O; int ld; float oscale;
    __device__ __forceinline__ void mid(f32x4 (&acc)[2][2][4][2], const Unit& u, int seg, int wr, int wc, int fr, int fq) const {
        int fr_ = fr; asm volatile("" : "+v"(fr_));
        const int row0 = u.pm * BM + wr * 64 + fr_, col0 = u.pn * BM + wc * 32 + 8 * fq;
#pragma unroll
        for (int ai = 0; ai < 2; ++ai)
#pragma unroll
            for (int m = 0; m < 4; ++m) { const auto* gp = G + (size_t)(row0 + ai * HALF + m * 16) * ldg + (seg - 1) * gstride + col0;
#pragma unroll
                for (int bj = 0; bj < 2; ++bj) {
                    f32x4 a0, a1, b0, b1;
#if GATES_U8
                    unpack_u8x8(*(const u32x2c_*)(gp + bj * HALF), a0, a1); unpack_u8x8(*(const u32x2c_*)(gp + gstride + bj * HALF), b0, b1);
#else
                    unpack_bf16x8(*(const u32x4*)(gp + bj * HALF), a0, a1); unpack_bf16x8(*(const u32x4*)(gp + gstride + bj * HALF), b0, b1);
#endif
#pragma unroll
                    for (int j = 0; j < 4; ++j) { acc[ai][bj][m][0][j] *= a0[j] * __builtin_amdgcn_rcpf(b0[j]); acc[ai][bj][m][1][j] *= a1[j] * __builtin_amdgcn_rcpf(b1[j]); } }
                if (GATES_U8 == 0 && m == 3) asm volatile("" ::: "memory"); }
    }
    __device__ __forceinline__ void operator()(const f32x4 (&acc)[2][2][4][2], const Unit& u, int wr, int wc, int fr, int fq) const {
        const int row0 = u.pm * BM + wr * 64 + fr, col0 = u.pn * BM + wc * 32 + 8 * fq;
#if GATES_U8
        u32x2c_ gq[16];
#pragma unroll
        for (int q = 0; q < 16; ++q) gq[q] = *(const u32x2c_*)(G + (size_t)(row0 + (q >> 3) * HALF + ((q >> 1) & 3) * 16) * ldg + 2 * gstride + col0 + (q & 1) * HALF);
#endif
#pragma unroll
        for (int ai = 0; ai < 2; ++ai)
#pragma unroll
            for (int m = 0; m < 4; ++m) { const int row = row0 + ai * HALF + m * 16;
#pragma unroll
                for (int bj = 0; bj < 2; ++bj) { const int col = col0 + bj * HALF;
                    f32x4 g0, g1;
#if GATES_U8
                    unpack_u8x8(gq[ai * 8 + m * 2 + bj], g0, g1);
                    const float osc = oscale * (1.0f / 255.0f);
#else
                    unpack_bf16x8(*(const u32x4*)(G + (size_t)row * ldg + 2 * gstride + col), g0, g1);
                    const float osc = oscale;
#endif
                    const f32x4 t0 = g0 * acc[ai][bj][m][0] * osc, t1 = g1 * acc[ai][bj][m][1] * osc;
                    typedef unsigned u32x2_ __attribute__((ext_vector_type(2)));
                    u32x2_ w; w.x = pk_fp8x4(t0[0], t0[1], t0[2], t0[3]); w.y = pk_fp8x4(t1[0], t1[1], t1[2], t1[3]);
                    *(u32x2_*)(O + (size_t)row * ld + col) = w; } }
    }
};
template <class E_, class = void> struct epi_i8 { static constexpr bool value = false; };
template <class E_> struct epi_i8<E_, decltype((void)E_::I8)> { static constexpr bool value = E_::I8; };
template <class E_, class = void> struct epi_fp8 { static constexpr bool value = false; };
template <class E_> struct epi_fp8<E_, decltype((void)E_::FP8)> { static constexpr bool value = E_::FP8; };
typedef int pg8_v4i __attribute__((ext_vector_type(4)));
typedef int pg8_v8i __attribute__((ext_vector_type(8)));
__device__ __forceinline__ pg8_v8i cat16(bf16x8 lo, bf16x8 hi) { const pg8_v4i a = __builtin_bit_cast(pg8_v4i, lo), b = __builtin_bit_cast(pg8_v4i, hi); return __builtin_shufflevector(a, b, 0, 1, 2, 3, 4, 5, 6, 7); }
__device__ __forceinline__ void mfma8_tied(f32x4& c, pg8_v8i a, pg8_v8i b, int unit_scale) {
    asm volatile("v_mfma_scale_f32_16x16x128_f8f6f4 %0, %1, %2, %0, %3, %3 op_sel_hi:[0,0,0]" : "+v"(c) : "v"(a), "v"(b), "v"(unit_scale)); }
template <class E_, class = void> struct epi_midk { static constexpr int value = 0; };
template <class E_> struct epi_midk<E_, decltype((void)E_::MIDK)> { static constexpr int value = E_::MIDK; };
template <class Epi, class Sched, bool ALIGN_EPI = false, bool SP2 = false>
__device__ __forceinline__ void gemm_phase(PG8_LAS unsigned char* lds, const Gemm g, const Sched& S, const Epi& E) {
    int tid_ = threadIdx.x; asm volatile("" : "+v"(tid_));
    const int tid = tid_, wid = __builtin_amdgcn_readfirstlane(tid >> 6), lane = tid & 63, wr = wid >> 2, wc = wid & 3, fr = lane & 15, fq = lane >> 4;
    const int K = g.K, nt = K / BK;
    unsigned voffA[2], voffB[2];
#pragma unroll
    for (int i = 0; i < 2; ++i) { int R, C; stage_rc(tid * 16 + i * 8192, R, C); const int Rb = Epi::PERM ? ((R & ~31) + perm32(R & 31)) : R;
        voffA[i] = (unsigned)(R * K + C) * 2u; voffB[i] = (unsigned)(Rb * K + C) * 2u; }
    const size_t kstep = (size_t)(BK * 2);
    const size_t hstep = (size_t)HALF * K * 2;
    const size_t tstep = 2 * hstep;
    const unsigned ldsw = (unsigned)wid * 1024u;
    const int aoff = lds_byte(wr * 64 + fr, fq * 8), boff = lds_byte(wc * 32 + fr, fq * 8);
#define PG8_SA(b, h) (((b) * 2 + (h)) * HTB)
#define PG8_SB(b, h) ((4 + (b) * 2 + (h)) * HTB)
#define PG8_STAGE(bufoff, gbase, voff) do { _Pragma("unroll") for (int _i = 0; _i < 2; ++_i) \
        __builtin_amdgcn_global_load_lds((const unsigned*)((const char*)(gbase) + (voff)[_i]), (PG8_LAS unsigned*)(lds + (bufoff) + ldsw + _i * 8192), 16, 0, 0); } while (0)
#define PG8_LDA(dst, b, h) do { _Pragma("unroll") for (int m = 0; m < 4; ++m) _Pragma("unroll") for (int k = 0; k < 2; ++k) dst[m][k] = *(const PG8_LAS bf16x8*)(lds + PG8_SA(b, h) + aoff + m * 2048 + k * 1024); } while (0)
#define PG8_LDB(dst, b, h) do { _Pragma("unroll") for (int n = 0; n < 2; ++n) _Pragma("unroll") for (int k = 0; k < 2; ++k) dst[n][k] = *(const PG8_LAS bf16x8*)(lds + PG8_SB(b, h) + boff + n * 2048 + k * 1024); } while (0)
#define PG8_MMA(ai, bj, At, Bt) do { __builtin_amdgcn_s_setprio(1); \
        if constexpr (epi_fp8<Epi>::value) { _Pragma("unroll") for (int m = 0; m < 4; ++m) _Pragma("unroll") for (int n = 0; n < 2; ++n) \
            mfma8_tied(acc[ai][bj][m][n], cat16(Bt[n][0], Bt[n][1]), cat16(At[m][0], At[m][1]), fp8_unit_scale); } \
        else if constexpr (epi_i8<Epi>::value) { _Pragma("unroll") for (int m = 0; m < 4; ++m) _Pragma("unroll") for (int n = 0; n < 2; ++n) _Pragma("unroll") for (int k = 0; k < 2; ++k) \
            acc[ai][bj][m][n] = __builtin_bit_cast(f32x4, __builtin_amdgcn_mfma_i32_16x16x64_i8(__builtin_bit_cast(pg8_v4i, Bt[n][k]), __builtin_bit_cast(pg8_v4i, At[m][k]), __builtin_bit_cast(pg8_v4i, acc[ai][bj][m][n]), 0, 0, 0)); }     \
        else { _Pragma("unroll") for (int m = 0; m < 4; ++m) _Pragma("unroll") for (int n = 0; n < 2; ++n) _Pragma("unroll") for (int k = 0; k < 2; ++k) \
            acc[ai][bj][m][n] = __builtin_amdgcn_mfma_f32_16x16x32_bf16(Bt[n][k], At[m][k], acc[ai][bj][m][n], 0, 0, 0); } \
        __builtin_amdgcn_s_setprio(0); } while (0)
#define PG8_WAIT_V(n) asm volatile("s_waitcnt vmcnt(" #n ")" ::: "memory")
#define PG8_WAIT_L(n) asm volatile("s_waitcnt lgkmcnt(" #n ")" ::: "memory")
#define PG8_BAR __builtin_amdgcn_s_barrier()
#define PG8_SCHED __builtin_amdgcn_sched_barrier(0)
    const int fp8_unit_scale = 0x7f7f7f7f; (void)fp8_unit_scale;
    Unit cur, nxt; int ui = 0;
    if (!S.next(0, cur)) return;
    f32x4 acc[2][2][4][2];
#pragma unroll
    for (int a = 0; a < 2; ++a)
#pragma unroll
        for (int b = 0; b < 2; ++b)
#pragma unroll
            for (int m = 0; m < 4; ++m)
#pragma unroll
                for (int n = 0; n < 2; ++n) acc[a][b][m][n] = (f32x4){0.f, 0.f, 0.f, 0.f};
    bf16x8 At[4][2], B0[2][2], B1[2][2];
    const char* cA = (const char*)g.A + (size_t)cur.pm * tstep; const char* cB = (const char*)g.Bt + (size_t)cur.pn * tstep;
    S.a_ready(cur);
    if constexpr (SP2) {
        PG8_STAGE(PG8_SB(0, 0), cB, voffB); PG8_STAGE(PG8_SB(0, 1), cB + hstep, voffB); PG8_STAGE(PG8_SA(0, 0), cA, voffA); PG8_STAGE(PG8_SA(0, 1), cA + hstep, voffA);
        if (wr == 1) PG8_BAR;
        PG8_WAIT_V(2); PG8_BAR;
        PG8_STAGE(PG8_SB(1, 0), cB + kstep, voffB); PG8_STAGE(PG8_SA(1, 0), cA + kstep, voffA); PG8_STAGE(PG8_SB(1, 1), cB + hstep + kstep, voffB);
        PG8_WAIT_V(6); PG8_BAR;
    } else {
        PG8_STAGE(PG8_SB(0, 0), cB, voffB); PG8_STAGE(PG8_SA(0, 0), cA, voffA); PG8_STAGE(PG8_SB(0, 1), cB + hstep, voffB); PG8_STAGE(PG8_SA(0, 1), cA + hstep, voffA);
        if (wr == 1) PG8_BAR;
        PG8_WAIT_V(4); PG8_BAR;
        PG8_STAGE(PG8_SB(1, 0), cB + kstep, voffB); PG8_STAGE(PG8_SA(1, 0), cA + kstep, voffA); PG8_STAGE(PG8_SB(1, 1), cB + hstep + kstep, voffB);
        PG8_WAIT_V(6); PG8_BAR;
    }
    for (;;) {
        const bool has_next = S.next(ui + 1, nxt);
        const char* nA = has_next ? (const char*)g.A + (size_t)nxt.pm * tstep : cA; const char* nB = has_next ? (const char*)g.Bt + (size_t)nxt.pn * tstep : cB;
        for (int t = 0; t < nt; t += 2) {
            const bool last = (t == nt - 2);
            const char* a1 = cA + (size_t)(t + 1) * kstep;
            const char* a2 = last ? nA : cA + (size_t)(t + 2) * kstep; const char* b2 = last ? nB : cB + (size_t)(t + 2) * kstep;
            const char* a3 = a2 + kstep; const char* b3 = b2 + kstep;
            if (last && has_next) S.a_ready(nxt);
            if constexpr (epi_midk<Epi>::value > 0) { if (t > 0 && (t % epi_midk<Epi>::value) == 0) { PG8_SCHED; E.mid(acc, cur, t / epi_midk<Epi>::value, wr, wc, fr, fq); PG8_SCHED; } }
            if constexpr (SP2) {
            PG8_LDB(B0, 0, 0); PG8_LDB(B1, 0, 1); PG8_SCHED; PG8_LDA(At, 0, 0); PG8_STAGE(PG8_SA(1, 1), a1 + hstep, voffA);
            PG8_WAIT_V(8); PG8_WAIT_L(0); PG8_BAR; PG8_MMA(0, 0, At, B0); PG8_MMA(0, 1, At, B1); PG8_BAR; PG8_SCHED;
            PG8_LDA(At, 0, 1); PG8_STAGE(PG8_SB(0, 0), b2, voffB); PG8_STAGE(PG8_SB(0, 1), b2 + hstep, voffB); PG8_STAGE(PG8_SA(0, 0), a2, voffA);
            PG8_WAIT_V(8); PG8_WAIT_L(0); PG8_BAR; PG8_MMA(1, 0, At, B0); PG8_MMA(1, 1, At, B1); PG8_BAR; PG8_SCHED;
            PG8_LDB(B0, 1, 0); PG8_LDB(B1, 1, 1); PG8_SCHED; PG8_LDA(At, 1, 0); PG8_STAGE(PG8_SA(0, 1), a2 + hstep, voffA);
            PG8_WAIT_V(8); PG8_WAIT_L(0); PG8_BAR; PG8_MMA(0, 0, At, B0); PG8_MMA(0, 1, At, B1); PG8_BAR; PG8_SCHED;
            PG8_LDA(At, 1, 1); PG8_STAGE(PG8_SB(1, 0), b3, voffB); PG8_STAGE(PG8_SB(1, 1), b3 + hstep, voffB); PG8_STAGE(PG8_SA(1, 0), a3, voffA);
            PG8_WAIT_V(8); PG8_WAIT_L(0); PG8_BAR; PG8_MMA(1, 0, At, B0); PG8_MMA(1, 1, At, B1); PG8_BAR; PG8_SCHED;
            } else {
            PG8_LDB(B0, 0, 0); PG8_SCHED; PG8_LDA(At, 0, 0); PG8_STAGE(PG8_SA(1, 1), a1 + hstep, voffA);
            PG8_WAIT_L(8); PG8_BAR; PG8_WAIT_L(0); PG8_MMA(0, 0, At, B0); PG8_BAR; PG8_SCHED;
            PG8_LDB(B1, 0, 1); PG8_STAGE(PG8_SB(0, 0), b2, voffB);
            PG8_BAR; PG8_WAIT_L(0); PG8_MMA(0, 1, At, B1); PG8_BAR;
            PG8_LDA(At, 0, 1); PG8_STAGE(PG8_SA(0, 0), a2, voffA);
            PG8_BAR; PG8_WAIT_L(0); PG8_MMA(1, 0, At, B0); PG8_BAR; PG8_SCHED;
            PG8_STAGE(PG8_SB(0, 1), b2 + hstep, voffB);
            PG8_WAIT_V(6); PG8_BAR; PG8_MMA(1, 1, At, B1); PG8_BAR;
            PG8_LDB(B0, 1, 0); PG8_SCHED; PG8_LDA(At, 1, 0); PG8_STAGE(PG8_SA(0, 1), a2 + hstep, voffA);
            PG8_WAIT_L(8); PG8_BAR; PG8_WAIT_L(0); PG8_MMA(0, 0, At, B0); PG8_BAR; PG8_SCHED;
            PG8_LDB(B1, 1, 1); PG8_STAGE(PG8_SB(1, 0), b3, voffB);
            PG8_BAR; PG8_WAIT_L(0); PG8_MMA(0, 1, At, B1); PG8_BAR;
            PG8_LDA(At, 1, 1); PG8_STAGE(PG8_SA(1, 0), a3, voffA);
            PG8_BAR; PG8_WAIT_L(0); PG8_MMA(1, 0, At, B0); PG8_BAR; PG8_SCHED;
            PG8_STAGE(PG8_SB(1, 1), b3 + hstep, voffB);
            PG8_WAIT_V(6); PG8_BAR; PG8_MMA(1, 1, At, B1); PG8_BAR;
            }
        }
        if constexpr (epi_fp8<Epi>::value) asm volatile("s_nop 15\n\ts_nop 15" ::: "memory");
        if constexpr (ALIGN_EPI) { if (wr == 0) PG8_BAR; }
        if constexpr (!Epi::AFTER_DRAIN) { E(acc, cur, wr, wc, fr, fq); S.done(cur); }
        if (!has_next) break;
#pragma unroll
        for (int a = 0; a < 2; ++a)
#pragma unroll
            for (int b = 0; b < 2; ++b)
#pragma unroll
                for (int m = 0; m < 4; ++m)
#pragma unroll
                    for (int n = 0; n < 2; ++n) acc[a][b][m][n] = (f32x4){0.f, 0.f, 0.f, 0.f};
        cur = nxt; cA = nA; cB = nB; ++ui;
        if constexpr (ALIGN_EPI) { if (wr == 1) PG8_BAR; }
    }
    PG8_WAIT_V(0);
    if constexpr (!ALIGN_EPI) { if (wr == 0) PG8_BAR; }
    PG8_BAR;
    if constexpr (Epi::AFTER_DRAIN) { E.fused(acc, cur, wr, wc, fr, fq, lds, wid, lane); S.done(cur); }
#undef PG8_SA
#undef PG8_SB
#undef PG8_STAGE
#undef PG8_LDA
#undef PG8_LDB
#undef PG8_MMA
#undef PG8_WAIT_V
#undef PG8_WAIT_L
#undef PG8_BAR
#undef PG8_SCHED
}
}
#ifndef VD_DIRECT
#define VD_DIRECT 1
#endif
constexpr int NWAVES = 8;
constexpr int BATCH = 2, SEQ = 8192, DM = 4096, DFF = 11008, MTOK = BATCH * SEQ;
constexpr int MEMLEN = 256, MROWS = BATCH * MEMLEN;
constexpr float EPS = 1e-6f;
constexpr int NF8 = 7936, NIDX = 2304, NPC = NF8 + NIDX;
constexpr int PC_CQ = 0, PC_CKV = 1536, PC_QD = 2048, PC_KD = 3584, PC_VD = 5120, PC_QM = 6656, PC_KR = 7680, PC_QI = NF8, PC_KI = NF8 + 2048, PC_WI = NF8 + 2112;
constexpr int NGC = 3 * DM;
constexpr int NGU = 2 * DFF;
constexpr int KCAT = 4096;
constexpr float LOG2E = 1.4426950408889634f;
constexpr float QS_MLA = 0.07216878364870322f * LOG2E;
constexpr float QS_DSA = 0.08838834764831845f * LOG2E;
constexpr float QS_MEM = 0.0625f * LOG2E;
constexpr float WG_SCALE = 64.0f, WIN_SCALE = 64.0f, WUQ_SCALE = 32.0f, WUKV_SCALE = 16.0f, WO_SCALE = 32.0f, WOUT_SCALE = 64.0f, Y_SCALE = 16.0f, GS_SCALE = 16.0f, H_SCALE = 8.0f, WD_SCALE = 64.0f;
constexpr float WGU_I8_SCALE = 1625.0f;
constexpr float WG_SCALE_UNUSED = 0.f;
constexpr float LOG2_THETA = 18.931568569324174f;

constexpr size_t MiB = 1u << 20;
constexpr size_t WS_CTL = 0, CTL_ZERO_BYTES = 1 * MiB;
constexpr size_t WS_WGU = 1 * MiB;
constexpr size_t WS_WD = 173 * MiB;
constexpr size_t WS_SC = 1 * MiB;
constexpr size_t WS_WIN = 259 * MiB;
constexpr size_t WS_WINI = 290 * MiB;
constexpr size_t WS_WG8 = 337 * MiB;
constexpr size_t WS_WUQ = 433 * MiB, WS_WUKV = 440 * MiB, WS_WMKV = 443 * MiB, WS_WOCAT = 459 * MiB  , WS_WOUT = 495 * MiB;
constexpr size_t WS_A = 527 * MiB;
constexpr size_t WS_BIG = 655 * MiB;
constexpr size_t WS_HMID8 = 999 * MiB;
constexpr size_t WS_WD8 = 87 * MiB;
constexpr size_t WS_HMID = WS_BIG;
constexpr size_t WS_G = WS_BIG;
constexpr size_t WS_P = 1039 * MiB;
constexpr size_t WS_QMLARAW = 1039 * MiB, WS_KVRAW = 1111 * MiB, WS_QMLA = 1207 * MiB, WS_KMLA = 1279 * MiB;
constexpr size_t WS_CQN = 1359 * MiB, WS_CKVN = 1407 * MiB, WS_QD = 1423 * MiB, WS_KD = 1471 * MiB, WS_VD = 1519 * MiB, WS_QI = 1567 * MiB, WS_KI = 1631 * MiB, WS_WI = 1633 * MiB, WS_KR = 1635 * MiB, WS_QM = 1637 * MiB;
constexpr size_t WS_YCAT = 1669 * MiB  , WS_MEMN = 1741 * MiB, WS_MKVRAW = 1745 * MiB, WS_MEMK = 1747 * MiB, WS_RS1 = 1748 * MiB  , WS_END = 1749 * MiB;
constexpr size_t WS_HN8 = WS_YCAT;
constexpr size_t WS_BM = WS_CQN;
constexpr size_t SC_BATCH = (size_t)4096 * 8256;
static_assert(WS_SC + 2 * SC_BATCH * 4 <= WS_WIN, "scores fit the FFN weight region");
static_assert(WS_WGU + (size_t)NGU * DM * 2 <= WS_WD && WS_WD + (size_t)DM * DFF * 2 <= WS_WIN, "FFN weights");
static_assert(WS_WIN + (size_t)NF8 * DM <= WS_WINI && WS_WINI + (size_t)NIDX * DM * 2 <= WS_WG8 && WS_WG8 + (size_t)NGC * DM <= WS_WUQ, "win");
static_assert(WS_HMID + (size_t)MTOK * DFF * 2 <= WS_P && WS_G + (size_t)MTOK * NGC * 2 <= WS_P && WS_P + (size_t)MTOK * NPC * 2 <= WS_CQN, "big region");
constexpr int CW_BAR = 4096, CW_QUEUE = 8192;

constexpr int RING_BYTES = 131072, MISC_OFF = RING_BYTES, LDS_BYTES = 147456;

#define GAS __attribute__((address_space(1)))
#define LAS __attribute__((address_space(3)))
#define DI __device__ __forceinline__
typedef unsigned short bf16;
typedef unsigned v4u __attribute__((ext_vector_type(4)));
typedef unsigned v2u __attribute__((ext_vector_type(2)));
typedef float f32x4 __attribute__((ext_vector_type(4)));
typedef float f32x16 __attribute__((ext_vector_type(16)));
typedef short bf16x8 __attribute__((ext_vector_type(8)));
typedef short s16x4 __attribute__((ext_vector_type(4)));
#define LDS_WAIT() asm volatile("s_waitcnt lgkmcnt(0)" ::: "memory")
DI float bf2f(bf16 v) { return __uint_as_float(((unsigned)v) << 16); }
DI unsigned f2bf(float f) { unsigned u = __float_as_uint(f); return (u + 0x7fffu + ((u >> 16) & 1u)) >> 16; }
DI unsigned pk2(float lo, float hi) { return f2bf(lo) | (f2bf(hi) << 16); }
DI float wave_sum(float v) {
#pragma unroll
    for (int o = 1; o < 64; o <<= 1) v += __shfl_xor(v, o);
    return v;
}
DI void sincos_rev(float ang, float& s, float& c) {
    double rev = (double)ang * 0.15915494309189535; rev -= __builtin_rint(rev);
    const float fr = (float)rev; s = __builtin_amdgcn_sinf(fr); c = __builtin_amdgcn_cosf(fr);
}
DI float inv_freq(int i, int half) { return __builtin_amdgcn_exp2f(-(float)i * (LOG2_THETA / (float)half)); }
#define XB_TMO      128
#define XB_XCNT(j)  (256  + 64 * (j))
#define XB_XSUB(j)  (1280 + 64 * (j))
#define XB_XGEN(j)  (2304 + 64 * (j))
#define XB_TOP      3328
#define XB_TOPGEN   3392
#define XCD_BAR_WORDS 3456
#define XB_SPIN_CAP (1u << 18)

__device__ __forceinline__ unsigned xb_ld(unsigned* p)              { return __hip_atomic_load(p, __ATOMIC_RELAXED, __HIP_MEMORY_SCOPE_AGENT); }
__device__ __forceinline__ unsigned xb_add(unsigned* p, unsigned v) { return __hip_atomic_fetch_add(p, v, __ATOMIC_RELAXED, __HIP_MEMORY_SCOPE_AGENT); }
__device__ __forceinline__ unsigned xb_xcc_id() { return (unsigned)__builtin_amdgcn_s_getreg((3 << 11) | 20) & 0xFu; }
#define XB_SPIN(cond, bar) do { unsigned _sp = 0; while (cond) { __builtin_amdgcn_s_sleep(1); \
    if ((++_sp & 255u) == 0u) { if (xb_ld(&(bar)[XB_TMO])) break; if (_sp > XB_SPIN_CAP) { atomicAdd(&(bar)[XB_TMO], 1u); break; } } } } while (0)

struct XcdBarrier {
    unsigned* bar; unsigned x;
    volatile LAS unsigned* st;
};

__device__ __forceinline__ XcdBarrier xcd_barrier_post(unsigned* bar, volatile LAS unsigned* st) {
    XcdBarrier b; b.bar = bar; b.x = xb_xcc_id(); b.st = st;
    if (threadIdx.x == 0) (void)xb_add(&bar[XB_XCNT(b.x)], 1u);
    return b;
}
__device__ __forceinline__ void xcd_barrier_complete(unsigned* bar, unsigned x, unsigned& nloc, unsigned& nx) {
    const unsigned G = gridDim.x * gridDim.y * gridDim.z;
    unsigned sum, cnt, mine, sp = 0u;
    for (;;) {
        sum = 0u; cnt = 0u; mine = 0u;
#pragma unroll
        for (unsigned j = 0; j < 16; ++j) { const unsigned c = xb_ld(&bar[XB_XCNT(j)]); sum += c; cnt += (c > 0u) ? 1u : 0u; mine = (j == x) ? c : mine; }
        if (sum == G) break;
        __builtin_amdgcn_s_sleep(1);
        if ((++sp & 255u) == 0u) { if (xb_ld(&bar[XB_TMO])) break; if (sp > XB_SPIN_CAP) { atomicAdd(&bar[XB_TMO], 1u); break; } }
    }
    nloc = mine > 0u ? mine : 1u; nx = cnt > 0u ? cnt : 1u;
}

__device__ __forceinline__ void xcd_barrier(const XcdBarrier& b) {
    asm volatile("s_waitcnt vmcnt(0)" ::: "memory");
    __syncthreads();
    if (threadIdx.x == 0) {
        unsigned* bar = b.bar;
        __builtin_amdgcn_s_waitcnt(0);
        unsigned nloc = b.st[0], nx = b.st[1];
        if (nloc == 0u) { xcd_barrier_complete(bar, b.x, nloc, nx); b.st[0] = nloc; b.st[1] = nx; }
        const unsigned old = xb_add(&bar[XB_XSUB(b.x)], 1u);
        const unsigned gen = old / nloc;
        if (old + 1u == (gen + 1u) * nloc) {
            __builtin_amdgcn_fence(__ATOMIC_RELEASE, "agent");
            asm volatile("s_waitcnt vmcnt(0)" ::: "memory");
            const unsigned og = xb_add(&bar[XB_TOP], 1u);
            const unsigned tg = og / nx;
            if (og + 1u == (tg + 1u) * nx) xb_add(&bar[XB_TOPGEN], 1u);
            else XB_SPIN(xb_ld(&bar[XB_TOPGEN]) == tg, bar);
            __builtin_amdgcn_fence(__ATOMIC_ACQUIRE, "agent");
            xb_add(&bar[XB_XGEN(b.x)], 1u);
            asm volatile("s_waitcnt vmcnt(0)" ::: "memory");
        } else {
            XB_SPIN(xb_ld(&bar[XB_XGEN(b.x)]) == gen, bar);
            __builtin_amdgcn_fence(__ATOMIC_ACQUIRE, "agent");
            asm volatile("s_waitcnt vmcnt(0)" ::: "memory");
        }
    }
    __syncthreads();
}
struct Ctx {
    LAS unsigned char* lds;
    int tid, lane, wave, G, gw, NGW;
};
DI Ctx make_ctx(LAS unsigned char* lds) {
    int t = threadIdx.x; asm volatile("" : "+v"(t));
    Ctx C; C.lds = lds; C.tid = t; C.lane = t & 63; C.wave = __builtin_amdgcn_readfirstlane(t >> 6);
    C.G = gridDim.x; C.gw = blockIdx.x * 8 + C.wave; C.NGW = C.G * 8; return C;
}

DI unsigned pack_fp8x4(float a, float b, float c, float d) { int p = __builtin_amdgcn_cvt_pk_fp8_f32(a, b, 0, false); p = __builtin_amdgcn_cvt_pk_fp8_f32(c, d, p, true); return (unsigned)p; }
DI unsigned pack_i8x4(float a, float b, float c, float d) {
    const int ia = (int)__builtin_rintf(__builtin_amdgcn_fmed3f(a, -127.f, 127.f)), ib = (int)__builtin_rintf(__builtin_amdgcn_fmed3f(b, -127.f, 127.f));
    const int ic = (int)__builtin_rintf(__builtin_amdgcn_fmed3f(c, -127.f, 127.f)), id = (int)__builtin_rintf(__builtin_amdgcn_fmed3f(d, -127.f, 127.f));
    return (unsigned)(ia & 255) | ((unsigned)(ib & 255) << 8) | ((unsigned)(ic & 255) << 16) | ((unsigned)(id & 255) << 24); }
struct CvSrc { const float* p; unsigned ldw; bool zero; };
DI void cv_load(const CvSrc s, int lane, float (&v)[32]) {
    if (s.zero) {
#pragma unroll
        for (int i = 0; i < 32; ++i) v[i] = 0.f;
    } else {
        const unsigned loff = (unsigned)(lane >> 5) * s.ldw + (unsigned)(lane & 31);
        const float* rp = s.p;
#pragma unroll
        for (int i = 0; i < 32; ++i) { v[i] = rp[loff]; rp += 2 * s.ldw; }
    }
}
DI void cv_emit_bf16(const LAS float* scr, int lane, bf16* WT, size_t K, int drow0, int kcol) {
    const int c = lane & 7;
#pragma unroll
    for (int j = 0; j < 4; ++j) { const int n = (lane >> 3) + 8 * j; const LAS float* s = scr + (8 * c) * 33 + n;
        v4u o; o.x = pk2(s[0 * 33], s[1 * 33]); o.y = pk2(s[2 * 33], s[3 * 33]); o.z = pk2(s[4 * 33], s[5 * 33]); o.w = pk2(s[6 * 33], s[7 * 33]);
        *(GAS v4u*)(WT + (size_t)(drow0 + n) * K + kcol + 8 * c) = o; }
}
DI void cv_emit_f8(const LAS float* scr, int lane, unsigned char* WT, size_t K, int drow0, int kcol, float scale) {
    const int c = lane & 3;
#pragma unroll
    for (int j = 0; j < 2; ++j) { const int n = (lane >> 2) + 16 * j; const LAS float* s = scr + (16 * c) * 33 + n;
        v4u o;
#pragma unroll
        for (int w = 0; w < 4; ++w) o[w] = pack_fp8x4(s[(4 * w) * 33] * scale, s[(4 * w + 1) * 33] * scale, s[(4 * w + 2) * 33] * scale, s[(4 * w + 3) * 33] * scale);
        *(GAS v4u*)(WT + (size_t)(drow0 + n) * K + kcol + 16 * c) = o; }
}
DI void cv_emit_i8(const LAS float* scr, int lane, unsigned char* WT, size_t K, int drow0, int kcol, float scale) {
    const int c = lane & 3;
#pragma unroll
    for (int j = 0; j < 2; ++j) { const int n = (lane >> 2) + 16 * j; const LAS float* s = scr + (16 * c) * 33 + n;
        v4u o;
#pragma unroll
        for (int w = 0; w < 4; ++w) o[w] = pack_i8x4(s[(4 * w) * 33] * scale, s[(4 * w + 1) * 33] * scale, s[(4 * w + 2) * 33] * scale, s[(4 * w + 3) * 33] * scale);
        *(GAS v4u*)(WT + (size_t)(drow0 + n) * K + kcol + 16 * c) = o; }
}
template <class Dec, class Emit> DI void cv_runx(const Ctx& C, int first, int nitems, int stride, Dec dec, Emit emit) {
    LAS float* scr = (LAS float*)(C.lds + C.wave * 16384);
    LAS float* sw = scr + (C.lane >> 5) * 33 + (C.lane & 31);
    float v[32];
    int it = first;
    if (it < nitems) cv_load(dec(it), C.lane, v);
#pragma unroll 1
    while (it < nitems) {
#pragma unroll
        for (int i = 0; i < 32; ++i) sw[66 * i] = v[i];
        const int nit = it + stride;
        if (nit < nitems) cv_load(dec(nit), C.lane, v);
        LDS_WAIT(); asm volatile("" ::: "memory");
        emit(it, scr);
        LDS_WAIT(); asm volatile("" ::: "memory");
        it = nit;
    }
}
template <class Dec, class Emit> DI void cv_run(const Ctx& C, int nitems, Dec dec, Emit emit) { cv_runx(C, C.gw, nitems, C.NGW, dec, emit); }
constexpr int CONV_WOCAT_ITEMS = (KCAT / 64) * (DM / 32), CONV_WOUT_ITEMS = (DM / 64) * (DM / 32);
DI void conv_wocat(const Ctx& C, const float* womla, const float* wodsa, const float* womem, unsigned char* wt, int first = -1, int last = 0, int stride = 0) {
    constexpr int nblk = DM / 32, items = (KCAT / 64) * nblk;
    cv_runx(C, first < 0 ? C.gw : first, first < 0 ? items : last, first < 0 ? C.NGW : stride,
        [&](int it) -> CvSrc { const int kb = it / nblk, nb = it % nblk, k = 64 * kb;
            const float* w = (k < 1536) ? womla + (size_t)k * DM : (k < 3072) ? wodsa + (size_t)(k - 1536) * DM : (k < 4096) ? womem + (size_t)(k - 3072) * DM : womem;
            return CvSrc{w + 32 * nb, (unsigned)DM, k >= 4096}; },
        [&](int it, const LAS float* scr) { const int kb = it / nblk, nb = it % nblk; cv_emit_f8(scr, C.lane, wt, KCAT, 32 * nb, 64 * kb, WO_SCALE); });
}
DI void conv_plain8(const Ctx& C, const float* w, int K, int N, unsigned char* wt, float scale, int first = -1, int last = 0, int stride = 0) {
    const int nblk = N / 32, items = (K / 64) * nblk;
    cv_runx(C, first < 0 ? C.gw : first, first < 0 ? items : last, first < 0 ? C.NGW : stride,
        [&](int it) -> CvSrc { const int kb = it / nblk, nb = it % nblk; return CvSrc{w + (size_t)(64 * kb) * N + 32 * nb, (unsigned)N, false}; },
        [&](int it, const LAS float* scr) { const int kb = it / nblk, nb = it % nblk; cv_emit_f8(scr, C.lane, wt, (size_t)K, 32 * nb, 64 * kb, scale); });
}
DI int inproj_src(int d) {
    if (d < 2048) return d;
    if (d < 6656) return d + 64;
    if (d < 7680) return d + 2208;
    if (d < 7744) return d - 5632;
    if (d < NF8) return -1;
    if (d < NF8 + 2144) return d - NF8 + 6720;
    return -1;
}
constexpr int CONV_FFN_ITEMS = (DM / 64) * (NGU / 32) + (DFF / 64) * (DM / 32);
template <int F8, bool I8UP = false> DI void conv_ffn(const Ctx& C, const float* wg, const float* wu, const float* wd, bf16* WGUt, unsigned char* WDt, unsigned char* WDt8 = nullptr, int first = -1, int last = 0, int stride = 0) {
    constexpr int I_GU = (DM / 64) * (NGU / 32), I_D = (DFF / 64) * (DM / 32), NB_GU = NGU / 32, NB_D = DM / 32;
    static_assert(CONV_FFN_ITEMS == I_GU + I_D, "item count");
    cv_runx(C, first < 0 ? C.gw : first, first < 0 ? I_GU + I_D : last, first < 0 ? C.NGW : stride,
        [&](int it) -> CvSrc {
            if (it < I_GU) { const int kb = it / NB_GU, nb = it % NB_GU, n0 = nb * 32, pn = n0 >> 8, bj = (n0 >> 7) & 1, c = n0 & 127;
                return CvSrc{(bj ? wu : wg) + (size_t)(64 * kb) * DFF + 128 * pn + c, (unsigned)DFF, false}; }
            const int r = it - I_GU, kb = r / NB_D, nb = r % NB_D; return CvSrc{wd + (size_t)(64 * kb) * DM + 32 * nb, (unsigned)DM, false}; },
        [&](int it, const LAS float* scr) {
            if (it < I_GU) { const int kb = it / NB_GU, nb = it % NB_GU;
                if constexpr (I8UP) cv_emit_i8(scr, C.lane, (unsigned char*)WGUt, DM, 32 * nb, 64 * kb, WGU_I8_SCALE); else cv_emit_bf16(scr, C.lane, WGUt, DM, 32 * nb, 64 * kb); }
            else { const int r = it - I_GU, kb = r / NB_D, nb = r % NB_D;
                if constexpr (F8 == 1) cv_emit_f8(scr, C.lane, WDt, DFF, 32 * nb, 64 * kb, WD_SCALE);
                else { cv_emit_bf16(scr, C.lane, (bf16*)WDt, DFF, 32 * nb, 64 * kb);
                    if constexpr (F8 == 2) cv_emit_f8(scr, C.lane, WDt8, DFF, 32 * nb, 64 * kb, WD_SCALE); } } });
}
DI void conv_plain(const Ctx& C, const float* w, int K, int N, bf16* wt, int& base, int total_dummy) { (void)base; (void)total_dummy;
    const int nblk = N / 32, items = (K / 64) * nblk;
    cv_run(C, items,
        [&](int it) -> CvSrc { const int kb = it / nblk, nb = it % nblk; return CvSrc{w + (size_t)(64 * kb) * N + 32 * nb, (unsigned)N, false}; },
        [&](int it, const LAS float* scr) { const int kb = it / nblk, nb = it % nblk; cv_emit_bf16(scr, C.lane, wt, (size_t)K, 32 * nb, 64 * kb); });
}
DI void conv_win(const Ctx& C, const float* w_in, const float* w_gate, unsigned char* wt8, bf16* wti, unsigned char* wg8) {
    constexpr int nblk = NPC / 32, items = (DM / 64) * nblk, nblkg = NGC / 32, itemsg = (DM / 64) * nblkg;
    cv_run(C, items,
        [&](int it) -> CvSrc { const int kb = it / nblk, nb = it % nblk, sc = inproj_src(32 * nb); return CvSrc{w_in + (size_t)(64 * kb) * 9888 + (sc < 0 ? 0 : sc), 9888u, sc < 0}; },
        [&](int it, const LAS float* scr) { const int kb = it / nblk, nb = it % nblk, n0 = 32 * nb;
            if (n0 < NF8) cv_emit_f8(scr, C.lane, wt8, DM, n0, 64 * kb, WIN_SCALE); else cv_emit_bf16(scr, C.lane, wti, DM, n0 - NF8, 64 * kb); });
    cv_run(C, itemsg,
        [&](int it) -> CvSrc { const int kb = it / nblkg, nb = it % nblkg, gi = 32 * nb, br = gi / DM, col = gi % DM; return CvSrc{w_gate + (size_t)br * DM * DM + (size_t)(64 * kb) * DM + col, (unsigned)DM, false}; },
        [&](int it, const LAS float* scr) { const int kb = it / nblkg, nb = it % nblkg; cv_emit_f8(scr, C.lane, wg8, DM, 32 * nb, 64 * kb, WG_SCALE); });
}
DI void rms_row4096(const float* xrow, const float* g, bf16* orow, int lane) {
    const GAS f32x4* xr = (const GAS f32x4*)xrow + lane; const GAS f32x4* gr = (const GAS f32x4*)g + lane;
    f32x4 v[16]; float s = 0.f;
#pragma unroll
    for (int j = 0; j < 16; ++j) { v[j] = xr[64 * j]; s += (v[j].x * v[j].x + v[j].y * v[j].y) + (v[j].z * v[j].z + v[j].w * v[j].w); }
    const float rstd = rsqrtf(wave_sum(s) * (1.f / 4096.f) + EPS);
    GAS v2u* o8 = (GAS v2u*)orow + lane;
#pragma unroll
    for (int j = 0; j < 16; ++j) { const f32x4 gg = gr[64 * j]; v2u o; o.x = pk2(v[j].x * rstd * gg.x, v[j].y * rstd * gg.y); o.y = pk2(v[j].z * rstd * gg.z, v[j].w * rstd * gg.w); o8[64 * j] = o; }
}
DI void rms_row4096_dual(const float* xrow, const float* g, bf16* orow, unsigned char* orow8, int lane) {
    const GAS f32x4* xr = (const GAS f32x4*)xrow + lane; const GAS f32x4* gr = (const GAS f32x4*)g + lane;
    f32x4 v[16]; float s = 0.f;
#pragma unroll
    for (int j = 0; j < 16; ++j) { v[j] = xr[64 * j]; s += (v[j].x * v[j].x + v[j].y * v[j].y) + (v[j].z * v[j].z + v[j].w * v[j].w); }
    const float rstd = rsqrtf(wave_sum(s) * (1.f / 4096.f) + EPS);
    GAS v2u* o8 = (GAS v2u*)orow + lane; GAS unsigned* q8 = (GAS unsigned*)orow8 + lane;
#pragma unroll
    for (int j = 0; j < 16; ++j) { const f32x4 gg = gr[64 * j]; const float a = v[j].x * rstd * gg.x, b = v[j].y * rstd * gg.y, c = v[j].z * rstd * gg.z, d = v[j].w * rstd * gg.w;
        v2u o; o.x = pk2(a, b); o.y = pk2(c, d); o8[64 * j] = o; q8[64 * j] = pack_fp8x4(a, b, c, d); }
}
DI void rms_row4096_dual_add(const float* xrow, const bf16* drow, float dscale, float* x1row, const float* g, bf16* orow, unsigned char* orow8, int lane) {
    const GAS f32x4* xr = (const GAS f32x4*)xrow + lane; const GAS v2u* dr = (const GAS v2u*)drow + lane; const GAS f32x4* gr = (const GAS f32x4*)g + lane;
    f32x4 v[16]; v2u dd[16]; float s = 0.f;
#pragma unroll
    for (int j = 0; j < 16; ++j) { v[j] = xr[64 * j]; dd[j] = dr[64 * j]; }
    GAS f32x4* xo = (GAS f32x4*)x1row + lane;
#pragma unroll
    for (int j = 0; j < 16; ++j) { v[j].x += dscale * __uint_as_float(dd[j].x << 16); v[j].y += dscale * __uint_as_float(dd[j].x & 0xffff0000u); v[j].z += dscale * __uint_as_float(dd[j].y << 16); v[j].w += dscale * __uint_as_float(dd[j].y & 0xffff0000u);
        if (x1row) xo[64 * j] = v[j];
        s += (v[j].x * v[j].x + v[j].y * v[j].y) + (v[j].z * v[j].z + v[j].w * v[j].w); }
    const float rstd = rsqrtf(wave_sum(s) * (1.f / 4096.f) + EPS);
    GAS v2u* o8 = (GAS v2u*)orow + lane; GAS unsigned* q8 = (GAS unsigned*)orow8 + lane;
#pragma unroll
    for (int j = 0; j < 16; ++j) { const f32x4 gg = gr[64 * j]; const float a = v[j].x * rstd * gg.x, b = v[j].y * rstd * gg.y, c = v[j].z * rstd * gg.z, d = v[j].w * rstd * gg.w;
        v2u o; o.x = pk2(a, b); o.y = pk2(c, d); o8[64 * j] = o; q8[64 * j] = pack_fp8x4(a, b, c, d); }
}
DI void rms_rows_dual_add(const Ctx& C, const float* x, const bf16* d, float dscale, float* x1, const float* g, bf16* o, unsigned char* o8, int rows) {
    for (int m = C.gw; m < rows; m += C.NGW) rms_row4096_dual_add(x + (size_t)m * DM, d + (size_t)m * DM, dscale, x1 ? x1 + (size_t)m * DM : nullptr, g, o + (size_t)m * DM, o8 + (size_t)m * DM, C.lane);
}
DI void rms_rows_dual(const Ctx& C, const float* x, const float* g, bf16* o, unsigned char* o8, int rows) {
    for (int m = C.gw; m < rows; m += C.NGW) rms_row4096_dual(x + (size_t)m * DM, g, o + (size_t)m * DM, o8 + (size_t)m * DM, C.lane);
}
DI void rms_row4096_i8(const float* xrow, const float* g, unsigned char* orow, float* rowscale, float wscale, int lane) {
    const GAS f32x4* xr = (const GAS f32x4*)xrow + lane; const GAS f32x4* gr = (const GAS f32x4*)g + lane;
    f32x4 v[16]; float s = 0.f;
#pragma unroll
    for (int j = 0; j < 16; ++j) { v[j] = xr[64 * j]; s += (v[j].x * v[j].x + v[j].y * v[j].y) + (v[j].z * v[j].z + v[j].w * v[j].w); }
    const float rstd = rsqrtf(wave_sum(s) * (1.f / 4096.f) + EPS);
    float am = 0.f;
#pragma unroll
    for (int j = 0; j < 16; ++j) { const f32x4 gg = gr[64 * j]; v[j] = v[j] * rstd * gg; am = fmaxf(am, fmaxf(fmaxf(__builtin_fabsf(v[j].x), __builtin_fabsf(v[j].y)), fmaxf(__builtin_fabsf(v[j].z), __builtin_fabsf(v[j].w)))); }
#pragma unroll
    for (int o = 1; o < 64; o <<= 1) am = fmaxf(am, __shfl_xor(am, o));
    am = fmaxf(am, 1e-20f);
    const float q = 127.f / am;
    GAS unsigned* q8 = (GAS unsigned*)orow + lane;
#pragma unroll
    for (int j = 0; j < 16; ++j) q8[64 * j] = pack_i8x4(v[j].x * q, v[j].y * q, v[j].z * q, v[j].w * q);
    if (lane == 0) *rowscale = am / (127.f * wscale);
}
DI void rms_row4096_i8_add(const float* xrow, const bf16* drow, const float* g, unsigned char* orow, float* rowscale, float wscale, int lane, bf16* x2row = nullptr, const bf16* d1row = nullptr, float d1scale = 0.f) {
    const GAS f32x4* xr = (const GAS f32x4*)xrow + lane; const GAS v2u* dr = (const GAS v2u*)drow + lane; const GAS f32x4* gr = (const GAS f32x4*)g + lane;
    f32x4 v[16]; v2u dd[16]; float s = 0.f;
#pragma unroll
    for (int j = 0; j < 16; ++j) { v[j] = xr[64 * j]; dd[j] = dr[64 * j]; }
    if (d1row) { const GAS v2u* d1r = (const GAS v2u*)d1row + lane; v2u d1[16];
#pragma unroll
        for (int j = 0; j < 16; ++j) d1[j] = d1r[64 * j];
#pragma unroll
        for (int j = 0; j < 16; ++j) { v[j].x += d1scale * __uint_as_float(d1[j].x << 16); v[j].y += d1scale * __uint_as_float(d1[j].x & 0xffff0000u); v[j].z += d1scale * __uint_as_float(d1[j].y << 16); v[j].w += d1scale * __uint_as_float(d1[j].y & 0xffff0000u); } }
#pragma unroll
    for (int j = 0; j < 16; ++j) { v[j].x += __uint_as_float(dd[j].x << 16); v[j].y += __uint_as_float(dd[j].x & 0xffff0000u); v[j].z += __uint_as_float(dd[j].y << 16); v[j].w += __uint_as_float(dd[j].y & 0xffff0000u);
        if (x2row) { v2u o; o.x = pk2(v[j].x, v[j].y); o.y = pk2(v[j].z, v[j].w); ((GAS v2u*)x2row + lane)[64 * j] = o; }
        s += (v[j].x * v[j].x + v[j].y * v[j].y) + (v[j].z * v[j].z + v[j].w * v[j].w); }
    const float rstd = rsqrtf(wave_sum(s) * (1.f / 4096.f) + EPS);
    float am = 0.f;
#pragma unroll
    for (int j = 0; j < 16; ++j) { const f32x4 gg = gr[64 * j]; v[j] = v[j] * rstd * gg; am = fmaxf(am, fmaxf(fmaxf(__builtin_fabsf(v[j].x), __builtin_fabsf(v[j].y)), fmaxf(__builtin_fabsf(v[j].z), __builtin_fabsf(v[j].w)))); }
#pragma unroll
    for (int o = 1; o < 64; o <<= 1) am = fmaxf(am, __shfl_xor(am, o));
    am = fmaxf(am, 1e-20f);
    const float q = 127.f / am;
    GAS unsigned* q8 = (GAS unsigned*)orow + lane;
#pragma unroll
    for (int j = 0; j < 16; ++j) q8[64 * j] = pack_i8x4(v[j].x * q, v[j].y * q, v[j].z * q, v[j].w * q);
    if (lane == 0) *rowscale = am / (127.f * wscale);
}
DI void rms_rows_i8_add(const Ctx& C, const float* x, const bf16* d, const float* g, unsigned char* o, float* rowscale, float wscale, int rows, bf16* x2 = nullptr, const bf16* d1 = nullptr, float d1scale = 0.f) {
    for (int m = C.gw; m < rows; m += C.NGW) rms_row4096_i8_add(x + (size_t)m * DM, d + (size_t)m * DM, g, o + (size_t)m * DM, rowscale + m, wscale, C.lane, x2 ? x2 + (size_t)m * DM : nullptr, d1 ? d1 + (size_t)m * DM : nullptr, d1scale);
}
DI void rms_rows_i8(const Ctx& C, const float* x, const float* g, unsigned char* o, float* rowscale, float wscale, int rows) {
    for (int m = C.gw; m < rows; m += C.NGW) rms_row4096_i8(x + (size_t)m * DM, g, o + (size_t)m * DM, rowscale + m, wscale, C.lane);
}
DI void rms_rows(const Ctx& C, const float* x, const float* g, bf16* o, int rows) {
    for (int m = C.gw; m < rows; m += C.NGW) rms_row4096(x + (size_t)m * DM, g, o + (size_t)m * DM, C.lane);
}

struct PP1 { const bf16* P; const int* pos; const float *g_cq, *g_ckv, *g_qd, *g_kd, *g_qm;
             unsigned char *CQn, *CKVn; bf16 *Qd, *Kd, *Vd, *Qi, *Ki, *Kr, *Qm; float* Wi; unsigned char* Ycat; };
DI void unpack8(const v4u w, float (&f)[8]) {
#pragma unroll
    for (int k = 0; k < 4; ++k) { f[2 * k] = __uint_as_float(w[k] << 16); f[2 * k + 1] = __uint_as_float(w[k] & 0xffff0000u); }
}
DI unsigned cvtpk_rne(float lo, float hi) { unsigned r; asm volatile("v_cvt_pk_bf16_f32 %0, %1, %2" : "=v"(r) : "v"(lo), "v"(hi)); return r; }
DI v4u pack8(const float (&f)[8]) { v4u w; w.x = cvtpk_rne(f[0], f[1]); w.y = cvtpk_rne(f[2], f[3]); w.z = cvtpk_rne(f[4], f[5]); w.w = cvtpk_rne(f[6], f[7]); return w; }
DI float sumsq8(const float (&f)[8]) { float s = 0.f;
#pragma unroll
    for (int e = 0; e < 8; ++e) s += f[e] * f[e];
    return s; }
DI void load8f(const float* p, float (&f)[8]) { const f32x4 a = *(const f32x4*)p, b = *(const f32x4*)(p + 4); f[0] = a.x; f[1] = a.y; f[2] = a.z; f[3] = a.w; f[4] = b.x; f[5] = b.y; f[6] = b.z; f[7] = b.w; }
DI void pp1_load(const PP1& A, int t, int lane, v4u (&R)[20], int& posi) {
    const bf16* pr = A.P + (size_t)t * NPC;
    posi = A.pos[t];
#pragma unroll
    for (int j = 0; j < 3; ++j) { R[j] = *(const v4u*)(pr + PC_CQ + 8 * (lane + 64 * j)); R[4 + j] = *(const v4u*)(pr + PC_QD + 8 * (lane + 64 * j));
        R[7 + j] = *(const v4u*)(pr + PC_KD + 8 * (lane + 64 * j));
#if !VD_DIRECT
        R[10 + j] = *(const v4u*)(pr + PC_VD + 8 * (lane + 64 * j));
#endif
    }
    R[3] = *(const v4u*)(pr + PC_CKV + 8 * lane);
#pragma unroll
    for (int j = 0; j < 4; ++j) R[13 + j] = *(const v4u*)(pr + PC_QI + 8 * (lane + 64 * j));
    R[17] = *(const v4u*)(pr + (lane < 8 ? PC_KR + 8 * lane : PC_KI + 8 * ((lane < 20 ? lane : 8) - 8)));
#pragma unroll
    for (int j = 0; j < 2; ++j) R[18 + j] = *(const v4u*)(pr + PC_QM + 8 * (lane + 64 * j));
}
DI void load8f_l(const LAS float* p, float (&f)[8]) { const f32x4 a = *(const LAS f32x4*)p, b = *(const LAS f32x4*)(p + 4); f[0] = a.x; f[1] = a.y; f[2] = a.z; f[3] = a.w; f[4] = b.x; f[5] = b.y; f[6] = b.z; f[7] = b.w; }
DI void pp1_token(const PP1& A, int t, int lane, LAS float* tab, const v4u (&R)[20], int posi, const LAS float* GL) {
    const float pos = (float)posi;
    {   float sn, cs;
        if (lane < 16) { sincos_rev(pos * inv_freq(lane, 16), sn, cs); tab[lane] = cs; tab[16 + lane] = sn; }
        else if (lane < 24) { sincos_rev(pos * inv_freq(lane - 16, 8), sn, cs); tab[32 + lane - 16] = cs; tab[40 + lane - 16] = sn; }
        LDS_WAIT(); }
    {
        float x[3][8]; float ss = 0.f;
#pragma unroll
        for (int j = 0; j < 3; ++j) { unpack8(R[j], x[j]); ss += sumsq8(x[j]); }
        const float rstd = rsqrtf(wave_sum(ss) * (1.f / 1536.f) + EPS);
#pragma unroll
        for (int j = 0; j < 3; ++j) { float g[8]; load8f_l(GL + 8 * (lane + 64 * j), g);
#pragma unroll
            for (int e = 0; e < 8; ++e) x[j][e] *= rstd * g[e];
            v2u w8; w8.x = pack_fp8x4(x[j][0], x[j][1], x[j][2], x[j][3]); w8.y = pack_fp8x4(x[j][4], x[j][5], x[j][6], x[j][7]);
            *(v2u*)(A.CQn + (size_t)t * 1536 + 8 * (lane + 64 * j)) = w8; }
    }
    {
        float x[8]; unpack8(R[3], x);
        const float rstd = rsqrtf(wave_sum(sumsq8(x)) * (1.f / 512.f) + EPS);
        float g[8]; load8f_l(GL + 1536 + 8 * lane, g);
#pragma unroll
        for (int e = 0; e < 8; ++e) x[e] *= rstd * g[e];
        v2u w8; w8.x = pack_fp8x4(x[0], x[1], x[2], x[3]); w8.y = pack_fp8x4(x[4], x[5], x[6], x[7]);
        *(v2u*)(A.CKVn + (size_t)t * 512 + 8 * lane) = w8;
    }
    {
        const int cc = lane & 15;
        float cs[8], sn[8];
#pragma unroll
        for (int e = 0; e < 8; ++e) { cs[e] = tab[8 * (cc & 1) + e]; sn[e] = tab[16 + 8 * (cc & 1) + e]; }
#pragma unroll
        for (int qk = 0; qk < 2; ++qk) {
            bf16* O = qk ? A.Kd : A.Qd; const float sc = qk ? 1.0f : QS_DSA;
            float g[8]; load8f_l(GL + 2048 + 128 * qk + 8 * cc, g);
#pragma unroll
            for (int j = 0; j < 3; ++j) {
                float x[8]; unpack8(R[4 + 3 * qk + j], x);
                float ss = sumsq8(x); ss += __shfl_xor(ss, 1); ss += __shfl_xor(ss, 2); ss += __shfl_xor(ss, 4); ss += __shfl_xor(ss, 8);
                const float rstd = rsqrtf(ss * (1.f / 128.f) + EPS);
#pragma unroll
                for (int e = 0; e < 8; ++e) x[e] *= rstd * g[e];
                float y[8];
#pragma unroll
                for (int e = 0; e < 8; ++e) { const float pv = __shfl_xor(x[e], 2); y[e] = (cc < 2) ? x[e] * cs[e] - pv * sn[e] : ((cc < 4) ? x[e] * cs[e] + pv * sn[e] : x[e]); y[e] *= sc; }
                *(v4u*)(O + (size_t)t * 1536 + 8 * (lane + 64 * j)) = pack8(y);
            }
        }
    }
    if constexpr (KCAT > 4096) *(v2u*)(A.Ycat + (size_t)t * KCAT + 4096 + 8 * lane) = (v2u){0u, 0u};
#if !VD_DIRECT
#pragma unroll
    for (int j = 0; j < 3; ++j) *(v4u*)(A.Vd + (size_t)t * 1536 + 8 * (lane + 64 * j)) = R[10 + j];
#endif
    {
        const int cc = lane & 7;
        float cs[8], sn[8];
#pragma unroll
        for (int e = 0; e < 8; ++e) { cs[e] = tab[32 + e]; sn[e] = tab[40 + e]; }
#pragma unroll
        for (int j = 0; j < 4; ++j) {
            float x[8]; unpack8(R[13 + j], x);
            float y[8];
#pragma unroll
            for (int e = 0; e < 8; ++e) { const float pv = __shfl_xor(x[e], 1); y[e] = (cc == 0) ? x[e] * cs[e] - pv * sn[e] : ((cc == 1) ? x[e] * cs[e] + pv * sn[e] : x[e]); }
            *(v4u*)(A.Qi + (size_t)t * 2048 + 8 * (lane + 64 * j)) = pack8(y);
        }
        float x[8]; unpack8(R[17], x);
        float y[8];
#pragma unroll
        for (int e = 0; e < 8; ++e) { const float pv = __shfl_xor(x[e], 1); y[e] = (lane == 8) ? x[e] * cs[e] - pv * sn[e] : ((lane == 9) ? x[e] * cs[e] + pv * sn[e] : x[e]); }
        if (lane < 8) *(v4u*)(A.Kr + (size_t)t * 64 + 8 * lane) = pack8(x);
        else if (lane < 16) *(v4u*)(A.Ki + (size_t)t * 64 + 8 * (lane - 8)) = pack8(y);
        else if (lane < 20) { float* wo = A.Wi + (size_t)t * 32 + 8 * (lane - 16); *(f32x4*)wo = (f32x4){x[0], x[1], x[2], x[3]}; *(f32x4*)(wo + 4) = (f32x4){x[4], x[5], x[6], x[7]}; }
    }
    {
        const int cc = lane & 31;
        float g[8]; load8f_l(GL + 2304 + 8 * cc, g);
#pragma unroll
        for (int j = 0; j < 2; ++j) {
            float x[8]; unpack8(R[18 + j], x);
            float ss = sumsq8(x); ss += __shfl_xor(ss, 1); ss += __shfl_xor(ss, 2); ss += __shfl_xor(ss, 4); ss += __shfl_xor(ss, 8); ss += __shfl_xor(ss, 16);
            const float rstd = rsqrtf(ss * (1.f / 256.f) + EPS) * QS_MEM;
#pragma unroll
            for (int e = 0; e < 8; ++e) x[e] *= rstd * g[e];
            *(v4u*)(A.Qm + (size_t)t * 1024 + 8 * (lane + 64 * j)) = pack8(x);
        }
    }
    LDS_WAIT();
}
struct PP2 { const bf16 *QmlaRaw, *KVraw, *Kr, *MKVraw; const int* pos; const float *g_q, *g_k, *g_km; bf16 *Qmla, *Kmla, *MemK; };
DI void pp2_token(const PP2& A, int t, int lane, LAS float* tab) {
    const float pos = (float)A.pos[t];
    if (lane < 32) { float sn, cs; sincos_rev(pos * inv_freq(lane, 32), sn, cs); tab[lane] = cs; tab[32 + lane] = sn; }
    LDS_WAIT();
    const int sub = lane & 7, slot = lane >> 3;
    float cs[8], sn[8], gq[3][8], gk[3][8], kr[8];
#pragma unroll
    for (int e = 0; e < 8; ++e) { cs[e] = tab[8 * (sub & 3) + e]; sn[e] = tab[32 + 8 * (sub & 3) + e]; }
#pragma unroll
    for (int j = 0; j < 3; ++j) { load8f(A.g_q + 64 * j + 8 * sub, gq[j]); load8f(A.g_k + 64 * j + 8 * sub, gk[j]); }
    unpack8(*(const v4u*)(A.Kr + (size_t)t * 64 + 8 * sub), kr);
#pragma unroll 1
    for (int pass = 0; pass < 2; ++pass) {
        const int h = 8 * pass + slot; const bool on = h < 12; const int hh = on ? h : 0;
#pragma unroll
        for (int qk = 0; qk < 2; ++qk) {
            float x[3][8];
            if (qk == 0) { const bf16* q = A.QmlaRaw + (size_t)t * 2304 + hh * 192;
#pragma unroll
                for (int j = 0; j < 3; ++j) unpack8(*(const v4u*)(q + 64 * j + 8 * sub), x[j]); }
            else { const bf16* kv = A.KVraw + (size_t)t * 3072 + hh * 256;
#pragma unroll
                for (int e = 0; e < 8; ++e) x[0][e] = kr[e];
                unpack8(*(const v4u*)(kv + 8 * sub), x[1]); unpack8(*(const v4u*)(kv + 64 + 8 * sub), x[2]); }
            float ss = sumsq8(x[0]) + sumsq8(x[1]) + sumsq8(x[2]); ss += __shfl_xor(ss, 1); ss += __shfl_xor(ss, 2); ss += __shfl_xor(ss, 4);
            const float rstd = rsqrtf(ss * (1.f / 192.f) + EPS), sc = qk ? 1.0f : QS_MLA;
#pragma unroll
            for (int j = 0; j < 3; ++j)
#pragma unroll
                for (int e = 0; e < 8; ++e) x[j][e] *= rstd * (qk ? gk[j][e] : gq[j][e]);
            float y[8];
#pragma unroll
            for (int e = 0; e < 8; ++e) { const float pv = __shfl_xor(x[0][e], 4); y[e] = ((sub < 4) ? x[0][e] * cs[e] - pv * sn[e] : x[0][e] * cs[e] + pv * sn[e]) * sc; }
#pragma unroll
            for (int e = 0; e < 8; ++e) { x[1][e] *= sc; x[2][e] *= sc; }
            if (on) { bf16* o = (qk ? A.Kmla : A.Qmla) + (size_t)t * 2304 + h * 192;
                *(v4u*)(o + 8 * sub) = pack8(y); *(v4u*)(o + 64 + 8 * sub) = pack8(x[1]); *(v4u*)(o + 128 + 8 * sub) = pack8(x[2]); }
        }
    }
    LDS_WAIT();
}
DI void pp2_memrow(const PP2& A, int r, int lane) {
#pragma unroll
    for (int h = 0; h < 4; ++h) {
        float x[4]; float ss = 0.f;
#pragma unroll
        for (int k = 0; k < 4; ++k) { x[k] = bf2f(A.MKVraw[(size_t)r * 2048 + h * 256 + lane + 64 * k]); ss += x[k] * x[k]; }
        const float rstd = rsqrtf(wave_sum(ss) * (1.f / 256.f) + EPS);
#pragma unroll
        for (int k = 0; k < 4; ++k) A.MemK[(size_t)r * 1024 + h * 256 + lane + 64 * k] = (bf16)f2bf(x[k] * rstd * A.g_km[lane + 64 * k]);
    }
}

#define MFMA32(a, b, c) __builtin_amdgcn_mfma_f32_32x32x16_bf16((a), (b), (c), 0, 0, 0)
DI float relu_asm(float x) { const int b = __float_as_int(x); return __int_as_float(b > 0 ? b : 0); }
DI float half_swap_sum(float v) { auto rr = __builtin_amdgcn_permlane32_swap(__float_as_uint(v), __float_as_uint(v), false, false); return __uint_as_float(rr[0]) + __uint_as_float(rr[1]); }
DI float half_swap_max(float v) { auto rr = __builtin_amdgcn_permlane32_swap(__float_as_uint(v), __float_as_uint(v), false, false); return fmaxf(__uint_as_float(rr[0]), __uint_as_float(rr[1])); }
DI size_t sc_block_off(int b, int bi) { return (size_t)b * SC_BATCH + (size_t)4096 * (size_t)(bi * (bi + 1) / 2); }
constexpr int IDX_KSTR = 144, IDX_TILE = 256 * IDX_KSTR;
DI void idx_item(int p, const bf16* Qi, const bf16* Ki, const float* Wi, float* Sc, LAS unsigned char* lds) {
    int tid_ = threadIdx.x; asm volatile("" : "+v"(tid_));
    const int tid = tid_, wave = __builtin_amdgcn_readfirstlane(tid >> 6), lane = tid & 63;
    const int b = p >> 7, r = p & 127, hs = r & 1, k = r >> 1, r32 = lane & 31, hi = lane >> 5;
    const int srow = tid >> 3, scc = tid & 7;
#pragma unroll 1
    for (int which = 0; which < 2; ++which) {
        const int bi = which ? 127 - k : k, ncol = (bi + 1) * 64, nT = (ncol + 255) >> 8;
        float* scb = Sc + sc_block_off(b, bi);
        const bf16* kbase = Ki + (size_t)(b * SEQ) * 64;
#pragma unroll 1
        for (int pass = 0; pass < 2; ++pass) {
            const int qa = 32 * hs + 4 * wave + 2 * pass, ta = b * SEQ + bi * 64 + qa;
            bf16x8 A0[4], A1[4]; f32x4 w0[4], w1[4];
#pragma unroll
            for (int d0 = 0; d0 < 4; ++d0) { A0[d0] = *(const bf16x8*)(Qi + (size_t)ta * 2048 + r32 * 64 + d0 * 16 + hi * 8); A1[d0] = *(const bf16x8*)(Qi + (size_t)(ta + 1) * 2048 + r32 * 64 + d0 * 16 + hi * 8); }
#pragma unroll
            for (int g = 0; g < 4; ++g) { w0[g] = *(const f32x4*)(Wi + (size_t)ta * 32 + 8 * g + 4 * hi); w1[g] = *(const f32x4*)(Wi + (size_t)(ta + 1) * 32 + 8 * g + 4 * hi); }
            float* o0 = scb + (size_t)qa * ncol + r32; float* o1 = o0 + ncol;
            v4u st[4];
#define IDX_GLOAD(T_) do { _Pragma("unroll") for (int i_ = 0; i_ < 4; ++i_) { const bf16* gp_ = kbase + (size_t)((T_) * 256 + srow + 64 * i_) * 64 + scc * 8; \
        asm volatile("global_load_dwordx4 %0, %1, off" : "=v"(st[i_]) : "v"(gp_) : "memory"); } } while (0)
#define IDX_LWRITE(buf_) do { _Pragma("unroll") for (int i_ = 0; i_ < 4; ++i_) *(LAS v4u*)(lds + (buf_) * IDX_TILE + (srow + 64 * i_) * IDX_KSTR + scc * 16) = st[i_]; } while (0)
#define IDX_LOADB(B, sub_) do { _Pragma("unroll") for (int d0_ = 0; d0_ < 4; ++d0_) B[d0_] = *(const LAS bf16x8*)(tb + ((sub_) * 32 + r32) * IDX_KSTR + d0_ * 32 + hi * 16); } while (0)
#define IDX_MMA(c0_, c1_, B) do { _Pragma("unroll") for (int i_ = 0; i_ < 16; ++i_) { c0_[i_] = 0.f; c1_[i_] = 0.f; } \
        _Pragma("unroll") for (int d0_ = 0; d0_ < 4; ++d0_) { c0_ = MFMA32(A0[d0_], B[d0_], c0_); c1_ = MFMA32(A1[d0_], B[d0_], c1_); } } while (0)
#define IDX_RELU(x_) relu_asm(x_)
#define IDX_EPI(c0_, c1_, col_) do { float s0_[4] = {0.f, 0.f, 0.f, 0.f}, s1_[4] = {0.f, 0.f, 0.f, 0.f};     \
        _Pragma("unroll") for (int i_ = 0; i_ < 16; ++i_) { s0_[i_ & 3] = fmaf(w0[i_ >> 2][i_ & 3], IDX_RELU(c0_[i_]), s0_[i_ & 3]); s1_[i_ & 3] = fmaf(w1[i_ >> 2][i_ & 3], IDX_RELU(c1_[i_]), s1_[i_ & 3]); } \
        float t0_ = (s0_[0] + s0_[1]) + (s0_[2] + s0_[3]), t1_ = (s1_[0] + s1_[1]) + (s1_[2] + s1_[3]); \
        t0_ = half_swap_sum(t0_); t1_ = half_swap_sum(t1_); if (hi == 0) { o0[(col_)] = t0_; o1[(col_)] = t1_; } } while (0)
            IDX_GLOAD(0); asm volatile("s_waitcnt vmcnt(0)" ::: "memory"); IDX_LWRITE(0);
            __syncthreads();
#pragma unroll 1
            for (int T = 0; T < nT; ++T) {
                if (T + 1 < nT) IDX_GLOAD(T + 1);
                const LAS unsigned char* tb = lds + (T & 1) * IDX_TILE;
                const int nsub = min(8, (ncol - T * 256) >> 5);
                bf16x8 BA[4], BB[4]; f32x16 cA0, cA1, cB0, cB1;
                IDX_LOADB(BA, 0); IDX_LOADB(BB, 1);
                IDX_MMA(cA0, cA1, BA);
#pragma unroll 1
                for (int sub = 0; sub < nsub; sub += 2) {
                    const bool more = sub + 2 < nsub;
                    IDX_MMA(cB0, cB1, BB);
                    if (more) IDX_LOADB(BA, sub + 2);
                    IDX_EPI(cA0, cA1, T * 256 + sub * 32);
                    if (more) { IDX_MMA(cA0, cA1, BA); IDX_LOADB(BB, sub + 3); }
                    IDX_EPI(cB0, cB1, T * 256 + sub * 32 + 32);
                }
                if (T + 1 < nT) { if (nsub == 8) asm volatile("s_waitcnt vmcnt(16)" ::: "memory"); else asm volatile("s_waitcnt vmcnt(0)" ::: "memory");
                    IDX_LWRITE((T + 1) & 1); }
                __syncthreads();
            }
#undef IDX_GLOAD
#undef IDX_LWRITE
#undef IDX_LOADB
#undef IDX_MMA
#undef IDX_EPI
#undef IDX_RELU
        }
    }
}
DI int suffix_scan64(int v, int lane) {
#pragma unroll
    for (int o = 1; o < 64; o <<= 1) { const int tv = __shfl_down(v, o); if (lane + o < 64) v += tv; }
    return v;
}
template <int NBITS, bool FIRST>
DI int radix_pass(const unsigned (&key)[128], int NG, int shift, unsigned& prefix, int& remaining, LAS unsigned* hist, int lane, unsigned floor_key = 0u) {
    constexpr int NB = 1 << NBITS, PER = NB / 64;
#pragma unroll
    for (int q = 0; q < PER / 4; ++q) *(LAS v4u*)(hist + PER * lane + 4 * q) = (v4u){0u, 0u, 0u, 0u};
#pragma unroll
    for (int g = 0; g < 8; ++g) {
        if (g < NG) {
#pragma unroll
            for (int r = 0; r < 16; ++r) { const unsigned k = key[16 * g + r];
                const unsigned dg = (k >> shift) & (unsigned)(NB - 1);
                if (FIRST) { if (k >= floor_key) __hip_atomic_fetch_add(hist + dg, 1u, __ATOMIC_RELAXED, __HIP_MEMORY_SCOPE_WORKGROUP); }
                else if ((k >> (shift + NBITS)) == prefix) __hip_atomic_fetch_add(hist + dg, 1u, __ATOMIC_RELAXED, __HIP_MEMORY_SCOPE_WORKGROUP); }
        }
    }
    LDS_WAIT();
    int lane_sum = 0;
#pragma unroll
    for (int q = 0; q < PER / 4; ++q) { const v4u bb = *(LAS v4u*)(hist + PER * lane + 4 * q); lane_sum += (int)(bb.x + bb.y + bb.z + bb.w); }
    const int S = suffix_scan64(lane_sum, lane), above = S - lane_sum;
    const int src = __builtin_amdgcn_readfirstlane((int)__ffsll((long long)__ballot((above < remaining) && (remaining <= S))) - 1) & 63;
    const int rem2 = remaining - __builtin_amdgcn_readlane(above, src);
    const int bv = (lane < PER) ? (int)hist[PER * src + lane] : 0;
    const int S2 = suffix_scan64(bv, lane), above2 = S2 - bv;
    const int src2 = __builtin_amdgcn_readfirstlane((int)__ffsll((long long)__ballot((above2 < rem2) && (rem2 <= S2))) - 1) & 63;
    prefix = (prefix << NBITS) | (unsigned)(PER * src + src2);
    remaining = rem2 - __builtin_amdgcn_readlane(above2, src2);
    const int cnt = __builtin_amdgcn_readlane(bv, src2);
    LDS_WAIT();
    return cnt;
}
DI void select_row(const float* Sc, unsigned long long* BM64, int t, int lane, LAS unsigned* hist, LAS unsigned long long* scr) {
    const int b = t / SEQ, s = t % SEQ, bi = s >> 6, n = (bi + 1) * 64;
    const float* row = Sc + sc_block_off(b, bi) + (size_t)(s & 63) * n;
    unsigned long long* out = BM64 + (size_t)t * 128;
    if (n <= 256) {
        out[lane] = (lane < n / 64) ? ~0ull : 0ull; out[64 + lane] = 0ull; return;
    }
    const int NG = (n + 1023) >> 10;
    unsigned key[128];
#pragma unroll
    for (int g = 0; g < 8; ++g) {
        if (g < NG) {
#pragma unroll
            for (int r = 0; r < 16; ++r) key[16 * g + r] = __float_as_uint(row[64 * (16 * g + r) + lane]);
        } else {
#pragma unroll
            for (int r = 0; r < 16; ++r) key[16 * g + r] = 0u;
        }
    }
#pragma unroll
    for (int g = 0; g < 8; ++g) {
        if (g < NG) {
#pragma unroll
            for (int r = 0; r < 16; ++r) { const int i = 16 * g + r; const unsigned u = key[i]; const unsigned kk = (u & 0x80000000u) ? ~u : (u | 0x80000000u); key[i] = (64 * i < n) ? kk : 0u; }
        }
    }
    unsigned cm0 = 0u, cm1 = 0u, cm2 = 0u, cm3 = 0u;
#pragma unroll
    for (int g = 0; g < 8; ++g) {
        if (g < NG) {
#pragma unroll
            for (int r = 0; r < 16; r += 4) { cm0 = max(cm0, key[16 * g + r]); cm1 = max(cm1, key[16 * g + r + 1]); cm2 = max(cm2, key[16 * g + r + 2]); cm3 = max(cm3, key[16 * g + r + 3]); }
        }
    }
    unsigned floor_key = min(min(cm0, cm1), min(cm2, cm3));
#pragma unroll
    for (int o = 1; o < 64; o <<= 1) floor_key = min(floor_key, (unsigned)__shfl_xor((int)floor_key, o));
    unsigned prefix = 0u; int remaining = 256;
    radix_pass<12, true>(key, NG, 20, prefix, remaining, hist, lane, floor_key);
    radix_pass<10, false>(key, NG, 10, prefix, remaining, hist, lane);
    const int cnt_eq = radix_pass<10, false>(key, NG, 0, prefix, remaining, hist, lane);
    const int need = remaining;
    if (cnt_eq == need) {
#pragma unroll
        for (int g = 0; g < 8; ++g) {
            if (g < NG) {
#pragma unroll
                for (int r = 0; r < 16; ++r) { const int i = 16 * g + r; const unsigned long long take = __ballot(key[i] >= prefix); if (lane == 0) scr[i] = take; }
            } else { if (lane < 16) scr[16 * g + lane] = 0ull; }
        }
    } else {
        int run = 0;
#pragma unroll
        for (int g = 0; g < 8; ++g) {
            if (g < NG) {
#pragma unroll
                for (int r = 0; r < 16; ++r) { const int i = 16 * g + r;
                    const bool gt = key[i] > prefix, eq = key[i] == prefix;
                    const unsigned long long eqb = __ballot(eq);
                    const int rank = run + (int)__builtin_amdgcn_mbcnt_hi((unsigned)(eqb >> 32), __builtin_amdgcn_mbcnt_lo((unsigned)eqb, 0u));
                    const unsigned long long take = __ballot(gt || (eq && rank < need));
                    run += __popcll(eqb);
                    if (lane == 0) scr[i] = take;
                    if ((r & 7) == 7) __builtin_amdgcn_sched_barrier(0); }
            } else { if (lane < 16) scr[16 * g + lane] = 0ull; }
        }
    }
    LDS_WAIT();
    const unsigned long long mine0 = scr[lane], mine1 = scr[64 + lane];
    out[lane] = mine0; out[64 + lane] = mine1;
    LDS_WAIT();
}
#ifndef ATT_LAZY
#define ATT_LAZY 2
#endif
#define ATT_TAU 8.0f
#ifndef ATT_PIPE
#define ATT_PIPE 1
#define ATT_PD 3
#endif
typedef short v4i16_t __attribute__((ext_vector_type(4)));
DI s16x4 vtr(const LAS unsigned char* p) { return __builtin_bit_cast(s16x4, __builtin_amdgcn_ds_read_tr16_b64_v4i16((LAS v4i16_t*)p)); }
DI unsigned cvtpk(float lo, float hi) { unsigned r; asm volatile("v_cvt_pk_bf16_f32 %0, %1, %2" : "=v"(r) : "v"(lo), "v"(hi)); return r; }
constexpr int VSTR = 320;
template <int DK> struct AttnLds { static constexpr int KSTR = DK * 2 + 16, KB = 64 * KSTR, VB = 64 * VSTR, K0 = 0, V0 = 2 * KB, TOTAL = 2 * KB + 2 * VB; };
static_assert(AttnLds<256>::TOTAL <= RING_BYTES, "attention LDS");

template <int DK, int MODE>
DI void attn_unit(LAS unsigned char* lds, const bf16* Qp, int LDQ, const bf16* Kp, int LDK, const bf16* Vp, int LDV, unsigned char* Op, int LDO, int NT, int chunk0, const unsigned* BMrow) {
    typedef AttnLds<DK> L;
    constexpr int ND = DK / 16, KCH = DK / 8, NKC = DK / 64;
    int tid_ = threadIdx.x; asm volatile("" : "+v"(tid_));
    const int tid = tid_, wid = __builtin_amdgcn_readfirstlane(tid >> 6), lane = tid & 63, r32 = lane & 31, hi = lane >> 5;
    const int mychunk = chunk0 + (wid >> 1);
    constexpr bool QLOOP = (DK > 192);
    bf16x8 qr[ND];
    const bf16* qw = Qp + (size_t)(wid * 32 + r32) * LDQ + hi * 8;
    if (!QLOOP) {
#pragma unroll
        for (int d0 = 0; d0 < ND; ++d0) qr[d0] = *(const bf16x8*)(qw + d0 * 16); }
    const unsigned* bmw = (MODE == 1) ? BMrow + (size_t)(wid * 32 + r32) * 256 : nullptr;
    int krow_[NKC], kcc_[NKC];
#pragma unroll
    for (int i = 0; i < NKC; ++i) { const int c = tid + 512 * i; krow_[i] = c / KCH; kcc_[i] = c % KCH; }
    const int vrow0 = tid >> 4, vcc = tid & 15;
    v4u kst[NKC], vst[2];
#define ATT_LOAD(j) do { const int key0_ = (j) * 64; \
        _Pragma("unroll") for (int i_ = 0; i_ < NKC; ++i_) kst[i_] = *(const v4u*)(Kp + (size_t)(key0_ + krow_[i_]) * LDK + kcc_[i_] * 8); \
        vst[0] = *(const v4u*)(Vp + (size_t)(key0_ + vrow0) * LDV + vcc * 8); vst[1] = *(const v4u*)(Vp + (size_t)(key0_ + 32 + vrow0) * LDV + vcc * 8); } while (0)
#define ATT_WRITE(buf) do { \
        _Pragma("unroll") for (int i_ = 0; i_ < NKC; ++i_) *(LAS v4u*)(lds + L::K0 + (buf) * L::KB + krow_[i_] * L::KSTR + kcc_[i_] * 16) = kst[i_]; \
        *(LAS v4u*)(lds + L::V0 + (buf) * L::VB + vrow0 * VSTR + vcc * 16) = vst[0]; *(LAS v4u*)(lds + L::V0 + (buf) * L::VB + (32 + vrow0) * VSTR + vcc * 16) = vst[1]; } while (0)
    float m_run = -1e30f, l_run = 0.f;
#if ATT_LAZY == 2
    float base = 0.f; f32x16 nbv;
#pragma unroll
    for (int i = 0; i < 16; ++i) nbv[i] = 0.f;
#endif
    f32x16 o[4];
#pragma unroll
    for (int d = 0; d < 4; ++d)
#pragma unroll
        for (int i = 0; i < 16; ++i) o[d][i] = 0.f;
    const int kbase = r32 * L::KSTR + hi * 16;
    const int q4 = (lane >> 2) & 3, p4 = lane & 3, blk = (lane >> 4) & 1;
    const int vbase = (4 * hi + q4) * VSTR + blk * 32 + p4 * 8;
    v2u mmn = {0xffffffffu, 0xffffffffu};
    if (MODE == 1) mmn = *(const v2u*)bmw;
    ATT_LOAD(0); ATT_WRITE(0);
    if (!QLOOP) {
#pragma unroll
        for (int d0 = 0; d0 < ND; ++d0) asm volatile("" :: "v"(qr[d0])); }
    __syncthreads();
#pragma unroll 1
    for (int j = 0; j < NT; ++j) {
        const int cur = j & 1;
        const bool active = (MODE == 2) || (j <= mychunk);
        const v2u mm = mmn;
        if (MODE == 1) { if (j + 1 < NT) mmn = *(const v2u*)(bmw + 2 * (j + 1)); }
        if (j + 1 < NT) ATT_LOAD(j + 1);
        const unsigned mw0 = mm.x >> (4 * hi), mw1 = mm.y >> (4 * hi);
        if (active) {
            f32x16 p0, p1;
#if ATT_LAZY != 2
#pragma unroll
            for (int i = 0; i < 16; ++i) { p0[i] = 0.f; p1[i] = 0.f; }
#endif
            const LAS unsigned char* kb = lds + L::K0 + cur * L::KB + kbase;
            const bf16* qwl = qw; if (QLOOP) asm volatile("" : "+v"(qwl));
#if ATT_PIPE
            constexpr int NS = 2 * ND;
            bf16x8 kf[ATT_PD + 1];
#define ATT_KLD(n_) (*(const LAS bf16x8*)(kb + ((n_) & 1) * 32 * L::KSTR + ((n_) >> 1) * 32))
#pragma unroll
            for (int n = 0; n < ATT_PD; ++n) kf[n] = ATT_KLD(n);
            __builtin_amdgcn_sched_barrier(0);
            bf16x8 qf = qr[0];
#pragma unroll
            for (int n = 0; n < NS; ++n) {
                if (n + ATT_PD < NS) kf[(n + ATT_PD) % (ATT_PD + 1)] = ATT_KLD(n + ATT_PD);
                if ((n & 1) == 0) qf = QLOOP ? *(const bf16x8*)(qwl + (n >> 1) * 16) : qr[n >> 1];
#if ATT_LAZY == 2
                if (n == 0) p0 = MFMA32(kf[0], qf, nbv); else if (n == 1) p1 = MFMA32(kf[1], qf, nbv); else
#endif
                if (n & 1) p1 = MFMA32(kf[n % (ATT_PD + 1)], qf, p1); else p0 = MFMA32(kf[n % (ATT_PD + 1)], qf, p0);
                __builtin_amdgcn_sched_barrier(0);
            }
#undef ATT_KLD
            const LAS unsigned char* vb = lds + L::V0 + cur * L::VB + vbase;
            s16x4 vlo[ATT_PD + 1], vhi[ATT_PD + 1];
#define ATT_VLD(n_) do { vlo[(n_) % (ATT_PD + 1)] = vtr(vb + (16 * ((n_) >> 2)) * VSTR + ((n_) & 3) * 64); vhi[(n_) % (ATT_PD + 1)] = vtr(vb + (16 * ((n_) >> 2) + 8) * VSTR + ((n_) & 3) * 64); } while (0)
#pragma unroll
            for (int n = 0; n < ATT_PD; ++n) ATT_VLD(n);
            __builtin_amdgcn_sched_barrier(0);
#else
#pragma unroll
            for (int d0 = 0; d0 < ND; ++d0) {
                const bf16x8 a0 = *(const LAS bf16x8*)(kb + d0 * 32), a1 = *(const LAS bf16x8*)(kb + 32 * L::KSTR + d0 * 32);
                const bf16x8 qf = QLOOP ? *(const bf16x8*)(qwl + d0 * 16) : qr[d0];
#if ATT_LAZY == 2
                if (d0 == 0) { p0 = MFMA32(a0, qf, nbv); p1 = MFMA32(a1, qf, nbv); } else { p0 = MFMA32(a0, qf, p0); p1 = MFMA32(a1, qf, p1); }
#else
                p0 = MFMA32(a0, qf, p0); p1 = MFMA32(a1, qf, p1);
#endif
                if ((d0 & 3) == 3) __builtin_amdgcn_sched_barrier(0);
            }
#endif
            if (MODE == 1) {
#pragma unroll
                for (int i = 0; i < 16; ++i) { const unsigned bit = 1u << ((i & 3) + 8 * (i >> 2));
                    p0[i] = (mw0 & bit) ? p0[i] : -INFINITY; p1[i] = (mw1 & bit) ? p1[i] : -INFINITY; }
            }
            float tmax = p0[0];
#pragma unroll
            for (int i = 1; i < 16; ++i) tmax = fmaxf(tmax, p0[i]);
#pragma unroll
            for (int i = 0; i < 16; ++i) tmax = fmaxf(tmax, p1[i]);
            tmax = half_swap_max(tmax);
#if ATT_LAZY == 0
            const float m_new = fmaxf(m_run, tmax), alpha = __builtin_amdgcn_exp2f(m_run - m_new);
            m_run = m_new;
            float ps = 0.f;
#pragma unroll
            for (int i = 0; i < 16; ++i) { p0[i] = __builtin_amdgcn_exp2f(p0[i] - m_new); ps += p0[i]; }
#pragma unroll
            for (int i = 0; i < 16; ++i) { p1[i] = __builtin_amdgcn_exp2f(p1[i] - m_new); ps += p1[i]; }
            ps = half_swap_sum(ps);
            l_run = l_run * alpha + ps;
            if (__any(alpha < 1.0f)) {
#pragma unroll
                for (int d = 0; d < 4; ++d)
#pragma unroll
                    for (int i = 0; i < 16; ++i) o[d][i] *= alpha;
            }
#elif ATT_LAZY == 1
            if (__any(tmax > m_run + ATT_TAU)) {
                const float m_new = fmaxf(m_run, tmax), alpha = __builtin_amdgcn_exp2f(m_run - m_new);
                m_run = m_new; l_run *= alpha;
#pragma unroll
                for (int d = 0; d < 4; ++d)
#pragma unroll
                    for (int i = 0; i < 16; ++i) o[d][i] *= alpha;
            }
            float ps = 0.f;
#pragma unroll
            for (int i = 0; i < 16; ++i) { p0[i] = __builtin_amdgcn_exp2f(p0[i] - m_run); ps += p0[i]; }
#pragma unroll
            for (int i = 0; i < 16; ++i) { p1[i] = __builtin_amdgcn_exp2f(p1[i] - m_run); ps += p1[i]; }
            ps = half_swap_sum(ps);
            l_run += ps;
#else
            if (__any(tmax + base > m_run + ATT_TAU)) {
                const float m_new = fmaxf(m_run, tmax + base), base_new = (m_new > -1e29f) ? m_new : 0.f, dlt = base_new - base, alpha = __builtin_amdgcn_exp2f(m_run - m_new);
#pragma unroll
                for (int i = 0; i < 16; ++i) { p0[i] -= dlt; p1[i] -= dlt; }
                m_run = m_new; base = base_new; l_run *= alpha;
#pragma unroll
                for (int i = 0; i < 16; ++i) nbv[i] = -base_new;
#pragma unroll
                for (int d = 0; d < 4; ++d)
#pragma unroll
                    for (int i = 0; i < 16; ++i) o[d][i] *= alpha;
            }
            float ps = 0.f;
#pragma unroll
            for (int i = 0; i < 16; ++i) { p0[i] = __builtin_amdgcn_exp2f(p0[i]); ps += p0[i]; }
#pragma unroll
            for (int i = 0; i < 16; ++i) { p1[i] = __builtin_amdgcn_exp2f(p1[i]); ps += p1[i]; }
            ps = half_swap_sum(ps);
            l_run += ps;
#endif
            bf16x8 pb[4];
#pragma unroll
            for (int s = 0; s < 4; ++s) { v4u w;
                if (s < 2) { w.x = cvtpk(p0[8 * s + 0], p0[8 * s + 1]); w.y = cvtpk(p0[8 * s + 2], p0[8 * s + 3]); w.z = cvtpk(p0[8 * s + 4], p0[8 * s + 5]); w.w = cvtpk(p0[8 * s + 6], p0[8 * s + 7]); }
                else { const int s2 = s - 2; w.x = cvtpk(p1[8 * s2 + 0], p1[8 * s2 + 1]); w.y = cvtpk(p1[8 * s2 + 2], p1[8 * s2 + 3]); w.z = cvtpk(p1[8 * s2 + 4], p1[8 * s2 + 5]); w.w = cvtpk(p1[8 * s2 + 6], p1[8 * s2 + 7]); }
                pb[s] = __builtin_bit_cast(bf16x8, w); }
#if ATT_PIPE
            __builtin_amdgcn_sched_barrier(0);
#pragma unroll
            for (int n = 0; n < 16; ++n) {
                if (n + ATT_PD < 16) ATT_VLD(n + ATT_PD);
                const s16x4 lo = vlo[n % (ATT_PD + 1)], hh = vhi[n % (ATT_PD + 1)];
                const bf16x8 va = (bf16x8){lo[0], lo[1], lo[2], lo[3], hh[0], hh[1], hh[2], hh[3]};
                o[n & 3] = MFMA32(va, pb[n >> 2], o[n & 3]);
                __builtin_amdgcn_sched_barrier(0);
            }
#undef ATT_VLD
#else
            const LAS unsigned char* vb = lds + L::V0 + cur * L::VB + vbase;
#pragma unroll
            for (int d0 = 0; d0 < 4; ++d0)
#pragma unroll
                for (int s = 0; s < 4; ++s) {
                    const s16x4 lo = vtr(vb + (16 * s) * VSTR + d0 * 64), hh = vtr(vb + (16 * s + 8) * VSTR + d0 * 64);
                    const bf16x8 va = (bf16x8){lo[0], lo[1], lo[2], lo[3], hh[0], hh[1], hh[2], hh[3]};
                    o[d0] = MFMA32(va, pb[s], o[d0]);
                    if (s == 3) __builtin_amdgcn_sched_barrier(0);
                }
#endif
        }
        if (j + 1 < NT) ATT_WRITE(cur ^ 1);
        __syncthreads();
    }
    const float rl = Y_SCALE / l_run;
    unsigned char* ow = Op + (size_t)(wid * 32 + r32) * LDO + 4 * hi;
#pragma unroll
    for (int d0 = 0; d0 < 4; ++d0)
#pragma unroll
        for (int g = 0; g < 4; ++g) *(unsigned*)(ow + 32 * d0 + 8 * g) = pack_fp8x4(o[d0][4 * g] * rl, o[d0][4 * g + 1] * rl, o[d0][4 * g + 2] * rl, o[d0][4 * g + 3] * rl);
#undef ATT_LOAD
#undef ATT_WRITE
}
#ifndef MK_MULTI
#define MK_MULTI 0
#endif
#ifndef DBG_SKIP_MIXER
#define DBG_SKIP_MIXER 0
#endif
#ifndef STAMP_A
#define STAMP_A -1
#define STAMP_B -1
#endif
#define CW_STAMP 12288
constexpr int NPH = 16;
#ifndef ATT_MASK
#define ATT_MASK 7
#endif
struct Args { const float* in[30]; float* out; unsigned char* ws; int ph_lo, ph_hi; };
static_assert(sizeof(Args) == 30 * 8 + 8 + 8 + 8, "no padding");

#ifndef FFN1_DOWN_FP8
#define FFN1_DOWN_FP8 0
#endif
#ifndef FFN2_DOWN_FP8
#define FFN2_DOWN_FP8 1
#define FFN2_F8_PANELS 64
#endif
#ifndef MEMKV_FP8
#define MEMKV_FP8 0
#endif
constexpr float WMKV_SCALE = 64.0f;
#ifndef FFN2_DOWN_CONV_IN_P14
#define FFN2_DOWN_CONV_IN_P14 1
#endif
#ifndef NO_X1
#define NO_X1 1
#endif
#define D1buf (NO_X1 ? (bf16*)XRES : Pbuf)
#ifndef X2_BF16
#define X2_BF16 1
#endif
#ifndef DEFER_FFN1_RESID
#define DEFER_FFN1_RESID 1
#endif
#ifndef DEFER_MIX_RESID
#define DEFER_MIX_RESID 1
#endif
#ifndef MEMKV_IN_P3
#define MEMKV_IN_P3 1
#endif
#ifndef FFN1_DOWN_CONV_IN_P1
#define FFN1_DOWN_CONV_IN_P1 1
#endif
#ifndef FFN2_CONV_IN_ATTN
#define FFN2_CONV_IN_ATTN 1
#endif
#ifndef FFN_UP_ALIGN
#define FFN_UP_ALIGN true
#endif
#ifndef FFN1_UP_I8
#define FFN1_UP_I8 true
#endif
#ifndef FFN2_UP_I8
#define FFN2_UP_I8 true
#endif
template <int F8, bool I8> DI void ffn_up_phase(LAS unsigned char* lds, const bf16* A, const bf16* WGUt, unsigned char* Hmid, int G, const float* rowscale, unsigned char* Hmid8 = nullptr) {
    pg8::Gemm g{A, WGUt, MTOK, NGU, I8 ? DM / 2 : DM}; pg8::StaticOrder S; S.init(MTOK, NGU, G, (int)blockIdx.x);
    pg8::EpiSwiGLU<F8, I8> E{Hmid, DFF, H_SCALE, rowscale, Hmid8, FFN2_F8_PANELS};
    pg8::gemm_phase<pg8::EpiSwiGLU<F8, I8>, pg8::StaticOrder, FFN_UP_ALIGN, true>(lds, g, S, E);
}
template <int F8> DI void ffn_down_phase(LAS unsigned char* lds, const unsigned char* Hmid, const unsigned char* WDt, const float* base, float* out, int G,
                                         const unsigned char* Hmid8 = nullptr, const unsigned char* WDt8 = nullptr, const bf16* addend = nullptr, bf16* defer = nullptr) {
    if constexpr (F8 == 1) {
        pg8::Gemm g{(const bf16*)Hmid, (const bf16*)WDt, MTOK, DM, DFF / 2}; pg8::StaticOrder S; S.init(MTOK, DM, G, (int)blockIdx.x);
        if (addend && !base) { pg8::EpiResid8B E{addend, out, DM, 0.5f / (H_SCALE * WD_SCALE)};
            pg8::gemm_phase<pg8::EpiResid8B, pg8::StaticOrder, true, true>(lds, g, S, E); }
        else if (addend) { pg8::EpiResid8A E{base, addend, out, DM, 0.5f / (H_SCALE * WD_SCALE)};
            pg8::gemm_phase<pg8::EpiResid8A, pg8::StaticOrder, true, true>(lds, g, S, E); }
        else { pg8::EpiResid8 E{base, out, DM, 0.5f / (H_SCALE * WD_SCALE)};
            pg8::gemm_phase<pg8::EpiResid8, pg8::StaticOrder, true, true>(lds, g, S, E); }
    } else if constexpr (F8 == 2) {
        constexpr int MS = FFN2_F8_PANELS * 256;
        { pg8::Gemm g{(const bf16*)Hmid8, (const bf16*)WDt8, MS, DM, DFF / 2}; pg8::StaticOrder S; S.init(MS, DM, G, (int)blockIdx.x);
          pg8::EpiResid8 E{base, out, DM, 0.5f / (H_SCALE * WD_SCALE)};
          pg8::gemm_phase<pg8::EpiResid8, pg8::StaticOrder, true, true>(lds, g, S, E); }
        { pg8::Gemm g{(const bf16*)Hmid + (size_t)MS * DFF, (const bf16*)WDt, MTOK - MS, DM, DFF}; pg8::StaticOrder S; S.init(MTOK - MS, DM, G, (int)blockIdx.x);
          pg8::EpiResid E{base + (size_t)MS * DM, out + (size_t)MS * DM, DM, 0.5f};
          pg8::gemm_phase<pg8::EpiResid, pg8::StaticOrder, true, true>(lds, g, S, E); }
    } else {
        pg8::Gemm g{(const bf16*)Hmid, (const bf16*)WDt, MTOK, DM, DFF}; pg8::StaticOrder S; S.init(MTOK, DM, G, (int)blockIdx.x);
        if (defer) { pg8::EpiPlain E{defer, DM};
            pg8::gemm_phase<pg8::EpiPlain, pg8::StaticOrder, true, true>(lds, g, S, E); }
        else { pg8::EpiResid E{base, out, DM, 0.5f};
            pg8::gemm_phase<pg8::EpiResid, pg8::StaticOrder, true, true>(lds, g, S, E); }
    }
}

__global__ void __launch_bounds__(NWAVES * 64, 2) mega_fwd(Args args) {
    extern __shared__ __attribute__((aligned(16))) unsigned char lds_raw[];
    LAS unsigned char* lds = (LAS unsigned char*)lds_raw;
    const int GRID = gridDim.x;
    const __attribute__((address_space(4))) unsigned char* ka = (const __attribute__((address_space(4))) unsigned char*)__builtin_amdgcn_kernarg_segment_ptr();
#define ARGQ(k) (*(void* const __attribute__((address_space(4)))*)(ka + 8 * (k)))
#define ARGP(k) ((const float*)ARGQ(k))
    unsigned char* ws = (unsigned char*)ARGQ(31);
    unsigned* ctl = (unsigned*)(ws + WS_CTL);
    volatile LAS unsigned* MISC = (volatile LAS unsigned*)(lds + MISC_OFF);
    for (int u = threadIdx.x; u < (LDS_BYTES - MISC_OFF) / 4; u += NWAVES * 64) ((LAS unsigned*)(lds + MISC_OFF))[u] = 0u;
    __syncthreads();
    const int lo = *(const __attribute__((address_space(4))) int*)(ka + 256), hi = *(const __attribute__((address_space(4))) int*)(ka + 260);
    XcdBarrier bar; bar.bar = ctl + CW_BAR; bar.x = 0; bar.st = nullptr;
    if (hi - lo > 1) bar = xcd_barrier_post(ctl + CW_BAR, MISC);
#ifndef PH_MASK
#define PH_MASK 0xffff
#endif
#define IN(k) ((((PH_MASK) >> (k)) & 1) && lo <= (k) && (k) < hi)
    if (STAMP_A >= 0 && blockIdx.x == 0 && threadIdx.x == 0) ctl[CW_STAMP] = (unsigned)__builtin_amdgcn_s_memrealtime();
#define SEAM(k) do { if (IN(k) && IN((k) + 1)) xcd_barrier(bar); if (STAMP_A >= 0 && blockIdx.x == 0 && threadIdx.x == 0) ctl[CW_STAMP + 2 * ((k) + 1)] = (unsigned)__builtin_amdgcn_s_memrealtime(); } while (0)
#ifndef REPEAT_MASK
#define REPEAT_MASK 0
#endif
#ifndef STAGGER_US
#define STAGGER_US 0
#define STAGGER_SHIFT 6
#endif
#define STAGGER() do { const unsigned sg_ = (blockIdx.x >> STAGGER_SHIFT) & 3u; if (STAGGER_US > 0 && sg_) { const unsigned long long t0_ = __builtin_amdgcn_s_memrealtime(); \
        while (__builtin_amdgcn_s_memrealtime() - t0_ < (unsigned long long)(sg_ * STAGGER_US * 100u)) __builtin_amdgcn_s_sleep(8); } } while (0)
#define NREP(k) (1 + (((REPEAT_MASK) >> (k)) & 1))
#define REPBAR(k) do { if (((REPEAT_MASK) >> (k)) & 1) xcd_barrier(bar); } while (0)

#define WGUt ((bf16*)(ws + WS_WGU))
#define WDt ((unsigned char*)(ws + WS_WD))
#define WINt ((unsigned char*)(ws + WS_WIN))
#define WINIt ((bf16*)(ws + WS_WINI))
#define WG8t ((unsigned char*)(ws + WS_WG8))
#define Hn8 ((unsigned char*)(ws + WS_HN8))
#define WUQt ((unsigned char*)(ws + WS_WUQ))
#define WUKVt ((unsigned char*)(ws + WS_WUKV))
#define WMKVt ((bf16*)(ws + WS_WMKV))
#define WOCATt ((unsigned char*)(ws + WS_WOCAT))
#define WOUTt ((unsigned char*)(ws + WS_WOUT))
#define Abuf ((bf16*)(ws + WS_A))
#define Hmid ((unsigned char*)(ws + WS_HMID))
#if GATES_U8
#define Gt ((unsigned char*)(ws + WS_G))
#else
#define Gt ((bf16*)(ws + WS_G))
#endif
#define Pbuf ((bf16*)(ws + WS_P))
#define QmlaRaw ((bf16*)(ws + WS_QMLARAW))
#define KVraw ((bf16*)(ws + WS_KVRAW))
#define Qmla ((bf16*)(ws + WS_QMLA))
#define Kmla ((bf16*)(ws + WS_KMLA))
#define CQn ((unsigned char*)(ws + WS_CQN))
#define CKVn ((unsigned char*)(ws + WS_CKVN))
#define Qd ((bf16*)(ws + WS_QD))
#define Kd ((bf16*)(ws + WS_KD))
#define Vd ((bf16*)(ws + WS_VD))
#define Qi ((bf16*)(ws + WS_QI))
#define Ki ((bf16*)(ws + WS_KI))
#define Wi ((float*)(ws + WS_WI))
#define Kr ((bf16*)(ws + WS_KR))
#define Qm ((bf16*)(ws + WS_QM))
#define Ycat ((unsigned char*)(ws + WS_YCAT))
#define BM ((unsigned*)(ws + WS_BM))
#define memn ((bf16*)(ws + WS_MEMN))
#define MKVraw ((bf16*)(ws + WS_MKVRAW))
#define MemK ((bf16*)(ws + WS_MEMK))
#define Sc ((float*)(ws + WS_SC))
#define X_IN (ARGP(0))
#define MEM_IN (ARGP(1))
#define POS_IN ((const int*)ARGP(2))
#define XRES ((float*)ARGQ(30))
    _Pragma("unroll") for (int rep_ = 0; rep_ < NREP(0); ++rep_) { if (rep_) REPBAR(0); if (IN(0)) { const Ctx C = make_ctx(lds);
#if FFN1_DOWN_CONV_IN_P1
        conv_ffn<FFN1_DOWN_FP8, FFN1_UP_I8>(C, ARGP(4), ARGP(5), ARGP(6), WGUt, WDt, nullptr, C.gw, (DM / 64) * (NGU / 32), C.NGW);
#else
        conv_ffn<FFN1_DOWN_FP8, FFN1_UP_I8>(C, ARGP(4), ARGP(5), ARGP(6), WGUt, WDt);
#endif
#if !DBG_SKIP_MIXER
        conv_win(C, ARGP(8), ARGP(24), WINt, WINIt, WG8t);
        int dummy = 0;
        conv_plain8(C, ARGP(10), 1536, 2304, WUQt, WUQ_SCALE);
        conv_plain8(C, ARGP(12), 512, 3072, WUKVt, WUKV_SCALE);
#if MEMKV_FP8
        conv_plain8(C, ARGP(18), 4096, 2048, (unsigned char*)WMKVt, WMKV_SCALE);
#else
        conv_plain(C, ARGP(18), 4096, 2048, WMKVt, dummy, 0);
#endif
#if !FFN2_CONV_IN_ATTN
        conv_wocat(C, ARGP(21), ARGP(22), ARGP(23), WOCATt);
        conv_plain8(C, ARGP(25), 4096, 4096, WOUTt, WOUT_SCALE);
#endif
#if MEMKV_FP8
        rms_rows_dual(C, MEM_IN, ARGP(17), memn, ws + WS_WMKV + 8 * MiB, MROWS);
#else
        rms_rows(C, MEM_IN, ARGP(17), memn, MROWS);
#endif
#endif
        if (FFN1_UP_I8) rms_rows_i8(C, X_IN, ARGP(3), (unsigned char*)Abuf, (float*)(ws + WS_RS1), WGU_I8_SCALE, MTOK);
        else rms_rows(C, X_IN, ARGP(3), Abuf, MTOK);
    }
    }
    SEAM(0);
    _Pragma("unroll") for (int rep_ = 0; rep_ < NREP(1); ++rep_) { if (rep_) REPBAR(1); if (IN(1)) { ffn_up_phase<FFN1_DOWN_FP8, FFN1_UP_I8>(lds, Abuf, WGUt, Hmid, GRID, (const float*)(ws + WS_RS1));
#if FFN1_DOWN_CONV_IN_P1
        constexpr int CW0 = MEMKV_IN_P3 ? 128 : 144;
        if ((int)blockIdx.x >= CW0) { const Ctx C = make_ctx(lds); __syncthreads();
            conv_ffn<FFN1_DOWN_FP8, FFN1_UP_I8>(C, ARGP(4), ARGP(5), ARGP(6), WGUt, WDt, nullptr, (DM / 64) * (NGU / 32) + ((int)blockIdx.x - CW0) * 8 + C.wave, CONV_FFN_ITEMS, (256 - CW0) * 8); __syncthreads(); }
#endif
#if MEMKV_IN_P3
        }
#elif MEMKV_FP8
        { pg8::Gemm g{(const bf16*)(ws + WS_WMKV + 8 * MiB), WMKVt, MROWS, 2048, DM / 2}; pg8::StaticOrder S; S.init(MROWS, 2048, GRID, (int)((blockIdx.x + 128u) % (unsigned)GRID)); pg8::EpiPlain8 E{MKVraw, 2048, 1.0f / WMKV_SCALE};
          pg8::gemm_phase<pg8::EpiPlain8, pg8::StaticOrder, true, true>(lds, g, S, E); } }
#else
        { pg8::Gemm g{memn, WMKVt, MROWS, 2048, DM}; pg8::StaticOrder S; S.init(MROWS, 2048, GRID, (int)((blockIdx.x + 128u) % (unsigned)GRID)); pg8::EpiPlain E{MKVraw, 2048};
          pg8::gemm_phase<pg8::EpiPlain, pg8::StaticOrder, true, true>(lds, g, S, E); } }
#endif
    }
    SEAM(1);
    _Pragma("unroll") for (int rep_ = 0; rep_ < NREP(2); ++rep_) { if (rep_) REPBAR(2); if (IN(2)) ffn_down_phase<FFN1_DOWN_FP8>(lds, Hmid, WDt, X_IN, XRES, GRID, nullptr, nullptr, nullptr, DEFER_FFN1_RESID ? D1buf : nullptr);
    }
    SEAM(2);
#if !DBG_SKIP_MIXER
#if MEMKV_IN_P3
    if (IN(3)) { if (blockIdx.x < 16) { pg8::Gemm g{memn, WMKVt, MROWS, 2048, DM}; pg8::StaticOrder S; S.init(MROWS, 2048, GRID, (int)blockIdx.x); pg8::EpiPlain E{MKVraw, 2048};
                                        pg8::gemm_phase<pg8::EpiPlain, pg8::StaticOrder, true, true>(lds, g, S, E); }
                 else { Ctx C = make_ctx(lds); C.gw -= 16 * 8; C.NGW -= 16 * 8;
                        if (DEFER_FFN1_RESID) rms_rows_dual_add(C, X_IN, D1buf, 0.5f, NO_X1 ? nullptr : XRES, ARGP(7), Abuf, Hn8, MTOK);
                        else rms_rows_dual(C, XRES, ARGP(7), Abuf, Hn8, MTOK); } }
#else
    if (IN(3)) { const Ctx C = make_ctx(lds); rms_rows_dual(C, XRES, ARGP(7), Abuf, Hn8, MTOK); }
#endif
    SEAM(3);
    _Pragma("unroll") for (int rep_ = 0; rep_ < NREP(4); ++rep_) { if (rep_) REPBAR(4); if (IN(4)) {
#if VD_DIRECT
        { pg8::Gemm g{(const bf16*)Hn8, (const bf16*)WINt, MTOK, NF8, DM / 2}; pg8::StaticOrder S; S.init(MTOK, NF8, GRID, (int)blockIdx.x);
          static_assert(PC_VD % 256 == 0 && PC_QM == PC_VD + 1536, "v_d block = whole column tiles");
          pg8::EpiPlain8R E{Pbuf, NPC, 1.0f / WIN_SCALE, Vd, 1536, PC_VD / 256, PC_QM / 256};
          pg8::gemm_phase<pg8::EpiPlain8R, pg8::StaticOrder, true, true>(lds, g, S, E); }
#else
        { pg8::Gemm g{(const bf16*)Hn8, (const bf16*)WINt, MTOK, NF8, DM / 2}; pg8::StaticOrder S; S.init(MTOK, NF8, GRID, (int)blockIdx.x); pg8::EpiPlain8 E{Pbuf, NPC, 1.0f / WIN_SCALE};
          pg8::gemm_phase<pg8::EpiPlain8, pg8::StaticOrder, true, true>(lds, g, S, E); }
#endif
        { pg8::Gemm g{Abuf, WINIt, MTOK, NIDX, DM}; pg8::StaticOrder S; S.init(MTOK, NIDX, GRID, (int)((blockIdx.x + 192u) % (unsigned)GRID)); pg8::EpiPlain E{Pbuf + NF8, NPC};
          pg8::gemm_phase<pg8::EpiPlain, pg8::StaticOrder, true, true>(lds, g, S, E); }
        { pg8::Gemm g{(const bf16*)Hn8, (const bf16*)WG8t, MTOK, NGC, DM / 2}; pg8::StaticOrder S; S.init(MTOK, NGC, GRID, (int)blockIdx.x); pg8::EpiGates8 E{Gt, NGC, 1.0f / WG_SCALE};
          pg8::gemm_phase<pg8::EpiGates8, pg8::StaticOrder, true, true>(lds, g, S, E); }
    }
    }
    SEAM(4);
    _Pragma("unroll") for (int rep_ = 0; rep_ < NREP(5); ++rep_) { if (rep_) REPBAR(5); if (IN(5)) { const Ctx C = make_ctx(lds);
        PP1 A{Pbuf, POS_IN, ARGP(9), ARGP(11), ARGP(15), ARGP(16), ARGP(19), CQn, CKVn, Qd, Kd, Vd, Qi, Ki, Kr, Qm, Wi, Ycat};
        LAS float* GL = (LAS float*)(lds + 4096);
        for (int i = C.tid; i < 2560; i += NWAVES * 64) GL[i] = i < 1536 ? A.g_cq[i] : i < 2048 ? A.g_ckv[i - 1536] : i < 2176 ? A.g_qd[i - 2048] : i < 2304 ? A.g_kd[i - 2176] : A.g_qm[i - 2304];
        __syncthreads();
        v4u R[20]; int posi = 0; int t = C.gw;
#pragma unroll
        for (int i = 0; i < 20; ++i) R[i] = (v4u){0u, 0u, 0u, 0u};
        if (t < MTOK) pp1_load(A, t, C.lane, R, posi);
#pragma unroll 1
        for (; t < MTOK; t += C.NGW) {
            v4u N[20]; int nposi = 0; const int nt = t + C.NGW;
#pragma unroll
            for (int i = 0; i < 20; ++i) N[i] = (v4u){0u, 0u, 0u, 0u};
            if (nt < MTOK) pp1_load(A, nt, C.lane, N, nposi);
            pp1_token(A, t, C.lane, (LAS float*)(lds + C.wave * 256), R, posi, GL);
#pragma unroll
            for (int i = 0; i < 20; ++i) R[i] = N[i];
            posi = nposi;
        }
        __syncthreads();
    }
    }
    SEAM(5);
    _Pragma("unroll") for (int rep_ = 0; rep_ < NREP(6); ++rep_) { if (rep_) REPBAR(6); if (IN(6)) {
        { pg8::Gemm g{(const bf16*)CQn, (const bf16*)WUQt, MTOK, 2304, 1536 / 2}; pg8::StaticOrder S; S.init(MTOK, 2304, GRID, (int)blockIdx.x); pg8::EpiPlain8 E{QmlaRaw, 2304, 1.0f / WUQ_SCALE};
          pg8::gemm_phase<pg8::EpiPlain8, pg8::StaticOrder, true, true>(lds, g, S, E); }
        { pg8::Gemm g{(const bf16*)CKVn, (const bf16*)WUKVt, MTOK, 3072, 512 / 2}; pg8::StaticOrder S; S.init(MTOK, 3072, GRID, (int)blockIdx.x); pg8::EpiPlain8 E{KVraw, 3072, 1.0f / WUKV_SCALE};
          pg8::gemm_phase<pg8::EpiPlain8, pg8::StaticOrder, true, true>(lds, g, S, E); }
        for (int p = blockIdx.x; p < 256; p += GRID) idx_item(p, Qi, Ki, Wi, Sc, lds);
    }
    }
    SEAM(6);
    _Pragma("unroll") for (int rep_ = 0; rep_ < NREP(7); ++rep_) { if (rep_) REPBAR(7); if (IN(7)) { const Ctx C = make_ctx(lds);
        PP2 A{QmlaRaw, KVraw, Kr, MKVraw, POS_IN, ARGP(13), ARGP(14), ARGP(20), Qmla, Kmla, MemK};
#pragma unroll 1
        for (int step = 0; step < 2; ++step) {
            if ((step ^ (int)(blockIdx.x & 1u)) == 0) {
                for (int t = C.gw; t < MTOK; t += C.NGW) pp2_token(A, t, C.lane, (LAS float*)(lds + C.wave * 256));
                for (int r = C.gw; r < MROWS; r += C.NGW) pp2_memrow(A, r, C.lane);
            } else {
                for (int t = C.gw; t < MTOK; t += C.NGW) select_row(Sc, (unsigned long long*)BM, t, C.lane, (LAS unsigned*)(lds + C.wave * 16384), (LAS unsigned long long*)(lds + MISC_OFF + 64 + C.wave * 1024));
            }
            __syncthreads();
        }
    }
    }
    SEAM(7);
    _Pragma("unroll") for (int rep_ = 0; rep_ < NREP(10); ++rep_) { if (rep_) REPBAR(10); if (IN(10)) {
        for (;;) {
            if (threadIdx.x == 0) MISC[4] = __hip_atomic_fetch_add(ctl + CW_QUEUE + 64 * rep_, 1u, __ATOMIC_RELAXED, __HIP_MEMORY_SCOPE_AGENT);
            __syncthreads();
            const int u0 = __builtin_amdgcn_readfirstlane((int)MISC[4]);
            __syncthreads();
#if FFN2_CONV_IN_ATTN
            if (u0 >= 2304) break;
            if (u0 < 2048 && (u0 & 7) == 7) { const int c = u0 >> 3; const Ctx C = make_ctx(lds);   constexpr int CVN = FFN2_DOWN_CONV_IN_P14 ? (DM / 64) * (NGU / 32) : CONV_FFN_ITEMS;        constexpr int PER = CVN / 256; static_assert(PER * 256 == CVN, "slices");
                conv_ffn<FFN2_DOWN_FP8, FFN2_UP_I8>(C, ARGP(27), ARGP(28), ARGP(29), WGUt, WDt, ws + WS_WD8, c * PER + C.wave, (c + 1) * PER, 8);
                constexpr int PWO = CONV_WOCAT_ITEMS / 256, PWT = CONV_WOUT_ITEMS / 256; static_assert(PWO * 256 == CONV_WOCAT_ITEMS && PWT * 256 == CONV_WOUT_ITEMS, "slices");
                conv_wocat(C, ARGP(21), ARGP(22), ARGP(23), WOCATt, c * PWO + C.wave, (c + 1) * PWO, 8);
                conv_plain8(C, ARGP(25), 4096, 4096, WOUTt, WOUT_SCALE, c * PWT + C.wave, (c + 1) * PWT, 8);
                continue; }
            const int u = u0 < 2048 ? u0 - (u0 >> 3) : u0 - 256;
#else
            const int u = u0;
            if (u >= 2048) break;
#endif
            if (u < 1536) {
                const int qt = 31 - u / 48, r = u % 48, type = r / 24, bh = r % 24, b = bh / 12, h = bh % 12;
                const size_t row0 = (size_t)b * SEQ + 256 * qt, krow0 = (size_t)b * SEQ;
                if (type == 0) attn_unit<192, 0>(lds, Qmla + row0 * 2304 + h * 192, 2304, Kmla + krow0 * 2304 + h * 192, 2304, KVraw + krow0 * 3072 + h * 256 + 128, 3072,
                                                 Ycat + row0 * KCAT + h * 128, KCAT, 4 * qt + 4, 4 * qt, nullptr);
                else attn_unit<128, 1>(lds, Qd + row0 * 1536 + h * 128, 1536, Kd + krow0 * 1536 + h * 128, 1536, Vd + krow0 * 1536 + h * 128, 1536,
                                       Ycat + row0 * KCAT + 1536 + h * 128, KCAT, 4 * qt + 4, 4 * qt, BM + row0 * 256);
            } else {
                const int v = u - 1536, b = v >> 8, h = (v >> 6) & 3, qt = (v >> 1) & 31, dvh = v & 1;
                const size_t row0 = (size_t)b * SEQ + 256 * qt, krow0 = (size_t)b * MEMLEN;
                attn_unit<256, 2>(lds, Qm + row0 * 1024 + h * 256, 1024, MemK + krow0 * 1024 + h * 256, 1024, MKVraw + krow0 * 2048 + 1024 + h * 256 + dvh * 128, 2048,
                                  Ycat + row0 * KCAT + 3072 + h * 256 + dvh * 128, KCAT, 4, 0, nullptr);
            }
        }
    }}
        SEAM(10);
    _Pragma("unroll") for (int rep_ = 0; rep_ < NREP(11); ++rep_) { if (rep_) REPBAR(11); if (IN(11)) {
        pg8::Gemm g{(const bf16*)Ycat, (const bf16*)WOCATt, MTOK, DM, KCAT / 2}; pg8::StaticOrder S; S.init(MTOK, DM, GRID, (int)blockIdx.x);
        pg8::EpiGateCat E{Gt, NGC, DM, (unsigned char*)Abuf, DM, GS_SCALE / (Y_SCALE * WO_SCALE)};
        pg8::gemm_phase<pg8::EpiGateCat, pg8::StaticOrder, true, true>(lds, g, S, E);
    }}
        SEAM(11);
#if defined(PROBE_P12)
    if (IN(12)) {
        pg8::Gemm g{Abuf, (const bf16*)WOUTt, MTOK, DM, DM / 2}; pg8::StaticOrder S; S.init(MTOK, DM, GRID, (int)blockIdx.x); pg8::EpiPlain8 E{Pbuf, DM, 1.0f};
        pg8::gemm_phase<pg8::EpiPlain8, pg8::StaticOrder, true, true>(lds, g, S, E);
        xcd_barrier(bar);
    }
#endif
    if (IN(12)) {
        STAGGER();
#if DEFER_MIX_RESID
        pg8::Gemm g{Abuf, (const bf16*)WOUTt, MTOK, DM, DM / 2}; pg8::StaticOrder S; S.init(MTOK, DM, GRID, (int)blockIdx.x); pg8::EpiPlain8 E{Pbuf, DM, 1.0f / (GS_SCALE * WOUT_SCALE)};
        pg8::gemm_phase<pg8::EpiPlain8, pg8::StaticOrder, true, true>(lds, g, S, E);
#else
        pg8::Gemm g{Abuf, (const bf16*)WOUTt, MTOK, DM, DM / 2}; pg8::StaticOrder S; S.init(MTOK, DM, GRID, (int)blockIdx.x); pg8::EpiResid8 E{XRES, XRES, DM, 1.0f / (GS_SCALE * WOUT_SCALE)};
        pg8::gemm_phase<pg8::EpiResid8, pg8::StaticOrder, true, true>(lds, g, S, E);
#endif
    }
    SEAM(12);
#endif
    if (IN(13)) { const Ctx C = make_ctx(lds);
#if !FFN2_CONV_IN_ATTN
        conv_ffn<FFN2_DOWN_FP8, FFN2_UP_I8>(C, ARGP(27), ARGP(28), ARGP(29), WGUt, WDt, ws + WS_WD8);
#endif
#if DEFER_MIX_RESID
        static_assert(FFN2_UP_I8 && FFN2_DOWN_FP8 == 1 && !DBG_SKIP_MIXER, "the deferred residual is wired for the int8 / MX-fp8 FFN2 only");
        if (NO_X1) rms_rows_i8_add(C, X_IN, Pbuf, ARGP(26), (unsigned char*)Abuf, (float*)(ws + WS_MEMN), WGU_I8_SCALE, MTOK, Pbuf + (size_t)MTOK * DM, D1buf, 0.5f);
        else rms_rows_i8_add(C, XRES, Pbuf, ARGP(26), (unsigned char*)Abuf, (float*)(ws + WS_MEMN), WGU_I8_SCALE, MTOK, X2_BF16 ? Pbuf + (size_t)MTOK * DM : nullptr);
#else
        if (FFN2_UP_I8) rms_rows_i8(C, XRES, ARGP(26), (unsigned char*)Abuf, (float*)(ws + WS_MEMN), WGU_I8_SCALE, MTOK);
        else rms_rows(C, XRES, ARGP(26), Abuf, MTOK);
#endif
    }
    SEAM(13);
    if (IN(14)) { ffn_up_phase<FFN2_DOWN_FP8, FFN2_UP_I8>(lds, Abuf, WGUt, Hmid, GRID, (const float*)(ws + WS_MEMN), ws + WS_HMID8);
#if FFN2_DOWN_CONV_IN_P14 && FFN2_CONV_IN_ATTN
        if (blockIdx.x >= 128) { const Ctx C = make_ctx(lds); __syncthreads();
            conv_ffn<FFN2_DOWN_FP8, FFN2_UP_I8>(C, ARGP(27), ARGP(28), ARGP(29), WGUt, WDt, ws + WS_WD8, (DM / 64) * (NGU / 32) + ((int)blockIdx.x - 128) * 8 + C.wave, CONV_FFN_ITEMS, 128 * 8); __syncthreads(); }
#endif
    }
    SEAM(14);
#if DEFER_MIX_RESID
    if (IN(15)) { if (X2_BF16) ffn_down_phase<FFN2_DOWN_FP8>(lds, Hmid, WDt, nullptr, XRES, GRID, ws + WS_HMID8, ws + WS_WD8, Pbuf + (size_t)MTOK * DM);
                  else ffn_down_phase<FFN2_DOWN_FP8>(lds, Hmid, WDt, XRES, XRES, GRID, ws + WS_HMID8, ws + WS_WD8, Pbuf); }
#else
    if (IN(15)) ffn_down_phase<FFN2_DOWN_FP8>(lds, Hmid, WDt, XRES, XRES, GRID, ws + WS_HMID8, ws + WS_WD8);
#endif
    if (STAMP_A >= 0) {
        if (blockIdx.x == 0 && threadIdx.x == 0) ctl[CW_STAMP + 2 * 16] = (unsigned)__builtin_amdgcn_s_memrealtime();
        xcd_barrier(bar);
        if (blockIdx.x == 0 && threadIdx.x < 64) {
            const unsigned a0 = __hip_atomic_load(ctl + CW_STAMP + 2 * (STAMP_A >= 16 ? 0 : STAMP_A), __ATOMIC_RELAXED, __HIP_MEMORY_SCOPE_AGENT), a1 = __hip_atomic_load(ctl + CW_STAMP + 2 * (STAMP_A >= 16 ? 16 : STAMP_A + 1), __ATOMIC_RELAXED, __HIP_MEMORY_SCOPE_AGENT);
            const unsigned b0 = __hip_atomic_load(ctl + CW_STAMP + 2 * STAMP_B, __ATOMIC_RELAXED, __HIP_MEMORY_SCOPE_AGENT), b1 = __hip_atomic_load(ctl + CW_STAMP + 2 * (STAMP_B + 1), __ATOMIC_RELAXED, __HIP_MEMORY_SCOPE_AGENT);
            const float va = (float)(a1 - a0) * (STAMP_A == 16 ? 0.00002f : 0.0002f), vb = (float)(b1 - b0) * 0.0002f;
            float* o = XRES;
            if (threadIdx.x == 0) o[0] = (STAMP_A == 17) ? 3.0f : va;
            if (STAMP_B >= 0) o[(threadIdx.x + 1) * 4096] = vb;
        }
    }
#undef IN
#undef SEAM
}

#undef WGUt
#undef WDt
#undef WINt
#undef WINIt
#undef WG8t
#undef Hn8
#undef WUQt
#undef WUKVt
#undef WMKVt
#undef WOCATt
#undef WOUTt
#undef Abuf
#undef Hmid
#undef Gt
#undef Pbuf
#undef QmlaRaw
#undef KVraw
#undef Qmla
#undef Kmla
#undef CQn
#undef CKVn
#undef Qd
#undef Kd
#undef Vd
#undef Qi
#undef Ki
#undef Wi
#undef Kr
#undef Qm
#undef Ycat
#undef BM
#undef memn
#undef MKVraw
#undef MemK
#undef Sc
#undef X_IN
#undef MEM_IN
#undef POS_IN
#undef D1buf
#undef XRES
#undef ARGQ
#undef ARGP
extern "C" void kernel_launch(void* const* d_in, const int* in_sizes, int n_in, void* d_out, int out_size, void* d_ws, size_t ws_size, hipStream_t stream) {
    static int grid = 0;
    if (grid == 0) {
        if (n_in != 30 || in_sizes[0] != MTOK * DM || out_size != MTOK * DM || ws_size < WS_END) {
            fprintf(stderr, "kernel_launch: built for 30 inputs, x/out of %d floats, >= %zu bytes of workspace; got n_in %d, in0 %d, out %d, ws %zu; nothing launched\n", MTOK * DM, (size_t)WS_END, n_in, n_in > 0 ? in_sizes[0] : -1, out_size, ws_size);
            grid = -1; return; }
        int dev = 0, cus = 0, per_cu = 0;
        if (hipGetDevice(&dev) != hipSuccess || hipDeviceGetAttribute(&cus, hipDeviceAttributeMultiprocessorCount, dev) != hipSuccess) { fprintf(stderr, "kernel_launch: device query failed\n"); grid = -1; return; }
        if (hipFuncSetAttribute((const void*)mega_fwd, hipFuncAttributeMaxDynamicSharedMemorySize, LDS_BYTES) != hipSuccess) { fprintf(stderr, "kernel_launch: hipFuncSetAttribute failed\n"); grid = -1; return; }
        if (hipOccupancyMaxActiveBlocksPerMultiprocessor(&per_cu, (const void*)mega_fwd, NWAVES * 64, LDS_BYTES) != hipSuccess || per_cu < 1)
            fprintf(stderr, "kernel_launch: note: occupancy query reports %d workgroups per CU\n", per_cu);
        (void)hipGetLastError();
        grid = cus;
    }
    if (grid < 0) return;
    if (hipMemsetAsync((char*)d_ws + WS_CTL, 0, CTL_ZERO_BYTES, stream) != hipSuccess) { fprintf(stderr, "kernel_launch: memset failed\n"); return; }
    Args a{};
    for (int i = 0; i < 30; ++i) a.in[i] = (const float*)d_in[i];
    a.out = (float*)d_out; a.ws = (unsigned char*)d_ws;
#if MK_MULTI
    for (int k = 0; k < NPH; ++k) { a.ph_lo = k; a.ph_hi = k + 1; hipLaunchKernelGGL(mega_fwd, dim3(grid), dim3(NWAVES * 64), LDS_BYTES, stream, a); }
#else
    a.ph_lo = 0; a.ph_hi = NPH;
    hipLaunchKernelGGL(mega_fwd, dim3(grid), dim3(NWAVES * 64), LDS_BYTES, stream, a);
#if defined(PROBE_TWICE)
    (void)hipMemsetAsync((char*)d_ws + WS_CTL, 0, CTL_ZERO_BYTES, stream);
    hipLaunchKernelGGL(mega_fwd, dim3(grid), dim3(NWAVES * 64), LDS_BYTES, stream, a);
#endif
#endif
    const hipError_t le = hipPeekAtLastError();
    if (le != hipSuccess) fprintf(stderr, "kernel_launch: launch failed: %s\n", hipGetErrorName(le));
}
```

```cpp
#include <hip/hip_runtime.h>
#include <cstdio>
#include <cstdint>
namespace pg8 {
#define PG8_LAS __attribute__((address_space(3)))
typedef unsigned short bf16_t;
typedef short bf16x8 __attribute__((ext_vector_type(8)));
typedef float f32x4 __attribute__((ext_vector_type(4)));
typedef unsigned u32x4 __attribute__((ext_vector_type(4)));
constexpr int BM = 256, BK = 64, HALF = 128, HTB = HALF * BK * 2  , STAGE_BYTES = 8 * HTB, NXCD = 8, WGM = 8;

__host__ __device__ __forceinline__ int lds_byte(int r, int c) { const int st = (r >> 4) * 2 + (c >> 5), rr = r & 15, cc = c & 31, ob = rr * 64 + cc * 2; return st * 1024 + (ob ^ (((ob >> 9) & 1) << 5)); }
__host__ __device__ __forceinline__ void stage_rc(int b, int& R, int& C) { const int st = b / 1024, sb = b % 1024, swz = sb ^ (((sb >> 9) & 1) << 5); R = (st >> 1) * 16 + swz / 64; C = (st & 1) * 32 + (swz % 64) / 2; }
__host__ __device__ __forceinline__ int perm32(int rho) { const int n = rho >> 4, i = rho & 15; return 8 * (i >> 2) + 4 * n + (i & 3); }

struct Unit { int pm, pn; };
struct Gemm { const bf16_t* A; const bf16_t* Bt; int M, N, K; };

struct StaticOrder {
    int nM, nN, nwg, G, c;
    __host__ __device__ void init(int M, int N, int G_, int c_) { nM = M / BM; nN = N / BM; nwg = nM * nN; G = G_; c = c_; }
    __host__ __device__ bool next(int i, Unit& u) const {
        const long L = (long)i * G + c; if (L >= nwg) return false;
        int wgid = (int)L; { const int q = nwg / NXCD, r = nwg % NXCD, xcd = wgid % NXCD, off = wgid / NXCD; wgid = (xcd < r ? xcd * (q + 1) : r * (q + 1) + (xcd - r) * q) + off; }
        const int nig = WGM * nN, gid = wgid / nig, fm = gid * WGM, gsz = (nM - fm) < WGM ? (nM - fm) : WGM;
        u.pm = fm + ((wgid % nig) % gsz); u.pn = (wgid % nig) / gsz; return true;
    }
    __device__ __forceinline__ void a_ready(const Unit&) const {}
    __device__ __forceinline__ void done(const Unit&) const {}
};
__device__ __forceinline__ unsigned cvt_pk_bf16(float lo, float hi) { unsigned r; asm volatile("v_cvt_pk_bf16_f32 %0, %1, %2" : "=v"(r) : "v"(lo), "v"(hi)); return r; }
#define DI_PG __device__ __forceinline__
#ifndef GATES_U8
#define GATES_U8 1
#endif
__device__ __forceinline__ unsigned pk_fp8x4(float a, float b, float c, float d) { int p = __builtin_amdgcn_cvt_pk_fp8_f32(a, b, 0, false); p = __builtin_amdgcn_cvt_pk_fp8_f32(c, d, p, true); return (unsigned)p; }
__device__ __forceinline__ float sigmoid_f(float x) { return __builtin_amdgcn_rcpf(1.0f + __builtin_amdgcn_exp2f(-1.4426950408889634f * x)); }
struct EpiPlain {
    static constexpr bool PERM = true, AFTER_DRAIN = false;
    bf16_t* O; int ldc;
    __device__ __forceinline__ void operator()(const f32x4 (&acc)[2][2][4][2], const Unit& u, int wr, int wc, int fr, int fq) const {
        const int row0 = u.pm * BM + wr * 64 + fr, col0 = u.pn * BM + wc * 32 + 8 * fq;
#pragma unroll
        for (int ai = 0; ai < 2; ++ai)
#pragma unroll
            for (int m = 0; m < 4; ++m) { bf16_t* rowp = O + (size_t)(row0 + ai * HALF + m * 16) * ldc + col0;
#pragma unroll
                for (int bj = 0; bj < 2; ++bj) { const f32x4 v0 = acc[ai][bj][m][0], v1 = acc[ai][bj][m][1];
                    u32x4 w; w.x = cvt_pk_bf16(v0[0], v0[1]); w.y = cvt_pk_bf16(v0[2], v0[3]); w.z = cvt_pk_bf16(v1[0], v1[1]); w.w = cvt_pk_bf16(v1[2], v1[3]);
                    *(u32x4*)(rowp + bj * HALF) = w; } }
    }
};
struct EpiPlain8 {
    static constexpr bool PERM = true, AFTER_DRAIN = false, FP8 = true;
    bf16_t* O; int ldc; float scale;
    __device__ __forceinline__ void operator()(const f32x4 (&acc)[2][2][4][2], const Unit& u, int wr, int wc, int fr, int fq) const {
        const int row0 = u.pm * BM + wr * 64 + fr, col0 = u.pn * BM + wc * 32 + 8 * fq;
#pragma unroll
        for (int ai = 0; ai < 2; ++ai)
#pragma unroll
            for (int m = 0; m < 4; ++m) { bf16_t* rowp = O + (size_t)(row0 + ai * HALF + m * 16) * ldc + col0;
#pragma unroll
                for (int bj = 0; bj < 2; ++bj) { const f32x4 v0 = acc[ai][bj][m][0] * scale, v1 = acc[ai][bj][m][1] * scale;
                    u32x4 w; w.x = cvt_pk_bf16(v0[0], v0[1]); w.y = cvt_pk_bf16(v0[2], v0[3]); w.z = cvt_pk_bf16(v1[0], v1[1]); w.w = cvt_pk_bf16(v1[2], v1[3]);
                    *(u32x4*)(rowp + bj * HALF) = w; } }
    }
};
struct EpiPlain8R {
    static constexpr bool PERM = true, AFTER_DRAIN = false, FP8 = true;
    bf16_t* O; int ldc; float scale; bf16_t* O2; int ld2; int pn0, pn1;
    __device__ __forceinline__ void operator()(const f32x4 (&acc)[2][2][4][2], const Unit& u, int wr, int wc, int fr, int fq) const {
        const bool alt = u.pn >= pn0 && u.pn < pn1;
        bf16_t* const B = alt ? O2 : O; const int ld = alt ? ld2 : ldc;
        const int row0 = u.pm * BM + wr * 64 + fr, col0 = (alt ? u.pn - pn0 : u.pn) * BM + wc * 32 + 8 * fq;
#pragma unroll
        for (int ai = 0; ai < 2; ++ai)
#pragma unroll
            for (int m = 0; m < 4; ++m) { bf16_t* rowp = B + (size_t)(row0 + ai * HALF + m * 16) * ld + col0;
#pragma unroll
                for (int bj = 0; bj < 2; ++bj) { const f32x4 v0 = acc[ai][bj][m][0] * scale, v1 = acc[ai][bj][m][1] * scale;
                    u32x4 w; w.x = cvt_pk_bf16(v0[0], v0[1]); w.y = cvt_pk_bf16(v0[2], v0[3]); w.z = cvt_pk_bf16(v1[0], v1[1]); w.w = cvt_pk_bf16(v1[2], v1[3]);
                    *(u32x4*)(rowp + bj * HALF) = w; } }
    }
};
template <int F8, bool I8_ = false> struct EpiSwiGLU {
    static constexpr bool PERM = true, AFTER_DRAIN = false, I8 = I8_;
    unsigned char* O; int ldc; float oscale; const float* rowscale; unsigned char* O8; int pm_split;
    __device__ __forceinline__ void operator()(const f32x4 (&acc)[2][2][4][2], const Unit& u, int wr, int wc, int fr, int fq) const {
        const int row0 = u.pm * BM + wr * 64 + fr, col0 = u.pn * HALF + wc * 32 + 8 * fq;
        const bool f8 = (F8 == 1) || (F8 == 2 && u.pm < pm_split); unsigned char* const OF8 = (F8 == 2) ? O8 : O;
        float rsv[8];
        if constexpr (I8_) {
#pragma unroll
            for (int q = 0; q < 8; ++q) rsv[q] = rowscale[row0 + (q >> 2) * HALF + (q & 3) * 16]; }
#pragma unroll
        for (int ai = 0; ai < 2; ++ai)
#pragma unroll
            for (int m = 0; m < 4; ++m) { const size_t eoff = (size_t)(row0 + ai * HALF + m * 16) * ldc + col0;
                f32x4 r0, r1;
                if constexpr (I8_) {
                    const float rs = rsv[ai * 4 + m], c = -1.4426950408889634f * rs, k = f8 ? rs * rs * oscale : rs * rs;
#pragma unroll
                    for (int j = 0; j < 4; ++j) {
                        const float g0 = (float)__float_as_int(acc[ai][0][m][0][j]), g1 = (float)__float_as_int(acc[ai][0][m][1][j]), u0 = (float)__float_as_int(acc[ai][1][m][0][j]), u1 = (float)__float_as_int(acc[ai][1][m][1][j]);
                        r0[j] = (g0 * u0) * __builtin_amdgcn_rcpf(1.0f + __builtin_amdgcn_exp2f(g0 * c)) * k; r1[j] = (g1 * u1) * __builtin_amdgcn_rcpf(1.0f + __builtin_amdgcn_exp2f(g1 * c)) * k; }
                } else {
#pragma unroll
                    for (int j = 0; j < 4; ++j) { const float g0 = acc[ai][0][m][0][j], g1 = acc[ai][0][m][1][j], u0 = acc[ai][1][m][0][j], u1 = acc[ai][1][m][1][j];
                        r0[j] = g0 * sigmoid_f(g0) * u0; r1[j] = g1 * sigmoid_f(g1) * u1; }
                }
                if (f8) {
#pragma unroll
                    for (int j = 0; j < 4; ++j) { const float os = I8_ ? 1.0f : oscale; r0[j] = __builtin_amdgcn_fmed3f(r0[j] * os, -448.f, 448.f); r1[j] = __builtin_amdgcn_fmed3f(r1[j] * os, -448.f, 448.f); }
                    typedef unsigned u32x2_ __attribute__((ext_vector_type(2)));
                    u32x2_ w; w.x = pk_fp8x4(r0[0], r0[1], r0[2], r0[3]); w.y = pk_fp8x4(r1[0], r1[1], r1[2], r1[3]);
                    *(u32x2_*)(OF8 + eoff) = w;
                } else {
                    u32x4 w; w.x = cvt_pk_bf16(r0[0], r0[1]); w.y = cvt_pk_bf16(r0[2], r0[3]); w.z = cvt_pk_bf16(r1[0], r1[1]); w.w = cvt_pk_bf16(r1[2], r1[3]);
                    *(u32x4*)((bf16_t*)O + eoff) = w; } }
    }
};
struct EpiResid {
    static constexpr bool PERM = true, AFTER_DRAIN = false;
    const float* base; float* out; int ldc; float scale;
    __device__ __forceinline__ void operator()(const f32x4 (&acc)[2][2][4][2], const Unit& u, int wr, int wc, int fr, int fq) const {
        const int row0 = u.pm * BM + wr * 64 + fr, col0 = u.pn * BM + wc * 32 + 8 * fq;
        f32x4 cur[8], nxt[8];
#define RESID_OFF(q_, j_) ((size_t)(row0 + ((q_) >> 2) * HALF + ((q_) & 3) * 16) * ldc + col0 + ((j_) >> 1) * HALF + ((j_) & 1) * 4)
#pragma unroll
        for (int e = 0; e < 8; ++e) cur[e] = *(const f32x4*)(base + RESID_OFF(e >> 2, e & 3));
#pragma unroll
        for (int b = 0; b < 4; ++b) {
            if (b + 1 < 4) {
#pragma unroll
                for (int e = 0; e < 8; ++e) nxt[e] = *(const f32x4*)(base + RESID_OFF(2 * (b + 1) + (e >> 2), e & 3)); }
#pragma unroll
            for (int e = 0; e < 8; ++e) { const int q = 2 * b + (e >> 2), j = e & 3;
                *(f32x4*)(out + RESID_OFF(q, j)) = cur[e] + acc[q >> 2][j >> 1][q & 3][j & 1] * scale; }
#pragma unroll
            for (int e = 0; e < 8; ++e) cur[e] = nxt[e];
        }
#undef RESID_OFF
    }
};
struct EpiResid8 {
    static constexpr bool PERM = true, AFTER_DRAIN = false, FP8 = true;
    const float* base; float* out; int ldc; float scale;
    __device__ __forceinline__ void operator()(const f32x4 (&acc)[2][2][4][2], const Unit& u, int wr, int wc, int fr, int fq) const {
        const int row0 = u.pm * BM + wr * 64 + fr, col0 = u.pn * BM + wc * 32 + 8 * fq;
        f32x4 cur[8], nxt[8];
#define RESID_OFF(q_, j_) ((size_t)(row0 + ((q_) >> 2) * HALF + ((q_) & 3) * 16) * ldc + col0 + ((j_) >> 1) * HALF + ((j_) & 1) * 4)
#pragma unroll
        for (int e = 0; e < 8; ++e) cur[e] = *(const f32x4*)(base + RESID_OFF(e >> 2, e & 3));
#pragma unroll
        for (int b = 0; b < 4; ++b) {
            if (b + 1 < 4) {
#pragma unroll
                for (int e = 0; e < 8; ++e) nxt[e] = *(const f32x4*)(base + RESID_OFF(2 * (b + 1) + (e >> 2), e & 3)); }
#pragma unroll
            for (int e = 0; e < 8; ++e) { const int q = 2 * b + (e >> 2), j = e & 3;
                *(f32x4*)(out + RESID_OFF(q, j)) = cur[e] + acc[q >> 2][j >> 1][q & 3][j & 1] * scale; }
#pragma unroll
            for (int e = 0; e < 8; ++e) cur[e] = nxt[e];
        }
#undef RESID_OFF
    }
};
struct EpiResid8A {
    static constexpr bool PERM = true, AFTER_DRAIN = false, FP8 = true;
    const float* base; const bf16_t* add; float* out; int ldc; float scale;
    __device__ __forceinline__ void operator()(const f32x4 (&acc)[2][2][4][2], const Unit& u, int wr, int wc, int fr, int fq) const {
        int fr_ = fr; asm volatile("" : "+v"(fr_));
        const int row0 = u.pm * BM + wr * 64 + fr_, col0 = u.pn * BM + wc * 32 + 8 * fq;
        typedef unsigned u32x2a_ __attribute__((ext_vector_type(2)));
        f32x4 cur[4], nxt[4]; u32x2a_ cd[4], nd[4];
#define RESID_OFF(q_, j_) ((size_t)(row0 + ((q_) >> 2) * HALF + ((q_) & 3) * 16) * ldc + col0 + ((j_) >> 1) * HALF + ((j_) & 1) * 4)
#pragma unroll
        for (int e = 0; e < 4; ++e) { cur[e] = *(const f32x4*)(base + RESID_OFF(0, e)); cd[e] = *(const u32x2a_*)(add + RESID_OFF(0, e)); }
#pragma unroll
        for (int q = 0; q < 8; ++q) {
            if (q + 1 < 8) {
#pragma unroll
                for (int e = 0; e < 4; ++e) { nxt[e] = *(const f32x4*)(base + RESID_OFF(q + 1, e)); nd[e] = *(const u32x2a_*)(add + RESID_OFF(q + 1, e)); } }
#pragma unroll
            for (int e = 0; e < 4; ++e) {
                f32x4 a; a[0] = __uint_as_float(cd[e].x << 16); a[1] = __uint_as_float(cd[e].x & 0xffff0000u); a[2] = __uint_as_float(cd[e].y << 16); a[3] = __uint_as_float(cd[e].y & 0xffff0000u);
                *(f32x4*)(out + RESID_OFF(q, e)) = (cur[e] + a) + acc[q >> 2][e >> 1][q & 3][e & 1] * scale; }
#pragma unroll
            for (int e = 0; e < 4; ++e) { cur[e] = nxt[e]; cd[e] = nd[e]; }
        }
#undef RESID_OFF
    }
};
struct EpiResid8B {
    static constexpr bool PERM = true, AFTER_DRAIN = false, FP8 = true;
    const bf16_t* base; float* out; int ldc; float scale;
    __device__ __forceinline__ void operator()(const f32x4 (&acc)[2][2][4][2], const Unit& u, int wr, int wc, int fr, int fq) const {
        int fr_ = fr; asm volatile("" : "+v"(fr_));
        const int row0 = u.pm * BM + wr * 64 + fr_, col0 = u.pn * BM + wc * 32 + 8 * fq;
        typedef unsigned u32x2b_ __attribute__((ext_vector_type(2)));
        u32x2b_ cd[8], nd[8];
#define RESID_OFF(q_, j_) ((size_t)(row0 + ((q_) >> 2) * HALF + ((q_) & 3) * 16) * ldc + col0 + ((j_) >> 1) * HALF + ((j_) & 1) * 4)
#pragma unroll
        for (int e = 0; e < 8; ++e) cd[e] = *(const u32x2b_*)(base + RESID_OFF(e >> 2, e & 3));
#pragma unroll
        for (int b = 0; b < 4; ++b) {
            if (b + 1 < 4) {
#pragma unroll
                for (int e = 0; e < 8; ++e) nd[e] = *(const u32x2b_*)(base + RESID_OFF(2 * (b + 1) + (e >> 2), e & 3)); }
#pragma unroll
            for (int e = 0; e < 8; ++e) { const int q = 2 * b + (e >> 2), j = e & 3;
                f32x4 a; a[0] = __uint_as_float(cd[e].x << 16); a[1] = __uint_as_float(cd[e].x & 0xffff0000u); a[2] = __uint_as_float(cd[e].y << 16); a[3] = __uint_as_float(cd[e].y & 0xffff0000u);
                *(f32x4*)(out + RESID_OFF(q, j)) = a + acc[q >> 2][j >> 1][q & 3][j & 1] * scale; }
#pragma unroll
            for (int e = 0; e < 8; ++e) cd[e] = nd[e];
        }
#undef RESID_OFF
    }
};
struct EpiInProj {
    static constexpr bool PERM = true, AFTER_DRAIN = false;
    bf16_t* P; int ldp; int np; bf16_t* G; int ldg;
    __device__ __forceinline__ void operator()(const f32x4 (&acc)[2][2][4][2], const Unit& u, int wr, int wc, int fr, int fq) const {
        const int row0 = u.pm * BM + wr * 64 + fr; const bool isg = u.pn >= np;
        bf16_t* O = isg ? G : P; const int ldc = isg ? ldg : ldp; const int col0 = (isg ? u.pn - np : u.pn) * BM + wc * 32 + 8 * fq;
#pragma unroll
        for (int ai = 0; ai < 2; ++ai)
#pragma unroll
            for (int m = 0; m < 4; ++m) { bf16_t* rowp = O + (size_t)(row0 + ai * HALF + m * 16) * ldc + col0;
#pragma unroll
                for (int bj = 0; bj < 2; ++bj) { f32x4 v0 = acc[ai][bj][m][0], v1 = acc[ai][bj][m][1];
                    if (isg) {
#pragma unroll
                        for (int j = 0; j < 4; ++j) { v0[j] = fmaxf(sigmoid_f(v0[j]), 5.9604645e-8f); v1[j] = fmaxf(sigmoid_f(v1[j]), 5.9604645e-8f); } }
                    u32x4 w; w.x = cvt_pk_bf16(v0[0], v0[1]); w.y = cvt_pk_bf16(v0[2], v0[3]); w.z = cvt_pk_bf16(v1[0], v1[1]); w.w = cvt_pk_bf16(v1[2], v1[3]);
                    *(u32x4*)(rowp + bj * HALF) = w; } }
    }
};
#if GATES_U8
struct EpiGates8 {
    static constexpr bool PERM = true, AFTER_DRAIN = false, FP8 = true;
    unsigned char* G; int ldg; float inv_wscale;
    __device__ __forceinline__ void operator()(const f32x4 (&acc)[2][2][4][2], const Unit& u, int wr, int wc, int fr, int fq) const {
        int fr_ = fr; asm volatile("" : "+v"(fr_));
        const int row0 = u.pm * BM + wr * 64 + fr_, col0 = u.pn * BM + wc * 32 + 8 * fq;
#pragma unroll
        for (int ai = 0; ai < 2; ++ai)
#pragma unroll
            for (int m = 0; m < 4; ++m) { unsigned char* rowp = G + (size_t)(row0 + ai * HALF + m * 16) * ldg + col0;
#pragma unroll
                for (int bj = 0; bj < 2; ++bj) { const f32x4 v0 = acc[ai][bj][m][0], v1 = acc[ai][bj][m][1];
                    unsigned w0 = 0u, w1 = 0u;
#pragma unroll
                    for (int j = 0; j < 4; ++j) {
                        w0 = __builtin_amdgcn_cvt_pk_u8_f32(fmaxf(__builtin_fmaf(sigmoid_f(v0[j] * inv_wscale), 255.0f, 0.5f), 1.0f), j, w0);
                        w1 = __builtin_amdgcn_cvt_pk_u8_f32(fmaxf(__builtin_fmaf(sigmoid_f(v1[j] * inv_wscale), 255.0f, 0.5f), 1.0f), j, w1); }
                    typedef unsigned u32x2g_ __attribute__((ext_vector_type(2)));
                    u32x2g_ w; w.x = w0; w.y = w1;
                    *(u32x2g_*)(rowp + bj * HALF) = w; } }
    }
};
#else
struct EpiGates8 {
    static constexpr bool PERM = true, AFTER_DRAIN = false, FP8 = true;
    bf16_t* G; int ldg; float inv_wscale;
    __device__ __forceinline__ void operator()(const f32x4 (&acc)[2][2][4][2], const Unit& u, int wr, int wc, int fr, int fq) const {
        int fr_ = fr; asm volatile("" : "+v"(fr_));
        const int row0 = u.pm * BM + wr * 64 + fr_, col0 = u.pn * BM + wc * 32 + 8 * fq;
#pragma unroll
        for (int ai = 0; ai < 2; ++ai)
#pragma unroll
            for (int m = 0; m < 4; ++m) { bf16_t* rowp = G + (size_t)(row0 + ai * HALF + m * 16) * ldg + col0;
#pragma unroll
                for (int bj = 0; bj < 2; ++bj) { f32x4 v0 = acc[ai][bj][m][0], v1 = acc[ai][bj][m][1];
#pragma unroll
                    for (int j = 0; j < 4; ++j) { v0[j] = fmaxf(sigmoid_f(v0[j] * inv_wscale), 5.9604645e-8f); v1[j] = fmaxf(sigmoid_f(v1[j] * inv_wscale), 5.9604645e-8f); }
                    u32x4 w; w.x = cvt_pk_bf16(v0[0], v0[1]); w.y = cvt_pk_bf16(v0[2], v0[3]); w.z = cvt_pk_bf16(v1[0], v1[1]); w.w = cvt_pk_bf16(v1[2], v1[3]);
                    *(u32x4*)(rowp + bj * HALF) = w; } }
    }
};
#endif
DI_PG void unpack_bf16x8(const u32x4 gw, f32x4& g0, f32x4& g1) {
    g0[0] = __uint_as_float(gw.x << 16); g0[1] = __uint_as_float(gw.x & 0xffff0000u); g0[2] = __uint_as_float(gw.y << 16); g0[3] = __uint_as_float(gw.y & 0xffff0000u);
    g1[0] = __uint_as_float(gw.z << 16); g1[1] = __uint_as_float(gw.z & 0xffff0000u); g1[2] = __uint_as_float(gw.w << 16); g1[3] = __uint_as_float(gw.w & 0xffff0000u);
}
#if GATES_U8
typedef unsigned u32x2c_ __attribute__((ext_vector_type(2)));
DI_PG void unpack_u8x8(const u32x2c_ gw, f32x4& g0, f32x4& g1) {
    g0[0] = (float)(gw.x & 255u); g0[1] = (float)((gw.x >> 8) & 255u); g0[2] = (float)((gw.x >> 16) & 255u); g0[3] = (float)(gw.x >> 24);
    g1[0] = (float)(gw.y & 255u); g1[1] = (float)((gw.y >> 8) & 255u); g1[2] = (float)((gw.y >> 16) & 255u); g1[3] = (float)(gw.y >> 24);
}
#endif
struct EpiGateCat {
    static constexpr bool PERM = true, AFTER_DRAIN = false, FP8 = true; static constexpr int MIDK = 12;
#if GATES_U8
    const unsigned char* G;
#else
    const bf16_t* G;
#endif
    int ldg; int gstride; unsigned char* O; int ld; float oscale;
    __device__ __forceinline__ void mid(f32x4 (&acc)[2][2][4][2], const Unit& u, int seg, int wr, int wc, int fr, int fq) const {
        int fr_ = fr; asm volatile("" : "+v"(fr_));
        const int row0 = u.pm * BM + wr * 64 + fr_, col0 = u.pn * BM + wc * 32 + 8 * fq;
#pragma unroll
        for (int ai = 0; ai < 2; ++ai)
#pragma unroll
            for (int m = 0; m < 4; ++m) { const auto* gp = G + (size_t)(row0 + ai * HALF + m * 16) * ldg + (seg - 1) * gstride + col0;
#pragma unroll
                for (int bj = 0; bj < 2; ++bj) {
                    f32x4 a0, a1, b0, b1;
#if GATES_U8
                    unpack_u8x8(*(const u32x2c_*)(gp + bj * HALF), a0, a1); unpack_u8x8(*(const u32x2c_*)(gp + gstride + bj * HALF), b0, b1);
#else
                    unpack_bf16x8(*(const u32x4*)(gp + bj * HALF), a0, a1); unpack_bf16x8(*(const u32x4*)(gp + gstride + bj * HALF), b0, b1);
#endif
#pragma unroll
                    for (int j = 0; j < 4; ++j) { acc[ai][bj][m][0][j] *= a0[j] * __builtin_amdgcn_rcpf(b0[j]); acc[ai][bj][m][1][j] *= a1[j] * __builtin_amdgcn_rcpf(b1[j]); } }
                if (m == 3) asm volatile("" ::: "memory"); }
    }
    __device__ __forceinline__ void operator()(const f32x4 (&acc)[2][2][4][2], const Unit& u, int wr, int wc, int fr, int fq) const {
        const int row0 = u.pm * BM + wr * 64 + fr, col0 = u.pn * BM + wc * 32 + 8 * fq;
#if GATES_U8
        u32x2c_ gq[16];
#pragma unroll
        for (int q = 0; q < 16; ++q) gq[q] = *(const u32x2c_*)(G + (size_t)(row0 + (q >> 3) * HALF + ((q >> 1) & 3) * 16) * ldg + 2 * gstride + col0 + (q & 1) * HALF);
#endif
#pragma unroll
        for (int ai = 0; ai < 2; ++ai)
#pragma unroll
            for (int m = 0; m < 4; ++m) { const int row = row0 + ai * HALF + m * 16;
#pragma unroll
                for (int bj = 0; bj < 2; ++bj) { const int col = col0 + bj * HALF;
                    f32x4 g0, g1;
#if GATES_U8
                    unpack_u8x8(gq[ai * 8 + m * 2 + bj], g0, g1);
                    const float osc = oscale * (1.0f / 255.0f);
#else
                    unpack_bf16x8(*(const u32x4*)(G + (size_t)row * ldg + 2 * gstride + col), g0, g1);
                    const float osc = oscale;
#endif
                    const f32x4 t0 = g0 * acc[ai][bj][m][0] * osc, t1 = g1 * acc[ai][bj][m][1] * osc;
                    typedef unsigned u32x2_ __attribute__((ext_vector_type(2)));
                    u32x2_ w; w.x = pk_fp8x4(t0[0], t0[1], t0[2], t0[3]); w.y = pk_fp8x4(t1[0], t1[1], t1[2], t1[3]);
                    *(u32x2_*)(O + (size_t)row * ld + col) = w; } }
    }
};
template <class E_, class = void> struct epi_i8 { static constexpr bool value = false; };
template <class E_> struct epi_i8<E_, decltype((void)E_::I8)> { static constexpr bool value = E_::I8; };
template <class E_, class = void> struct epi_fp8 { static constexpr bool value = false; };
template <class E_> struct epi_fp8<E_, decltype((void)E_::FP8)> { static constexpr bool value = E_::FP8; };
typedef int pg8_v4i __attribute__((ext_vector_type(4)));
typedef int pg8_v8i __attribute__((ext_vector_type(8)));
__device__ __forceinline__ pg8_v8i cat16(bf16x8 lo, bf16x8 hi) { const pg8_v4i a = __builtin_bit_cast(pg8_v4i, lo), b = __builtin_bit_cast(pg8_v4i, hi); return __builtin_shufflevector(a, b, 0, 1, 2, 3, 4, 5, 6, 7); }
__device__ __forceinline__ void mfma8_tied(f32x4& c, pg8_v8i a, pg8_v8i b, int unit_scale) {
    asm volatile("v_mfma_scale_f32_16x16x128_f8f6f4 %0, %1, %2, %0, %3, %3 op_sel_hi:[0,0,0]" : "+v"(c) : "v"(a), "v"(b), "v"(unit_scale)); }
template <class E_, class = void> struct epi_midk { static constexpr int value = 0; };
template <class E_> struct epi_midk<E_, decltype((void)E_::MIDK)> { static constexpr int value = E_::MIDK; };
template <class Epi, class Sched, bool ALIGN_EPI = false, bool SP2 = false>
__device__ __forceinline__ void gemm_phase(PG8_LAS unsigned char* lds, const Gemm g, const Sched& S, const Epi& E) {
    int tid_ = threadIdx.x; asm volatile("" : "+v"(tid_));
    const int tid = tid_, wid = __builtin_amdgcn_readfirstlane(tid >> 6), lane = tid & 63, wr = wid >> 2, wc = wid & 3, fr = lane & 15, fq = lane >> 4;
    const int K = g.K, nt = K / BK;
    unsigned voffA[2], voffB[2];
#pragma unroll
    for (int i = 0; i < 2; ++i) { int R, C; stage_rc(tid * 16 + i * 8192, R, C); const int Rb = Epi::PERM ? ((R & ~31) + perm32(R & 31)) : R;
        voffA[i] = (unsigned)(R * K + C) * 2u; voffB[i] = (unsigned)(Rb * K + C) * 2u; }
    const size_t kstep = (size_t)(BK * 2);
    const size_t hstep = (size_t)HALF * K * 2;
    const size_t tstep = 2 * hstep;
    const unsigned ldsw = (unsigned)wid * 1024u;
    const int aoff = lds_byte(wr * 64 + fr, fq * 8), boff = lds_byte(wc * 32 + fr, fq * 8);
#define PG8_SA(b, h) (((b) * 2 + (h)) * HTB)
#define PG8_SB(b, h) ((4 + (b) * 2 + (h)) * HTB)
#define PG8_STAGE(bufoff, gbase, voff) do { _Pragma("unroll") for (int _i = 0; _i < 2; ++_i) \
        __builtin_amdgcn_global_load_lds((const unsigned*)((const char*)(gbase) + (voff)[_i]), (PG8_LAS unsigned*)(lds + (bufoff) + ldsw + _i * 8192), 16, 0, 0); } while (0)
#define PG8_LDA(dst, b, h) do { _Pragma("unroll") for (int m = 0; m < 4; ++m) _Pragma("unroll") for (int k = 0; k < 2; ++k) dst[m][k] = *(const PG8_LAS bf16x8*)(lds + PG8_SA(b, h) + aoff + m * 2048 + k * 1024); } while (0)
#define PG8_LDB(dst, b, h) do { _Pragma("unroll") for (int n = 0; n < 2; ++n) _Pragma("unroll") for (int k = 0; k < 2; ++k) dst[n][k] = *(const PG8_LAS bf16x8*)(lds + PG8_SB(b, h) + boff + n * 2048 + k * 1024); } while (0)
#define PG8_MMA(ai, bj, At, Bt) do { __builtin_amdgcn_s_setprio(1); \
        if constexpr (epi_fp8<Epi>::value) { _Pragma("unroll") for (int m = 0; m < 4; ++m) _Pragma("unroll") for (int n = 0; n < 2; ++n) \
            mfma8_tied(acc[ai][bj][m][n], cat16(Bt[n][0], Bt[n][1]), cat16(At[m][0], At[m][1]), fp8_unit_scale); } \
        else if constexpr (epi_i8<Epi>::value) { _Pragma("unroll") for (int m = 0; m < 4; ++m) _Pragma("unroll") for (int n = 0; n < 2; ++n) _Pragma("unroll") for (int k = 0; k < 2; ++k) \
            acc[ai][bj][m][n] = __builtin_bit_cast(f32x4, __builtin_amdgcn_mfma_i32_16x16x64_i8(__builtin_bit_cast(pg8_v4i, Bt[n][k]), __builtin_bit_cast(pg8_v4i, At[m][k]), __builtin_bit_cast(pg8_v4i, acc[ai][bj][m][n]), 0, 0, 0)); }     \
        else { _Pragma("unroll") for (int m = 0; m < 4; ++m) _Pragma("unroll") for (int n = 0; n < 2; ++n) _Pragma("unroll") for (int k = 0; k < 2; ++k) \
            acc[ai][bj][m][n] = __builtin_amdgcn_mfma_f32_16x16x32_bf16(Bt[n][k], At[m][k], acc[ai][bj][m][n], 0, 0, 0); } \
        __builtin_amdgcn_s_setprio(0); } while (0)
#define PG8_WAIT_V(n) asm volatile("s_waitcnt vmcnt(" #n ")" ::: "memory")
#define PG8_WAIT_L(n) asm volatile("s_waitcnt lgkmcnt(" #n ")" ::: "memory")
#define PG8_BAR __builtin_amdgcn_s_barrier()
#define PG8_SCHED __builtin_amdgcn_sched_barrier(0)
    const int fp8_unit_scale = 0x7f7f7f7f; (void)fp8_unit_scale;
    Unit cur, nxt; int ui = 0;
    if (!S.next(0, cur)) return;
    f32x4 acc[2][2][4][2];
#pragma unroll
    for (int a = 0; a < 2; ++a)
#pragma unroll
        for (int b = 0; b < 2; ++b)
#pragma unroll
            for (int m = 0; m < 4; ++m)
#pragma unroll
                for (int n = 0; n < 2; ++n) acc[a][b][m][n] = (f32x4){0.f, 0.f, 0.f, 0.f};
    bf16x8 At[4][2], B0[2][2], B1[2][2];
    const char* cA = (const char*)g.A + (size_t)cur.pm * tstep; const char* cB = (const char*)g.Bt + (size_t)cur.pn * tstep;
    S.a_ready(cur);
    if constexpr (SP2) {
        PG8_STAGE(PG8_SB(0, 0), cB, voffB); PG8_STAGE(PG8_SB(0, 1), cB + hstep, voffB); PG8_STAGE(PG8_SA(0, 0), cA, voffA); PG8_STAGE(PG8_SA(0, 1), cA + hstep, voffA);
        if (wr == 1) PG8_BAR;
        PG8_WAIT_V(2); PG8_BAR;
        PG8_STAGE(PG8_SB(1, 0), cB + kstep, voffB); PG8_STAGE(PG8_SA(1, 0), cA + kstep, voffA); PG8_STAGE(PG8_SB(1, 1), cB + hstep + kstep, voffB);
        PG8_WAIT_V(6); PG8_BAR;
    } else {
        PG8_STAGE(PG8_SB(0, 0), cB, voffB); PG8_STAGE(PG8_SA(0, 0), cA, voffA); PG8_STAGE(PG8_SB(0, 1), cB + hstep, voffB); PG8_STAGE(PG8_SA(0, 1), cA + hstep, voffA);
        if (wr == 1) PG8_BAR;
        PG8_WAIT_V(4); PG8_BAR;
        PG8_STAGE(PG8_SB(1, 0), cB + kstep, voffB); PG8_STAGE(PG8_SA(1, 0), cA + kstep, voffA); PG8_STAGE(PG8_SB(1, 1), cB + hstep + kstep, voffB);
        PG8_WAIT_V(6); PG8_BAR;
    }
    for (;;) {
        const bool has_next = S.next(ui + 1, nxt);
        const char* nA = has_next ? (const char*)g.A + (size_t)nxt.pm * tstep : cA; const char* nB = has_next ? (const char*)g.Bt + (size_t)nxt.pn * tstep : cB;
        for (int t = 0; t < nt; t += 2) {
            const bool last = (t == nt - 2);
            const char* a1 = cA + (size_t)(t + 1) * kstep;
            const char* a2 = last ? nA : cA + (size_t)(t + 2) * kstep; const char* b2 = last ? nB : cB + (size_t)(t + 2) * kstep;
            const char* a3 = a2 + kstep; const char* b3 = b2 + kstep;
            if (last && has_next) S.a_ready(nxt);
            if constexpr (epi_midk<Epi>::value > 0) { if (t > 0 && (t % epi_midk<Epi>::value) == 0) { PG8_SCHED; E.mid(acc, cur, t / epi_midk<Epi>::value, wr, wc, fr, fq); PG8_SCHED; } }
            if constexpr (SP2) {
            PG8_LDB(B0, 0, 0); PG8_LDB(B1, 0, 1); PG8_SCHED; PG8_LDA(At, 0, 0); PG8_STAGE(PG8_SA(1, 1), a1 + hstep, voffA);
            PG8_WAIT_V(8); PG8_WAIT_L(0); PG8_BAR; PG8_MMA(0, 0, At, B0); PG8_MMA(0, 1, At, B1); PG8_BAR; PG8_SCHED;
            PG8_LDA(At, 0, 1); PG8_STAGE(PG8_SB(0, 0), b2, voffB); PG8_STAGE(PG8_SB(0, 1), b2 + hstep, voffB); PG8_STAGE(PG8_SA(0, 0), a2, voffA);
            PG8_WAIT_V(8); PG8_WAIT_L(0); PG8_BAR; PG8_MMA(1, 0, At, B0); PG8_MMA(1, 1, At, B1); PG8_BAR; PG8_SCHED;
            PG8_LDB(B0, 1, 0); PG8_LDB(B1, 1, 1); PG8_SCHED; PG8_LDA(At, 1, 0); PG8_STAGE(PG8_SA(0, 1), a2 + hstep, voffA);
            PG8_WAIT_V(8); PG8_WAIT_L(0); PG8_BAR; PG8_MMA(0, 0, At, B0); PG8_MMA(0, 1, At, B1); PG8_BAR; PG8_SCHED;
            PG8_LDA(At, 1, 1); PG8_STAGE(PG8_SB(1, 0), b3, voffB); PG8_STAGE(PG8_SB(1, 1), b3 + hstep, voffB); PG8_STAGE(PG8_SA(1, 0), a3, voffA);
            PG8_WAIT_V(8); PG8_WAIT_L(0); PG8_BAR; PG8_MMA(1, 0, At, B0); PG8_MMA(1, 1, At, B1); PG8_BAR; PG8_SCHED;
            } else {
            PG8_LDB(B0, 0, 0); PG8_SCHED; PG8_LDA(At, 0, 0); PG8_STAGE(PG8_SA(1, 1), a1 + hstep, voffA);
            PG8_WAIT_L(8); PG8_BAR; PG8_WAIT_L(0); PG8_MMA(0, 0, At, B0); PG8_BAR; PG8_SCHED;
            PG8_LDB(B1, 0, 1); PG8_STAGE(PG8_SB(0, 0), b2, voffB);
            PG8_BAR; PG8_WAIT_L(0); PG8_MMA(0, 1, At, B1); PG8_BAR;
            PG8_LDA(At, 0, 1); PG8_STAGE(PG8_SA(0, 0), a2, voffA);
            PG8_BAR; PG8_WAIT_L(0); PG8_MMA(1, 0, At, B0); PG8_BAR; PG8_SCHED;
            PG8_STAGE(PG8_SB(0, 1), b2 + hstep, voffB);
            PG8_WAIT_V(6); PG8_BAR; PG8_MMA(1, 1, At, B1); PG8_BAR;
            PG8_LDB(B0, 1, 0); PG8_SCHED; PG8_LDA(At, 1, 0); PG8_STAGE(PG8_SA(0, 1), a2 + hstep, voffA);
            PG8_WAIT_L(8); PG8_BAR; PG8_WAIT_L(0); PG8_MMA(0, 0, At, B0); PG8_BAR; PG8_SCHED;
            PG8_LDB(B1, 1, 1); PG8_STAGE(PG8_SB(1, 0), b3, voffB);
            PG8_BAR; PG8_WAIT_L(0); PG8_MMA(0, 1, At, B1); PG8_BAR;
            PG8_LDA(At, 1, 1); PG8_STAGE(PG8_SA(1, 0), a3, voffA);
            PG8_BAR; PG8_WAIT_L(0); PG8_MMA(1, 0, At, B0); PG8_BAR; PG8_SCHED;
            PG8_STAGE(PG8_SB(1, 1), b3 + hstep, voffB);
            PG8_WAIT_V(6); PG8_BAR; PG8_MMA(1, 1, At, B1); PG8_BAR;
            }
        }
        if constexpr (epi_fp8<Epi>::value) asm volatile("s_nop 15\n\ts_nop 15" ::: "memory");
        if constexpr (ALIGN_EPI) { if (wr == 0) PG8_BAR; }
        if constexpr (!Epi::AFTER_DRAIN) { E(acc, cur, wr, wc, fr, fq); S.done(cur); }
        if (!has_next) break;
#pragma unroll
        for (int a = 0; a < 2; ++a)
#pragma unroll
            for (int b = 0; b < 2; ++b)
#pragma unroll
                for (int m = 0; m < 4; ++m)
#pragma unroll
                    for (int n = 0; n < 2; ++n) acc[a][b][m][n] = (f32x4){0.f, 0.f, 0.f, 0.f};
        cur = nxt; cA = nA; cB = nB; ++ui;
        if constexpr (ALIGN_EPI) { if (wr == 1) PG8_BAR; }
    }
    PG8_WAIT_V(0);
    if constexpr (!ALIGN_EPI) { if (wr == 0) PG8_BAR; }
    PG8_BAR;
    if constexpr (Epi::AFTER_DRAIN) { E.fused(acc, cur, wr, wc, fr, fq, lds, wid, lane); S.done(cur); }
#undef PG8_SA
#undef PG8_SB
#undef PG8_STAGE
#undef PG8_LDA
#undef PG8_LDB
#undef PG8_MMA
#undef PG8_WAIT_V
#undef PG8_WAIT_L
#undef PG8_BAR
#undef PG8_SCHED
}
}
#ifndef VD_DIRECT
#define VD_DIRECT 1
#endif
constexpr int NWAVES = 8;
constexpr int BATCH = 2, SEQ = 8192, DM = 4096, DFF = 11008, MTOK = BATCH * SEQ;
constexpr int MEMLEN = 256, MROWS = BATCH * MEMLEN;
constexpr float EPS = 1e-6f;
constexpr int NF8 = 7936, NIDX = 2304, NPC = NF8 + NIDX;
constexpr int PC_CQ = 0, PC_CKV = 1536, PC_QD = 2048, PC_KD = 3584, PC_VD = 5120, PC_QM = 6656, PC_KR = 7680, PC_QI = NF8, PC_KI = NF8 + 2048, PC_WI = NF8 + 2112;
constexpr int NGC = 3 * DM;
constexpr int NGU = 2 * DFF;
constexpr int KCAT = 4096;
constexpr float LOG2E = 1.4426950408889634f;
constexpr float QS_MLA = 0.07216878364870322f * LOG2E;
constexpr float QS_DSA = 0.08838834764831845f * LOG2E;
constexpr float QS_MEM = 0.0625f * LOG2E;
constexpr float WG_SCALE = 64.0f, WIN_SCALE = 64.0f, WUQ_SCALE = 32.0f, WUKV_SCALE = 16.0f, WO_SCALE = 32.0f, WOUT_SCALE = 64.0f, Y_SCALE = 16.0f, GS_SCALE = 16.0f, H_SCALE = 8.0f, WD_SCALE = 64.0f;
constexpr float WGU_I8_SCALE = 1625.0f;
constexpr float WG_SCALE_UNUSED = 0.f;
constexpr float LOG2_THETA = 18.931568569324174f;

constexpr size_t MiB = 1u << 20;
constexpr size_t WS_CTL = 0, CTL_ZERO_BYTES = 1 * MiB;
constexpr size_t WS_WGU = 1 * MiB;
constexpr size_t WS_WD = 173 * MiB;
constexpr size_t WS_SC = 1 * MiB;
constexpr size_t WS_WIN = 259 * MiB;
constexpr size_t WS_WINI = 290 * MiB;
constexpr size_t WS_WG8 = 337 * MiB;
constexpr size_t WS_WUQ = 433 * MiB, WS_WUKV = 440 * MiB, WS_WMKV = 443 * MiB, WS_WOCAT = 459 * MiB  , WS_WOUT = 495 * MiB;
constexpr size_t WS_A = 527 * MiB;
constexpr size_t WS_BIG = 655 * MiB;
constexpr size_t WS_HMID8 = 999 * MiB;
constexpr size_t WS_WD8 = 87 * MiB;
constexpr size_t WS_HMID = WS_BIG;
constexpr size_t WS_G = WS_BIG;
constexpr size_t WS_P = 1039 * MiB;
constexpr size_t WS_QMLARAW = 1039 * MiB, WS_KVRAW = 1111 * MiB, WS_QMLA = 1207 * MiB, WS_KMLA = 1279 * MiB;
constexpr size_t WS_CQN = 1359 * MiB, WS_CKVN = 1407 * MiB, WS_QD = 1423 * MiB, WS_KD = 1471 * MiB, WS_VD = 1519 * MiB, WS_QI = 1567 * MiB, WS_KI = 1631 * MiB, WS_WI = 1633 * MiB, WS_KR = 1635 * MiB, WS_QM = 1637 * MiB;
constexpr size_t WS_YCAT = 1669 * MiB  , WS_MEMN = 1741 * MiB, WS_MKVRAW = 1745 * MiB, WS_MEMK = 1747 * MiB, WS_RS1 = 1748 * MiB  , WS_END = 1749 * MiB;
constexpr size_t WS_HN8 = WS_YCAT;
constexpr size_t WS_BM = WS_CQN;
constexpr size_t SC_BATCH = (size_t)4096 * 8256;
static_assert(WS_SC + 2 * SC_BATCH * 4 <= WS_WIN, "scores fit the FFN weight region");
static_assert(WS_WGU + (size_t)NGU * DM * 2 <= WS_WD && WS_WD + (size_t)DM * DFF * 2 <= WS_WIN, "FFN weights");
static_assert(WS_WIN + (size_t)NF8 * DM <= WS_WINI && WS_WINI + (size_t)NIDX * DM * 2 <= WS_WG8 && WS_WG8 + (size_t)NGC * DM <= WS_WUQ, "win");
static_assert(WS_HMID + (size_t)MTOK * DFF * 2 <= WS_P && WS_G + (size_t)MTOK * NGC * 2 <= WS_P && WS_P + (size_t)MTOK * NPC * 2 <= WS_CQN, "big region");
constexpr int CW_BAR = 4096, CW_QUEUE = 8192;

constexpr int RING_BYTES = 131072, MISC_OFF = RING_BYTES, LDS_BYTES = 147456;

#define GAS __attribute__((address_space(1)))
#define LAS __attribute__((address_space(3)))
#define DI __device__ __forceinline__
typedef unsigned short bf16;
typedef unsigned v4u __attribute__((ext_vector_type(4)));
typedef unsigned v2u __attribute__((ext_vector_type(2)));
typedef float f32x4 __attribute__((ext_vector_type(4)));
typedef float f32x16 __attribute__((ext_vector_type(16)));
typedef short bf16x8 __attribute__((ext_vector_type(8)));
typedef short s16x4 __attribute__((ext_vector_type(4)));
#define LDS_WAIT() asm volatile("s_waitcnt lgkmcnt(0)" ::: "memory")
DI float bf2f(bf16 v) { return __uint_as_float(((unsigned)v) << 16); }
DI unsigned f2bf(float f) { unsigned u = __float_as_uint(f); return (u + 0x7fffu + ((u >> 16) & 1u)) >> 16; }
DI unsigned pk2(float lo, float hi) { return f2bf(lo) | (f2bf(hi) << 16); }
DI float wave_sum(float v) {
#pragma unroll
    for (int o = 1; o < 64; o <<= 1) v += __shfl_xor(v, o);
    return v;
}
DI void sincos_rev(float ang, float& s, float& c) {
    double rev = (double)ang * 0.15915494309189535; rev -= __builtin_rint(rev);
    const float fr = (float)rev; s = __builtin_amdgcn_sinf(fr); c = __builtin_amdgcn_cosf(fr);
}
DI float inv_freq(int i, int half) { return __builtin_amdgcn_exp2f(-(float)i * (LOG2_THETA / (float)half)); }
#define XB_TMO      128
#define XB_XCNT(j)  (256  + 64 * (j))
#define XB_XSUB(j)  (1280 + 64 * (j))
#define XB_XGEN(j)  (2304 + 64 * (j))
#define XB_TOP      3328
#define XB_TOPGEN   3392
#define XCD_BAR_WORDS 3456
#define XB_SPIN_CAP (1u << 18)

__device__ __forceinline__ unsigned xb_ld(unsigned* p)              { return __hip_atomic_load(p, __ATOMIC_RELAXED, __HIP_MEMORY_SCOPE_AGENT); }
__device__ __forceinline__ unsigned xb_add(unsigned* p, unsigned v) { return __hip_atomic_fetch_add(p, v, __ATOMIC_RELAXED, __HIP_MEMORY_SCOPE_AGENT); }
__device__ __forceinline__ unsigned xb_xcc_id() { return (unsigned)__builtin_amdgcn_s_getreg((3 << 11) | 20) & 0xFu; }
#define XB_SPIN(cond, bar) do { unsigned _sp = 0; while (cond) { __builtin_amdgcn_s_sleep(1); \
    if ((++_sp & 255u) == 0u) { if (xb_ld(&(bar)[XB_TMO])) break; if (_sp > XB_SPIN_CAP) { atomicAdd(&(bar)[XB_TMO], 1u); break; } } } } while (0)

struct XcdBarrier {
    unsigned* bar; unsigned x;
    volatile LAS unsigned* st;
};

__device__ __forceinline__ XcdBarrier xcd_barrier_post(unsigned* bar, volatile LAS unsigned* st) {
    XcdBarrier b; b.bar = bar; b.x = xb_xcc_id(); b.st = st;
    if (threadIdx.x == 0) (void)xb_add(&bar[XB_XCNT(b.x)], 1u);
    return b;
}
__device__ __forceinline__ void xcd_barrier_complete(unsigned* bar, unsigned x, unsigned& nloc, unsigned& nx) {
    const unsigned G = gridDim.x * gridDim.y * gridDim.z;
    unsigned sum, cnt, mine, sp = 0u;
    for (;;) {
        sum = 0u; cnt = 0u; mine = 0u;
#pragma unroll
        for (unsigned j = 0; j < 16; ++j) { const unsigned c = xb_ld(&bar[XB_XCNT(j)]); sum += c; cnt += (c > 0u) ? 1u : 0u; mine = (j == x) ? c : mine; }
        if (sum == G) break;
        __builtin_amdgcn_s_sleep(1);
        if ((++sp & 255u) == 0u) { if (xb_ld(&bar[XB_TMO])) break; if (sp > XB_SPIN_CAP) { atomicAdd(&bar[XB_TMO], 1u); break; } }
    }
    nloc = mine > 0u ? mine : 1u; nx = cnt > 0u ? cnt : 1u;
}

__device__ __forceinline__ void xcd_barrier(const XcdBarrier& b) {
    asm volatile("s_waitcnt vmcnt(0)" ::: "memory");
    __syncthreads();
    if (threadIdx.x == 0) {
        unsigned* bar = b.bar;
        __builtin_amdgcn_s_waitcnt(0);
        unsigned nloc = b.st[0], nx = b.st[1];
        if (nloc == 0u) { xcd_barrier_complete(bar, b.x, nloc, nx); b.st[0] = nloc; b.st[1] = nx; }
        const unsigned old = xb_add(&bar[XB_XSUB(b.x)], 1u);
        const unsigned gen = old / nloc;
        if (old + 1u == (gen + 1u) * nloc) {
            __builtin_amdgcn_fence(__ATOMIC_RELEASE, "agent");
            asm volatile("s_waitcnt vmcnt(0)" ::: "memory");
            const unsigned og = xb_add(&bar[XB_TOP], 1u);
            const unsigned tg = og / nx;
            if (og + 1u == (tg + 1u) * nx) xb_add(&bar[XB_TOPGEN], 1u);
            else XB_SPIN(xb_ld(&bar[XB_TOPGEN]) == tg, bar);
            __builtin_amdgcn_fence(__ATOMIC_ACQUIRE, "agent");
            xb_add(&bar[XB_XGEN(b.x)], 1u);
            asm volatile("s_waitcnt vmcnt(0)" ::: "memory");
        } else {
            XB_SPIN(xb_ld(&bar[XB_XGEN(b.x)]) == gen, bar);
            __builtin_amdgcn_fence(__ATOMIC_ACQUIRE, "agent");
            asm volatile("s_waitcnt vmcnt(0)" ::: "memory");
        }
    }
    __syncthreads();
}
struct Ctx {
    LAS unsigned char* lds;
    int tid, lane, wave, G, gw, NGW;
};
DI Ctx make_ctx(LAS unsigned char* lds) {
    int t = threadIdx.x; asm volatile("" : "+v"(t));
    Ctx C; C.lds = lds; C.tid = t; C.lane = t & 63; C.wave = __builtin_amdgcn_readfirstlane(t >> 6);
    C.G = gridDim.x; C.gw = blockIdx.x * 8 + C.wave; C.NGW = C.G * 8; return C;
}

DI unsigned pack_fp8x4(float a, float b, float c, float d) { int p = __builtin_amdgcn_cvt_pk_fp8_f32(a, b, 0, false); p = __builtin_amdgcn_cvt_pk_fp8_f32(c, d, p, true); return (unsigned)p; }
DI unsigned pack_i8x4(float a, float b, float c, float d) {
    const int ia = (int)__builtin_rintf(__builtin_amdgcn_fmed3f(a, -127.f, 127.f)), ib = (int)__builtin_rintf(__builtin_amdgcn_fmed3f(b, -127.f, 127.f));
    const int ic = (int)__builtin_rintf(__builtin_amdgcn_fmed3f(c, -127.f, 127.f)), id = (int)__builtin_rintf(__builtin_amdgcn_fmed3f(d, -127.f, 127.f));
    return (unsigned)(ia & 255) | ((unsigned)(ib & 255) << 8) | ((unsigned)(ic & 255) << 16) | ((unsigned)(id & 255) << 24); }
struct CvSrc { const float* p; unsigned ldw; bool zero; };
DI void cv_load(const CvSrc s, int lane, float (&v)[32]) {
    if (s.zero) {
#pragma unroll
        for (int i = 0; i < 32; ++i) v[i] = 0.f;
    } else {
        const unsigned loff = (unsigned)(lane >> 5) * s.ldw + (unsigned)(lane & 31);
        const float* rp = s.p;
#pragma unroll
        for (int i = 0; i < 32; ++i) { v[i] = rp[loff]; rp += 2 * s.ldw; }
    }
}
DI void cv_emit_bf16(const LAS float* scr, int lane, bf16* WT, size_t K, int drow0, int kcol) {
    const int c = lane & 7;
#pragma unroll
    for (int j = 0; j < 4; ++j) { const int n = (lane >> 3) + 8 * j; const LAS float* s = scr + (8 * c) * 33 + n;
        v4u o; o.x = pk2(s[0 * 33], s[1 * 33]); o.y = pk2(s[2 * 33], s[3 * 33]); o.z = pk2(s[4 * 33], s[5 * 33]); o.w = pk2(s[6 * 33], s[7 * 33]);
        *(GAS v4u*)(WT + (size_t)(drow0 + n) * K + kcol + 8 * c) = o; }
}
DI void cv_emit_f8(const LAS float* scr, int lane, unsigned char* WT, size_t K, int drow0, int kcol, float scale) {
    const int c = lane & 3;
#pragma unroll
    for (int j = 0; j < 2; ++j) { const int n = (lane >> 2) + 16 * j; const LAS float* s = scr + (16 * c) * 33 + n;
        v4u o;
#pragma unroll
        for (int w = 0; w < 4; ++w) o[w] = pack_fp8x4(s[(4 * w) * 33] * scale, s[(4 * w + 1) * 33] * scale, s[(4 * w + 2) * 33] * scale, s[(4 * w + 3) * 33] * scale);
        *(GAS v4u*)(WT + (size_t)(drow0 + n) * K + kcol + 16 * c) = o; }
}
DI void cv_emit_i8(const LAS float* scr, int lane, unsigned char* WT, size_t K, int drow0, int kcol, float scale) {
    const int c = lane & 3;
#pragma unroll
    for (int j = 0; j < 2; ++j) { const int n = (lane >> 2) + 16 * j; const LAS float* s = scr + (16 * c) * 33 + n;
        v4u o;
#pragma unroll
        for (int w = 0; w < 4; ++w) o[w] = pack_i8x4(s[(4 * w) * 33] * scale, s[(4 * w + 1) * 33] * scale, s[(4 * w + 2) * 33] * scale, s[(4 * w + 3) * 33] * scale);
        *(GAS v4u*)(WT + (size_t)(drow0 + n) * K + kcol + 16 * c) = o; }
}
template <class Dec, class Emit> DI void cv_runx(const Ctx& C, int first, int nitems, int stride, Dec dec, Emit emit) {
    LAS float* scr = (LAS float*)(C.lds + C.wave * 16384);
    LAS float* sw = scr + (C.lane >> 5) * 33 + (C.lane & 31);
    float v[32];
    int it = first;
    if (it < nitems) cv_load(dec(it), C.lane, v);
#pragma unroll 1
    while (it < nitems) {
#pragma unroll
        for (int i = 0; i < 32; ++i) sw[66 * i] = v[i];
        const int nit = it + stride;
        if (nit < nitems) cv_load(dec(nit), C.lane, v);
        LDS_WAIT(); asm volatile("" ::: "memory");
        emit(it, scr);
        LDS_WAIT(); asm volatile("" ::: "memory");
        it = nit;
    }
}
template <class Dec, class Emit> DI void cv_run(const Ctx& C, int nitems, Dec dec, Emit emit) { cv_runx(C, C.gw, nitems, C.NGW, dec, emit); }
constexpr int CONV_WOCAT_ITEMS = (KCAT / 64) * (DM / 32), CONV_WOUT_ITEMS = (DM / 64) * (DM / 32);
DI void conv_wocat(const Ctx& C, const float* womla, const float* wodsa, const float* womem, unsigned char* wt, int first = -1, int last = 0, int stride = 0) {
    constexpr int nblk = DM / 32, items = (KCAT / 64) * nblk;
    cv_runx(C, first < 0 ? C.gw : first, first < 0 ? items : last, first < 0 ? C.NGW : stride,
        [&](int it) -> CvSrc { const int kb = it / nblk, nb = it % nblk, k = 64 * kb;
            const float* w = (k < 1536) ? womla + (size_t)k * DM : (k < 3072) ? wodsa + (size_t)(k - 1536) * DM : (k < 4096) ? womem + (size_t)(k - 3072) * DM : womem;
            return CvSrc{w + 32 * nb, (unsigned)DM, k >= 4096}; },
        [&](int it, const LAS float* scr) { const int kb = it / nblk, nb = it % nblk; cv_emit_f8(scr, C.lane, wt, KCAT, 32 * nb, 64 * kb, WO_SCALE); });
}
DI void conv_plain8(const Ctx& C, const float* w, int K, int N, unsigned char* wt, float scale, int first = -1, int last = 0, int stride = 0) {
    const int nblk = N / 32, items = (K / 64) * nblk;
    cv_runx(C, first < 0 ? C.gw : first, first < 0 ? items : last, first < 0 ? C.NGW : stride,
        [&](int it) -> CvSrc { const int kb = it / nblk, nb = it % nblk; return CvSrc{w + (size_t)(64 * kb) * N + 32 * nb, (unsigned)N, false}; },
        [&](int it, const LAS float* scr) { const int kb = it / nblk, nb = it % nblk; cv_emit_f8(scr, C.lane, wt, (size_t)K, 32 * nb, 64 * kb, scale); });
}
DI int inproj_src(int d) {
    if (d < 2048) return d;
    if (d < 6656) return d + 64;
    if (d < 7680) return d + 2208;
    if (d < 7744) return d - 5632;
    if (d < NF8) return -1;
    if (d < NF8 + 2144) return d - NF8 + 6720;
    return -1;
}
constexpr int CONV_FFN_ITEMS = (DM / 64) * (NGU / 32) + (DFF / 64) * (DM / 32);
template <int F8, bool I8UP = false> DI void conv_ffn(const Ctx& C, const float* wg, const float* wu, const float* wd, bf16* WGUt, unsigned char* WDt, unsigned char* WDt8 = nullptr, int first = -1, int last = 0, int stride = 0) {
    constexpr int I_GU = (DM / 64) * (NGU / 32), I_D = (DFF / 64) * (DM / 32), NB_GU = NGU / 32, NB_D = DM / 32;
    static_assert(CONV_FFN_ITEMS == I_GU + I_D, "item count");
    cv_runx(C, first < 0 ? C.gw : first, first < 0 ? I_GU + I_D : last, first < 0 ? C.NGW : stride,
        [&](int it) -> CvSrc {
            if (it < I_GU) { const int kb = it / NB_GU, nb = it % NB_GU, n0 = nb * 32, pn = n0 >> 8, bj = (n0 >> 7) & 1, c = n0 & 127;
                return CvSrc{(bj ? wu : wg) + (size_t)(64 * kb) * DFF + 128 * pn + c, (unsigned)DFF, false}; }
            const int r = it - I_GU, kb = r / NB_D, nb = r % NB_D; return CvSrc{wd + (size_t)(64 * kb) * DM + 32 * nb, (unsigned)DM, false}; },
        [&](int it, const LAS float* scr) {
            if (it < I_GU) { const int kb = it / NB_GU, nb = it % NB_GU;
                if constexpr (I8UP) cv_emit_i8(scr, C.lane, (unsigned char*)WGUt, DM, 32 * nb, 64 * kb, WGU_I8_SCALE); else cv_emit_bf16(scr, C.lane, WGUt, DM, 32 * nb, 64 * kb); }
            else { const int r = it - I_GU, kb = r / NB_D, nb = r % NB_D;
                if constexpr (F8 == 1) cv_emit_f8(scr, C.lane, WDt, DFF, 32 * nb, 64 * kb, WD_SCALE);
                else { cv_emit_bf16(scr, C.lane, (bf16*)WDt, DFF, 32 * nb, 64 * kb);
                    if constexpr (F8 == 2) cv_emit_f8(scr, C.lane, WDt8, DFF, 32 * nb, 64 * kb, WD_SCALE); } } });
}
DI void conv_plain(const Ctx& C, const float* w, int K, int N, bf16* wt, int& base, int total_dummy) { (void)base; (void)total_dummy;
    const int nblk = N / 32, items = (K / 64) * nblk;
    cv_run(C, items,
        [&](int it) -> CvSrc { const int kb = it / nblk, nb = it % nblk; return CvSrc{w + (size_t)(64 * kb) * N + 32 * nb, (unsigned)N, false}; },
        [&](int it, const LAS float* scr) { const int kb = it / nblk, nb = it % nblk; cv_emit_bf16(scr, C.lane, wt, (size_t)K, 32 * nb, 64 * kb); });
}
DI void conv_win(const Ctx& C, const float* w_in, const float* w_gate, unsigned char* wt8, bf16* wti, unsigned char* wg8) {
    constexpr int nblk = NPC / 32, items = (DM / 64) * nblk, nblkg = NGC / 32, itemsg = (DM / 64) * nblkg;
    cv_run(C, items,
        [&](int it) -> CvSrc { const int kb = it / nblk, nb = it % nblk, sc = inproj_src(32 * nb); return CvSrc{w_in + (size_t)(64 * kb) * 9888 + (sc < 0 ? 0 : sc), 9888u, sc < 0}; },
        [&](int it, const LAS float* scr) { const int kb = it / nblk, nb = it % nblk, n0 = 32 * nb;
            if (n0 < NF8) cv_emit_f8(scr, C.lane, wt8, DM, n0, 64 * kb, WIN_SCALE); else cv_emit_bf16(scr, C.lane, wti, DM, n0 - NF8, 64 * kb); });
    cv_run(C, itemsg,
        [&](int it) -> CvSrc { const int kb = it / nblkg, nb = it % nblkg, gi = 32 * nb, br = gi / DM, col = gi % DM; return CvSrc{w_gate + (size_t)br * DM * DM + (size_t)(64 * kb) * DM + col, (unsigned)DM, false}; },
        [&](int it, const LAS float* scr) { const int kb = it / nblkg, nb = it % nblkg; cv_emit_f8(scr, C.lane, wg8, DM, 32 * nb, 64 * kb, WG_SCALE); });
}
DI void rms_row4096(const float* xrow, const float* g, bf16* orow, int lane) {
    const GAS f32x4* xr = (const GAS f32x4*)xrow + lane; const GAS f32x4* gr = (const GAS f32x4*)g + lane;
    f32x4 v[16]; float s = 0.f;
#pragma unroll
    for (int j = 0; j < 16; ++j) { v[j] = xr[64 * j]; s += (v[j].x * v[j].x + v[j].y * v[j].y) + (v[j].z * v[j].z + v[j].w * v[j].w); }
    const float rstd = rsqrtf(wave_sum(s) * (1.f / 4096.f) + EPS);
    GAS v2u* o8 = (GAS v2u*)orow + lane;
#pragma unroll
    for (int j = 0; j < 16; ++j) { const f32x4 gg = gr[64 * j]; v2u o; o.x = pk2(v[j].x * rstd * gg.x, v[j].y * rstd * gg.y); o.y = pk2(v[j].z * rstd * gg.z, v[j].w * rstd * gg.w); o8[64 * j] = o; }
}
DI void rms_row4096_dual(const float* xrow, const float* g, bf16* orow, unsigned char* orow8, int lane) {
    const GAS f32x4* xr = (const GAS f32x4*)xrow + lane; const GAS f32x4* gr = (const GAS f32x4*)g + lane;
    f32x4 v[16]; float s = 0.f;
#pragma unroll
    for (int j = 0; j < 16; ++j) { v[j] = xr[64 * j]; s += (v[j].x * v[j].x + v[j].y * v[j].y) + (v[j].z * v[j].z + v[j].w * v[j].w); }
    const float rstd = rsqrtf(wave_sum(s) * (1.f / 4096.f) + EPS);
    GAS v2u* o8 = (GAS v2u*)orow + lane; GAS unsigned* q8 = (GAS unsigned*)orow8 + lane;
#pragma unroll
    for (int j = 0; j < 16; ++j) { const f32x4 gg = gr[64 * j]; const float a = v[j].x * rstd * gg.x, b = v[j].y * rstd * gg.y, c = v[j].z * rstd * gg.z, d = v[j].w * rstd * gg.w;
        v2u o; o.x = pk2(a, b); o.y = pk2(c, d); o8[64 * j] = o; q8[64 * j] = pack_fp8x4(a, b, c, d); }
}
DI void rms_row4096_dual_add(const float* xrow, const bf16* drow, float dscale, float* x1row, const float* g, bf16* orow, unsigned char* orow8, int lane) {
    const GAS f32x4* xr = (const GAS f32x4*)xrow + lane; const GAS v2u* dr = (const GAS v2u*)drow + lane; const GAS f32x4* gr = (const GAS f32x4*)g + lane;
    f32x4 v[16]; v2u dd[16]; float s = 0.f;
#pragma unroll
    for (int j = 0; j < 16; ++j) { v[j] = xr[64 * j]; dd[j] = dr[64 * j]; }
    GAS f32x4* xo = (GAS f32x4*)x1row + lane;
#pragma unroll
    for (int j = 0; j < 16; ++j) { v[j].x += dscale * __uint_as_float(dd[j].x << 16); v[j].y += dscale * __uint_as_float(dd[j].x & 0xffff0000u); v[j].z += dscale * __uint_as_float(dd[j].y << 16); v[j].w += dscale * __uint_as_float(dd[j].y & 0xffff0000u);
        if (x1row) xo[64 * j] = v[j];
        s += (v[j].x * v[j].x + v[j].y * v[j].y) + (v[j].z * v[j].z + v[j].w * v[j].w); }
    const float rstd = rsqrtf(wave_sum(s) * (1.f / 4096.f) + EPS);
    GAS v2u* o8 = (GAS v2u*)orow + lane; GAS unsigned* q8 = (GAS unsigned*)orow8 + lane;
#pragma unroll
    for (int j = 0; j < 16; ++j) { const f32x4 gg = gr[64 * j]; const float a = v[j].x * rstd * gg.x, b = v[j].y * rstd * gg.y, c = v[j].z * rstd * gg.z, d = v[j].w * rstd * gg.w;
        v2u o; o.x = pk2(a, b); o.y = pk2(c, d); o8[64 * j] = o; q8[64 * j] = pack_fp8x4(a, b, c, d); }
}
DI void rms_rows_dual_add(const Ctx& C, const float* x, const bf16* d, float dscale, float* x1, const float* g, bf16* o, unsigned char* o8, int rows) {
    for (int m = C.gw; m < rows; m += C.NGW) rms_row4096_dual_add(x + (size_t)m * DM, d + (size_t)m * DM, dscale, x1 ? x1 + (size_t)m * DM : nullptr, g, o + (size_t)m * DM, o8 + (size_t)m * DM, C.lane);
}
DI void rms_rows_dual(const Ctx& C, const float* x, const float* g, bf16* o, unsigned char* o8, int rows) {
    for (int m = C.gw; m < rows; m += C.NGW) rms_row4096_dual(x + (size_t)m * DM, g, o + (size_t)m * DM, o8 + (size_t)m * DM, C.lane);
}
DI void rms_row4096_i8(const float* xrow, const float* g, unsigned char* orow, float* rowscale, float wscale, int lane) {
    const GAS f32x4* xr = (const GAS f32x4*)xrow + lane; const GAS f32x4* gr = (const GAS f32x4*)g + lane;
    f32x4 v[16]; float s = 0.f;
#pragma unroll
    for (int j = 0; j < 16; ++j) { v[j] = xr[64 * j]; s += (v[j].x * v[j].x + v[j].y * v[j].y) + (v[j].z * v[j].z + v[j].w * v[j].w); }
    const float rstd = rsqrtf(wave_sum(s) * (1.f / 4096.f) + EPS);
    float am = 0.f;
#pragma unroll
    for (int j = 0; j < 16; ++j) { const f32x4 gg = gr[64 * j]; v[j] = v[j] * rstd * gg; am = fmaxf(am, fmaxf(fmaxf(__builtin_fabsf(v[j].x), __builtin_fabsf(v[j].y)), fmaxf(__builtin_fabsf(v[j].z), __builtin_fabsf(v[j].w)))); }
#pragma unroll
    for (int o = 1; o < 64; o <<= 1) am = fmaxf(am, __shfl_xor(am, o));
    am = fmaxf(am, 1e-20f);
    const float q = 127.f / am;
    GAS unsigned* q8 = (GAS unsigned*)orow + lane;
#pragma unroll
    for (int j = 0; j < 16; ++j) q8[64 * j] = pack_i8x4(v[j].x * q, v[j].y * q, v[j].z * q, v[j].w * q);
    if (lane == 0) *rowscale = am / (127.f * wscale);
}
DI void rms_row4096_i8_add(const float* xrow, const bf16* drow, const float* g, unsigned char* orow, float* rowscale, float wscale, int lane, bf16* x2row = nullptr, const bf16* d1row = nullptr, float d1scale = 0.f) {
    const GAS f32x4* xr = (const GAS f32x4*)xrow + lane; const GAS v2u* dr = (const GAS v2u*)drow + lane; const GAS f32x4* gr = (const GAS f32x4*)g + lane;
    f32x4 v[16]; v2u dd[16]; float s = 0.f;
#pragma unroll
    for (int j = 0; j < 16; ++j) { v[j] = xr[64 * j]; dd[j] = dr[64 * j]; }
    if (d1row) { const GAS v2u* d1r = (const GAS v2u*)d1row + lane; v2u d1[16];
#pragma unroll
        for (int j = 0; j < 16; ++j) d1[j] = d1r[64 * j];
#pragma unroll
        for (int j = 0; j < 16; ++j) { v[j].x += d1scale * __uint_as_float(d1[j].x << 16); v[j].y += d1scale * __uint_as_float(d1[j].x & 0xffff0000u); v[j].z += d1scale * __uint_as_float(d1[j].y << 16); v[j].w += d1scale * __uint_as_float(d1[j].y & 0xffff0000u); } }
#pragma unroll
    for (int j = 0; j < 16; ++j) { v[j].x += __uint_as_float(dd[j].x << 16); v[j].y += __uint_as_float(dd[j].x & 0xffff0000u); v[j].z += __uint_as_float(dd[j].y << 16); v[j].w += __uint_as_float(dd[j].y & 0xffff0000u);
        if (x2row) { v2u o; o.x = pk2(v[j].x, v[j].y); o.y = pk2(v[j].z, v[j].w); ((GAS v2u*)x2row + lane)[64 * j] = o; }
        s += (v[j].x * v[j].x + v[j].y * v[j].y) + (v[j].z * v[j].z + v[j].w * v[j].w); }
    const float rstd = rsqrtf(wave_sum(s) * (1.f / 4096.f) + EPS);
    float am = 0.f;
#pragma unroll
    for (int j = 0; j < 16; ++j) { const f32x4 gg = gr[64 * j]; v[j] = v[j] * rstd * gg; am = fmaxf(am, fmaxf(fmaxf(__builtin_fabsf(v[j].x), __builtin_fabsf(v[j].y)), fmaxf(__builtin_fabsf(v[j].z), __builtin_fabsf(v[j].w)))); }
#pragma unroll
    for (int o = 1; o < 64; o <<= 1) am = fmaxf(am, __shfl_xor(am, o));
    am = fmaxf(am, 1e-20f);
    const float q = 127.f / am;
    GAS unsigned* q8 = (GAS unsigned*)orow + lane;
#pragma unroll
    for (int j = 0; j < 16; ++j) q8[64 * j] = pack_i8x4(v[j].x * q, v[j].y * q, v[j].z * q, v[j].w * q);
    if (lane == 0) *rowscale = am / (127.f * wscale);
}
DI void rms_rows_i8_add(const Ctx& C, const float* x, const bf16* d, const float* g, unsigned char* o, float* rowscale, float wscale, int rows, bf16* x2 = nullptr, const bf16* d1 = nullptr, float d1scale = 0.f) {
    for (int m = C.gw; m < rows; m += C.NGW) rms_row4096_i8_add(x + (size_t)m * DM, d + (size_t)m * DM, g, o + (size_t)m * DM, rowscale + m, wscale, C.lane, x2 ? x2 + (size_t)m * DM : nullptr, d1 ? d1 + (size_t)m * DM : nullptr, d1scale);
}
DI void rms_rows_i8(const Ctx& C, const float* x, const float* g, unsigned char* o, float* rowscale, float wscale, int rows) {
    for (int m = C.gw; m < rows; m += C.NGW) rms_row4096_i8(x + (size_t)m * DM, g, o + (size_t)m * DM, rowscale + m, wscale, C.lane);
}
DI void rms_rows(const Ctx& C, const float* x, const float* g, bf16* o, int rows) {
    for (int m = C.gw; m < rows; m += C.NGW) rms_row4096(x + (size_t)m * DM, g, o + (size_t)m * DM, C.lane);
}

struct PP1 { const bf16* P; const int* pos; const float *g_cq, *g_ckv, *g_qd, *g_kd, *g_qm;
             unsigned char *CQn, *CKVn; bf16 *Qd, *Kd, *Vd, *Qi, *Ki, *Kr, *Qm; float* Wi; unsigned char* Ycat; };
DI void unpack8(const v4u w, float (&f)[8]) {
#pragma unroll
    for (int k = 0; k < 4; ++k) { f[2 * k] = __uint_as_float(w[k] << 16); f[2 * k + 1] = __uint_as_float(w[k] & 0xffff0000u); }
}
DI unsigned cvtpk_rne(float lo, float hi) { unsigned r; asm volatile("v_cvt_pk_bf16_f32 %0, %1, %2" : "=v"(r) : "v"(lo), "v"(hi)); return r; }
DI v4u pack8(const float (&f)[8]) { v4u w; w.x = cvtpk_rne(f[0], f[1]); w.y = cvtpk_rne(f[2], f[3]); w.z = cvtpk_rne(f[4], f[5]); w.w = cvtpk_rne(f[6], f[7]); return w; }
DI float sumsq8(const float (&f)[8]) { float s = 0.f;
#pragma unroll
    for (int e = 0; e < 8; ++e) s += f[e] * f[e];
    return s; }
DI void load8f(const float* p, float (&f)[8]) { const f32x4 a = *(const f32x4*)p, b = *(const f32x4*)(p + 4); f[0] = a.x; f[1] = a.y; f[2] = a.z; f[3] = a.w; f[4] = b.x; f[5] = b.y; f[6] = b.z; f[7] = b.w; }
DI void pp1_load(const PP1& A, int t, int lane, v4u (&R)[20], int& posi) {
    const bf16* pr = A.P + (size_t)t * NPC;
    posi = A.pos[t];
#pragma unroll
    for (int j = 0; j < 3; ++j) { R[j] = *(const v4u*)(pr + PC_CQ + 8 * (lane + 64 * j)); R[4 + j] = *(const v4u*)(pr + PC_QD + 8 * (lane + 64 * j));
        R[7 + j] = *(const v4u*)(pr + PC_KD + 8 * (lane + 64 * j));
#if !VD_DIRECT
        R[10 + j] = *(const v4u*)(pr + PC_VD + 8 * (lane + 64 * j));
#endif
    }
    R[3] = *(const v4u*)(pr + PC_CKV + 8 * lane);
#pragma unroll
    for (int j = 0; j < 4; ++j) R[13 + j] = *(const v4u*)(pr + PC_QI + 8 * (lane + 64 * j));
    R[17] = *(const v4u*)(pr + (lane < 8 ? PC_KR + 8 * lane : PC_KI + 8 * ((lane < 20 ? lane : 8) - 8)));
#pragma unroll
    for (int j = 0; j < 2; ++j) R[18 + j] = *(const v4u*)(pr + PC_QM + 8 * (lane + 64 * j));
}
DI void load8f_l(const LAS float* p, float (&f)[8]) { const f32x4 a = *(const LAS f32x4*)p, b = *(const LAS f32x4*)(p + 4); f[0] = a.x; f[1] = a.y; f[2] = a.z; f[3] = a.w; f[4] = b.x; f[5] = b.y; f[6] = b.z; f[7] = b.w; }
DI void pp1_token(const PP1& A, int t, int lane, LAS float* tab, const v4u (&R)[20], int posi, const LAS float* GL) {
    const float pos = (float)posi;
    {   float sn, cs;
        if (lane < 16) { sincos_rev(pos * inv_freq(lane, 16), sn, cs); tab[lane] = cs; tab[16 + lane] = sn; }
        else if (lane < 24) { sincos_rev(pos * inv_freq(lane - 16, 8), sn, cs); tab[32 + lane - 16] = cs; tab[40 + lane - 16] = sn; }
        LDS_WAIT(); }
    {
        float x[3][8]; float ss = 0.f;
#pragma unroll
        for (int j = 0; j < 3; ++j) { unpack8(R[j], x[j]); ss += sumsq8(x[j]); }
        const float rstd = rsqrtf(wave_sum(ss) * (1.f / 1536.f) + EPS);
#pragma unroll
        for (int j = 0; j < 3; ++j) { float g[8]; load8f_l(GL + 8 * (lane + 64 * j), g);
#pragma unroll
            for (int e = 0; e < 8; ++e) x[j][e] *= rstd * g[e];
            v2u w8; w8.x = pack_fp8x4(x[j][0], x[j][1], x[j][2], x[j][3]); w8.y = pack_fp8x4(x[j][4], x[j][5], x[j][6], x[j][7]);
            *(v2u*)(A.CQn + (size_t)t * 1536 + 8 * (lane + 64 * j)) = w8; }
    }
    {
        float x[8]; unpack8(R[3], x);
        const float rstd = rsqrtf(wave_sum(sumsq8(x)) * (1.f / 512.f) + EPS);
        float g[8]; load8f_l(GL + 1536 + 8 * lane, g);
#pragma unroll
        for (int e = 0; e < 8; ++e) x[e] *= rstd * g[e];
        v2u w8; w8.x = pack_fp8x4(x[0], x[1], x[2], x[3]); w8.y = pack_fp8x4(x[4], x[5], x[6], x[7]);
        *(v2u*)(A.CKVn + (size_t)t * 512 + 8 * lane) = w8;
    }
    {
        const int cc = lane & 15;
        float cs[8], sn[8];
#pragma unroll
        for (int e = 0; e < 8; ++e) { cs[e] = tab[8 * (cc & 1) + e]; sn[e] = tab[16 + 8 * (cc & 1) + e]; }
#pragma unroll
        for (int qk = 0; qk < 2; ++qk) {
            bf16* O = qk ? A.Kd : A.Qd; const float sc = qk ? 1.0f : QS_DSA;
            float g[8]; load8f_l(GL + 2048 + 128 * qk + 8 * cc, g);
#pragma unroll
            for (int j = 0; j < 3; ++j) {
                float x[8]; unpack8(R[4 + 3 * qk + j], x);
                float ss = sumsq8(x); ss += __shfl_xor(ss, 1); ss += __shfl_xor(ss, 2); ss += __shfl_xor(ss, 4); ss += __shfl_xor(ss, 8);
                const float rstd = rsqrtf(ss * (1.f / 128.f) + EPS);
#pragma unroll
                for (int e = 0; e < 8; ++e) x[e] *= rstd * g[e];
                float y[8];
#pragma unroll
                for (int e = 0; e < 8; ++e) { const float pv = __shfl_xor(x[e], 2); y[e] = (cc < 2) ? x[e] * cs[e] - pv * sn[e] : ((cc < 4) ? x[e] * cs[e] + pv * sn[e] : x[e]); y[e] *= sc; }
                *(v4u*)(O + (size_t)t * 1536 + 8 * (lane + 64 * j)) = pack8(y);
            }
        }
    }
    if constexpr (KCAT > 4096) *(v2u*)(A.Ycat + (size_t)t * KCAT + 4096 + 8 * lane) = (v2u){0u, 0u};
#if !VD_DIRECT
#pragma unroll
    for (int j = 0; j < 3; ++j) *(v4u*)(A.Vd + (size_t)t * 1536 + 8 * (lane + 64 * j)) = R[10 + j];
#endif
    {
        const int cc = lane & 7;
        float cs[8], sn[8];
#pragma unroll
        for (int e = 0; e < 8; ++e) { cs[e] = tab[32 + e]; sn[e] = tab[40 + e]; }
#pragma unroll
        for (int j = 0; j < 4; ++j) {
            float x[8]; unpack8(R[13 + j], x);
            float y[8];
#pragma unroll
            for (int e = 0; e < 8; ++e) { const float pv = __shfl_xor(x[e], 1); y[e] = (cc == 0) ? x[e] * cs[e] - pv * sn[e] : ((cc == 1) ? x[e] * cs[e] + pv * sn[e] : x[e]); }
            *(v4u*)(A.Qi + (size_t)t * 2048 + 8 * (lane + 64 * j)) = pack8(y);
        }
        float x[8]; unpack8(R[17], x);
        float y[8];
#pragma unroll
        for (int e = 0; e < 8; ++e) { const float pv = __shfl_xor(x[e], 1); y[e] = (lane == 8) ? x[e] * cs[e] - pv * sn[e] : ((lane == 9) ? x[e] * cs[e] + pv * sn[e] : x[e]); }
        if (lane < 8) *(v4u*)(A.Kr + (size_t)t * 64 + 8 * lane) = pack8(x);
        else if (lane < 16) *(v4u*)(A.Ki + (size_t)t * 64 + 8 * (lane - 8)) = pack8(y);
        else if (lane < 20) { float* wo = A.Wi + (size_t)t * 32 + 8 * (lane - 16); *(f32x4*)wo = (f32x4){x[0], x[1], x[2], x[3]}; *(f32x4*)(wo + 4) = (f32x4){x[4], x[5], x[6], x[7]}; }
    }
    {
        const int cc = lane & 31;
        float g[8]; load8f_l(GL + 2304 + 8 * cc, g);
#pragma unroll
        for (int j = 0; j < 2; ++j) {
            float x[8]; unpack8(R[18 + j], x);
            float ss = sumsq8(x); ss += __shfl_xor(ss, 1); ss += __shfl_xor(ss, 2); ss += __shfl_xor(ss, 4); ss += __shfl_xor(ss, 8); ss += __shfl_xor(ss, 16);
            const float rstd = rsqrtf(ss * (1.f / 256.f) + EPS) * QS_MEM;
#pragma unroll
            for (int e = 0; e < 8; ++e) x[e] *= rstd * g[e];
            *(v4u*)(A.Qm + (size_t)t * 1024 + 8 * (lane + 64 * j)) = pack8(x);
        }
    }
    LDS_WAIT();
}
struct PP2 { const bf16 *QmlaRaw, *KVraw, *Kr, *MKVraw; const int* pos; const float *g_q, *g_k, *g_km; bf16 *Qmla, *Kmla, *MemK; };
DI void pp2_token(const PP2& A, int t, int lane, LAS float* tab) {
    const float pos = (float)A.pos[t];
    if (lane < 32) { float sn, cs; sincos_rev(pos * inv_freq(lane, 32), sn, cs); tab[lane] = cs; tab[32 + lane] = sn; }
    LDS_WAIT();
    const int sub = lane & 7, slot = lane >> 3;
    float cs[8], sn[8], gq[3][8], gk[3][8], kr[8];
#pragma unroll
    for (int e = 0; e < 8; ++e) { cs[e] = tab[8 * (sub & 3) + e]; sn[e] = tab[32 + 8 * (sub & 3) + e]; }
#pragma unroll
    for (int j = 0; j < 3; ++j) { load8f(A.g_q + 64 * j + 8 * sub, gq[j]); load8f(A.g_k + 64 * j + 8 * sub, gk[j]); }
    unpack8(*(const v4u*)(A.Kr + (size_t)t * 64 + 8 * sub), kr);
#pragma unroll 1
    for (int pass = 0; pass < 2; ++pass) {
        const int h = 8 * pass + slot; const bool on = h < 12; const int hh = on ? h : 0;
#pragma unroll
        for (int qk = 0; qk < 2; ++qk) {
            float x[3][8];
            if (qk == 0) { const bf16* q = A.QmlaRaw + (size_t)t * 2304 + hh * 192;
#pragma unroll
                for (int j = 0; j < 3; ++j) unpack8(*(const v4u*)(q + 64 * j + 8 * sub), x[j]); }
            else { const bf16* kv = A.KVraw + (size_t)t * 3072 + hh * 256;
#pragma unroll
                for (int e = 0; e < 8; ++e) x[0][e] = kr[e];
                unpack8(*(const v4u*)(kv + 8 * sub), x[1]); unpack8(*(const v4u*)(kv + 64 + 8 * sub), x[2]); }
            float ss = sumsq8(x[0]) + sumsq8(x[1]) + sumsq8(x[2]); ss += __shfl_xor(ss, 1); ss += __shfl_xor(ss, 2); ss += __shfl_xor(ss, 4);
            const float rstd = rsqrtf(ss * (1.f / 192.f) + EPS), sc = qk ? 1.0f : QS_MLA;
#pragma unroll
            for (int j = 0; j < 3; ++j)
#pragma unroll
                for (int e = 0; e < 8; ++e) x[j][e] *= rstd * (qk ? gk[j][e] : gq[j][e]);
            float y[8];
#pragma unroll
            for (int e = 0; e < 8; ++e) { const float pv = __shfl_xor(x[0][e], 4); y[e] = ((sub < 4) ? x[0][e] * cs[e] - pv * sn[e] : x[0][e] * cs[e] + pv * sn[e]) * sc; }
#pragma unroll
            for (int e = 0; e < 8; ++e) { x[1][e] *= sc; x[2][e] *= sc; }
            if (on) { bf16* o = (qk ? A.Kmla : A.Qmla) + (size_t)t * 2304 + h * 192;
                *(v4u*)(o + 8 * sub) = pack8(y); *(v4u*)(o + 64 + 8 * sub) = pack8(x[1]); *(v4u*)(o + 128 + 8 * sub) = pack8(x[2]); }
        }
    }
    LDS_WAIT();
}
DI void pp2_memrow(const PP2& A, int r, int lane) {
#pragma unroll
    for (int h = 0; h < 4; ++h) {
        float x[4]; float ss = 0.f;
#pragma unroll
        for (int k = 0; k < 4; ++k) { x[k] = bf2f(A.MKVraw[(size_t)r * 2048 + h * 256 + lane + 64 * k]); ss += x[k] * x[k]; }
        const float rstd = rsqrtf(wave_sum(ss) * (1.f / 256.f) + EPS);
#pragma unroll
        for (int k = 0; k < 4; ++k) A.MemK[(size_t)r * 1024 + h * 256 + lane + 64 * k] = (bf16)f2bf(x[k] * rstd * A.g_km[lane + 64 * k]);
    }
}

#define MFMA32(a, b, c) __builtin_amdgcn_mfma_f32_32x32x16_bf16((a), (b), (c), 0, 0, 0)
DI float relu_asm(float x) { const int b = __float_as_int(x); return __int_as_float(b > 0 ? b : 0); }
DI float half_swap_sum(float v) { auto rr = __builtin_amdgcn_permlane32_swap(__float_as_uint(v), __float_as_uint(v), false, false); return __uint_as_float(rr[0]) + __uint_as_float(rr[1]); }
DI float half_swap_max(float v) { auto rr = __builtin_amdgcn_permlane32_swap(__float_as_uint(v), __float_as_uint(v), false, false); return fmaxf(__uint_as_float(rr[0]), __uint_as_float(rr[1])); }
DI size_t sc_block_off(int b, int bi) { return (size_t)b * SC_BATCH + (size_t)4096 * (size_t)(bi * (bi + 1) / 2); }
constexpr int IDX_KSTR = 144, IDX_TILE = 256 * IDX_KSTR;
DI void idx_item(int p, const bf16* Qi, const bf16* Ki, const float* Wi, float* Sc, LAS unsigned char* lds) {
    int tid_ = threadIdx.x; asm volatile("" : "+v"(tid_));
    const int tid = tid_, wave = __builtin_amdgcn_readfirstlane(tid >> 6), lane = tid & 63;
    const int b = p >> 7, r = p & 127, hs = r & 1, k = r >> 1, r32 = lane & 31, hi = lane >> 5;
    const int srow = tid >> 3, scc = tid & 7;
#pragma unroll 1
    for (int which = 0; which < 2; ++which) {
        const int bi = which ? 127 - k : k, ncol = (bi + 1) * 64, nT = (ncol + 255) >> 8;
        float* scb = Sc + sc_block_off(b, bi);
        const bf16* kbase = Ki + (size_t)(b * SEQ) * 64;
#pragma unroll 1
        for (int pass = 0; pass < 2; ++pass) {
            const int qa = 32 * hs + 4 * wave + 2 * pass, ta = b * SEQ + bi * 64 + qa;
            bf16x8 A0[4], A1[4]; f32x4 w0[4], w1[4];
#pragma unroll
            for (int d0 = 0; d0 < 4; ++d0) { A0[d0] = *(const bf16x8*)(Qi + (size_t)ta * 2048 + r32 * 64 + d0 * 16 + hi * 8); A1[d0] = *(const bf16x8*)(Qi + (size_t)(ta + 1) * 2048 + r32 * 64 + d0 * 16 + hi * 8); }
#pragma unroll
            for (int g = 0; g < 4; ++g) { w0[g] = *(const f32x4*)(Wi + (size_t)ta * 32 + 8 * g + 4 * hi); w1[g] = *(const f32x4*)(Wi + (size_t)(ta + 1) * 32 + 8 * g + 4 * hi); }
            float* o0 = scb + (size_t)qa * ncol + r32; float* o1 = o0 + ncol;
            v4u st[4];
#define IDX_GLOAD(T_) do { _Pragma("unroll") for (int i_ = 0; i_ < 4; ++i_) { const bf16* gp_ = kbase + (size_t)((T_) * 256 + srow + 64 * i_) * 64 + scc * 8; \
        asm volatile("global_load_dwordx4 %0, %1, off" : "=v"(st[i_]) : "v"(gp_) : "memory"); } } while (0)
#define IDX_LWRITE(buf_) do { _Pragma("unroll") for (int i_ = 0; i_ < 4; ++i_) *(LAS v4u*)(lds + (buf_) * IDX_TILE + (srow + 64 * i_) * IDX_KSTR + scc * 16) = st[i_]; } while (0)
#define IDX_LOADB(B, sub_) do { _Pragma("unroll") for (int d0_ = 0; d0_ < 4; ++d0_) B[d0_] = *(const LAS bf16x8*)(tb + ((sub_) * 32 + r32) * IDX_KSTR + d0_ * 32 + hi * 16); } while (0)
#define IDX_MMA(c0_, c1_, B) do { _Pragma("unroll") for (int i_ = 0; i_ < 16; ++i_) { c0_[i_] = 0.f; c1_[i_] = 0.f; } \
        _Pragma("unroll") for (int d0_ = 0; d0_ < 4; ++d0_) { c0_ = MFMA32(A0[d0_], B[d0_], c0_); c1_ = MFMA32(A1[d0_], B[d0_], c1_); } } while (0)
#define IDX_RELU(x_) relu_asm(x_)
#define IDX_EPI(c0_, c1_, col_) do { float s0_[4] = {0.f, 0.f, 0.f, 0.f}, s1_[4] = {0.f, 0.f, 0.f, 0.f};     \
        _Pragma("unroll") for (int i_ = 0; i_ < 16; ++i_) { s0_[i_ & 3] = fmaf(w0[i_ >> 2][i_ & 3], IDX_RELU(c0_[i_]), s0_[i_ & 3]); s1_[i_ & 3] = fmaf(w1[i_ >> 2][i_ & 3], IDX_RELU(c1_[i_]), s1_[i_ & 3]); } \
        float t0_ = (s0_[0] + s0_[1]) + (s0_[2] + s0_[3]), t1_ = (s1_[0] + s1_[1]) + (s1_[2] + s1_[3]); \
        t0_ = half_swap_sum(t0_); t1_ = half_swap_sum(t1_); if (hi == 0) { o0[(col_)] = t0_; o1[(col_)] = t1_; } } while (0)
            IDX_GLOAD(0); asm volatile("s_waitcnt vmcnt(0)" ::: "memory"); IDX_LWRITE(0);
            __syncthreads();
#pragma unroll 1
            for (int T = 0; T < nT; ++T) {
                if (T + 1 < nT) IDX_GLOAD(T + 1);
                const LAS unsigned char* tb = lds + (T & 1) * IDX_TILE;
                const int nsub = min(8, (ncol - T * 256) >> 5);
                bf16x8 BA[4], BB[4]; f32x16 cA0, cA1, cB0, cB1;
                IDX_LOADB(BA, 0); IDX_LOADB(BB, 1);
                IDX_MMA(cA0, cA1, BA);
#pragma unroll 1
                for (int sub = 0; sub < nsub; sub += 2) {
                    const bool more = sub + 2 < nsub;
                    IDX_MMA(cB0, cB1, BB);
                    if (more) IDX_LOADB(BA, sub + 2);
                    IDX_EPI(cA0, cA1, T * 256 + sub * 32);
                    if (more) { IDX_MMA(cA0, cA1, BA); IDX_LOADB(BB, sub + 3); }
                    IDX_EPI(cB0, cB1, T * 256 + sub * 32 + 32);
                }
                if (T + 1 < nT) { if (nsub == 8) asm volatile("s_waitcnt vmcnt(16)" ::: "memory"); else asm volatile("s_waitcnt vmcnt(0)" ::: "memory");
                    IDX_LWRITE((T + 1) & 1); }
                __syncthreads();
            }
#undef IDX_GLOAD
#undef IDX_LWRITE
#undef IDX_LOADB
#undef IDX_MMA
#undef IDX_EPI
#undef IDX_RELU
        }
    }
}
DI int suffix_scan64(int v, int lane) {
#pragma unroll
    for (int o = 1; o < 64; o <<= 1) { const int tv = __shfl_down(v, o); if (lane + o < 64) v += tv; }
    return v;
}
template <int NBITS, bool FIRST>
DI int radix_pass(const unsigned (&key)[128], int NG, int shift, unsigned& prefix, int& remaining, LAS unsigned* hist, int lane, unsigned floor_key = 0u) {
    constexpr int NB = 1 << NBITS, PER = NB / 64;
#pragma unroll
    for (int q = 0; q < PER / 4; ++q) *(LAS v4u*)(hist + PER * lane + 4 * q) = (v4u){0u, 0u, 0u, 0u};
#pragma unroll
    for (int g = 0; g < 8; ++g) {
        if (g < NG) {
#pragma unroll
            for (int r = 0; r < 16; ++r) { const unsigned k = key[16 * g + r];
                const unsigned dg = (k >> shift) & (unsigned)(NB - 1);
                if (FIRST) { if (k >= floor_key) __hip_atomic_fetch_add(hist + dg, 1u, __ATOMIC_RELAXED, __HIP_MEMORY_SCOPE_WORKGROUP); }
                else if ((k >> (shift + NBITS)) == prefix) __hip_atomic_fetch_add(hist + dg, 1u, __ATOMIC_RELAXED, __HIP_MEMORY_SCOPE_WORKGROUP); }
        }
    }
    LDS_WAIT();
    int lane_sum = 0;
#pragma unroll
    for (int q = 0; q < PER / 4; ++q) { const v4u bb = *(LAS v4u*)(hist + PER * lane + 4 * q); lane_sum += (int)(bb.x + bb.y + bb.z + bb.w); }
    const int S = suffix_scan64(lane_sum, lane), above = S - lane_sum;
    const int src = __builtin_amdgcn_readfirstlane((int)__ffsll((long long)__ballot((above < remaining) && (remaining <= S))) - 1) & 63;
    const int rem2 = remaining - __builtin_amdgcn_readlane(above, src);
    const int bv = (lane < PER) ? (int)hist[PER * src + lane] : 0;
    const int S2 = suffix_scan64(bv, lane), above2 = S2 - bv;
    const int src2 = __builtin_amdgcn_readfirstlane((int)__ffsll((long long)__ballot((above2 < rem2) && (rem2 <= S2))) - 1) & 63;
    prefix = (prefix << NBITS) | (unsigned)(PER * src + src2);
    remaining = rem2 - __builtin_amdgcn_readlane(above2, src2);
    const int cnt = __builtin_amdgcn_readlane(bv, src2);
    LDS_WAIT();
    return cnt;
}
DI void select_row(const float* Sc, unsigned long long* BM64, int t, int lane, LAS unsigned* hist, LAS unsigned long long* scr) {
    const int b = t / SEQ, s = t % SEQ, bi = s >> 6, n = (bi + 1) * 64;
    const float* row = Sc + sc_block_off(b, bi) + (size_t)(s & 63) * n;
    unsigned long long* out = BM64 + (size_t)t * 128;
    if (n <= 256) {
        out[lane] = (lane < n / 64) ? ~0ull : 0ull; out[64 + lane] = 0ull; return;
    }
    const int NG = (n + 1023) >> 10;
    unsigned key[128];
#pragma unroll
    for (int g = 0; g < 8; ++g) {
        if (g < NG) {
#pragma unroll
            for (int r = 0; r < 16; ++r) key[16 * g + r] = __float_as_uint(row[64 * (16 * g + r) + lane]);
        } else {
#pragma unroll
            for (int r = 0; r < 16; ++r) key[16 * g + r] = 0u;
        }
    }
#pragma unroll
    for (int g = 0; g < 8; ++g) {
        if (g < NG) {
#pragma unroll
            for (int r = 0; r < 16; ++r) { const int i = 16 * g + r; const unsigned u = key[i]; const unsigned kk = (u & 0x80000000u) ? ~u : (u | 0x80000000u); key[i] = (64 * i < n) ? kk : 0u; }
        }
    }
    unsigned cm0 = 0u, cm1 = 0u, cm2 = 0u, cm3 = 0u;
#pragma unroll
    for (int g = 0; g < 8; ++g) {
        if (g < NG) {
#pragma unroll
            for (int r = 0; r < 16; r += 4) { cm0 = max(cm0, key[16 * g + r]); cm1 = max(cm1, key[16 * g + r + 1]); cm2 = max(cm2, key[16 * g + r + 2]); cm3 = max(cm3, key[16 * g + r + 3]); }
        }
    }
    unsigned floor_key = min(min(cm0, cm1), min(cm2, cm3));
#pragma unroll
    for (int o = 1; o < 64; o <<= 1) floor_key = min(floor_key, (unsigned)__shfl_xor((int)floor_key, o));
    unsigned prefix = 0u; int remaining = 256;
    radix_pass<12, true>(key, NG, 20, prefix, remaining, hist, lane, floor_key);
    radix_pass<10, false>(key, NG, 10, prefix, remaining, hist, lane);
    const int cnt_eq = radix_pass<10, false>(key, NG, 0, prefix, remaining, hist, lane);
    const int need = remaining;
    if (cnt_eq == need) {
#pragma unroll
        for (int g = 0; g < 8; ++g) {
            if (g < NG) {
#pragma unroll
                for (int r = 0; r < 16; ++r) { const int i = 16 * g + r; const unsigned long long take = __ballot(key[i] >= prefix); if (lane == 0) scr[i] = take; }
            } else { if (lane < 16) scr[16 * g + lane] = 0ull; }
        }
    } else {
        int run = 0;
#pragma unroll
        for (int g = 0; g < 8; ++g) {
            if (g < NG) {
#pragma unroll
                for (int r = 0; r < 16; ++r) { const int i = 16 * g + r;
                    const bool gt = key[i] > prefix, eq = key[i] == prefix;
                    const unsigned long long eqb = __ballot(eq);
                    const int rank = run + (int)__builtin_amdgcn_mbcnt_hi((unsigned)(eqb >> 32), __builtin_amdgcn_mbcnt_lo((unsigned)eqb, 0u));
                    const unsigned long long take = __ballot(gt || (eq && rank < need));
                    run += __popcll(eqb);
                    if (lane == 0) scr[i] = take;
                    if ((r & 7) == 7) __builtin_amdgcn_sched_barrier(0); }
            } else { if (lane < 16) scr[16 * g + lane] = 0ull; }
        }
    }
    LDS_WAIT();
    const unsigned long long mine0 = scr[lane], mine1 = scr[64 + lane];
    out[lane] = mine0; out[64 + lane] = mine1;
    LDS_WAIT();
}
#ifndef ATT_LAZY
#define ATT_LAZY 2
#endif
#define ATT_TAU 8.0f
#ifndef ATT_PIPE
#define ATT_PIPE 1
#define ATT_PD 3
#endif
typedef short v4i16_t __attribute__((ext_vector_type(4)));
DI s16x4 vtr(const LAS unsigned char* p) { return __builtin_bit_cast(s16x4, __builtin_amdgcn_ds_read_tr16_b64_v4i16((LAS v4i16_t*)p)); }
DI unsigned cvtpk(float lo, float hi) { unsigned r; asm volatile("v_cvt_pk_bf16_f32 %0, %1, %2" : "=v"(r) : "v"(lo), "v"(hi)); return r; }
constexpr int VSTR = 320;
template <int DK> struct AttnLds { static constexpr int KSTR = DK * 2 + 16, KB = 64 * KSTR, VB = 64 * VSTR, K0 = 0, V0 = 2 * KB, TOTAL = 2 * KB + 2 * VB; };
static_assert(AttnLds<256>::TOTAL <= RING_BYTES, "attention LDS");

template <int DK, int MODE>
DI void attn_unit(LAS unsigned char* lds, const bf16* Qp, int LDQ, const bf16* Kp, int LDK, const bf16* Vp, int LDV, unsigned char* Op, int LDO, int NT, int chunk0, const unsigned* BMrow) {
    typedef AttnLds<DK> L;
    constexpr int ND = DK / 16, KCH = DK / 8, NKC = DK / 64;
    int tid_ = threadIdx.x; asm volatile("" : "+v"(tid_));
    const int tid = tid_, wid = __builtin_amdgcn_readfirstlane(tid >> 6), lane = tid & 63, r32 = lane & 31, hi = lane >> 5;
    const int mychunk = chunk0 + (wid >> 1);
    constexpr bool QLOOP = (DK > 192);
    bf16x8 qr[ND];
    const bf16* qw = Qp + (size_t)(wid * 32 + r32) * LDQ + hi * 8;
    if (!QLOOP) {
#pragma unroll
        for (int d0 = 0; d0 < ND; ++d0) qr[d0] = *(const bf16x8*)(qw + d0 * 16); }
    const unsigned* bmw = (MODE == 1) ? BMrow + (size_t)(wid * 32 + r32) * 256 : nullptr;
    int krow_[NKC], kcc_[NKC];
#pragma unroll
    for (int i = 0; i < NKC; ++i) { const int c = tid + 512 * i; krow_[i] = c / KCH; kcc_[i] = c % KCH; }
    const int vrow0 = tid >> 4, vcc = tid & 15;
    v4u kst[NKC], vst[2];
#define ATT_LOAD(j) do { const int key0_ = (j) * 64; \
        _Pragma("unroll") for (int i_ = 0; i_ < NKC; ++i_) kst[i_] = *(const v4u*)(Kp + (size_t)(key0_ + krow_[i_]) * LDK + kcc_[i_] * 8); \
        vst[0] = *(const v4u*)(Vp + (size_t)(key0_ + vrow0) * LDV + vcc * 8); vst[1] = *(const v4u*)(Vp + (size_t)(key0_ + 32 + vrow0) * LDV + vcc * 8); } while (0)
#define ATT_WRITE(buf) do { \
        _Pragma("unroll") for (int i_ = 0; i_ < NKC; ++i_) *(LAS v4u*)(lds + L::K0 + (buf) * L::KB + krow_[i_] * L::KSTR + kcc_[i_] * 16) = kst[i_]; \
        *(LAS v4u*)(lds + L::V0 + (buf) * L::VB + vrow0 * VSTR + vcc * 16) = vst[0]; *(LAS v4u*)(lds + L::V0 + (buf) * L::VB + (32 + vrow0) * VSTR + vcc * 16) = vst[1]; } while (0)
    float m_run = -1e30f, l_run = 0.f;
#if ATT_LAZY == 2
    float base = 0.f; f32x16 nbv;
#pragma unroll
    for (int i = 0; i < 16; ++i) nbv[i] = 0.f;
#endif
    f32x16 o[4];
#pragma unroll
    for (int d = 0; d < 4; ++d)
#pragma unroll
        for (int i = 0; i < 16; ++i) o[d][i] = 0.f;
    const int kbase = r32 * L::KSTR + hi * 16;
    const int q4 = (lane >> 2) & 3, p4 = lane & 3, blk = (lane >> 4) & 1;
    const int vbase = (4 * hi + q4) * VSTR + blk * 32 + p4 * 8;
    v2u mmn = {0xffffffffu, 0xffffffffu};
    if (MODE == 1) mmn = *(const v2u*)bmw;
    ATT_LOAD(0); ATT_WRITE(0);
    if (!QLOOP) {
#pragma unroll
        for (int d0 = 0; d0 < ND; ++d0) asm volatile("" :: "v"(qr[d0])); }
    __syncthreads();
#pragma unroll 1
    for (int j = 0; j < NT; ++j) {
        const int cur = j & 1;
        const bool active = (MODE == 2) || (j <= mychunk);
        const v2u mm = mmn;
        if (MODE == 1) { if (j + 1 < NT) mmn = *(const v2u*)(bmw + 2 * (j + 1)); }
        if (j + 1 < NT) ATT_LOAD(j + 1);
        const unsigned mw0 = mm.x >> (4 * hi), mw1 = mm.y >> (4 * hi);
        if (active) {
            f32x16 p0, p1;
#if ATT_LAZY != 2
#pragma unroll
            for (int i = 0; i < 16; ++i) { p0[i] = 0.f; p1[i] = 0.f; }
#endif
            const LAS unsigned char* kb = lds + L::K0 + cur * L::KB + kbase;
            const bf16* qwl = qw; if (QLOOP) asm volatile("" : "+v"(qwl));
#if ATT_PIPE
            constexpr int NS = 2 * ND;
            bf16x8 kf[ATT_PD + 1];
#define ATT_KLD(n_) (*(const LAS bf16x8*)(kb + ((n_) & 1) * 32 * L::KSTR + ((n_) >> 1) * 32))
#pragma unroll
            for (int n = 0; n < ATT_PD; ++n) kf[n] = ATT_KLD(n);
            __builtin_amdgcn_sched_barrier(0);
            bf16x8 qf = qr[0];
#pragma unroll
            for (int n = 0; n < NS; ++n) {
                if (n + ATT_PD < NS) kf[(n + ATT_PD) % (ATT_PD + 1)] = ATT_KLD(n + ATT_PD);
                if ((n & 1) == 0) qf = QLOOP ? *(const bf16x8*)(qwl + (n >> 1) * 16) : qr[n >> 1];
#if ATT_LAZY == 2
                if (n == 0) p0 = MFMA32(kf[0], qf, nbv); else if (n == 1) p1 = MFMA32(kf[1], qf, nbv); else
#endif
                if (n & 1) p1 = MFMA32(kf[n % (ATT_PD + 1)], qf, p1); else p0 = MFMA32(kf[n % (ATT_PD + 1)], qf, p0);
                __builtin_amdgcn_sched_barrier(0);
            }
#undef ATT_KLD
            const LAS unsigned char* vb = lds + L::V0 + cur * L::VB + vbase;
            s16x4 vlo[ATT_PD + 1], vhi[ATT_PD + 1];
#define ATT_VLD(n_) do { vlo[(n_) % (ATT_PD + 1)] = vtr(vb + (16 * ((n_) >> 2)) * VSTR + ((n_) & 3) * 64); vhi[(n_) % (ATT_PD + 1)] = vtr(vb + (16 * ((n_) >> 2) + 8) * VSTR + ((n_) & 3) * 64); } while (0)
#pragma unroll
            for (int n = 0; n < ATT_PD; ++n) ATT_VLD(n);
            __builtin_amdgcn_sched_barrier(0);
#else
#pragma unroll
            for (int d0 = 0; d0 < ND; ++d0) {
                const bf16x8 a0 = *(const LAS bf16x8*)(kb + d0 * 32), a1 = *(const LAS bf16x8*)(kb + 32 * L::KSTR + d0 * 32);
                const bf16x8 qf = QLOOP ? *(const bf16x8*)(qwl + d0 * 16) : qr[d0];
#if ATT_LAZY == 2
                if (d0 == 0) { p0 = MFMA32(a0, qf, nbv); p1 = MFMA32(a1, qf, nbv); } else { p0 = MFMA32(a0, qf, p0); p1 = MFMA32(a1, qf, p1); }
#else
                p0 = MFMA32(a0, qf, p0); p1 = MFMA32(a1, qf, p1);
#endif
                if ((d0 & 3) == 3) __builtin_amdgcn_sched_barrier(0);
            }
#endif
            if (MODE == 1) {
#pragma unroll
                for (int i = 0; i < 16; ++i) { const unsigned bit = 1u << ((i & 3) + 8 * (i >> 2));
                    p0[i] = (mw0 & bit) ? p0[i] : -INFINITY; p1[i] = (mw1 & bit) ? p1[i] : -INFINITY; }
            }
            float tmax = p0[0];
#pragma unroll
            for (int i = 1; i < 16; ++i) tmax = fmaxf(tmax, p0[i]);
#pragma unroll
            for (int i = 0; i < 16; ++i) tmax = fmaxf(tmax, p1[i]);
            tmax = half_swap_max(tmax);
#if ATT_LAZY == 0
            const float m_new = fmaxf(m_run, tmax), alpha = __builtin_amdgcn_exp2f(m_run - m_new);
            m_run = m_new;
            float ps = 0.f;
#pragma unroll
            for (int i = 0; i < 16; ++i) { p0[i] = __builtin_amdgcn_exp2f(p0[i] - m_new); ps += p0[i]; }
#pragma unroll
            for (int i = 0; i < 16; ++i) { p1[i] = __builtin_amdgcn_exp2f(p1[i] - m_new); ps += p1[i]; }
            ps = half_swap_sum(ps);
            l_run = l_run * alpha + ps;
            if (__any(alpha < 1.0f)) {
#pragma unroll
                for (int d = 0; d < 4; ++d)
#pragma unroll
                    for (int i = 0; i < 16; ++i) o[d][i] *= alpha;
            }
#elif ATT_LAZY == 1
            if (__any(tmax > m_run + ATT_TAU)) {
                const float m_new = fmaxf(m_run, tmax), alpha = __builtin_amdgcn_exp2f(m_run - m_new);
                m_run = m_new; l_run *= alpha;
#pragma unroll
                for (int d = 0; d < 4; ++d)
#pragma unroll
                    for (int i = 0; i < 16; ++i) o[d][i] *= alpha;
            }
            float ps = 0.f;
#pragma unroll
            for (int i = 0; i < 16; ++i) { p0[i] = __builtin_amdgcn_exp2f(p0[i] - m_run); ps += p0[i]; }
#pragma unroll
            for (int i = 0; i < 16; ++i) { p1[i] = __builtin_amdgcn_exp2f(p1[i] - m_run); ps += p1[i]; }
            ps = half_swap_sum(ps);
            l_run += ps;
#else
            if (__any(tmax + base > m_run + ATT_TAU)) {
                const float m_new = fmaxf(m_run, tmax + base), base_new = (m_new > -1e29f) ? m_new : 0.f, dlt = base_new - base, alpha = __builtin_amdgcn_exp2f(m_run - m_new);
#pragma unroll
                for (int i = 0; i < 16; ++i) { p0[i] -= dlt; p1[i] -= dlt; }
                m_run = m_new; base = base_new; l_run *= alpha;
#pragma unroll
                for (int i = 0; i < 16; ++i) nbv[i] = -base_new;
#pragma unroll
                for (int d = 0; d < 4; ++d)
#pragma unroll
                    for (int i = 0; i < 16; ++i) o[d][i] *= alpha;
            }
            float ps = 0.f;
#pragma unroll
            for (int i = 0; i < 16; ++i) { p0[i] = __builtin_amdgcn_exp2f(p0[i]); ps += p0[i]; }
#pragma unroll
            for (int i = 0; i < 16; ++i) { p1[i] = __builtin_amdgcn_exp2f(p1[i]); ps += p1[i]; }
            ps = half_swap_sum(ps);
            l_run += ps;
#endif
            bf16x8 pb[4];
#pragma unroll
            for (int s = 0; s < 4; ++s) { v4u w;
                if (s < 2) { w.x = cvtpk(p0[8 * s + 0], p0[8 * s + 1]); w.y = cvtpk(p0[8 * s + 2], p0[8 * s + 3]); w.z = cvtpk(p0[8 * s + 4], p0[8 * s + 5]); w.w = cvtpk(p0[8 * s + 6], p0[8 * s + 7]); }
                else { const int s2 = s - 2; w.x = cvtpk(p1[8 * s2 + 0], p1[8 * s2 + 1]); w.y = cvtpk(p1[8 * s2 + 2], p1[8 * s2 + 3]); w.z = cvtpk(p1[8 * s2 + 4], p1[8 * s2 + 5]); w.w = cvtpk(p1[8 * s2 + 6], p1[8 * s2 + 7]); }
                pb[s] = __builtin_bit_cast(bf16x8, w); }
#if ATT_PIPE
            __builtin_amdgcn_sched_barrier(0);
#pragma unroll
            for (int n = 0; n < 16; ++n) {
                if (n + ATT_PD < 16) ATT_VLD(n + ATT_PD);
                const s16x4 lo = vlo[n % (ATT_PD + 1)], hh = vhi[n % (ATT_PD + 1)];
                const bf16x8 va = (bf16x8){lo[0], lo[1], lo[2], lo[3], hh[0], hh[1], hh[2], hh[3]};
                o[n & 3] = MFMA32(va, pb[n >> 2], o[n & 3]);
                __builtin_amdgcn_sched_barrier(0);
            }
#undef ATT_VLD
#else
            const LAS unsigned char* vb = lds + L::V0 + cur * L::VB + vbase;
#pragma unroll
            for (int d0 = 0; d0 < 4; ++d0)
#pragma unroll
                for (int s = 0; s < 4; ++s) {
                    const s16x4 lo = vtr(vb + (16 * s) * VSTR + d0 * 64), hh = vtr(vb + (16 * s + 8) * VSTR + d0 * 64);
                    const bf16x8 va = (bf16x8){lo[0], lo[1], lo[2], lo[3], hh[0], hh[1], hh[2], hh[3]};
                    o[d0] = MFMA32(va, pb[s], o[d0]);
                    if (s == 3) __builtin_amdgcn_sched_barrier(0);
                }
#endif
        }
        if (j + 1 < NT) ATT_WRITE(cur ^ 1);
        __syncthreads();
    }
    const float rl = Y_SCALE / l_run;
    unsigned char* ow = Op + (size_t)(wid * 32 + r32) * LDO + 4 * hi;
#pragma unroll
    for (int d0 = 0; d0 < 4; ++d0)
#pragma unroll
        for (int g = 0; g < 4; ++g) *(unsigned*)(ow + 32 * d0 + 8 * g) = pack_fp8x4(o[d0][4 * g] * rl, o[d0][4 * g + 1] * rl, o[d0][4 * g + 2] * rl, o[d0][4 * g + 3] * rl);
#undef ATT_LOAD
#undef ATT_WRITE
}
#ifndef MK_MULTI
#define MK_MULTI 0
#endif
#ifndef DBG_SKIP_MIXER
#define DBG_SKIP_MIXER 0
#endif
#ifndef STAMP_A
#define STAMP_A -1
#define STAMP_B -1
#endif
#define CW_STAMP 12288
constexpr int NPH = 16;
#ifndef ATT_MASK
#define ATT_MASK 7
#endif
struct Args { const float* in[30]; float* out; unsigned char* ws; int ph_lo, ph_hi; };
static_assert(sizeof(Args) == 30 * 8 + 8 + 8 + 8, "no padding");

#ifndef FFN1_DOWN_FP8
#define FFN1_DOWN_FP8 0
#endif
#ifndef FFN2_DOWN_FP8
#define FFN2_DOWN_FP8 1
#define FFN2_F8_PANELS 64
#endif
#ifndef MEMKV_FP8
#define MEMKV_FP8 0
#endif
constexpr float WMKV_SCALE = 64.0f;
#ifndef FFN2_DOWN_CONV_IN_P14
#define FFN2_DOWN_CONV_IN_P14 1
#endif
#ifndef NO_X1
#define NO_X1 1
#endif
#define D1buf (NO_X1 ? (bf16*)XRES : Pbuf)
#ifndef X2_BF16
#define X2_BF16 1
#endif
#ifndef DEFER_FFN1_RESID
#define DEFER_FFN1_RESID 1
#endif
#ifndef DEFER_MIX_RESID
#define DEFER_MIX_RESID 1
#endif
#ifndef MEMKV_IN_P3
#define MEMKV_IN_P3 1
#endif
#ifndef FFN1_DOWN_CONV_IN_P1
#define FFN1_DOWN_CONV_IN_P1 1
#endif
#ifndef FFN2_CONV_IN_ATTN
#define FFN2_CONV_IN_ATTN 1
#endif
#ifndef FFN_UP_ALIGN
#define FFN_UP_ALIGN true
#endif
#ifndef FFN1_UP_I8
#define FFN1_UP_I8 true
#endif
#ifndef FFN2_UP_I8
#define FFN2_UP_I8 true
#endif
template <int F8, bool I8> DI void ffn_up_phase(LAS unsigned char* lds, const bf16* A, const bf16* WGUt, unsigned char* Hmid, int G, const float* rowscale, unsigned char* Hmid8 = nullptr) {
    pg8::Gemm g{A, WGUt, MTOK, NGU, I8 ? DM / 2 : DM}; pg8::StaticOrder S; S.init(MTOK, NGU, G, (int)blockIdx.x);
    pg8::EpiSwiGLU<F8, I8> E{Hmid, DFF, H_SCALE, rowscale, Hmid8, FFN2_F8_PANELS};
    pg8::gemm_phase<pg8::EpiSwiGLU<F8, I8>, pg8::StaticOrder, FFN_UP_ALIGN, true>(lds, g, S, E);
}
template <int F8> DI void ffn_down_phase(LAS unsigned char* lds, const unsigned char* Hmid, const unsigned char* WDt, const float* base, float* out, int G,
                                         const unsigned char* Hmid8 = nullptr, const unsigned char* WDt8 = nullptr, const bf16* addend = nullptr, bf16* defer = nullptr) {
    if constexpr (F8 == 1) {
        pg8::Gemm g{(const bf16*)Hmid, (const bf16*)WDt, MTOK, DM, DFF / 2}; pg8::StaticOrder S; S.init(MTOK, DM, G, (int)blockIdx.x);
        if (addend && !base) { pg8::EpiResid8B E{addend, out, DM, 0.5f / (H_SCALE * WD_SCALE)};
            pg8::gemm_phase<pg8::EpiResid8B, pg8::StaticOrder, true, true>(lds, g, S, E); }
        else if (addend) { pg8::EpiResid8A E{base, addend, out, DM, 0.5f / (H_SCALE * WD_SCALE)};
            pg8::gemm_phase<pg8::EpiResid8A, pg8::StaticOrder, true, true>(lds, g, S, E); }
        else { pg8::EpiResid8 E{base, out, DM, 0.5f / (H_SCALE * WD_SCALE)};
            pg8::gemm_phase<pg8::EpiResid8, pg8::StaticOrder, true, true>(lds, g, S, E); }
    } else if constexpr (F8 == 2) {
        constexpr int MS = FFN2_F8_PANELS * 256;
        { pg8::Gemm g{(const bf16*)Hmid8, (const bf16*)WDt8, MS, DM, DFF / 2}; pg8::StaticOrder S; S.init(MS, DM, G, (int)blockIdx.x);
          pg8::EpiResid8 E{base, out, DM, 0.5f / (H_SCALE * WD_SCALE)};
          pg8::gemm_phase<pg8::EpiResid8, pg8::StaticOrder, true, true>(lds, g, S, E); }
        { pg8::Gemm g{(const bf16*)Hmid + (size_t)MS * DFF, (const bf16*)WDt, MTOK - MS, DM, DFF}; pg8::StaticOrder S; S.init(MTOK - MS, DM, G, (int)blockIdx.x);
          pg8::EpiResid E{base + (size_t)MS * DM, out + (size_t)MS * DM, DM, 0.5f};
          pg8::gemm_phase<pg8::EpiResid, pg8::StaticOrder, true, true>(lds, g, S, E); }
    } else {
        pg8::Gemm g{(const bf16*)Hmid, (const bf16*)WDt, MTOK, DM, DFF}; pg8::StaticOrder S; S.init(MTOK, DM, G, (int)blockIdx.x);
        if (defer) { pg8::EpiPlain E{defer, DM};
            pg8::gemm_phase<pg8::EpiPlain, pg8::StaticOrder, true, true>(lds, g, S, E); }
        else { pg8::EpiResid E{base, out, DM, 0.5f};
            pg8::gemm_phase<pg8::EpiResid, pg8::StaticOrder, true, true>(lds, g, S, E); }
    }
}

__global__ void __launch_bounds__(NWAVES * 64, 2) mega_fwd(Args args) {
    extern __shared__ __attribute__((aligned(16))) unsigned char lds_raw[];
    LAS unsigned char* lds = (LAS unsigned char*)lds_raw;
    const int GRID = gridDim.x;
    const __attribute__((address_space(4))) unsigned char* ka = (const __attribute__((address_space(4))) unsigned char*)__builtin_amdgcn_kernarg_segment_ptr();
#define ARGQ(k) (*(void* const __attribute__((address_space(4)))*)(ka + 8 * (k)))
#define ARGP(k) ((const float*)ARGQ(k))
    unsigned char* ws = (unsigned char*)ARGQ(31);
    unsigned* ctl = (unsigned*)(ws + WS_CTL);
    volatile LAS unsigned* MISC = (volatile LAS unsigned*)(lds + MISC_OFF);
    for (int u = threadIdx.x; u < (LDS_BYTES - MISC_OFF) / 4; u += NWAVES * 64) ((LAS unsigned*)(lds + MISC_OFF))[u] = 0u;
    __syncthreads();
    const int lo = *(const __attribute__((address_space(4))) int*)(ka + 256), hi = *(const __attribute__((address_space(4))) int*)(ka + 260);
    XcdBarrier bar; bar.bar = ctl + CW_BAR; bar.x = 0; bar.st = nullptr;
    if (hi - lo > 1) bar = xcd_barrier_post(ctl + CW_BAR, MISC);
#ifndef PH_MASK
#define PH_MASK 0xffff
#endif
#define IN(k) ((((PH_MASK) >> (k)) & 1) && lo <= (k) && (k) < hi)
    if (STAMP_A >= 0 && blockIdx.x == 0 && threadIdx.x == 0) ctl[CW_STAMP] = (unsigned)__builtin_amdgcn_s_memrealtime();
#define SEAM(k) do { if (IN(k) && IN((k) + 1)) xcd_barrier(bar); if (STAMP_A >= 0 && blockIdx.x == 0 && threadIdx.x == 0) ctl[CW_STAMP + 2 * ((k) + 1)] = (unsigned)__builtin_amdgcn_s_memrealtime(); } while (0)
#ifndef REPEAT_MASK
#define REPEAT_MASK 0
#endif
#ifndef STAGGER_US
#define STAGGER_US 0
#define STAGGER_SHIFT 6
#endif
#define STAGGER() do { const unsigned sg_ = (blockIdx.x >> STAGGER_SHIFT) & 3u; if (STAGGER_US > 0 && sg_) { const unsigned long long t0_ = __builtin_amdgcn_s_memrealtime(); \
        while (__builtin_amdgcn_s_memrealtime() - t0_ < (unsigned long long)(sg_ * STAGGER_US * 100u)) __builtin_amdgcn_s_sleep(8); } } while (0)
#define NREP(k) (1 + (((REPEAT_MASK) >> (k)) & 1))
#define REPBAR(k) do { if (((REPEAT_MASK) >> (k)) & 1) xcd_barrier(bar); } while (0)

#define WGUt ((bf16*)(ws + WS_WGU))
#define WDt ((unsigned char*)(ws + WS_WD))
#define WINt ((unsigned char*)(ws + WS_WIN))
#define WINIt ((bf16*)(ws + WS_WINI))
#define WG8t ((unsigned char*)(ws + WS_WG8))
#define Hn8 ((unsigned char*)(ws + WS_HN8))
#define WUQt ((unsigned char*)(ws + WS_WUQ))
#define WUKVt ((unsigned char*)(ws + WS_WUKV))
#define WMKVt ((bf16*)(ws + WS_WMKV))
#define WOCATt ((unsigned char*)(ws + WS_WOCAT))
#define WOUTt ((unsigned char*)(ws + WS_WOUT))
#define Abuf ((bf16*)(ws + WS_A))
#define Hmid ((unsigned char*)(ws + WS_HMID))
#if GATES_U8
#define Gt ((unsigned char*)(ws + WS_G))
#else
#define Gt ((bf16*)(ws + WS_G))
#endif
#define Pbuf ((bf16*)(ws + WS_P))
#define QmlaRaw ((bf16*)(ws + WS_QMLARAW))
#define KVraw ((bf16*)(ws + WS_KVRAW))
#define Qmla ((bf16*)(ws + WS_QMLA))
#define Kmla ((bf16*)(ws + WS_KMLA))
#define CQn ((unsigned char*)(ws + WS_CQN))
#define CKVn ((unsigned char*)(ws + WS_CKVN))
#define Qd ((bf16*)(ws + WS_QD))
#define Kd ((bf16*)(ws + WS_KD))
#define Vd ((bf16*)(ws + WS_VD))
#define Qi ((bf16*)(ws + WS_QI))
#define Ki ((bf16*)(ws + WS_KI))
#define Wi ((float*)(ws + WS_WI))
#define Kr ((bf16*)(ws + WS_KR))
#define Qm ((bf16*)(ws + WS_QM))
#define Ycat ((unsigned char*)(ws + WS_YCAT))
#define BM ((unsigned*)(ws + WS_BM))
#define memn ((bf16*)(ws + WS_MEMN))
#define MKVraw ((bf16*)(ws + WS_MKVRAW))
#define MemK ((bf16*)(ws + WS_MEMK))
#define Sc ((float*)(ws + WS_SC))
#define X_IN (ARGP(0))
#define MEM_IN (ARGP(1))
#define POS_IN ((const int*)ARGP(2))
#define XRES ((float*)ARGQ(30))
    _Pragma("unroll") for (int rep_ = 0; rep_ < NREP(0); ++rep_) { if (rep_) REPBAR(0); if (IN(0)) { const Ctx C = make_ctx(lds);
#if FFN1_DOWN_CONV_IN_P1
        conv_ffn<FFN1_DOWN_FP8, FFN1_UP_I8>(C, ARGP(4), ARGP(5), ARGP(6), WGUt, WDt, nullptr, C.gw, (DM / 64) * (NGU / 32), C.NGW);
#else
        conv_ffn<FFN1_DOWN_FP8, FFN1_UP_I8>(C, ARGP(4), ARGP(5), ARGP(6), WGUt, WDt);
#endif
#if !DBG_SKIP_MIXER
        conv_win(C, ARGP(8), ARGP(24), WINt, WINIt, WG8t);
        int dummy = 0;
        conv_plain8(C, ARGP(10), 1536, 2304, WUQt, WUQ_SCALE);
        conv_plain8(C, ARGP(12), 512, 3072, WUKVt, WUKV_SCALE);
#if MEMKV_FP8
        conv_plain8(C, ARGP(18), 4096, 2048, (unsigned char*)WMKVt, WMKV_SCALE);
#else
        conv_plain(C, ARGP(18), 4096, 2048, WMKVt, dummy, 0);
#endif
#if !FFN2_CONV_IN_ATTN
        conv_wocat(C, ARGP(21), ARGP(22), ARGP(23), WOCATt);
        conv_plain8(C, ARGP(25), 4096, 4096, WOUTt, WOUT_SCALE);
#endif
#if MEMKV_FP8
        rms_rows_dual(C, MEM_IN, ARGP(17), memn, ws + WS_WMKV + 8 * MiB, MROWS);
#else
        rms_rows(C, MEM_IN, ARGP(17), memn, MROWS);
#endif
#endif
        if (FFN1_UP_I8) rms_rows_i8(C, X_IN, ARGP(3), (unsigned char*)Abuf, (float*)(ws + WS_RS1), WGU_I8_SCALE, MTOK);
        else rms_rows(C, X_IN, ARGP(3), Abuf, MTOK);
    }
    }
    SEAM(0);
    _Pragma("unroll") for (int rep_ = 0; rep_ < NREP(1); ++rep_) { if (rep_) REPBAR(1); if (IN(1)) { ffn_up_phase<FFN1_DOWN_FP8, FFN1_UP_I8>(lds, Abuf, WGUt, Hmid, GRID, (const float*)(ws + WS_RS1));
#if FFN1_DOWN_CONV_IN_P1
        constexpr int CW0 = MEMKV_IN_P3 ? 128 : 144;
        if ((int)blockIdx.x >= CW0) { const Ctx C = make_ctx(lds); __syncthreads();
            conv_ffn<FFN1_DOWN_FP8, FFN1_UP_I8>(C, ARGP(4), ARGP(5), ARGP(6), WGUt, WDt, nullptr, (DM / 64) * (NGU / 32) + ((int)blockIdx.x - CW0) * 8 + C.wave, CONV_FFN_ITEMS, (256 - CW0) * 8); __syncthreads(); }
#endif
#if MEMKV_IN_P3
        }
#elif MEMKV_FP8
        { pg8::Gemm g{(const bf16*)(ws + WS_WMKV + 8 * MiB), WMKVt, MROWS, 2048, DM / 2}; pg8::StaticOrder S; S.init(MROWS, 2048, GRID, (int)((blockIdx.x + 128u) % (unsigned)GRID)); pg8::EpiPlain8 E{MKVraw, 2048, 1.0f / WMKV_SCALE};
          pg8::gemm_phase<pg8::EpiPlain8, pg8::StaticOrder, true, true>(lds, g, S, E); } }
#else
        { pg8::Gemm g{memn, WMKVt, MROWS, 2048, DM}; pg8::StaticOrder S; S.init(MROWS, 2048, GRID, (int)((blockIdx.x + 128u) % (unsigned)GRID)); pg8::EpiPlain E{MKVraw, 2048};
          pg8::gemm_phase<pg8::EpiPlain, pg8::StaticOrder, true, true>(lds, g, S, E); } }
#endif
    }
    SEAM(1);
    _Pragma("unroll") for (int rep_ = 0; rep_ < NREP(2); ++rep_) { if (rep_) REPBAR(2); if (IN(2)) ffn_down_phase<FFN1_DOWN_FP8>(lds, Hmid, WDt, X_IN, XRES, GRID, nullptr, nullptr, nullptr, DEFER_FFN1_RESID ? D1buf : nullptr);
    }
    SEAM(2);
#if !DBG_SKIP_MIXER
#if MEMKV_IN_P3
    if (IN(3)) { if (blockIdx.x < 16) { pg8::Gemm g{memn, WMKVt, MROWS, 2048, DM}; pg8::StaticOrder S; S.init(MROWS, 2048, GRID, (int)blockIdx.x); pg8::EpiPlain E{MKVraw, 2048};
                                        pg8::gemm_phase<pg8::EpiPlain, pg8::StaticOrder, true, true>(lds, g, S, E); }
                 else { Ctx C = make_ctx(lds); C.gw -= 16 * 8; C.NGW -= 16 * 8;
                        if (DEFER_FFN1_RESID) rms_rows_dual_add(C, X_IN, D1buf, 0.5f, NO_X1 ? nullptr : XRES, ARGP(7), Abuf, Hn8, MTOK);
                        else rms_rows_dual(C, XRES, ARGP(7), Abuf, Hn8, MTOK); } }
#else
    if (IN(3)) { const Ctx C = make_ctx(lds); rms_rows_dual(C, XRES, ARGP(7), Abuf, Hn8, MTOK); }
#endif
    SEAM(3);
    _Pragma("unroll") for (int rep_ = 0; rep_ < NREP(4); ++rep_) { if (rep_) REPBAR(4); if (IN(4)) {
#if VD_DIRECT
        { pg8::Gemm g{(const bf16*)Hn8, (const bf16*)WINt, MTOK, NF8, DM / 2}; pg8::StaticOrder S; S.init(MTOK, NF8, GRID, (int)blockIdx.x);
          static_assert(PC_VD % 256 == 0 && PC_QM == PC_VD + 1536, "v_d block = whole column tiles");
          pg8::EpiPlain8R E{Pbuf, NPC, 1.0f / WIN_SCALE, Vd, 1536, PC_VD / 256, PC_QM / 256};
          pg8::gemm_phase<pg8::EpiPlain8R, pg8::StaticOrder, true, true>(lds, g, S, E); }
#else
        { pg8::Gemm g{(const bf16*)Hn8, (const bf16*)WINt, MTOK, NF8, DM / 2}; pg8::StaticOrder S; S.init(MTOK, NF8, GRID, (int)blockIdx.x); pg8::EpiPlain8 E{Pbuf, NPC, 1.0f / WIN_SCALE};
          pg8::gemm_phase<pg8::EpiPlain8, pg8::StaticOrder, true, true>(lds, g, S, E); }
#endif
        { pg8::Gemm g{Abuf, WINIt, MTOK, NIDX, DM}; pg8::StaticOrder S; S.init(MTOK, NIDX, GRID, (int)((blockIdx.x + 192u) % (unsigned)GRID)); pg8::EpiPlain E{Pbuf + NF8, NPC};
          pg8::gemm_phase<pg8::EpiPlain, pg8::StaticOrder, true, true>(lds, g, S, E); }
        { pg8::Gemm g{(const bf16*)Hn8, (const bf16*)WG8t, MTOK, NGC, DM / 2}; pg8::StaticOrder S; S.init(MTOK, NGC, GRID, (int)blockIdx.x); pg8::EpiGates8 E{Gt, NGC, 1.0f / WG_SCALE};
          pg8::gemm_phase<pg8::EpiGates8, pg8::StaticOrder, true, true>(lds, g, S, E); }
    }
    }
    SEAM(4);
    _Pragma("unroll") for (int rep_ = 0; rep_ < NREP(5); ++rep_) { if (rep_) REPBAR(5); if (IN(5)) { const Ctx C = make_ctx(lds);
        PP1 A{Pbuf, POS_IN, ARGP(9), ARGP(11), ARGP(15), ARGP(16), ARGP(19), CQn, CKVn, Qd, Kd, Vd, Qi, Ki, Kr, Qm, Wi, Ycat};
        LAS float* GL = (LAS float*)(lds + 4096);
        for (int i = C.tid; i < 2560; i += NWAVES * 64) GL[i] = i < 1536 ? A.g_cq[i] : i < 2048 ? A.g_ckv[i - 1536] : i < 2176 ? A.g_qd[i - 2048] : i < 2304 ? A.g_kd[i - 2176] : A.g_qm[i - 2304];
        __syncthreads();
        v4u R[20]; int posi = 0; int t = C.gw;
#pragma unroll
        for (int i = 0; i < 20; ++i) R[i] = (v4u){0u, 0u, 0u, 0u};
        if (t < MTOK) pp1_load(A, t, C.lane, R, posi);
#pragma unroll 1
        for (; t < MTOK; t += C.NGW) {
            v4u N[20]; int nposi = 0; const int nt = t + C.NGW;
#pragma unroll
            for (int i = 0; i < 20; ++i) N[i] = (v4u){0u, 0u, 0u, 0u};
            if (nt < MTOK) pp1_load(A, nt, C.lane, N, nposi);
            pp1_token(A, t, C.lane, (LAS float*)(lds + C.wave * 256), R, posi, GL);
#pragma unroll
            for (int i = 0; i < 20; ++i) R[i] = N[i];
            posi = nposi;
        }
        __syncthreads();
    }
    }
    SEAM(5);
    _Pragma("unroll") for (int rep_ = 0; rep_ < NREP(6); ++rep_) { if (rep_) REPBAR(6); if (IN(6)) {
        { pg8::Gemm g{(const bf16*)CQn, (const bf16*)WUQt, MTOK, 2304, 1536 / 2}; pg8::StaticOrder S; S.init(MTOK, 2304, GRID, (int)blockIdx.x); pg8::EpiPlain8 E{QmlaRaw, 2304, 1.0f / WUQ_SCALE};
          pg8::gemm_phase<pg8::EpiPlain8, pg8::StaticOrder, true, true>(lds, g, S, E); }
        if (GRID != 256 || blockIdx.x >= 64)
        { pg8::Gemm g{(const bf16*)CKVn, (const bf16*)WUKVt, MTOK, 3072, 512 / 2}; pg8::StaticOrder S;
          if (GRID == 256) S.init(MTOK, 3072, 192, (int)blockIdx.x - 64); else S.init(MTOK, 3072, GRID, (int)blockIdx.x);
          pg8::EpiPlain8 E{KVraw, 3072, 1.0f / WUKV_SCALE};
          pg8::gemm_phase<pg8::EpiPlain8, pg8::StaticOrder, true, true>(lds, g, S, E); }
        for (int p = blockIdx.x; p < 256; p += GRID) idx_item(p, Qi, Ki, Wi, Sc, lds);
    }
    }
    SEAM(6);
    _Pragma("unroll") for (int rep_ = 0; rep_ < NREP(7); ++rep_) { if (rep_) REPBAR(7); if (IN(7)) { const Ctx C = make_ctx(lds);
        PP2 A{QmlaRaw, KVraw, Kr, MKVraw, POS_IN, ARGP(13), ARGP(14), ARGP(20), Qmla, Kmla, MemK};
#pragma unroll 1
        for (int step = 0; step < 2; ++step) {
            if ((step ^ (int)(blockIdx.x & 1u)) == 0) {
                for (int t = C.gw; t < MTOK; t += C.NGW) pp2_token(A, t, C.lane, (LAS float*)(lds + C.wave * 256));
                for (int r = C.gw; r < MROWS; r += C.NGW) pp2_memrow(A, r, C.lane);
            } else {
                for (int t = C.gw; t < MTOK; t += C.NGW) select_row(Sc, (unsigned long long*)BM, t, C.lane, (LAS unsigned*)(lds + C.wave * 16384), (LAS unsigned long long*)(lds + MISC_OFF + 64 + C.wave * 1024));
            }
            __syncthreads();
        }
    }
    }
    SEAM(7);
    _Pragma("unroll") for (int rep_ = 0; rep_ < NREP(10); ++rep_) { if (rep_) REPBAR(10); if (IN(10)) {
        for (;;) {
            if (threadIdx.x == 0) MISC[4] = __hip_atomic_fetch_add(ctl + CW_QUEUE + 64 * rep_, 1u, __ATOMIC_RELAXED, __HIP_MEMORY_SCOPE_AGENT);
            __syncthreads();
            const int u0 = __builtin_amdgcn_readfirstlane((int)MISC[4]);
            __syncthreads();
#if FFN2_CONV_IN_ATTN
            if (u0 >= 2304) break;
            if (u0 < 2048 && (u0 & 7) == 7) { const int c = u0 >> 3; const Ctx C = make_ctx(lds);   constexpr int CVN = FFN2_DOWN_CONV_IN_P14 ? (DM / 64) * (NGU / 32) : CONV_FFN_ITEMS;        constexpr int PER = CVN / 256; static_assert(PER * 256 == CVN, "slices");
                conv_ffn<FFN2_DOWN_FP8, FFN2_UP_I8>(C, ARGP(27), ARGP(28), ARGP(29), WGUt, WDt, ws + WS_WD8, c * PER + C.wave, (c + 1) * PER, 8);
                constexpr int PWO = CONV_WOCAT_ITEMS / 256, PWT = CONV_WOUT_ITEMS / 256; static_assert(PWO * 256 == CONV_WOCAT_ITEMS && PWT * 256 == CONV_WOUT_ITEMS, "slices");
                conv_wocat(C, ARGP(21), ARGP(22), ARGP(23), WOCATt, c * PWO + C.wave, (c + 1) * PWO, 8);
                conv_plain8(C, ARGP(25), 4096, 4096, WOUTt, WOUT_SCALE, c * PWT + C.wave, (c + 1) * PWT, 8);
                continue; }
            const int u = u0 < 2048 ? u0 - (u0 >> 3) : u0 - 256;
#else
            const int u = u0;
            if (u >= 2048) break;
#endif
            if (u < 1536) {
                const int qt = 31 - u / 48, r = u % 48, type = r / 24, bh = r % 24, b = bh / 12, h = bh % 12;
                const size_t row0 = (size_t)b * SEQ + 256 * qt, krow0 = (size_t)b * SEQ;
                if (type == 0) attn_unit<192, 0>(lds, Qmla + row0 * 2304 + h * 192, 2304, Kmla + krow0 * 2304 + h * 192, 2304, KVraw + krow0 * 3072 + h * 256 + 128, 3072,
                                                 Ycat + row0 * KCAT + h * 128, KCAT, 4 * qt + 4, 4 * qt, nullptr);
                else attn_unit<128, 1>(lds, Qd + row0 * 1536 + h * 128, 1536, Kd + krow0 * 1536 + h * 128, 1536, Vd + krow0 * 1536 + h * 128, 1536,
                                       Ycat + row0 * KCAT + 1536 + h * 128, KCAT, 4 * qt + 4, 4 * qt, BM + row0 * 256);
            } else {
                const int v = u - 1536, b = v >> 8, h = (v >> 6) & 3, qt = (v >> 1) & 31, dvh = v & 1;
                const size_t row0 = (size_t)b * SEQ + 256 * qt, krow0 = (size_t)b * MEMLEN;
                attn_unit<256, 2>(lds, Qm + row0 * 1024 + h * 256, 1024, MemK + krow0 * 1024 + h * 256, 1024, MKVraw + krow0 * 2048 + 1024 + h * 256 + dvh * 128, 2048,
                                  Ycat + row0 * KCAT + 3072 + h * 256 + dvh * 128, KCAT, 4, 0, nullptr);
            }
        }
    }}
        SEAM(10);
    _Pragma("unroll") for (int rep_ = 0; rep_ < NREP(11); ++rep_) { if (rep_) REPBAR(11); if (IN(11)) {
        pg8::Gemm g{(const bf16*)Ycat, (const bf16*)WOCATt, MTOK, DM, KCAT / 2}; pg8::StaticOrder S; S.init(MTOK, DM, GRID, (int)blockIdx.x);
        pg8::EpiGateCat E{Gt, NGC, DM, (unsigned char*)Abuf, DM, GS_SCALE / (Y_SCALE * WO_SCALE)};
        pg8::gemm_phase<pg8::EpiGateCat, pg8::StaticOrder, true, true>(lds, g, S, E);
    }}
        SEAM(11);
#if defined(PROBE_P12)
    if (IN(12)) {
        pg8::Gemm g{Abuf, (const bf16*)WOUTt, MTOK, DM, DM / 2}; pg8::StaticOrder S; S.init(MTOK, DM, GRID, (int)blockIdx.x); pg8::EpiPlain8 E{Pbuf, DM, 1.0f};
        pg8::gemm_phase<pg8::EpiPlain8, pg8::StaticOrder, true, true>(lds, g, S, E);
        xcd_barrier(bar);
    }
#endif
    if (IN(12)) {
        STAGGER();
#if DEFER_MIX_RESID
        pg8::Gemm g{Abuf, (const bf16*)WOUTt, MTOK, DM, DM / 2}; pg8::StaticOrder S; S.init(MTOK, DM, GRID, (int)blockIdx.x); pg8::EpiPlain8 E{Pbuf, DM, 1.0f / (GS_SCALE * WOUT_SCALE)};
        pg8::gemm_phase<pg8::EpiPlain8, pg8::StaticOrder, true, true>(lds, g, S, E);
#else
        pg8::Gemm g{Abuf, (const bf16*)WOUTt, MTOK, DM, DM / 2}; pg8::StaticOrder S; S.init(MTOK, DM, GRID, (int)blockIdx.x); pg8::EpiResid8 E{XRES, XRES, DM, 1.0f / (GS_SCALE * WOUT_SCALE)};
        pg8::gemm_phase<pg8::EpiResid8, pg8::StaticOrder, true, true>(lds, g, S, E);
#endif
    }
    SEAM(12);
#endif
    if (IN(13)) { const Ctx C = make_ctx(lds);
#if !FFN2_CONV_IN_ATTN
        conv_ffn<FFN2_DOWN_FP8, FFN2_UP_I8>(C, ARGP(27), ARGP(28), ARGP(29), WGUt, WDt, ws + WS_WD8);
#endif
#if DEFER_MIX_RESID
        static_assert(FFN2_UP_I8 && FFN2_DOWN_FP8 == 1 && !DBG_SKIP_MIXER, "the deferred residual is wired for the int8 / MX-fp8 FFN2 only");
        if (NO_X1) rms_rows_i8_add(C, X_IN, Pbuf, ARGP(26), (unsigned char*)Abuf, (float*)(ws + WS_MEMN), WGU_I8_SCALE, MTOK, Pbuf + (size_t)MTOK * DM, D1buf, 0.5f);
        else rms_rows_i8_add(C, XRES, Pbuf, ARGP(26), (unsigned char*)Abuf, (float*)(ws + WS_MEMN), WGU_I8_SCALE, MTOK, X2_BF16 ? Pbuf + (size_t)MTOK * DM : nullptr);
#else
        if (FFN2_UP_I8) rms_rows_i8(C, XRES, ARGP(26), (unsigned char*)Abuf, (float*)(ws + WS_MEMN), WGU_I8_SCALE, MTOK);
        else rms_rows(C, XRES, ARGP(26), Abuf, MTOK);
#endif
    }
    SEAM(13);
    if (IN(14)) { ffn_up_phase<FFN2_DOWN_FP8, FFN2_UP_I8>(lds, Abuf, WGUt, Hmid, GRID, (const float*)(ws + WS_MEMN), ws + WS_HMID8);
#if FFN2_DOWN_CONV_IN_P14 && FFN2_CONV_IN_ATTN
        if (blockIdx.x >= 128) { const Ctx C = make_ctx(lds); __syncthreads();
            conv_ffn<FFN2_DOWN_FP8, FFN2_UP_I8>(C, ARGP(27), ARGP(28), ARGP(29), WGUt, WDt, ws + WS_WD8, (DM / 64) * (NGU / 32) + ((int)blockIdx.x - 128) * 8 + C.wave, CONV_FFN_ITEMS, 128 * 8); __syncthreads(); }
#endif
    }
    SEAM(14);
#if DEFER_MIX_RESID
    if (IN(15)) { if (X2_BF16) ffn_down_phase<FFN2_DOWN_FP8>(lds, Hmid, WDt, nullptr, XRES, GRID, ws + WS_HMID8, ws + WS_WD8, Pbuf + (size_t)MTOK * DM);
                  else ffn_down_phase<FFN2_DOWN_FP8>(lds, Hmid, WDt, XRES, XRES, GRID, ws + WS_HMID8, ws + WS_WD8, Pbuf); }
#else
    if (IN(15)) ffn_down_phase<FFN2_DOWN_FP8>(lds, Hmid, WDt, XRES, XRES, GRID, ws + WS_HMID8, ws + WS_WD8);
#endif
    if (STAMP_A >= 0) {
        if (blockIdx.x == 0 && threadIdx.x == 0) ctl[CW_STAMP + 2 * 16] = (unsigned)__builtin_amdgcn_s_memrealtime();
        xcd_barrier(bar);
        if (blockIdx.x == 0 && threadIdx.x < 64) {
            const unsigned a0 = __hip_atomic_load(ctl + CW_STAMP + 2 * (STAMP_A >= 16 ? 0 : STAMP_A), __ATOMIC_RELAXED, __HIP_MEMORY_SCOPE_AGENT), a1 = __hip_atomic_load(ctl + CW_STAMP + 2 * (STAMP_A >= 16 ? 16 : STAMP_A + 1), __ATOMIC_RELAXED, __HIP_MEMORY_SCOPE_AGENT);
            const unsigned b0 = __hip_atomic_load(ctl + CW_STAMP + 2 * STAMP_B, __ATOMIC_RELAXED, __HIP_MEMORY_SCOPE_AGENT), b1 = __hip_atomic_load(ctl + CW_STAMP + 2 * (STAMP_B + 1), __ATOMIC_RELAXED, __HIP_MEMORY_SCOPE_AGENT);
            const float va = (float)(a1 - a0) * (STAMP_A == 16 ? 0.00002f : 0.0002f), vb = (float)(b1 - b0) * 0.0002f;
            float* o = XRES;
            if (threadIdx.x == 0) o[0] = (STAMP_A == 17) ? 3.0f : va;
            if (STAMP_B >= 0) o[(threadIdx.x + 1) * 4096] = vb;
        }
    }
#undef IN
#undef SEAM
}

#undef WGUt
#undef WDt
#undef WINt
#undef WINIt
#undef WG8t
#undef Hn8
#undef WUQt
#undef WUKVt
#undef WMKVt
#undef WOCATt
#undef WOUTt
#undef Abuf
#undef Hmid
#undef Gt
#undef Pbuf
#undef QmlaRaw
#undef KVraw
#undef Qmla
#undef Kmla
#undef CQn
#undef CKVn
#undef Qd
#undef Kd
#undef Vd
#undef Qi
#undef Ki
#undef Wi
#undef Kr
#undef Qm
#undef Ycat
#undef BM
#undef memn
#undef MKVraw
#undef MemK
#undef Sc
#undef X_IN
#undef MEM_IN
#undef POS_IN
#undef D1buf
#undef XRES
#undef ARGQ
#undef ARGP
extern "C" void kernel_launch(void* const* d_in, const int* in_sizes, int n_in, void* d_out, int out_size, void* d_ws, size_t ws_size, hipStream_t stream) {
    static int grid = 0;
    if (grid == 0) {
        if (n_in != 30 || in_sizes[0] != MTOK * DM || out_size != MTOK * DM || ws_size < WS_END) {
            fprintf(stderr, "kernel_launch: built for 30 inputs, x/out of %d floats, >= %zu bytes of workspace; got n_in %d, in0 %d, out %d, ws %zu; nothing launched\n", MTOK * DM, (size_t)WS_END, n_in, n_in > 0 ? in_sizes[0] : -1, out_size, ws_size);
            grid = -1; return; }
        int dev = 0, cus = 0, per_cu = 0;
        if (hipGetDevice(&dev) != hipSuccess || hipDeviceGetAttribute(&cus, hipDeviceAttributeMultiprocessorCount, dev) != hipSuccess) { fprintf(stderr, "kernel_launch: device query failed\n"); grid = -1; return; }
        if (hipFuncSetAttribute((const void*)mega_fwd, hipFuncAttributeMaxDynamicSharedMemorySize, LDS_BYTES) != hipSuccess) { fprintf(stderr, "kernel_launch: hipFuncSetAttribute failed\n"); grid = -1; return; }
        if (hipOccupancyMaxActiveBlocksPerMultiprocessor(&per_cu, (const void*)mega_fwd, NWAVES * 64, LDS_BYTES) != hipSuccess || per_cu < 1)
            fprintf(stderr, "kernel_launch: note: occupancy query reports %d workgroups per CU\n", per_cu);
        (void)hipGetLastError();
        grid = cus;
    }
    if (grid < 0) return;
    if (hipMemsetAsync((char*)d_ws + WS_CTL, 0, CTL_ZERO_BYTES, stream) != hipSuccess) { fprintf(stderr, "kernel_launch: memset failed\n"); return; }
    Args a{};
    for (int i = 0; i < 30; ++i) a.in[i] = (const float*)d_in[i];
    a.out = (float*)d_out; a.ws = (unsigned char*)d_ws;
#if MK_MULTI
    for (int k = 0; k < NPH; ++k) { a.ph_lo = k; a.ph_hi = k + 1; hipLaunchKernelGGL(mega_fwd, dim3(grid), dim3(NWAVES * 64), LDS_BYTES, stream, a); }
#else
    a.ph_lo = 0; a.ph_hi = NPH;
    hipLaunchKernelGGL(mega_fwd, dim3(grid), dim3(NWAVES * 64), LDS_BYTES, stream, a);
#if defined(PROBE_TWICE)
    (void)hipMemsetAsync((char*)d_ws + WS_CTL, 0, CTL_ZERO_BYTES, stream);
    hipLaunchKernelGGL(mega_fwd, dim3(grid), dim3(NWAVES * 64), LDS_BYTES, stream, a);
#endif
#endif
    const hipError_t le = hipPeekAtLastError();
    if (le != hipSuccess) fprintf(stderr, "kernel_launch: launch failed: %s\n", hipGetErrorName(le));
}
```

```cpp
#include <hip/hip_runtime.h>
#include <cstdio>
#include <cstdint>
namespace pg8 {
#define PG8_LAS __attribute__((address_space(3)))
typedef unsigned short bf16_t;
typedef short bf16x8 __attribute__((ext_vector_type(8)));
typedef float f32x4 __attribute__((ext_vector_type(4)));
typedef unsigned u32x4 __attribute__((ext_vector_type(4)));
constexpr int BM = 256, BK = 64, HALF = 128, HTB = HALF * BK * 2  , STAGE_BYTES = 8 * HTB, NXCD = 8, WGM = 8;

__host__ __device__ __forceinline__ int lds_byte(int r, int c) { const int st = (r >> 4) * 2 + (c >> 5), rr = r & 15, cc = c & 31, ob = rr * 64 + cc * 2; return st * 1024 + (ob ^ (((ob >> 9) & 1) << 5)); }
__host__ __device__ __forceinline__ void stage_rc(int b, int& R, int& C) { const int st = b / 1024, sb = b % 1024, swz = sb ^ (((sb >> 9) & 1) << 5); R = (st >> 1) * 16 + swz / 64; C = (st & 1) * 32 + (swz % 64) / 2; }
__host__ __device__ __forceinline__ int perm32(int rho) { const int n = rho >> 4, i = rho & 15; return 8 * (i >> 2) + 4 * n + (i & 3); }

struct Unit { int pm, pn; };
struct Gemm { const bf16_t* A; const bf16_t* Bt; int M, N, K; };

struct StaticOrder {
    int nM, nN, nwg, G, c;
    __host__ __device__ void init(int M, int N, int G_, int c_) { nM = M / BM; nN = N / BM; nwg = nM * nN; G = G_; c = c_; }
    __host__ __device__ bool next(int i, Unit& u) const {
        const long L = (long)i * G + c; if (L >= nwg) return false;
        int wgid = (int)L; { const int q = nwg / NXCD, r = nwg % NXCD, xcd = wgid % NXCD, off = wgid / NXCD; wgid = (xcd < r ? xcd * (q + 1) : r * (q + 1) + (xcd - r) * q) + off; }
        const int nig = WGM * nN, gid = wgid / nig, fm = gid * WGM, gsz = (nM - fm) < WGM ? (nM - fm) : WGM;
        u.pm = fm + ((wgid % nig) % gsz); u.pn = (wgid % nig) / gsz; return true;
    }
    __device__ __forceinline__ void a_ready(const Unit&) const {}
    __device__ __forceinline__ void done(const Unit&) const {}
};
__device__ __forceinline__ unsigned cvt_pk_bf16(float lo, float hi) { unsigned r; asm volatile("v_cvt_pk_bf16_f32 %0, %1, %2" : "=v"(r) : "v"(lo), "v"(hi)); return r; }
#define DI_PG __device__ __forceinline__
#ifndef GATES_U8
#define GATES_U8 1
#endif
__device__ __forceinline__ unsigned pk_fp8x4(float a, float b, float c, float d) { int p = __builtin_amdgcn_cvt_pk_fp8_f32(a, b, 0, false); p = __builtin_amdgcn_cvt_pk_fp8_f32(c, d, p, true); return (unsigned)p; }
__device__ __forceinline__ float sigmoid_f(float x) { return __builtin_amdgcn_rcpf(1.0f + __builtin_amdgcn_exp2f(-1.4426950408889634f * x)); }
struct EpiPlain {
    static constexpr bool PERM = true, AFTER_DRAIN = false;
    bf16_t* O; int ldc;
    __device__ __forceinline__ void operator()(const f32x4 (&acc)[2][2][4][2], const Unit& u, int wr, int wc, int fr, int fq) const {
        const int row0 = u.pm * BM + wr * 64 + fr, col0 = u.pn * BM + wc * 32 + 8 * fq;
#pragma unroll
        for (int ai = 0; ai < 2; ++ai)
#pragma unroll
            for (int m = 0; m < 4; ++m) { bf16_t* rowp = O + (size_t)(row0 + ai * HALF + m * 16) * ldc + col0;
#pragma unroll
                for (int bj = 0; bj < 2; ++bj) { const f32x4 v0 = acc[ai][bj][m][0], v1 = acc[ai][bj][m][1];
                    u32x4 w; w.x = cvt_pk_bf16(v0[0], v0[1]); w.y = cvt_pk_bf16(v0[2], v0[3]); w.z = cvt_pk_bf16(v1[0], v1[1]); w.w = cvt_pk_bf16(v1[2], v1[3]);
                    *(u32x4*)(rowp + bj * HALF) = w; } }
    }
};
struct EpiPlain8 {
    static constexpr bool PERM = true, AFTER_DRAIN = false, FP8 = true;
    bf16_t* O; int ldc; float scale;
    __device__ __forceinline__ void operator()(const f32x4 (&acc)[2][2][4][2], const Unit& u, int wr, int wc, int fr, int fq) const {
        const int row0 = u.pm * BM + wr * 64 + fr, col0 = u.pn * BM + wc * 32 + 8 * fq;
#pragma unroll
        for (int ai = 0; ai < 2; ++ai)
#pragma unroll
            for (int m = 0; m < 4; ++m) { bf16_t* rowp = O + (size_t)(row0 + ai * HALF + m * 16) * ldc + col0;
#pragma unroll
                for (int bj = 0; bj < 2; ++bj) { const f32x4 v0 = acc[ai][bj][m][0] * scale, v1 = acc[ai][bj][m][1] * scale;
                    u32x4 w; w.x = cvt_pk_bf16(v0[0], v0[1]); w.y = cvt_pk_bf16(v0[2], v0[3]); w.z = cvt_pk_bf16(v1[0], v1[1]); w.w = cvt_pk_bf16(v1[2], v1[3]);
                    *(u32x4*)(rowp + bj * HALF) = w; } }
    }
};
struct EpiPlain8R {
    static constexpr bool PERM = true, AFTER_DRAIN = false, FP8 = true;
    bf16_t* O; int ldc; float scale; bf16_t* O2; int ld2; int pn0, pn1;
    __device__ __forceinline__ void operator()(const f32x4 (&acc)[2][2][4][2], const Unit& u, int wr, int wc, int fr, int fq) const {
        const bool alt = u.pn >= pn0 && u.pn < pn1;
        bf16_t* const B = alt ? O2 : O; const int ld = alt ? ld2 : ldc;
        const int row0 = u.pm * BM + wr * 64 + fr, col0 = (alt ? u.pn - pn0 : u.pn) * BM + wc * 32 + 8 * fq;
#pragma unroll
        for (int ai = 0; ai < 2; ++ai)
#pragma unroll
            for (int m = 0; m < 4; ++m) { bf16_t* rowp = B + (size_t)(row0 + ai * HALF + m * 16) * ld + col0;
#pragma unroll
                for (int bj = 0; bj < 2; ++bj) { const f32x4 v0 = acc[ai][bj][m][0] * scale, v1 = acc[ai][bj][m][1] * scale;
                    u32x4 w; w.x = cvt_pk_bf16(v0[0], v0[1]); w.y = cvt_pk_bf16(v0[2], v0[3]); w.z = cvt_pk_bf16(v1[0], v1[1]); w.w = cvt_pk_bf16(v1[2], v1[3]);
                    *(u32x4*)(rowp + bj * HALF) = w; } }
    }
};
template <int F8, bool I8_ = false> struct EpiSwiGLU {
    static constexpr bool PERM = true, AFTER_DRAIN = false, I8 = I8_;
    unsigned char* O; int ldc; float oscale; const float* rowscale; unsigned char* O8; int pm_split;
    __device__ __forceinline__ void operator()(const f32x4 (&acc)[2][2][4][2], const Unit& u, int wr, int wc, int fr, int fq) const {
        const int row0 = u.pm * BM + wr * 64 + fr, col0 = u.pn * HALF + wc * 32 + 8 * fq;
        const bool f8 = (F8 == 1) || (F8 == 2 && u.pm < pm_split); unsigned char* const OF8 = (F8 == 2) ? O8 : O;
        float rsv[8];
        if constexpr (I8_) {
#pragma unroll
            for (int q = 0; q < 8; ++q) rsv[q] = rowscale[row0 + (q >> 2) * HALF + (q & 3) * 16]; }
#pragma unroll
        for (int ai = 0; ai < 2; ++ai)
#pragma unroll
            for (int m = 0; m < 4; ++m) { const size_t eoff = (size_t)(row0 + ai * HALF + m * 16) * ldc + col0;
                f32x4 r0, r1;
                if constexpr (I8_) {
                    const float rs = rsv[ai * 4 + m], c = -1.4426950408889634f * rs, k = f8 ? rs * rs * oscale : rs * rs;
#pragma unroll
                    for (int j = 0; j < 4; ++j) {
                        const float g0 = (float)__float_as_int(acc[ai][0][m][0][j]), g1 = (float)__float_as_int(acc[ai][0][m][1][j]), u0 = (float)__float_as_int(acc[ai][1][m][0][j]), u1 = (float)__float_as_int(acc[ai][1][m][1][j]);
                        r0[j] = (g0 * u0) * __builtin_amdgcn_rcpf(1.0f + __builtin_amdgcn_exp2f(g0 * c)) * k; r1[j] = (g1 * u1) * __builtin_amdgcn_rcpf(1.0f + __builtin_amdgcn_exp2f(g1 * c)) * k; }
                } else {
#pragma unroll
                    for (int j = 0; j < 4; ++j) { const float g0 = acc[ai][0][m][0][j], g1 = acc[ai][0][m][1][j], u0 = acc[ai][1][m][0][j], u1 = acc[ai][1][m][1][j];
                        r0[j] = g0 * sigmoid_f(g0) * u0; r1[j] = g1 * sigmoid_f(g1) * u1; }
                }
                if (f8) {
#pragma unroll
                    for (int j = 0; j < 4; ++j) { const float os = I8_ ? 1.0f : oscale; r0[j] = __builtin_amdgcn_fmed3f(r0[j] * os, -448.f, 448.f); r1[j] = __builtin_amdgcn_fmed3f(r1[j] * os, -448.f, 448.f); }
                    typedef unsigned u32x2_ __attribute__((ext_vector_type(2)));
                    u32x2_ w; w.x = pk_fp8x4(r0[0], r0[1], r0[2], r0[3]); w.y = pk_fp8x4(r1[0], r1[1], r1[2], r1[3]);
                    *(u32x2_*)(OF8 + eoff) = w;
                } else {
                    u32x4 w; w.x = cvt_pk_bf16(r0[0], r0[1]); w.y = cvt_pk_bf16(r0[2], r0[3]); w.z = cvt_pk_bf16(r1[0], r1[1]); w.w = cvt_pk_bf16(r1[2], r1[3]);
                    *(u32x4*)((bf16_t*)O + eoff) = w; } }
    }
};
struct EpiResid {
    static constexpr bool PERM = true, AFTER_DRAIN = false;
    const float* base; float* out; int ldc; float scale;
    __device__ __forceinline__ void operator()(const f32x4 (&acc)[2][2][4][2], const Unit& u, int wr, int wc, int fr, int fq) const {
        const int row0 = u.pm * BM + wr * 64 + fr, col0 = u.pn * BM + wc * 32 + 8 * fq;
        f32x4 cur[8], nxt[8];
#define RESID_OFF(q_, j_) ((size_t)(row0 + ((q_) >> 2) * HALF + ((q_) & 3) * 16) * ldc + col0 + ((j_) >> 1) * HALF + ((j_) & 1) * 4)
#pragma unroll
        for (int e = 0; e < 8; ++e) cur[e] = *(const f32x4*)(base + RESID_OFF(e >> 2, e & 3));
#pragma unroll
        for (int b = 0; b < 4; ++b) {
            if (b + 1 < 4) {
#pragma unroll
                for (int e = 0; e < 8; ++e) nxt[e] = *(const f32x4*)(base + RESID_OFF(2 * (b + 1) + (e >> 2), e & 3)); }
#pragma unroll
            for (int e = 0; e < 8; ++e) { const int q = 2 * b + (e >> 2), j = e & 3;
                *(f32x4*)(out + RESID_OFF(q, j)) = cur[e] + acc[q >> 2][j >> 1][q & 3][j & 1] * scale; }
#pragma unroll
            for (int e = 0; e < 8; ++e) cur[e] = nxt[e];
        }
#undef RESID_OFF
    }
};
struct EpiResid8 {
    static constexpr bool PERM = true, AFTER_DRAIN = false, FP8 = true;
    const float* base; float* out; int ldc; float scale;
    __device__ __forceinline__ void operator()(const f32x4 (&acc)[2][2][4][2], const Unit& u, int wr, int wc, int fr, int fq) const {
        const int row0 = u.pm * BM + wr * 64 + fr, col0 = u.pn * BM + wc * 32 + 8 * fq;
        f32x4 cur[8], nxt[8];
#define RESID_OFF(q_, j_) ((size_t)(row0 + ((q_) >> 2) * HALF + ((q_) & 3) * 16) * ldc + col0 + ((j_) >> 1) * HALF + ((j_) & 1) * 4)
#pragma unroll
        for (int e = 0; e < 8; ++e) cur[e] = *(const f32x4*)(base + RESID_OFF(e >> 2, e & 3));
#pragma unroll
        for (int b = 0; b < 4; ++b) {
            if (b + 1 < 4) {
#pragma unroll
                for (int e = 0; e < 8; ++e) nxt[e] = *(const f32x4*)(base + RESID_OFF(2 * (b + 1) + (e >> 2), e & 3)); }
#pragma unroll
            for (int e = 0; e < 8; ++e) { const int q = 2 * b + (e >> 2), j = e & 3;
                *(f32x4*)(out + RESID_OFF(q, j)) = cur[e] + acc[q >> 2][j >> 1][q & 3][j & 1] * scale; }
#pragma unroll
            for (int e = 0; e < 8; ++e) cur[e] = nxt[e];
        }
#undef RESID_OFF
    }
};
struct EpiResid8A {
    static constexpr bool PERM = true, AFTER_DRAIN = false, FP8 = true;
    const float* base; const bf16_t* add; float* out; int ldc; float scale;
    __device__ __forceinline__ void operator()(const f32x4 (&acc)[2][2][4][2], const Unit& u, int wr, int wc, int fr, int fq) const {
        int fr_ = fr; asm volatile("" : "+v"(fr_));
        const int row0 = u.pm * BM + wr * 64 + fr_, col0 = u.pn * BM + wc * 32 + 8 * fq;
        typedef unsigned u32x2a_ __attribute__((ext_vector_type(2)));
        f32x4 cur[4], nxt[4]; u32x2a_ cd[4], nd[4];
#define RESID_OFF(q_, j_) ((size_t)(row0 + ((q_) >> 2) * HALF + ((q_) & 3) * 16) * ldc + col0 + ((j_) >> 1) * HALF + ((j_) & 1) * 4)
#pragma unroll
        for (int e = 0; e < 4; ++e) { cur[e] = *(const f32x4*)(base + RESID_OFF(0, e)); cd[e] = *(const u32x2a_*)(add + RESID_OFF(0, e)); }
#pragma unroll
        for (int q = 0; q < 8; ++q) {
            if (q + 1 < 8) {
#pragma unroll
                for (int e = 0; e < 4; ++e) { nxt[e] = *(const f32x4*)(base + RESID_OFF(q + 1, e)); nd[e] = *(const u32x2a_*)(add + RESID_OFF(q + 1, e)); } }
#pragma unroll
            for (int e = 0; e < 4; ++e) {
                f32x4 a; a[0] = __uint_as_float(cd[e].x << 16); a[1] = __uint_as_float(cd[e].x & 0xffff0000u); a[2] = __uint_as_float(cd[e].y << 16); a[3] = __uint_as_float(cd[e].y & 0xffff0000u);
                *(f32x4*)(out + RESID_OFF(q, e)) = (cur[e] + a) + acc[q >> 2][e >> 1][q & 3][e & 1] * scale; }
#pragma unroll
            for (int e = 0; e < 4; ++e) { cur[e] = nxt[e]; cd[e] = nd[e]; }
        }
#undef RESID_OFF
    }
};
struct EpiResid8B {
    static constexpr bool PERM = true, AFTER_DRAIN = false, FP8 = true;
    const bf16_t* base; float* out; int ldc; float scale;
    __device__ __forceinline__ void operator()(const f32x4 (&acc)[2][2][4][2], const Unit& u, int wr, int wc, int fr, int fq) const {
        int fr_ = fr; asm volatile("" : "+v"(fr_));
        const int row0 = u.pm * BM + wr * 64 + fr_, col0 = u.pn * BM + wc * 32 + 8 * fq;
        typedef unsigned u32x2b_ __attribute__((ext_vector_type(2)));
        u32x2b_ cd[8], nd[8];
#define RESID_OFF(q_, j_) ((size_t)(row0 + ((q_) >> 2) * HALF + ((q_) & 3) * 16) * ldc + col0 + ((j_) >> 1) * HALF + ((j_) & 1) * 4)
#pragma unroll
        for (int e = 0; e < 8; ++e) cd[e] = *(const u32x2b_*)(base + RESID_OFF(e >> 2, e & 3));
#pragma unroll
        for (int b = 0; b < 4; ++b) {
            if (b + 1 < 4) {
#pragma unroll
                for (int e = 0; e < 8; ++e) nd[e] = *(const u32x2b_*)(base + RESID_OFF(2 * (b + 1) + (e >> 2), e & 3)); }
#pragma unroll
            for (int e = 0; e < 8; ++e) { const int q = 2 * b + (e >> 2), j = e & 3;
                f32x4 a; a[0] = __uint_as_float(cd[e].x << 16); a[1] = __uint_as_float(cd[e].x & 0xffff0000u); a[2] = __uint_as_float(cd[e].y << 16); a[3] = __uint_as_float(cd[e].y & 0xffff0000u);
                *(f32x4*)(out + RESID_OFF(q, j)) = a + acc[q >> 2][j >> 1][q & 3][j & 1] * scale; }
#pragma unroll
            for (int e = 0; e < 8; ++e) cd[e] = nd[e];
        }
#undef RESID_OFF
    }
};
struct EpiInProj {
    static constexpr bool PERM = true, AFTER_DRAIN = false;
    bf16_t* P; int ldp; int np; bf16_t* G; int ldg;
    __device__ __forceinline__ void operator()(const f32x4 (&acc)[2][2][4][2], const Unit& u, int wr, int wc, int fr, int fq) const {
        const int row0 = u.pm * BM + wr * 64 + fr; const bool isg = u.pn >= np;
        bf16_t* O = isg ? G : P; const int ldc = isg ? ldg : ldp; const int col0 = (isg ? u.pn - np : u.pn) * BM + wc * 32 + 8 * fq;
#pragma unroll
        for (int ai = 0; ai < 2; ++ai)
#pragma unroll
            for (int m = 0; m < 4; ++m) { bf16_t* rowp = O + (size_t)(row0 + ai * HALF + m * 16) * ldc + col0;
#pragma unroll
                for (int bj = 0; bj < 2; ++bj) { f32x4 v0 = acc[ai][bj][m][0], v1 = acc[ai][bj][m][1];
                    if (isg) {
#pragma unroll
                        for (int j = 0; j < 4; ++j) { v0[j] = fmaxf(sigmoid_f(v0[j]), 5.9604645e-8f); v1[j] = fmaxf(sigmoid_f(v1[j]), 5.9604645e-8f); } }
                    u32x4 w; w.x = cvt_pk_bf16(v0[0], v0[1]); w.y = cvt_pk_bf16(v0[2], v0[3]); w.z = cvt_pk_bf16(v1[0], v1[1]); w.w = cvt_pk_bf16(v1[2], v1[3]);
                    *(u32x4*)(rowp + bj * HALF) = w; } }
    }
};
#if GATES_U8
struct EpiGates8 {
    static constexpr bool PERM = true, AFTER_DRAIN = false, FP8 = true;
    unsigned char* G; int ldg; float inv_wscale;
    __device__ __forceinline__ void operator()(const f32x4 (&acc)[2][2][4][2], const Unit& u, int wr, int wc, int fr, int fq) const {
        int fr_ = fr; asm volatile("" : "+v"(fr_));
        const int row0 = u.pm * BM + wr * 64 + fr_, col0 = u.pn * BM + wc * 32 + 8 * fq;
        const float nls = -1.4426950408889634f * inv_wscale;
#pragma unroll
        for (int ai = 0; ai < 2; ++ai)
#pragma unroll
            for (int m = 0; m < 4; ++m) { unsigned char* rowp = G + (size_t)(row0 + ai * HALF + m * 16) * ldg + col0;
#pragma unroll
                for (int bj = 0; bj < 2; ++bj) { const f32x4 v0 = acc[ai][bj][m][0], v1 = acc[ai][bj][m][1];
                    unsigned w0 = 0u, w1 = 0u;
#pragma unroll
                    for (int j = 0; j < 4; ++j) {
                        w0 = __builtin_amdgcn_cvt_pk_u8_f32(fmaxf(__builtin_fmaf(__builtin_amdgcn_rcpf(1.0f + __builtin_amdgcn_exp2f(v0[j] * nls)), 255.0f, 0.5f), 1.0f), j, w0);
                        w1 = __builtin_amdgcn_cvt_pk_u8_f32(fmaxf(__builtin_fmaf(__builtin_amdgcn_rcpf(1.0f + __builtin_amdgcn_exp2f(v1[j] * nls)), 255.0f, 0.5f), 1.0f), j, w1); }
                    typedef unsigned u32x2g_ __attribute__((ext_vector_type(2)));
                    u32x2g_ w; w.x = w0; w.y = w1;
                    *(u32x2g_*)(rowp + bj * HALF) = w; } }
    }
};
#else
struct EpiGates8 {
    static constexpr bool PERM = true, AFTER_DRAIN = false, FP8 = true;
    bf16_t* G; int ldg; float inv_wscale;
    __device__ __forceinline__ void operator()(const f32x4 (&acc)[2][2][4][2], const Unit& u, int wr, int wc, int fr, int fq) const {
        int fr_ = fr; asm volatile("" : "+v"(fr_));
        const int row0 = u.pm * BM + wr * 64 + fr_, col0 = u.pn * BM + wc * 32 + 8 * fq;
#pragma unroll
        for (int ai = 0; ai < 2; ++ai)
#pragma unroll
            for (int m = 0; m < 4; ++m) { bf16_t* rowp = G + (size_t)(row0 + ai * HALF + m * 16) * ldg + col0;
#pragma unroll
                for (int bj = 0; bj < 2; ++bj) { f32x4 v0 = acc[ai][bj][m][0], v1 = acc[ai][bj][m][1];
#pragma unroll
                    for (int j = 0; j < 4; ++j) { v0[j] = fmaxf(sigmoid_f(v0[j] * inv_wscale), 5.9604645e-8f); v1[j] = fmaxf(sigmoid_f(v1[j] * inv_wscale), 5.9604645e-8f); }
                    u32x4 w; w.x = cvt_pk_bf16(v0[0], v0[1]); w.y = cvt_pk_bf16(v0[2], v0[3]); w.z = cvt_pk_bf16(v1[0], v1[1]); w.w = cvt_pk_bf16(v1[2], v1[3]);
                    *(u32x4*)(rowp + bj * HALF) = w; } }
    }
};
#endif
DI_PG void unpack_bf16x8(const u32x4 gw, f32x4& g0, f32x4& g1) {
    g0[0] = __uint_as_float(gw.x << 16); g0[1] = __uint_as_float(gw.x & 0xffff0000u); g0[2] = __uint_as_float(gw.y << 16); g0[3] = __uint_as_float(gw.y & 0xffff0000u);
    g1[0] = __uint_as_float(gw.z << 16); g1[1] = __uint_as_float(gw.z & 0xffff0000u); g1[2] = __uint_as_float(gw.w << 16); g1[3] = __uint_as_float(gw.w & 0xffff0000u);
}
#if GATES_U8
typedef unsigned u32x2c_ __attribute__((ext_vector_type(2)));
DI_PG void unpack_u8x8(const u32x2c_ gw, f32x4& g0, f32x4& g1) {
    g0[0] = (float)(gw.x & 255u); g0[1] = (float)((gw.x >> 8) & 255u); g0[2] = (float)((gw.x >> 16) & 255u); g0[3] = (float)(gw.x >> 24);
    g1[0] = (float)(gw.y & 255u); g1[1] = (float)((gw.y >> 8) & 255u); g1[2] = (float)((gw.y >> 16) & 255u); g1[3] = (float)(gw.y >> 24);
}
#endif
struct EpiGateCat {
    static constexpr bool PERM = true, AFTER_DRAIN = false, FP8 = true; static constexpr int MIDK = 12;
#if GATES_U8
    const unsigned char* G;
#else
    const bf16_t* G;
#endif
    int ldg; int gstride; unsigned char* O; int ld; float oscale;
    __device__ __forceinline__ void mid(f32x4 (&acc)[2][2][4][2], const Unit& u, int seg, int wr, int wc, int fr, int fq) const {
        int fr_ = fr; asm volatile("" : "+v"(fr_));
        const int row0 = u.pm * BM + wr * 64 + fr_, col0 = u.pn * BM + wc * 32 + 8 * fq;
#pragma unroll
        for (int ai = 0; ai < 2; ++ai)
#pragma unroll
            for (int m = 0; m < 4; ++m) { const auto* gp = G + (size_t)(row0 + ai * HALF + m * 16) * ldg + (seg - 1) * gstride + col0;
#pragma unroll
                for (int bj = 0; bj < 2; ++bj) {
                    f32x4 a0, a1, b0, b1;
#if GATES_U8
                    unpack_u8x8(*(const u32x2c_*)(gp + bj * HALF), a0, a1); unpack_u8x8(*(const u32x2c_*)(gp + gstride + bj * HALF), b0, b1);
#else
                    unpack_bf16x8(*(const u32x4*)(gp + bj * HALF), a0, a1); unpack_bf16x8(*(const u32x4*)(gp + gstride + bj * HALF), b0, b1);
#endif
#pragma unroll
                    for (int j = 0; j < 4; ++j) { acc[ai][bj][m][0][j] *= a0[j] * __builtin_amdgcn_rcpf(b0[j]); acc[ai][bj][m][1][j] *= a1[j] * __builtin_amdgcn_rcpf(b1[j]); } }
                if (m == 3) asm volatile("" ::: "memory"); }
    }
    __device__ __forceinline__ void operator()(const f32x4 (&acc)[2][2][4][2], const Unit& u, int wr, int wc, int fr, int fq) const {
        const int row0 = u.pm * BM + wr * 64 + fr, col0 = u.pn * BM + wc * 32 + 8 * fq;
#if GATES_U8
        u32x2c_ gq[16];
#pragma unroll
        for (int q = 0; q < 16; ++q) gq[q] = *(const u32x2c_*)(G + (size_t)(row0 + (q >> 3) * HALF + ((q >> 1) & 3) * 16) * ldg + 2 * gstride + col0 + (q & 1) * HALF);
#endif
#pragma unroll
        for (int ai = 0; ai < 2; ++ai)
#pragma unroll
            for (int m = 0; m < 4; ++m) { const int row = row0 + ai * HALF + m * 16;
#pragma unroll
                for (int bj = 0; bj < 2; ++bj) { const int col = col0 + bj * HALF;
                    f32x4 g0, g1;
#if GATES_U8
                    unpack_u8x8(gq[ai * 8 + m * 2 + bj], g0, g1);
                    const float osc = oscale * (1.0f / 255.0f);
#else
                    unpack_bf16x8(*(const u32x4*)(G + (size_t)row * ldg + 2 * gstride + col), g0, g1);
                    const float osc = oscale;
#endif
                    const f32x4 t0 = g0 * acc[ai][bj][m][0] * osc, t1 = g1 * acc[ai][bj][m][1] * osc;
                    typedef unsigned u32x2_ __attribute__((ext_vector_type(2)));
                    u32x2_ w; w.x = pk_fp8x4(t0[0], t0[1], t0[2], t0[3]); w.y = pk_fp8x4(t1[0], t1[1], t1[2], t1[3]);
                    *(u32x2_*)(O + (size_t)row * ld + col) = w; } }
    }
};
template <class E_, class = void> struct epi_i8 { static constexpr bool value = false; };
template <class E_> struct epi_i8<E_, decltype((void)E_::I8)> { static constexpr bool value = E_::I8; };
template <class E_, class = void> struct epi_fp8 { static constexpr bool value = false; };
template <class E_> struct epi_fp8<E_, decltype((void)E_::FP8)> { static constexpr bool value = E_::FP8; };
typedef int pg8_v4i __attribute__((ext_vector_type(4)));
typedef int pg8_v8i __attribute__((ext_vector_type(8)));
__device__ __forceinline__ pg8_v8i cat16(bf16x8 lo, bf16x8 hi) { const pg8_v4i a = __builtin_bit_cast(pg8_v4i, lo), b = __builtin_bit_cast(pg8_v4i, hi); return __builtin_shufflevector(a, b, 0, 1, 2, 3, 4, 5, 6, 7); }
__device__ __forceinline__ void mfma8_tied(f32x4& c, pg8_v8i a, pg8_v8i b, int unit_scale) {
    asm volatile("v_mfma_scale_f32_16x16x128_f8f6f4 %0, %1, %2, %0, %3, %3 op_sel_hi:[0,0,0]" : "+v"(c) : "v"(a), "v"(b), "v"(unit_scale)); }
template <class E_, class = void> struct epi_midk { static constexpr int value = 0; };
template <class E_> struct epi_midk<E_, decltype((void)E_::MIDK)> { static constexpr int value = E_::MIDK; };
template <class Epi, class Sched, bool ALIGN_EPI = false, bool SP2 = false>
__device__ __forceinline__ void gemm_phase(PG8_LAS unsigned char* lds, const Gemm g, const Sched& S, const Epi& E) {
    int tid_ = threadIdx.x; asm volatile("" : "+v"(tid_));
    const int tid = tid_, wid = __builtin_amdgcn_readfirstlane(tid >> 6), lane = tid & 63, wr = wid >> 2, wc = wid & 3, fr = lane & 15, fq = lane >> 4;
    const int K = g.K, nt = K / BK;
    unsigned voffA[2], voffB[2];
#pragma unroll
    for (int i = 0; i < 2; ++i) { int R, C; stage_rc(tid * 16 + i * 8192, R, C); const int Rb = Epi::PERM ? ((R & ~31) + perm32(R & 31)) : R;
        voffA[i] = (unsigned)(R * K + C) * 2u; voffB[i] = (unsigned)(Rb * K + C) * 2u; }
    const size_t kstep = (size_t)(BK * 2);
    const size_t hstep = (size_t)HALF * K * 2;
    const size_t tstep = 2 * hstep;
    const unsigned ldsw = (unsigned)wid * 1024u;
    const int aoff = lds_byte(wr * 64 + fr, fq * 8), boff = lds_byte(wc * 32 + fr, fq * 8);
#define PG8_SA(b, h) (((b) * 2 + (h)) * HTB)
#define PG8_SB(b, h) ((4 + (b) * 2 + (h)) * HTB)
#define PG8_STAGE(bufoff, gbase, voff) do { _Pragma("unroll") for (int _i = 0; _i < 2; ++_i) \
        __builtin_amdgcn_global_load_lds((const unsigned*)((const char*)(gbase) + (voff)[_i]), (PG8_LAS unsigned*)(lds + (bufoff) + ldsw + _i * 8192), 16, 0, 0); } while (0)
#define PG8_LDA(dst, b, h) do { _Pragma("unroll") for (int m = 0; m < 4; ++m) _Pragma("unroll") for (int k = 0; k < 2; ++k) dst[m][k] = *(const PG8_LAS bf16x8*)(lds + PG8_SA(b, h) + aoff + m * 2048 + k * 1024); } while (0)
#define PG8_LDB(dst, b, h) do { _Pragma("unroll") for (int n = 0; n < 2; ++n) _Pragma("unroll") for (int k = 0; k < 2; ++k) dst[n][k] = *(const PG8_LAS bf16x8*)(lds + PG8_SB(b, h) + boff + n * 2048 + k * 1024); } while (0)
#define PG8_MMA(ai, bj, At, Bt) do { __builtin_amdgcn_s_setprio(1); \
        if constexpr (epi_fp8<Epi>::value) { _Pragma("unroll") for (int m = 0; m < 4; ++m) _Pragma("unroll") for (int n = 0; n < 2; ++n) \
            mfma8_tied(acc[ai][bj][m][n], cat16(Bt[n][0], Bt[n][1]), cat16(At[m][0], At[m][1]), fp8_unit_scale); } \
        else if constexpr (epi_i8<Epi>::value) { _Pragma("unroll") for (int m = 0; m < 4; ++m) _Pragma("unroll") for (int n = 0; n < 2; ++n) _Pragma("unroll") for (int k = 0; k < 2; ++k) \
            acc[ai][bj][m][n] = __builtin_bit_cast(f32x4, __builtin_amdgcn_mfma_i32_16x16x64_i8(__builtin_bit_cast(pg8_v4i, Bt[n][k]), __builtin_bit_cast(pg8_v4i, At[m][k]), __builtin_bit_cast(pg8_v4i, acc[ai][bj][m][n]), 0, 0, 0)); }     \
        else { _Pragma("unroll") for (int m = 0; m < 4; ++m) _Pragma("unroll") for (int n = 0; n < 2; ++n) _Pragma("unroll") for (int k = 0; k < 2; ++k) \
            acc[ai][bj][m][n] = __builtin_amdgcn_mfma_f32_16x16x32_bf16(Bt[n][k], At[m][k], acc[ai][bj][m][n], 0, 0, 0); } \
        __builtin_amdgcn_s_setprio(0); } while (0)
#define PG8_WAIT_V(n) asm volatile("s_waitcnt vmcnt(" #n ")" ::: "memory")
#define PG8_WAIT_L(n) asm volatile("s_waitcnt lgkmcnt(" #n ")" ::: "memory")
#define PG8_BAR __builtin_amdgcn_s_barrier()
#define PG8_SCHED __builtin_amdgcn_sched_barrier(0)
    const int fp8_unit_scale = 0x7f7f7f7f; (void)fp8_unit_scale;
    Unit cur, nxt; int ui = 0;
    if (!S.next(0, cur)) return;
    f32x4 acc[2][2][4][2];
#pragma unroll
    for (int a = 0; a < 2; ++a)
#pragma unroll
        for (int b = 0; b < 2; ++b)
#pragma unroll
            for (int m = 0; m < 4; ++m)
#pragma unroll
                for (int n = 0; n < 2; ++n) acc[a][b][m][n] = (f32x4){0.f, 0.f, 0.f, 0.f};
    bf16x8 At[4][2], B0[2][2], B1[2][2];
    const char* cA = (const char*)g.A + (size_t)cur.pm * tstep; const char* cB = (const char*)g.Bt + (size_t)cur.pn * tstep;
    S.a_ready(cur);
    if constexpr (SP2) {
        PG8_STAGE(PG8_SB(0, 0), cB, voffB); PG8_STAGE(PG8_SB(0, 1), cB + hstep, voffB); PG8_STAGE(PG8_SA(0, 0), cA, voffA); PG8_STAGE(PG8_SA(0, 1), cA + hstep, voffA);
        if (wr == 1) PG8_BAR;
        PG8_WAIT_V(2); PG8_BAR;
        PG8_STAGE(PG8_SB(1, 0), cB + kstep, voffB); PG8_STAGE(PG8_SA(1, 0), cA + kstep, voffA); PG8_STAGE(PG8_SB(1, 1), cB + hstep + kstep, voffB);
        PG8_WAIT_V(6); PG8_BAR;
    } else {
        PG8_STAGE(PG8_SB(0, 0), cB, voffB); PG8_STAGE(PG8_SA(0, 0), cA, voffA); PG8_STAGE(PG8_SB(0, 1), cB + hstep, voffB); PG8_STAGE(PG8_SA(0, 1), cA + hstep, voffA);
        if (wr == 1) PG8_BAR;
        PG8_WAIT_V(4); PG8_BAR;
        PG8_STAGE(PG8_SB(1, 0), cB + kstep, voffB); PG8_STAGE(PG8_SA(1, 0), cA + kstep, voffA); PG8_STAGE(PG8_SB(1, 1), cB + hstep + kstep, voffB);
        PG8_WAIT_V(6); PG8_BAR;
    }
    for (;;) {
        const bool has_next = S.next(ui + 1, nxt);
        const char* nA = has_next ? (const char*)g.A + (size_t)nxt.pm * tstep : cA; const char* nB = has_next ? (const char*)g.Bt + (size_t)nxt.pn * tstep : cB;
        for (int t = 0; t < nt; t += 2) {
            const bool last = (t == nt - 2);
            const char* a1 = cA + (size_t)(t + 1) * kstep;
            const char* a2 = last ? nA : cA + (size_t)(t + 2) * kstep; const char* b2 = last ? nB : cB + (size_t)(t + 2) * kstep;
            const char* a3 = a2 + kstep; const char* b3 = b2 + kstep;
            if (last && has_next) S.a_ready(nxt);
            if constexpr (epi_midk<Epi>::value > 0) { if (t > 0 && (t % epi_midk<Epi>::value) == 0) { PG8_SCHED; E.mid(acc, cur, t / epi_midk<Epi>::value, wr, wc, fr, fq); PG8_SCHED; } }
            if constexpr (SP2) {
            PG8_LDB(B0, 0, 0); PG8_LDB(B1, 0, 1); PG8_SCHED; PG8_LDA(At, 0, 0); PG8_STAGE(PG8_SA(1, 1), a1 + hstep, voffA);
            PG8_WAIT_V(8); PG8_WAIT_L(0); PG8_BAR; PG8_MMA(0, 0, At, B0); PG8_MMA(0, 1, At, B1); PG8_BAR; PG8_SCHED;
            PG8_LDA(At, 0, 1); PG8_STAGE(PG8_SB(0, 0), b2, voffB); PG8_STAGE(PG8_SB(0, 1), b2 + hstep, voffB); PG8_STAGE(PG8_SA(0, 0), a2, voffA);
            PG8_WAIT_V(8); PG8_WAIT_L(0); PG8_BAR; PG8_MMA(1, 0, At, B0); PG8_MMA(1, 1, At, B1); PG8_BAR; PG8_SCHED;
            PG8_LDB(B0, 1, 0); PG8_LDB(B1, 1, 1); PG8_SCHED; PG8_LDA(At, 1, 0); PG8_STAGE(PG8_SA(0, 1), a2 + hstep, voffA);
            PG8_WAIT_V(8); PG8_WAIT_L(0); PG8_BAR; PG8_MMA(0, 0, At, B0); PG8_MMA(0, 1, At, B1); PG8_BAR; PG8_SCHED;
            PG8_LDA(At, 1, 1); PG8_STAGE(PG8_SB(1, 0), b3, voffB); PG8_STAGE(PG8_SB(1, 1), b3 + hstep, voffB); PG8_STAGE(PG8_SA(1, 0), a3, voffA);
            PG8_WAIT_V(8); PG8_WAIT_L(0); PG8_BAR; PG8_MMA(1, 0, At, B0); PG8_MMA(1, 1, At, B1); PG8_BAR; PG8_SCHED;
            } else {
            PG8_LDB(B0, 0, 0); PG8_SCHED; PG8_LDA(At, 0, 0); PG8_STAGE(PG8_SA(1, 1), a1 + hstep, voffA);
            PG8_WAIT_L(8); PG8_BAR; PG8_WAIT_L(0); PG8_MMA(0, 0, At, B0); PG8_BAR; PG8_SCHED;
            PG8_LDB(B1, 0, 1); PG8_STAGE(PG8_SB(0, 0), b2, voffB);
            PG8_BAR; PG8_WAIT_L(0); PG8_MMA(0, 1, At, B1); PG8_BAR;
            PG8_LDA(At, 0, 1); PG8_STAGE(PG8_SA(0, 0), a2, voffA);
            PG8_BAR; PG8_WAIT_L(0); PG8_MMA(1, 0, At, B0); PG8_BAR; PG8_SCHED;
            PG8_STAGE(PG8_SB(0, 1), b2 + hstep, voffB);
            PG8_WAIT_V(6); PG8_BAR; PG8_MMA(1, 1, At, B1); PG8_BAR;
            PG8_LDB(B0, 1, 0); PG8_SCHED; PG8_LDA(At, 1, 0); PG8_STAGE(PG8_SA(0, 1), a2 + hstep, voffA);
            PG8_WAIT_L(8); PG8_BAR; PG8_WAIT_L(0); PG8_MMA(0, 0, At, B0); PG8_BAR; PG8_SCHED;
            PG8_LDB(B1, 1, 1); PG8_STAGE(PG8_SB(1, 0), b3, voffB);
            PG8_BAR; PG8_WAIT_L(0); PG8_MMA(0, 1, At, B1); PG8_BAR;
            PG8_LDA(At, 1, 1); PG8_STAGE(PG8_SA(1, 0), a3, voffA);
            PG8_BAR; PG8_WAIT_L(0); PG8_MMA(1, 0, At, B0); PG8_BAR; PG8_SCHED;
            PG8_STAGE(PG8_SB(1, 1), b3 + hstep, voffB);
            PG8_WAIT_V(6); PG8_BAR; PG8_MMA(1, 1, At, B1); PG8_BAR;
            }
        }
        if constexpr (epi_fp8<Epi>::value) asm volatile("s_nop 15\n\ts_nop 15" ::: "memory");
        if constexpr (ALIGN_EPI) { if (wr == 0) PG8_BAR; }
        if constexpr (!Epi::AFTER_DRAIN) { E(acc, cur, wr, wc, fr, fq); S.done(cur); }
        if (!has_next) break;
#pragma unroll
        for (int a = 0; a < 2; ++a)
#pragma unroll
            for (int b = 0; b < 2; ++b)
#pragma unroll
                for (int m = 0; m < 4; ++m)
#pragma unroll
                    for (int n = 0; n < 2; ++n) acc[a][b][m][n] = (f32x4){0.f, 0.f, 0.f, 0.f};
        cur = nxt; cA = nA; cB = nB; ++ui;
        if constexpr (ALIGN_EPI) { if (wr == 1) PG8_BAR; }
    }
    PG8_WAIT_V(0);
    if constexpr (!ALIGN_EPI) { if (wr == 0) PG8_BAR; }
    PG8_BAR;
    if constexpr (Epi::AFTER_DRAIN) { E.fused(acc, cur, wr, wc, fr, fq, lds, wid, lane); S.done(cur); }
#undef PG8_SA
#undef PG8_SB
#undef PG8_STAGE
#undef PG8_LDA
#undef PG8_LDB
#undef PG8_MMA
#undef PG8_WAIT_V
#undef PG8_WAIT_L
#undef PG8_BAR
#undef PG8_SCHED
}
}
#ifndef VD_DIRECT
#define VD_DIRECT 1
#endif
constexpr int NWAVES = 8;
constexpr int BATCH = 2, SEQ = 8192, DM = 4096, DFF = 11008, MTOK = BATCH * SEQ;
constexpr int MEMLEN = 256, MROWS = BATCH * MEMLEN;
constexpr float EPS = 1e-6f;
constexpr int NF8 = 7936, NIDX = 2304, NPC = NF8 + NIDX;
constexpr int PC_CQ = 0, PC_CKV = 1536, PC_QD = 2048, PC_KD = 3584, PC_VD = 5120, PC_QM = 6656, PC_KR = 7680, PC_QI = NF8, PC_KI = NF8 + 2048, PC_WI = NF8 + 2112;
constexpr int NGC = 3 * DM;
constexpr int NGU = 2 * DFF;
constexpr int KCAT = 4096;
constexpr float LOG2E = 1.4426950408889634f;
constexpr float QS_MLA = 0.07216878364870322f * LOG2E;
constexpr float QS_DSA = 0.08838834764831845f * LOG2E;
constexpr float QS_MEM = 0.0625f * LOG2E;
constexpr float WG_SCALE = 64.0f, WIN_SCALE = 64.0f, WUQ_SCALE = 32.0f, WUKV_SCALE = 16.0f, WO_SCALE = 32.0f, WOUT_SCALE = 64.0f, Y_SCALE = 16.0f, GS_SCALE = 16.0f, H_SCALE = 8.0f, WD_SCALE = 64.0f;
constexpr float WGU_I8_SCALE = 1625.0f;
constexpr float WG_SCALE_UNUSED = 0.f;
constexpr float LOG2_THETA = 18.931568569324174f;

constexpr size_t MiB = 1u << 20;
constexpr size_t WS_CTL = 0, CTL_ZERO_BYTES = 1 * MiB;
constexpr size_t WS_WGU = 1 * MiB;
constexpr size_t WS_WD = 173 * MiB;
constexpr size_t WS_SC = 1 * MiB;
constexpr size_t WS_WIN = 259 * MiB;
constexpr size_t WS_WINI = 290 * MiB;
constexpr size_t WS_WG8 = 337 * MiB;
constexpr size_t WS_WUQ = 433 * MiB, WS_WUKV = 440 * MiB, WS_WMKV = 443 * MiB, WS_WOCAT = 459 * MiB  , WS_WOUT = 495 * MiB;
constexpr size_t WS_A = 527 * MiB;
constexpr size_t WS_BIG = 655 * MiB;
constexpr size_t WS_HMID8 = 999 * MiB;
constexpr size_t WS_WD8 = 87 * MiB;
constexpr size_t WS_HMID = WS_BIG;
constexpr size_t WS_G = WS_BIG;
constexpr size_t WS_P = 1039 * MiB;
constexpr size_t WS_QMLARAW = 1039 * MiB, WS_KVRAW = 1111 * MiB, WS_QMLA = 1207 * MiB, WS_KMLA = 1279 * MiB;
constexpr size_t WS_CQN = 1359 * MiB, WS_CKVN = 1407 * MiB, WS_QD = 1423 * MiB, WS_KD = 1471 * MiB, WS_VD = 1519 * MiB, WS_QI = 1567 * MiB, WS_KI = 1631 * MiB, WS_WI = 1633 * MiB, WS_KR = 1635 * MiB, WS_QM = 1637 * MiB;
constexpr size_t WS_YCAT = 1669 * MiB  , WS_MEMN = 1741 * MiB, WS_MKVRAW = 1745 * MiB, WS_MEMK = 1747 * MiB, WS_RS1 = 1748 * MiB  , WS_END = 1749 * MiB;
constexpr size_t WS_HN8 = WS_YCAT;
constexpr size_t WS_BM = WS_CQN;
constexpr size_t SC_BATCH = (size_t)4096 * 8256;
static_assert(WS_SC + 2 * SC_BATCH * 4 <= WS_WIN, "scores fit the FFN weight region");
static_assert(WS_WGU + (size_t)NGU * DM * 2 <= WS_WD && WS_WD + (size_t)DM * DFF * 2 <= WS_WIN, "FFN weights");
static_assert(WS_WIN + (size_t)NF8 * DM <= WS_WINI && WS_WINI + (size_t)NIDX * DM * 2 <= WS_WG8 && WS_WG8 + (size_t)NGC * DM <= WS_WUQ, "win");
static_assert(WS_HMID + (size_t)MTOK * DFF * 2 <= WS_P && WS_G + (size_t)MTOK * NGC * 2 <= WS_P && WS_P + (size_t)MTOK * NPC * 2 <= WS_CQN, "big region");
constexpr int CW_BAR = 4096, CW_QUEUE = 8192;

constexpr int RING_BYTES = 131072, MISC_OFF = RING_BYTES, LDS_BYTES = 147456;

#define GAS __attribute__((address_space(1)))
#define LAS __attribute__((address_space(3)))
#define DI __device__ __forceinline__
typedef unsigned short bf16;
typedef unsigned v4u __attribute__((ext_vector_type(4)));
typedef unsigned v2u __attribute__((ext_vector_type(2)));
typedef float f32x4 __attribute__((ext_vector_type(4)));
typedef float f32x16 __attribute__((ext_vector_type(16)));
typedef short bf16x8 __attribute__((ext_vector_type(8)));
typedef short s16x4 __attribute__((ext_vector_type(4)));
#define LDS_WAIT() asm volatile("s_waitcnt lgkmcnt(0)" ::: "memory")
DI float bf2f(bf16 v) { return __uint_as_float(((unsigned)v) << 16); }
DI unsigned f2bf(float f) { unsigned u = __float_as_uint(f); return (u + 0x7fffu + ((u >> 16) & 1u)) >> 16; }
DI unsigned pk2(float lo, float hi) { return f2bf(lo) | (f2bf(hi) << 16); }
DI float wave_sum(float v) {
#pragma unroll
    for (int o = 1; o < 64; o <<= 1) v += __shfl_xor(v, o);
    return v;
}
DI void sincos_rev(float ang, float& s, float& c) {
    double rev = (double)ang * 0.15915494309189535; rev -= __builtin_rint(rev);
    const float fr = (float)rev; s = __builtin_amdgcn_sinf(fr); c = __builtin_amdgcn_cosf(fr);
}
DI float inv_freq(int i, int half) { return __builtin_amdgcn_exp2f(-(float)i * (LOG2_THETA / (float)half)); }
#define XB_TMO      128
#define XB_XCNT(j)  (256  + 64 * (j))
#define XB_XSUB(j)  (1280 + 64 * (j))
#define XB_XGEN(j)  (2304 + 64 * (j))
#define XB_TOP      3328
#define XB_TOPGEN   3392
#define XCD_BAR_WORDS 3456
#define XB_SPIN_CAP (1u << 18)

__device__ __forceinline__ unsigned xb_ld(unsigned* p)              { return __hip_atomic_load(p, __ATOMIC_RELAXED, __HIP_MEMORY_SCOPE_AGENT); }
__device__ __forceinline__ unsigned xb_add(unsigned* p, unsigned v) { return __hip_atomic_fetch_add(p, v, __ATOMIC_RELAXED, __HIP_MEMORY_SCOPE_AGENT); }
__device__ __forceinline__ unsigned xb_xcc_id() { return (unsigned)__builtin_amdgcn_s_getreg((3 << 11) | 20) & 0xFu; }
#define XB_SPIN(cond, bar) do { unsigned _sp = 0; while (cond) { __builtin_amdgcn_s_sleep(1); \
    if ((++_sp & 255u) == 0u) { if (xb_ld(&(bar)[XB_TMO])) break; if (_sp > XB_SPIN_CAP) { atomicAdd(&(bar)[XB_TMO], 1u); break; } } } } while (0)

struct XcdBarrier {
    unsigned* bar; unsigned x;
    volatile LAS unsigned* st;
};

__device__ __forceinline__ XcdBarrier xcd_barrier_post(unsigned* bar, volatile LAS unsigned* st) {
    XcdBarrier b; b.bar = bar; b.x = xb_xcc_id(); b.st = st;
    if (threadIdx.x == 0) (void)xb_add(&bar[XB_XCNT(b.x)], 1u);
    return b;
}
__device__ __forceinline__ void xcd_barrier_complete(unsigned* bar, unsigned x, unsigned& nloc, unsigned& nx) {
    const unsigned G = gridDim.x * gridDim.y * gridDim.z;
    unsigned sum, cnt, mine, sp = 0u;
    for (;;) {
        sum = 0u; cnt = 0u; mine = 0u;
#pragma unroll
        for (unsigned j = 0; j < 16; ++j) { const unsigned c = xb_ld(&bar[XB_XCNT(j)]); sum += c; cnt += (c > 0u) ? 1u : 0u; mine = (j == x) ? c : mine; }
        if (sum == G) break;
        __builtin_amdgcn_s_sleep(1);
        if ((++sp & 255u) == 0u) { if (xb_ld(&bar[XB_TMO])) break; if (sp > XB_SPIN_CAP) { atomicAdd(&bar[XB_TMO], 1u); break; } }
    }
    nloc = mine > 0u ? mine : 1u; nx = cnt > 0u ? cnt : 1u;
}

__device__ __forceinline__ void xcd_barrier(const XcdBarrier& b) {
    asm volatile("s_waitcnt vmcnt(0)" ::: "memory");
    __syncthreads();
    if (threadIdx.x == 0) {
        unsigned* bar = b.bar;
        __builtin_amdgcn_s_waitcnt(0);
        unsigned nloc = b.st[0], nx = b.st[1];
        if (nloc == 0u) { xcd_barrier_complete(bar, b.x, nloc, nx); b.st[0] = nloc; b.st[1] = nx; }
        const unsigned old = xb_add(&bar[XB_XSUB(b.x)], 1u);
        const unsigned gen = old / nloc;
        if (old + 1u == (gen + 1u) * nloc) {
            __builtin_amdgcn_fence(__ATOMIC_RELEASE, "agent");
            asm volatile("s_waitcnt vmcnt(0)" ::: "memory");
            const unsigned og = xb_add(&bar[XB_TOP], 1u);
            const unsigned tg = og / nx;
            if (og + 1u == (tg + 1u) * nx) xb_add(&bar[XB_TOPGEN], 1u);
            else XB_SPIN(xb_ld(&bar[XB_TOPGEN]) == tg, bar);
            __builtin_amdgcn_fence(__ATOMIC_ACQUIRE, "agent");
            xb_add(&bar[XB_XGEN(b.x)], 1u);
            asm volatile("s_waitcnt vmcnt(0)" ::: "memory");
        } else {
            XB_SPIN(xb_ld(&bar[XB_XGEN(b.x)]) == gen, bar);
            __builtin_amdgcn_fence(__ATOMIC_ACQUIRE, "agent");
            asm volatile("s_waitcnt vmcnt(0)" ::: "memory");
        }
    }
    __syncthreads();
}
struct Ctx {
    LAS unsigned char* lds;
    int tid, lane, wave, G, gw, NGW;
};
DI Ctx make_ctx(LAS unsigned char* lds) {
    int t = threadIdx.x; asm volatile("" : "+v"(t));
    Ctx C; C.lds = lds; C.tid = t; C.lane = t & 63; C.wave = __builtin_amdgcn_readfirstlane(t >> 6);
    C.G = gridDim.x; C.gw = blockIdx.x * 8 + C.wave; C.NGW = C.G * 8; return C;
}

DI unsigned pack_fp8x4(float a, float b, float c, float d) { int p = __builtin_amdgcn_cvt_pk_fp8_f32(a, b, 0, false); p = __builtin_amdgcn_cvt_pk_fp8_f32(c, d, p, true); return (unsigned)p; }
DI unsigned pack_i8x4(float a, float b, float c, float d) {
    const int ia = (int)__builtin_rintf(__builtin_amdgcn_fmed3f(a, -127.f, 127.f)), ib = (int)__builtin_rintf(__builtin_amdgcn_fmed3f(b, -127.f, 127.f));
    const int ic = (int)__builtin_rintf(__builtin_amdgcn_fmed3f(c, -127.f, 127.f)), id = (int)__builtin_rintf(__builtin_amdgcn_fmed3f(d, -127.f, 127.f));
    return (unsigned)(ia & 255) | ((unsigned)(ib & 255) << 8) | ((unsigned)(ic & 255) << 16) | ((unsigned)(id & 255) << 24); }
struct CvSrc { const float* p; unsigned ldw; bool zero; };
DI void cv_load(const CvSrc s, int lane, float (&v)[32]) {
    if (s.zero) {
#pragma unroll
        for (int i = 0; i < 32; ++i) v[i] = 0.f;
    } else {
        const unsigned loff = (unsigned)(lane >> 5) * s.ldw + (unsigned)(lane & 31);
        const float* rp = s.p;
#pragma unroll
        for (int i = 0; i < 32; ++i) { v[i] = rp[loff]; rp += 2 * s.ldw; }
    }
}
DI void cv_emit_bf16(const LAS float* scr, int lane, bf16* WT, size_t K, int drow0, int kcol) {
    const int c = lane & 7;
#pragma unroll
    for (int j = 0; j < 4; ++j) { const int n = (lane >> 3) + 8 * j; const LAS float* s = scr + (8 * c) * 33 + n;
        v4u o; o.x = pk2(s[0 * 33], s[1 * 33]); o.y = pk2(s[2 * 33], s[3 * 33]); o.z = pk2(s[4 * 33], s[5 * 33]); o.w = pk2(s[6 * 33], s[7 * 33]);
        *(GAS v4u*)(WT + (size_t)(drow0 + n) * K + kcol + 8 * c) = o; }
}
DI void cv_emit_f8(const LAS float* scr, int lane, unsigned char* WT, size_t K, int drow0, int kcol, float scale) {
    const int c = lane & 3;
#pragma unroll
    for (int j = 0; j < 2; ++j) { const int n = (lane >> 2) + 16 * j; const LAS float* s = scr + (16 * c) * 33 + n;
        v4u o;
#pragma unroll
        for (int w = 0; w < 4; ++w) o[w] = pack_fp8x4(s[(4 * w) * 33] * scale, s[(4 * w + 1) * 33] * scale, s[(4 * w + 2) * 33] * scale, s[(4 * w + 3) * 33] * scale);
        *(GAS v4u*)(WT + (size_t)(drow0 + n) * K + kcol + 16 * c) = o; }
}
DI void cv_emit_i8(const LAS float* scr, int lane, unsigned char* WT, size_t K, int drow0, int kcol, float scale) {
    const int c = lane & 3;
#pragma unroll
    for (int j = 0; j < 2; ++j) { const int n = (lane >> 2) + 16 * j; const LAS float* s = scr + (16 * c) * 33 + n;
        v4u o;
#pragma unroll
        for (int w = 0; w < 4; ++w) o[w] = pack_i8x4(s[(4 * w) * 33] * scale, s[(4 * w + 1) * 33] * scale, s[(4 * w + 2) * 33] * scale, s[(4 * w + 3) * 33] * scale);
        *(GAS v4u*)(WT + (size_t)(drow0 + n) * K + kcol + 16 * c) = o; }
}
template <class Dec, class Emit> DI void cv_runx(const Ctx& C, int first, int nitems, int stride, Dec dec, Emit emit) {
    LAS float* scr = (LAS float*)(C.lds + C.wave * 16384);
    LAS float* sw = scr + (C.lane >> 5) * 33 + (C.lane & 31);
    float v[32];
    int it = first;
    if (it < nitems) cv_load(dec(it), C.lane, v);
#pragma unroll 1
    while (it < nitems) {
#pragma unroll
        for (int i = 0; i < 32; ++i) sw[66 * i] = v[i];
        const int nit = it + stride;
        if (nit < nitems) cv_load(dec(nit), C.lane, v);
        LDS_WAIT(); asm volatile("" ::: "memory");
        emit(it, scr);
        LDS_WAIT(); asm volatile("" ::: "memory");
        it = nit;
    }
}
template <class Dec, class Emit> DI void cv_run(const Ctx& C, int nitems, Dec dec, Emit emit) { cv_runx(C, C.gw, nitems, C.NGW, dec, emit); }
constexpr int CONV_WOCAT_ITEMS = (KCAT / 64) * (DM / 32), CONV_WOUT_ITEMS = (DM / 64) * (DM / 32);
DI void conv_wocat(const Ctx& C, const float* womla, const float* wodsa, const float* womem, unsigned char* wt, int first = -1, int last = 0, int stride = 0) {
    constexpr int nblk = DM / 32, items = (KCAT / 64) * nblk;
    cv_runx(C, first < 0 ? C.gw : first, first < 0 ? items : last, first < 0 ? C.NGW : stride,
        [&](int it) -> CvSrc { const int kb = it / nblk, nb = it % nblk, k = 64 * kb;
            const float* w = (k < 1536) ? womla + (size_t)k * DM : (k < 3072) ? wodsa + (size_t)(k - 1536) * DM : (k < 4096) ? womem + (size_t)(k - 3072) * DM : womem;
            return CvSrc{w + 32 * nb, (unsigned)DM, k >= 4096}; },
        [&](int it, const LAS float* scr) { const int kb = it / nblk, nb = it % nblk; cv_emit_f8(scr, C.lane, wt, KCAT, 32 * nb, 64 * kb, WO_SCALE); });
}
DI void conv_plain8(const Ctx& C, const float* w, int K, int N, unsigned char* wt, float scale, int first = -1, int last = 0, int stride = 0) {
    const int nblk = N / 32, items = (K / 64) * nblk;
    cv_runx(C, first < 0 ? C.gw : first, first < 0 ? items : last, first < 0 ? C.NGW : stride,
        [&](int it) -> CvSrc { const int kb = it / nblk, nb = it % nblk; return CvSrc{w + (size_t)(64 * kb) * N + 32 * nb, (unsigned)N, false}; },
        [&](int it, const LAS float* scr) { const int kb = it / nblk, nb = it % nblk; cv_emit_f8(scr, C.lane, wt, (size_t)K, 32 * nb, 64 * kb, scale); });
}
DI int inproj_src(int d) {
    if (d < 2048) return d;
    if (d < 6656) return d + 64;
    if (d < 7680) return d + 2208;
    if (d < 7744) return d - 5632;
    if (d < NF8) return -1;
    if (d < NF8 + 2144) return d - NF8 + 6720;
    return -1;
}
constexpr int CONV_FFN_ITEMS = (DM / 64) * (NGU / 32) + (DFF / 64) * (DM / 32);
template <int F8, bool I8UP = false> DI void conv_ffn(const Ctx& C, const float* wg, const float* wu, const float* wd, bf16* WGUt, unsigned char* WDt, unsigned char* WDt8 = nullptr, int first = -1, int last = 0, int stride = 0) {
    constexpr int I_GU = (DM / 64) * (NGU / 32), I_D = (DFF / 64) * (DM / 32), NB_GU = NGU / 32, NB_D = DM / 32;
    static_assert(CONV_FFN_ITEMS == I_GU + I_D, "item count");
    cv_runx(C, first < 0 ? C.gw : first, first < 0 ? I_GU + I_D : last, first < 0 ? C.NGW : stride,
        [&](int it) -> CvSrc {
            if (it < I_GU) { const int kb = it / NB_GU, nb = it % NB_GU, n0 = nb * 32, pn = n0 >> 8, bj = (n0 >> 7) & 1, c = n0 & 127;
                return CvSrc{(bj ? wu : wg) + (size_t)(64 * kb) * DFF + 128 * pn + c, (unsigned)DFF, false}; }
            const int r = it - I_GU, kb = r / NB_D, nb = r % NB_D; return CvSrc{wd + (size_t)(64 * kb) * DM + 32 * nb, (unsigned)DM, false}; },
        [&](int it, const LAS float* scr) {
            if (it < I_GU) { const int kb = it / NB_GU, nb = it % NB_GU;
                if constexpr (I8UP) cv_emit_i8(scr, C.lane, (unsigned char*)WGUt, DM, 32 * nb, 64 * kb, WGU_I8_SCALE); else cv_emit_bf16(scr, C.lane, WGUt, DM, 32 * nb, 64 * kb); }
            else { const int r = it - I_GU, kb = r / NB_D, nb = r % NB_D;
                if constexpr (F8 == 1) cv_emit_f8(scr, C.lane, WDt, DFF, 32 * nb, 64 * kb, WD_SCALE);
                else { cv_emit_bf16(scr, C.lane, (bf16*)WDt, DFF, 32 * nb, 64 * kb);
                    if constexpr (F8 == 2) cv_emit_f8(scr, C.lane, WDt8, DFF, 32 * nb, 64 * kb, WD_SCALE); } } });
}
DI void conv_plain(const Ctx& C, const float* w, int K, int N, bf16* wt, int& base, int total_dummy) { (void)base; (void)total_dummy;
    const int nblk = N / 32, items = (K / 64) * nblk;
    cv_run(C, items,
        [&](int it) -> CvSrc { const int kb = it / nblk, nb = it % nblk; return CvSrc{w + (size_t)(64 * kb) * N + 32 * nb, (unsigned)N, false}; },
        [&](int it, const LAS float* scr) { const int kb = it / nblk, nb = it % nblk; cv_emit_bf16(scr, C.lane, wt, (size_t)K, 32 * nb, 64 * kb); });
}
DI void conv_win(const Ctx& C, const float* w_in, const float* w_gate, unsigned char* wt8, bf16* wti, unsigned char* wg8) {
    constexpr int nblk = NPC / 32, items = (DM / 64) * nblk, nblkg = NGC / 32, itemsg = (DM / 64) * nblkg;
    cv_run(C, items,
        [&](int it) -> CvSrc { const int kb = it / nblk, nb = it % nblk, sc = inproj_src(32 * nb); return CvSrc{w_in + (size_t)(64 * kb) * 9888 + (sc < 0 ? 0 : sc), 9888u, sc < 0}; },
        [&](int it, const LAS float* scr) { const int kb = it / nblk, nb = it % nblk, n0 = 32 * nb;
            if (n0 < NF8) cv_emit_f8(scr, C.lane, wt8, DM, n0, 64 * kb, WIN_SCALE); else cv_emit_bf16(scr, C.lane, wti, DM, n0 - NF8, 64 * kb); });
    cv_run(C, itemsg,
        [&](int it) -> CvSrc { const int kb = it / nblkg, nb = it % nblkg, gi = 32 * nb, br = gi / DM, col = gi % DM; return CvSrc{w_gate + (size_t)br * DM * DM + (size_t)(64 * kb) * DM + col, (unsigned)DM, false}; },
        [&](int it, const LAS float* scr) { const int kb = it / nblkg, nb = it % nblkg; cv_emit_f8(scr, C.lane, wg8, DM, 32 * nb, 64 * kb, WG_SCALE); });
}
DI void rms_row4096(const float* xrow, const float* g, bf16* orow, int lane) {
    const GAS f32x4* xr = (const GAS f32x4*)xrow + lane; const GAS f32x4* gr = (const GAS f32x4*)g + lane;
    f32x4 v[16]; float s = 0.f;
#pragma unroll
    for (int j = 0; j < 16; ++j) { v[j] = xr[64 * j]; s += (v[j].x * v[j].x + v[j].y * v[j].y) + (v[j].z * v[j].z + v[j].w * v[j].w); }
    const float rstd = rsqrtf(wave_sum(s) * (1.f / 4096.f) + EPS);
    GAS v2u* o8 = (GAS v2u*)orow + lane;
#pragma unroll
    for (int j = 0; j < 16; ++j) { const f32x4 gg = gr[64 * j]; v2u o; o.x = pk2(v[j].x * rstd * gg.x, v[j].y * rstd * gg.y); o.y = pk2(v[j].z * rstd * gg.z, v[j].w * rstd * gg.w); o8[64 * j] = o; }
}
DI void rms_row4096_dual(const float* xrow, const float* g, bf16* orow, unsigned char* orow8, int lane) {
    const GAS f32x4* xr = (const GAS f32x4*)xrow + lane; const GAS f32x4* gr = (const GAS f32x4*)g + lane;
    f32x4 v[16]; float s = 0.f;
#pragma unroll
    for (int j = 0; j < 16; ++j) { v[j] = xr[64 * j]; s += (v[j].x * v[j].x + v[j].y * v[j].y) + (v[j].z * v[j].z + v[j].w * v[j].w); }
    const float rstd = rsqrtf(wave_sum(s) * (1.f / 4096.f) + EPS);
    GAS v2u* o8 = (GAS v2u*)orow + lane; GAS unsigned* q8 = (GAS unsigned*)orow8 + lane;
#pragma unroll
    for (int j = 0; j < 16; ++j) { const f32x4 gg = gr[64 * j]; const float a = v[j].x * rstd * gg.x, b = v[j].y * rstd * gg.y, c = v[j].z * rstd * gg.z, d = v[j].w * rstd * gg.w;
        v2u o; o.x = pk2(a, b); o.y = pk2(c, d); o8[64 * j] = o; q8[64 * j] = pack_fp8x4(a, b, c, d); }
}
DI void rms_row4096_dual_add(const float* xrow, const bf16* drow, float dscale, float* x1row, const float* g, bf16* orow, unsigned char* orow8, int lane) {
    const GAS f32x4* xr = (const GAS f32x4*)xrow + lane; const GAS v2u* dr = (const GAS v2u*)drow + lane; const GAS f32x4* gr = (const GAS f32x4*)g + lane;
    f32x4 v[16]; v2u dd[16]; float s = 0.f;
#pragma unroll
    for (int j = 0; j < 16; ++j) { v[j] = xr[64 * j]; dd[j] = dr[64 * j]; }
    GAS f32x4* xo = (GAS f32x4*)x1row + lane;
#pragma unroll
    for (int j = 0; j < 16; ++j) { v[j].x += dscale * __uint_as_float(dd[j].x << 16); v[j].y += dscale * __uint_as_float(dd[j].x & 0xffff0000u); v[j].z += dscale * __uint_as_float(dd[j].y << 16); v[j].w += dscale * __uint_as_float(dd[j].y & 0xffff0000u);
        if (x1row) xo[64 * j] = v[j];
        s += (v[j].x * v[j].x + v[j].y * v[j].y) + (v[j].z * v[j].z + v[j].w * v[j].w); }
    const float rstd = rsqrtf(wave_sum(s) * (1.f / 4096.f) + EPS);
    GAS v2u* o8 = (GAS v2u*)orow + lane; GAS unsigned* q8 = (GAS unsigned*)orow8 + lane;
#pragma unroll
    for (int j = 0; j < 16; ++j) { const f32x4 gg = gr[64 * j]; const float a = v[j].x * rstd * gg.x, b = v[j].y * rstd * gg.y, c = v[j].z * rstd * gg.z, d = v[j].w * rstd * gg.w;
        v2u o; o.x = pk2(a, b); o.y = pk2(c, d); o8[64 * j] = o; q8[64 * j] = pack_fp8x4(a, b, c, d); }
}
DI void rms_rows_dual_add(const Ctx& C, const float* x, const bf16* d, float dscale, float* x1, const float* g, bf16* o, unsigned char* o8, int rows) {
    for (int m = C.gw; m < rows; m += C.NGW) rms_row4096_dual_add(x + (size_t)m * DM, d + (size_t)m * DM, dscale, x1 ? x1 + (size_t)m * DM : nullptr, g, o + (size_t)m * DM, o8 + (size_t)m * DM, C.lane);
}
DI void rms_rows_dual(const Ctx& C, const float* x, const float* g, bf16* o, unsigned char* o8, int rows) {
    for (int m = C.gw; m < rows; m += C.NGW) rms_row4096_dual(x + (size_t)m * DM, g, o + (size_t)m * DM, o8 + (size_t)m * DM, C.lane);
}
DI void rms_row4096_i8(const float* xrow, const float* g, unsigned char* orow, float* rowscale, float wscale, int lane) {
    const GAS f32x4* xr = (const GAS f32x4*)xrow + lane; const GAS f32x4* gr = (const GAS f32x4*)g + lane;
    f32x4 v[16]; float s = 0.f;
#pragma unroll
    for (int j = 0; j < 16; ++j) { v[j] = xr[64 * j]; s += (v[j].x * v[j].x + v[j].y * v[j].y) + (v[j].z * v[j].z + v[j].w * v[j].w); }
    const float rstd = rsqrtf(wave_sum(s) * (1.f / 4096.f) + EPS);
    float am = 0.f;
#pragma unroll
    for (int j = 0; j < 16; ++j) { const f32x4 gg = gr[64 * j]; v[j] = v[j] * rstd * gg; am = fmaxf(am, fmaxf(fmaxf(__builtin_fabsf(v[j].x), __builtin_fabsf(v[j].y)), fmaxf(__builtin_fabsf(v[j].z), __builtin_fabsf(v[j].w)))); }
#pragma unroll
    for (int o = 1; o < 64; o <<= 1) am = fmaxf(am, __shfl_xor(am, o));
    am = fmaxf(am, 1e-20f);
    const float q = 127.f / am;
    GAS unsigned* q8 = (GAS unsigned*)orow + lane;
#pragma unroll
    for (int j = 0; j < 16; ++j) q8[64 * j] = pack_i8x4(v[j].x * q, v[j].y * q, v[j].z * q, v[j].w * q);
    if (lane == 0) *rowscale = am / (127.f * wscale);
}
DI void rms_row4096_i8_add(const float* xrow, const bf16* drow, const float* g, unsigned char* orow, float* rowscale, float wscale, int lane, bf16* x2row = nullptr, const bf16* d1row = nullptr, float d1scale = 0.f) {
    const GAS f32x4* xr = (const GAS f32x4*)xrow + lane; const GAS v2u* dr = (const GAS v2u*)drow + lane; const GAS f32x4* gr = (const GAS f32x4*)g + lane;
    f32x4 v[16]; v2u dd[16]; float s = 0.f;
#pragma unroll
    for (int j = 0; j < 16; ++j) { v[j] = xr[64 * j]; dd[j] = dr[64 * j]; }
    if (d1row) { const GAS v2u* d1r = (const GAS v2u*)d1row + lane; v2u d1[16];
#pragma unroll
        for (int j = 0; j < 16; ++j) d1[j] = d1r[64 * j];
#pragma unroll
        for (int j = 0; j < 16; ++j) { v[j].x += d1scale * __uint_as_float(d1[j].x << 16); v[j].y += d1scale * __uint_as_float(d1[j].x & 0xffff0000u); v[j].z += d1scale * __uint_as_float(d1[j].y << 16); v[j].w += d1scale * __uint_as_float(d1[j].y & 0xffff0000u); } }
#pragma unroll
    for (int j = 0; j < 16; ++j) { v[j].x += __uint_as_float(dd[j].x << 16); v[j].y += __uint_as_float(dd[j].x & 0xffff0000u); v[j].z += __uint_as_float(dd[j].y << 16); v[j].w += __uint_as_float(dd[j].y & 0xffff0000u);
        if (x2row) { v2u o; o.x = pk2(v[j].x, v[j].y); o.y = pk2(v[j].z, v[j].w); ((GAS v2u*)x2row + lane)[64 * j] = o; }
        s += (v[j].x * v[j].x + v[j].y * v[j].y) + (v[j].z * v[j].z + v[j].w * v[j].w); }
    const float rstd = rsqrtf(wave_sum(s) * (1.f / 4096.f) + EPS);
    float am = 0.f;
#pragma unroll
    for (int j = 0; j < 16; ++j) { const f32x4 gg = gr[64 * j]; v[j] = v[j] * rstd * gg; am = fmaxf(am, fmaxf(fmaxf(__builtin_fabsf(v[j].x), __builtin_fabsf(v[j].y)), fmaxf(__builtin_fabsf(v[j].z), __builtin_fabsf(v[j].w)))); }
#pragma unroll
    for (int o = 1; o < 64; o <<= 1) am = fmaxf(am, __shfl_xor(am, o));
    am = fmaxf(am, 1e-20f);
    const float q = 127.f / am;
    GAS unsigned* q8 = (GAS unsigned*)orow + lane;
#pragma unroll
    for (int j = 0; j < 16; ++j) q8[64 * j] = pack_i8x4(v[j].x * q, v[j].y * q, v[j].z * q, v[j].w * q);
    if (lane == 0) *rowscale = am / (127.f * wscale);
}
DI void rms_rows_i8_add(const Ctx& C, const float* x, const bf16* d, const float* g, unsigned char* o, float* rowscale, float wscale, int rows, bf16* x2 = nullptr, const bf16* d1 = nullptr, float d1scale = 0.f) {
    for (int m = C.gw; m < rows; m += C.NGW) rms_row4096_i8_add(x + (size_t)m * DM, d + (size_t)m * DM, g, o + (size_t)m * DM, rowscale + m, wscale, C.lane, x2 ? x2 + (size_t)m * DM : nullptr, d1 ? d1 + (size_t)m * DM : nullptr, d1scale);
}
DI void rms_rows_i8(const Ctx& C, const float* x, const float* g, unsigned char* o, float* rowscale, float wscale, int rows) {
    for (int m = C.gw; m < rows; m += C.NGW) rms_row4096_i8(x + (size_t)m * DM, g, o + (size_t)m * DM, rowscale + m, wscale, C.lane);
}
DI void rms_rows(const Ctx& C, const float* x, const float* g, bf16* o, int rows) {
    for (int m = C.gw; m < rows; m += C.NGW) rms_row4096(x + (size_t)m * DM, g, o + (size_t)m * DM, C.lane);
}

struct PP1 { const bf16* P; const int* pos; const float *g_cq, *g_ckv, *g_qd, *g_kd, *g_qm;
             unsigned char *CQn, *CKVn; bf16 *Qd, *Kd, *Vd, *Qi, *Ki, *Kr, *Qm; float* Wi; unsigned char* Ycat; };
DI void unpack8(const v4u w, float (&f)[8]) {
#pragma unroll
    for (int k = 0; k < 4; ++k) { f[2 * k] = __uint_as_float(w[k] << 16); f[2 * k + 1] = __uint_as_float(w[k] & 0xffff0000u); }
}
DI unsigned cvtpk_rne(float lo, float hi) { unsigned r; asm volatile("v_cvt_pk_bf16_f32 %0, %1, %2" : "=v"(r) : "v"(lo), "v"(hi)); return r; }
DI v4u pack8(const float (&f)[8]) { v4u w; w.x = cvtpk_rne(f[0], f[1]); w.y = cvtpk_rne(f[2], f[3]); w.z = cvtpk_rne(f[4], f[5]); w.w = cvtpk_rne(f[6], f[7]); return w; }
DI float sumsq8(const float (&f)[8]) { float s = 0.f;
#pragma unroll
    for (int e = 0; e < 8; ++e) s += f[e] * f[e];
    return s; }
DI void load8f(const float* p, float (&f)[8]) { const f32x4 a = *(const f32x4*)p, b = *(const f32x4*)(p + 4); f[0] = a.x; f[1] = a.y; f[2] = a.z; f[3] = a.w; f[4] = b.x; f[5] = b.y; f[6] = b.z; f[7] = b.w; }
DI void pp1_load(const PP1& A, int t, int lane, v4u (&R)[20], int& posi) {
    const bf16* pr = A.P + (size_t)t * NPC;
    posi = A.pos[t];
#pragma unroll
    for (int j = 0; j < 3; ++j) { R[j] = *(const v4u*)(pr + PC_CQ + 8 * (lane + 64 * j)); R[4 + j] = *(const v4u*)(pr + PC_QD + 8 * (lane + 64 * j));
        R[7 + j] = *(const v4u*)(pr + PC_KD + 8 * (lane + 64 * j));
#if !VD_DIRECT
        R[10 + j] = *(const v4u*)(pr + PC_VD + 8 * (lane + 64 * j));
#endif
    }
    R[3] = *(const v4u*)(pr + PC_CKV + 8 * lane);
#pragma unroll
    for (int j = 0; j < 4; ++j) R[13 + j] = *(const v4u*)(pr + PC_QI + 8 * (lane + 64 * j));
    R[17] = *(const v4u*)(pr + (lane < 8 ? PC_KR + 8 * lane : PC_KI + 8 * ((lane < 20 ? lane : 8) - 8)));
#pragma unroll
    for (int j = 0; j < 2; ++j) R[18 + j] = *(const v4u*)(pr + PC_QM + 8 * (lane + 64 * j));
}
DI void load8f_l(const LAS float* p, float (&f)[8]) { const f32x4 a = *(const LAS f32x4*)p, b = *(const LAS f32x4*)(p + 4); f[0] = a.x; f[1] = a.y; f[2] = a.z; f[3] = a.w; f[4] = b.x; f[5] = b.y; f[6] = b.z; f[7] = b.w; }
DI void pp1_token(const PP1& A, int t, int lane, LAS float* tab, const v4u (&R)[20], int posi, const LAS float* GL) {
    const float pos = (float)posi;
    {   float sn, cs;
        if (lane < 16) { sincos_rev(pos * inv_freq(lane, 16), sn, cs); tab[lane] = cs; tab[16 + lane] = sn; }
        else if (lane < 24) { sincos_rev(pos * inv_freq(lane - 16, 8), sn, cs); tab[32 + lane - 16] = cs; tab[40 + lane - 16] = sn; }
        LDS_WAIT(); }
    {
        float x[3][8]; float ss = 0.f;
#pragma unroll
        for (int j = 0; j < 3; ++j) { unpack8(R[j], x[j]); ss += sumsq8(x[j]); }
        const float rstd = rsqrtf(wave_sum(ss) * (1.f / 1536.f) + EPS);
#pragma unroll
        for (int j = 0; j < 3; ++j) { float g[8]; load8f_l(GL + 8 * (lane + 64 * j), g);
#pragma unroll
            for (int e = 0; e < 8; ++e) x[j][e] *= rstd * g[e];
            v2u w8; w8.x = pack_fp8x4(x[j][0], x[j][1], x[j][2], x[j][3]); w8.y = pack_fp8x4(x[j][4], x[j][5], x[j][6], x[j][7]);
            *(v2u*)(A.CQn + (size_t)t * 1536 + 8 * (lane + 64 * j)) = w8; }
    }
    {
        float x[8]; unpack8(R[3], x);
        const float rstd = rsqrtf(wave_sum(sumsq8(x)) * (1.f / 512.f) + EPS);
        float g[8]; load8f_l(GL + 1536 + 8 * lane, g);
#pragma unroll
        for (int e = 0; e < 8; ++e) x[e] *= rstd * g[e];
        v2u w8; w8.x = pack_fp8x4(x[0], x[1], x[2], x[3]); w8.y = pack_fp8x4(x[4], x[5], x[6], x[7]);
        *(v2u*)(A.CKVn + (size_t)t * 512 + 8 * lane) = w8;
    }
    {
        const int cc = lane & 15;
        float cs[8], sn[8];
#pragma unroll
        for (int e = 0; e < 8; ++e) { cs[e] = tab[8 * (cc & 1) + e]; sn[e] = tab[16 + 8 * (cc & 1) + e]; }
#pragma unroll
        for (int qk = 0; qk < 2; ++qk) {
            bf16* O = qk ? A.Kd : A.Qd; const float sc = qk ? 1.0f : QS_DSA;
            float g[8]; load8f_l(GL + 2048 + 128 * qk + 8 * cc, g);
#pragma unroll
            for (int j = 0; j < 3; ++j) {
                float x[8]; unpack8(R[4 + 3 * qk + j], x);
                float ss = sumsq8(x); ss += __shfl_xor(ss, 1); ss += __shfl_xor(ss, 2); ss += __shfl_xor(ss, 4); ss += __shfl_xor(ss, 8);
                const float rstd = rsqrtf(ss * (1.f / 128.f) + EPS);
#pragma unroll
                for (int e = 0; e < 8; ++e) x[e] *= rstd * g[e];
                float y[8];
#pragma unroll
                for (int e = 0; e < 8; ++e) { const float pv = __shfl_xor(x[e], 2); y[e] = (cc < 2) ? x[e] * cs[e] - pv * sn[e] : ((cc < 4) ? x[e] * cs[e] + pv * sn[e] : x[e]); y[e] *= sc; }
                *(v4u*)(O + (size_t)t * 1536 + 8 * (lane + 64 * j)) = pack8(y);
            }
        }
    }
    if constexpr (KCAT > 4096) *(v2u*)(A.Ycat + (size_t)t * KCAT + 4096 + 8 * lane) = (v2u){0u, 0u};
#if !VD_DIRECT
#pragma unroll
    for (int j = 0; j < 3; ++j) *(v4u*)(A.Vd + (size_t)t * 1536 + 8 * (lane + 64 * j)) = R[10 + j];
#endif
    {
        const int cc = lane & 7;
        float cs[8], sn[8];
#pragma unroll
        for (int e = 0; e < 8; ++e) { cs[e] = tab[32 + e]; sn[e] = tab[40 + e]; }
#pragma unroll
        for (int j = 0; j < 4; ++j) {
            float x[8]; unpack8(R[13 + j], x);
            float y[8];
#pragma unroll
            for (int e = 0; e < 8; ++e) { const float pv = __shfl_xor(x[e], 1); y[e] = (cc == 0) ? x[e] * cs[e] - pv * sn[e] : ((cc == 1) ? x[e] * cs[e] + pv * sn[e] : x[e]); }
            *(v4u*)(A.Qi + (size_t)t * 2048 + 8 * (lane + 64 * j)) = pack8(y);
        }
        float x[8]; unpack8(R[17], x);
        float y[8];
#pragma unroll
        for (int e = 0; e < 8; ++e) { const float pv = __shfl_xor(x[e], 1); y[e] = (lane == 8) ? x[e] * cs[e] - pv * sn[e] : ((lane == 9) ? x[e] * cs[e] + pv * sn[e] : x[e]); }
        if (lane < 8) *(v4u*)(A.Kr + (size_t)t * 64 + 8 * lane) = pack8(x);
        else if (lane < 16) *(v4u*)(A.Ki + (size_t)t * 64 + 8 * (lane - 8)) = pack8(y);
        else if (lane < 20) { float* wo = A.Wi + (size_t)t * 32 + 8 * (lane - 16); *(f32x4*)wo = (f32x4){x[0], x[1], x[2], x[3]}; *(f32x4*)(wo + 4) = (f32x4){x[4], x[5], x[6], x[7]}; }
    }
    {
        const int cc = lane & 31;
        float g[8]; load8f_l(GL + 2304 + 8 * cc, g);
#pragma unroll
        for (int j = 0; j < 2; ++j) {
            float x[8]; unpack8(R[18 + j], x);
            float ss = sumsq8(x); ss += __shfl_xor(ss, 1); ss += __shfl_xor(ss, 2); ss += __shfl_xor(ss, 4); ss += __shfl_xor(ss, 8); ss += __shfl_xor(ss, 16);
            const float rstd = rsqrtf(ss * (1.f / 256.f) + EPS) * QS_MEM;
#pragma unroll
            for (int e = 0; e < 8; ++e) x[e] *= rstd * g[e];
            *(v4u*)(A.Qm + (size_t)t * 1024 + 8 * (lane + 64 * j)) = pack8(x);
        }
    }
    LDS_WAIT();
}
struct PP2 { const bf16 *QmlaRaw, *KVraw, *Kr, *MKVraw; const int* pos; const float *g_q, *g_k, *g_km; bf16 *Qmla, *Kmla, *MemK; };
DI void pp2_token(const PP2& A, int t, int lane, LAS float* tab) {
    const float pos = (float)A.pos[t];
    if (lane < 32) { float sn, cs; sincos_rev(pos * inv_freq(lane, 32), sn, cs); tab[lane] = cs; tab[32 + lane] = sn; }
    LDS_WAIT();
    const int sub = lane & 7, slot = lane >> 3;
    float cs[8], sn[8], gq[3][8], gk[3][8], kr[8];
#pragma unroll
    for (int e = 0; e < 8; ++e) { cs[e] = tab[8 * (sub & 3) + e]; sn[e] = tab[32 + 8 * (sub & 3) + e]; }
#pragma unroll
    for (int j = 0; j < 3; ++j) { load8f(A.g_q + 64 * j + 8 * sub, gq[j]); load8f(A.g_k + 64 * j + 8 * sub, gk[j]); }
    unpack8(*(const v4u*)(A.Kr + (size_t)t * 64 + 8 * sub), kr);
#pragma unroll 1
    for (int pass = 0; pass < 2; ++pass) {
        const int h = 8 * pass + slot; const bool on = h < 12; const int hh = on ? h : 0;
#pragma unroll
        for (int qk = 0; qk < 2; ++qk) {
            float x[3][8];
            if (qk == 0) { const bf16* q = A.QmlaRaw + (size_t)t * 2304 + hh * 192;
#pragma unroll
                for (int j = 0; j < 3; ++j) unpack8(*(const v4u*)(q + 64 * j + 8 * sub), x[j]); }
            else { const bf16* kv = A.KVraw + (size_t)t * 3072 + hh * 256;
#pragma unroll
                for (int e = 0; e < 8; ++e) x[0][e] = kr[e];
                unpack8(*(const v4u*)(kv + 8 * sub), x[1]); unpack8(*(const v4u*)(kv + 64 + 8 * sub), x[2]); }
            float ss = sumsq8(x[0]) + sumsq8(x[1]) + sumsq8(x[2]); ss += __shfl_xor(ss, 1); ss += __shfl_xor(ss, 2); ss += __shfl_xor(ss, 4);
            const float rstd = rsqrtf(ss * (1.f / 192.f) + EPS), sc = qk ? 1.0f : QS_MLA;
#pragma unroll
            for (int j = 0; j < 3; ++j)
#pragma unroll
                for (int e = 0; e < 8; ++e) x[j][e] *= rstd * (qk ? gk[j][e] : gq[j][e]);
            float y[8];
#pragma unroll
            for (int e = 0; e < 8; ++e) { const float pv = __shfl_xor(x[0][e], 4); y[e] = ((sub < 4) ? x[0][e] * cs[e] - pv * sn[e] : x[0][e] * cs[e] + pv * sn[e]) * sc; }
#pragma unroll
            for (int e = 0; e < 8; ++e) { x[1][e] *= sc; x[2][e] *= sc; }
            if (on) { bf16* o = (qk ? A.Kmla : A.Qmla) + (size_t)t * 2304 + h * 192;
                *(v4u*)(o + 8 * sub) = pack8(y); *(v4u*)(o + 64 + 8 * sub) = pack8(x[1]); *(v4u*)(o + 128 + 8 * sub) = pack8(x[2]); }
        }
    }
    LDS_WAIT();
}
DI void pp2_memrow(const PP2& A, int r, int lane) {
#pragma unroll
    for (int h = 0; h < 4; ++h) {
        float x[4]; float ss = 0.f;
#pragma unroll
        for (int k = 0; k < 4; ++k) { x[k] = bf2f(A.MKVraw[(size_t)r * 2048 + h * 256 + lane + 64 * k]); ss += x[k] * x[k]; }
        const float rstd = rsqrtf(wave_sum(ss) * (1.f / 256.f) + EPS);
#pragma unroll
        for (int k = 0; k < 4; ++k) A.MemK[(size_t)r * 1024 + h * 256 + lane + 64 * k] = (bf16)f2bf(x[k] * rstd * A.g_km[lane + 64 * k]);
    }
}

#define MFMA32(a, b, c) __builtin_amdgcn_mfma_f32_32x32x16_bf16((a), (b), (c), 0, 0, 0)
DI float relu_asm(float x) { const int b = __float_as_int(x); return __int_as_float(b > 0 ? b : 0); }
DI float half_swap_sum(float v) { auto rr = __builtin_amdgcn_permlane32_swap(__float_as_uint(v), __float_as_uint(v), false, false); return __uint_as_float(rr[0]) + __uint_as_float(rr[1]); }
DI float half_swap_max(float v) { auto rr = __builtin_amdgcn_permlane32_swap(__float_as_uint(v), __float_as_uint(v), false, false); return fmaxf(__uint_as_float(rr[0]), __uint_as_float(rr[1])); }
DI size_t sc_block_off(int b, int bi) { return (size_t)b * SC_BATCH + (size_t)4096 * (size_t)(bi * (bi + 1) / 2); }
constexpr int IDX_KSTR = 144, IDX_TILE = 256 * IDX_KSTR;
DI void idx_item(int p, const bf16* Qi, const bf16* Ki, const float* Wi, float* Sc, LAS unsigned char* lds) {
    int tid_ = threadIdx.x; asm volatile("" : "+v"(tid_));
    const int tid = tid_, wave = __builtin_amdgcn_readfirstlane(tid >> 6), lane = tid & 63;
    const int b = p >> 7, r = p & 127, hs = r & 1, k = r >> 1, r32 = lane & 31, hi = lane >> 5;
    const int srow = tid >> 3, scc = tid & 7;
#pragma unroll 1
    for (int which = 0; which < 2; ++which) {
        const int bi = which ? 127 - k : k, ncol = (bi + 1) * 64, nT = (ncol + 255) >> 8;
        float* scb = Sc + sc_block_off(b, bi);
        const bf16* kbase = Ki + (size_t)(b * SEQ) * 64;
#pragma unroll 1
        for (int pass = 0; pass < 2; ++pass) {
            const int qa = 32 * hs + 4 * wave + 2 * pass, ta = b * SEQ + bi * 64 + qa;
            bf16x8 A0[4], A1[4]; f32x4 w0[4], w1[4];
#pragma unroll
            for (int d0 = 0; d0 < 4; ++d0) { A0[d0] = *(const bf16x8*)(Qi + (size_t)ta * 2048 + r32 * 64 + d0 * 16 + hi * 8); A1[d0] = *(const bf16x8*)(Qi + (size_t)(ta + 1) * 2048 + r32 * 64 + d0 * 16 + hi * 8); }
#pragma unroll
            for (int g = 0; g < 4; ++g) { w0[g] = *(const f32x4*)(Wi + (size_t)ta * 32 + 8 * g + 4 * hi); w1[g] = *(const f32x4*)(Wi + (size_t)(ta + 1) * 32 + 8 * g + 4 * hi); }
            float* o0 = scb + (size_t)qa * ncol + r32; float* o1 = o0 + ncol;
            v4u st[4];
#define IDX_GLOAD(T_) do { _Pragma("unroll") for (int i_ = 0; i_ < 4; ++i_) { const bf16* gp_ = kbase + (size_t)((T_) * 256 + srow + 64 * i_) * 64 + scc * 8; \
        asm volatile("global_load_dwordx4 %0, %1, off" : "=v"(st[i_]) : "v"(gp_) : "memory"); } } while (0)
#define IDX_LWRITE(buf_) do { _Pragma("unroll") for (int i_ = 0; i_ < 4; ++i_) *(LAS v4u*)(lds + (buf_) * IDX_TILE + (srow + 64 * i_) * IDX_KSTR + scc * 16) = st[i_]; } while (0)
#define IDX_LOADB(B, sub_) do { _Pragma("unroll") for (int d0_ = 0; d0_ < 4; ++d0_) B[d0_] = *(const LAS bf16x8*)(tb + ((sub_) * 32 + r32) * IDX_KSTR + d0_ * 32 + hi * 16); } while (0)
#define IDX_MMA(c0_, c1_, B) do { _Pragma("unroll") for (int i_ = 0; i_ < 16; ++i_) { c0_[i_] = 0.f; c1_[i_] = 0.f; } \
        _Pragma("unroll") for (int d0_ = 0; d0_ < 4; ++d0_) { c0_ = MFMA32(A0[d0_], B[d0_], c0_); c1_ = MFMA32(A1[d0_], B[d0_], c1_); } } while (0)
#define IDX_RELU(x_) relu_asm(x_)
#define IDX_EPI(c0_, c1_, col_) do { float s0_[4] = {0.f, 0.f, 0.f, 0.f}, s1_[4] = {0.f, 0.f, 0.f, 0.f};     \
        _Pragma("unroll") for (int i_ = 0; i_ < 16; ++i_) { s0_[i_ & 3] = fmaf(w0[i_ >> 2][i_ & 3], IDX_RELU(c0_[i_]), s0_[i_ & 3]); s1_[i_ & 3] = fmaf(w1[i_ >> 2][i_ & 3], IDX_RELU(c1_[i_]), s1_[i_ & 3]); } \
        float t0_ = (s0_[0] + s0_[1]) + (s0_[2] + s0_[3]), t1_ = (s1_[0] + s1_[1]) + (s1_[2] + s1_[3]); \
        t0_ = half_swap_sum(t0_); t1_ = half_swap_sum(t1_); if (hi == 0) { o0[(col_)] = t0_; o1[(col_)] = t1_; } } while (0)
            IDX_GLOAD(0); asm volatile("s_waitcnt vmcnt(0)" ::: "memory"); IDX_LWRITE(0);
            __syncthreads();
#pragma unroll 1
            for (int T = 0; T < nT; ++T) {
                if (T + 1 < nT) IDX_GLOAD(T + 1);
                const LAS unsigned char* tb = lds + (T & 1) * IDX_TILE;
                const int nsub = min(8, (ncol - T * 256) >> 5);
                bf16x8 BA[4], BB[4]; f32x16 cA0, cA1, cB0, cB1;
                IDX_LOADB(BA, 0); IDX_LOADB(BB, 1);
                IDX_MMA(cA0, cA1, BA);
#pragma unroll 1
                for (int sub = 0; sub < nsub; sub += 2) {
                    const bool more = sub + 2 < nsub;
                    IDX_MMA(cB0, cB1, BB);
                    if (more) IDX_LOADB(BA, sub + 2);
                    IDX_EPI(cA0, cA1, T * 256 + sub * 32);
                    if (more) { IDX_MMA(cA0, cA1, BA); IDX_LOADB(BB, sub + 3); }
                    IDX_EPI(cB0, cB1, T * 256 + sub * 32 + 32);
                }
                if (T + 1 < nT) { if (nsub == 8) asm volatile("s_waitcnt vmcnt(16)" ::: "memory"); else asm volatile("s_waitcnt vmcnt(0)" ::: "memory");
                    IDX_LWRITE((T + 1) & 1); }
                __syncthreads();
            }
#undef IDX_GLOAD
#undef IDX_LWRITE
#undef IDX_LOADB
#undef IDX_MMA
#undef IDX_EPI
#undef IDX_RELU
        }
    }
}
DI int suffix_scan64(int v, int lane) {
#pragma unroll
    for (int o = 1; o < 64; o <<= 1) { const int tv = __shfl_down(v, o); if (lane + o < 64) v += tv; }
    return v;
}
template <int NBITS, bool FIRST>
DI int radix_pass(const unsigned (&key)[128], int NG, int shift, unsigned& prefix, int& remaining, LAS unsigned* hist, int lane, unsigned floor_key = 0u) {
    constexpr int NB = 1 << NBITS, PER = NB / 64;
#pragma unroll
    for (int q = 0; q < PER / 4; ++q) *(LAS v4u*)(hist + PER * lane + 4 * q) = (v4u){0u, 0u, 0u, 0u};
#pragma unroll
    for (int g = 0; g < 8; ++g) {
        if (g < NG) {
#pragma unroll
            for (int r = 0; r < 16; ++r) { const unsigned k = key[16 * g + r];
                const unsigned dg = (k >> shift) & (unsigned)(NB - 1);
                if (FIRST) { if (k >= floor_key) __hip_atomic_fetch_add(hist + dg, 1u, __ATOMIC_RELAXED, __HIP_MEMORY_SCOPE_WORKGROUP); }
                else if ((k >> (shift + NBITS)) == prefix) __hip_atomic_fetch_add(hist + dg, 1u, __ATOMIC_RELAXED, __HIP_MEMORY_SCOPE_WORKGROUP); }
        }
    }
    LDS_WAIT();
    int lane_sum = 0;
#pragma unroll
    for (int q = 0; q < PER / 4; ++q) { const v4u bb = *(LAS v4u*)(hist + PER * lane + 4 * q); lane_sum += (int)(bb.x + bb.y + bb.z + bb.w); }
    const int S = suffix_scan64(lane_sum, lane), above = S - lane_sum;
    const int src = __builtin_amdgcn_readfirstlane((int)__ffsll((long long)__ballot((above < remaining) && (remaining <= S))) - 1) & 63;
    const int rem2 = remaining - __builtin_amdgcn_readlane(above, src);
    const int bv = (lane < PER) ? (int)hist[PER * src + lane] : 0;
    const int S2 = suffix_scan64(bv, lane), above2 = S2 - bv;
    const int src2 = __builtin_amdgcn_readfirstlane((int)__ffsll((long long)__ballot((above2 < rem2) && (rem2 <= S2))) - 1) & 63;
    prefix = (prefix << NBITS) | (unsigned)(PER * src + src2);
    remaining = rem2 - __builtin_amdgcn_readlane(above2, src2);
    const int cnt = __builtin_amdgcn_readlane(bv, src2);
    LDS_WAIT();
    return cnt;
}
DI void select_row(const float* Sc, unsigned long long* BM64, int t, int lane, LAS unsigned* hist, LAS unsigned long long* scr) {
    const int b = t / SEQ, s = t % SEQ, bi = s >> 6, n = (bi + 1) * 64;
    const float* row = Sc + sc_block_off(b, bi) + (size_t)(s & 63) * n;
    unsigned long long* out = BM64 + (size_t)t * 128;
    if (n <= 256) {
        out[lane] = (lane < n / 64) ? ~0ull : 0ull; out[64 + lane] = 0ull; return;
    }
    const int NG = (n + 1023) >> 10;
    unsigned key[128];
#pragma unroll
    for (int g = 0; g < 8; ++g) {
        if (g < NG) {
#pragma unroll
            for (int r = 0; r < 16; ++r) key[16 * g + r] = __float_as_uint(row[64 * (16 * g + r) + lane]);
        } else {
#pragma unroll
            for (int r = 0; r < 16; ++r) key[16 * g + r] = 0u;
        }
    }
#pragma unroll
    for (int g = 0; g < 8; ++g) {
        if (g < NG) {
#pragma unroll
            for (int r = 0; r < 16; ++r) { const int i = 16 * g + r; const unsigned u = key[i]; const unsigned kk = (u & 0x80000000u) ? ~u : (u | 0x80000000u); key[i] = (64 * i < n) ? kk : 0u; }
        }
    }
    unsigned cm0 = 0u, cm1 = 0u, cm2 = 0u, cm3 = 0u;
#pragma unroll
    for (int g = 0; g < 8; ++g) {
        if (g < NG) {
#pragma unroll
            for (int r = 0; r < 16; r += 4) { cm0 = max(cm0, key[16 * g + r]); cm1 = max(cm1, key[16 * g + r + 1]); cm2 = max(cm2, key[16 * g + r + 2]); cm3 = max(cm3, key[16 * g + r + 3]); }
        }
    }
    unsigned floor_key = min(min(cm0, cm1), min(cm2, cm3));
#pragma unroll
    for (int o = 1; o < 64; o <<= 1) floor_key = min(floor_key, (unsigned)__shfl_xor((int)floor_key, o));
    unsigned prefix = 0u; int remaining = 256;
    radix_pass<12, true>(key, NG, 20, prefix, remaining, hist, lane, floor_key);
    radix_pass<10, false>(key, NG, 10, prefix, remaining, hist, lane);
    const int cnt_eq = radix_pass<10, false>(key, NG, 0, prefix, remaining, hist, lane);
    const int need = remaining;
    if (cnt_eq == need) {
#pragma unroll
        for (int g = 0; g < 8; ++g) {
            if (g < NG) {
#pragma unroll
                for (int r = 0; r < 16; ++r) { const int i = 16 * g + r; const unsigned long long take = __ballot(key[i] >= prefix); if (lane == 0) scr[i] = take; }
            } else { if (lane < 16) scr[16 * g + lane] = 0ull; }
        }
    } else {
        int run = 0;
#pragma unroll
        for (int g = 0; g < 8; ++g) {
            if (g < NG) {
#pragma unroll
                for (int r = 0; r < 16; ++r) { const int i = 16 * g + r;
                    const bool gt = key[i] > prefix, eq = key[i] == prefix;
                    const unsigned long long eqb = __ballot(eq);
                    const int rank = run + (int)__builtin_amdgcn_mbcnt_hi((unsigned)(eqb >> 32), __builtin_amdgcn_mbcnt_lo((unsigned)eqb, 0u));
                    const unsigned long long take = __ballot(gt || (eq && rank < need));
                    run += __popcll(eqb);
                    if (lane == 0) scr[i] = take;
                    if ((r & 7) == 7) __builtin_amdgcn_sched_barrier(0); }
            } else { if (lane < 16) scr[16 * g + lane] = 0ull; }
        }
    }
    LDS_WAIT();
    const unsigned long long mine0 = scr[lane], mine1 = scr[64 + lane];
    out[lane] = mine0; out[64 + lane] = mine1;
    LDS_WAIT();
}
#ifndef ATT_LAZY
#define ATT_LAZY 2
#endif
#define ATT_TAU 8.0f
#ifndef ATT_PIPE
#define ATT_PIPE 1
#define ATT_PD 3
#endif
typedef short v4i16_t __attribute__((ext_vector_type(4)));
DI s16x4 vtr(const LAS unsigned char* p) { return __builtin_bit_cast(s16x4, __builtin_amdgcn_ds_read_tr16_b64_v4i16((LAS v4i16_t*)p)); }
DI unsigned cvtpk(float lo, float hi) { unsigned r; asm volatile("v_cvt_pk_bf16_f32 %0, %1, %2" : "=v"(r) : "v"(lo), "v"(hi)); return r; }
constexpr int VSTR = 320;
template <int DK> struct AttnLds { static constexpr int KSTR = DK * 2 + 16, KB = 64 * KSTR, VB = 64 * VSTR, K0 = 0, V0 = 2 * KB, TOTAL = 2 * KB + 2 * VB; };
static_assert(AttnLds<256>::TOTAL <= RING_BYTES, "attention LDS");

template <int DK, int MODE>
DI void attn_unit(LAS unsigned char* lds, const bf16* Qp, int LDQ, const bf16* Kp, int LDK, const bf16* Vp, int LDV, unsigned char* Op, int LDO, int NT, int chunk0, const unsigned* BMrow) {
    typedef AttnLds<DK> L;
    constexpr int ND = DK / 16, KCH = DK / 8, NKC = DK / 64;
    int tid_ = threadIdx.x; asm volatile("" : "+v"(tid_));
    const int tid = tid_, wid = __builtin_amdgcn_readfirstlane(tid >> 6), lane = tid & 63, r32 = lane & 31, hi = lane >> 5;
    const int mychunk = chunk0 + (wid >> 1);
    constexpr bool QLOOP = (DK > 192);
    bf16x8 qr[ND];
    const bf16* qw = Qp + (size_t)(wid * 32 + r32) * LDQ + hi * 8;
    if (!QLOOP) {
#pragma unroll
        for (int d0 = 0; d0 < ND; ++d0) qr[d0] = *(const bf16x8*)(qw + d0 * 16); }
    const unsigned* bmw = (MODE == 1) ? BMrow + (size_t)(wid * 32 + r32) * 256 : nullptr;
    int krow_[NKC], kcc_[NKC];
#pragma unroll
    for (int i = 0; i < NKC; ++i) { const int c = tid + 512 * i; krow_[i] = c / KCH; kcc_[i] = c % KCH; }
    const int vrow0 = tid >> 4, vcc = tid & 15;
    v4u kst[NKC], vst[2];
#define ATT_LOAD(j) do { const int key0_ = (j) * 64; \
        _Pragma("unroll") for (int i_ = 0; i_ < NKC; ++i_) kst[i_] = *(const v4u*)(Kp + (size_t)(key0_ + krow_[i_]) * LDK + kcc_[i_] * 8); \
        vst[0] = *(const v4u*)(Vp + (size_t)(key0_ + vrow0) * LDV + vcc * 8); vst[1] = *(const v4u*)(Vp + (size_t)(key0_ + 32 + vrow0) * LDV + vcc * 8); } while (0)
#define ATT_WRITE(buf) do { \
        _Pragma("unroll") for (int i_ = 0; i_ < NKC; ++i_) *(LAS v4u*)(lds + L::K0 + (buf) * L::KB + krow_[i_] * L::KSTR + kcc_[i_] * 16) = kst[i_]; \
        *(LAS v4u*)(lds + L::V0 + (buf) * L::VB + vrow0 * VSTR + vcc * 16) = vst[0]; *(LAS v4u*)(lds + L::V0 + (buf) * L::VB + (32 + vrow0) * VSTR + vcc * 16) = vst[1]; } while (0)
    float m_run = -1e30f, l_run = 0.f;
#if ATT_LAZY == 2
    float base = 0.f; f32x16 nbv;
#pragma unroll
    for (int i = 0; i < 16; ++i) nbv[i] = 0.f;
#endif
    f32x16 o[4];
#pragma unroll
    for (int d = 0; d < 4; ++d)
#pragma unroll
        for (int i = 0; i < 16; ++i) o[d][i] = 0.f;
    const int kbase = r32 * L::KSTR + hi * 16;
    const int q4 = (lane >> 2) & 3, p4 = lane & 3, blk = (lane >> 4) & 1;
    const int vbase = (4 * hi + q4) * VSTR + blk * 32 + p4 * 8;
    v2u mmn = {0xffffffffu, 0xffffffffu};
    if (MODE == 1) mmn = *(const v2u*)bmw;
    ATT_LOAD(0); ATT_WRITE(0);
    if (!QLOOP) {
#pragma unroll
        for (int d0 = 0; d0 < ND; ++d0) asm volatile("" :: "v"(qr[d0])); }
    __syncthreads();
#pragma unroll 1
    for (int j = 0; j < NT; ++j) {
        const int cur = j & 1;
        const bool active = (MODE == 2) || (j <= mychunk);
        const v2u mm = mmn;
        if (MODE == 1) { if (j + 1 < NT) mmn = *(const v2u*)(bmw + 2 * (j + 1)); }
        if (j + 1 < NT) ATT_LOAD(j + 1);
        const unsigned mw0 = mm.x >> (4 * hi), mw1 = mm.y >> (4 * hi);
        if (active) {
            f32x16 p0, p1;
#if ATT_LAZY != 2
#pragma unroll
            for (int i = 0; i < 16; ++i) { p0[i] = 0.f; p1[i] = 0.f; }
#endif
            const LAS unsigned char* kb = lds + L::K0 + cur * L::KB + kbase;
            const bf16* qwl = qw; if (QLOOP) asm volatile("" : "+v"(qwl));
#if ATT_PIPE
            constexpr int NS = 2 * ND;
            bf16x8 kf[ATT_PD + 1];
#define ATT_KLD(n_) (*(const LAS bf16x8*)(kb + ((n_) & 1) * 32 * L::KSTR + ((n_) >> 1) * 32))
#pragma unroll
            for (int n = 0; n < ATT_PD; ++n) kf[n] = ATT_KLD(n);
            __builtin_amdgcn_sched_barrier(0);
            bf16x8 qf = qr[0];
#pragma unroll
            for (int n = 0; n < NS; ++n) {
                if (n + ATT_PD < NS) kf[(n + ATT_PD) % (ATT_PD + 1)] = ATT_KLD(n + ATT_PD);
                if ((n & 1) == 0) qf = QLOOP ? *(const bf16x8*)(qwl + (n >> 1) * 16) : qr[n >> 1];
#if ATT_LAZY == 2
                if (n == 0) p0 = MFMA32(kf[0], qf, nbv); else if (n == 1) p1 = MFMA32(kf[1], qf, nbv); else
#endif
                if (n & 1) p1 = MFMA32(kf[n % (ATT_PD + 1)], qf, p1); else p0 = MFMA32(kf[n % (ATT_PD + 1)], qf, p0);
                __builtin_amdgcn_sched_barrier(0);
            }
#undef ATT_KLD
            const LAS unsigned char* vb = lds + L::V0 + cur * L::VB + vbase;
            s16x4 vlo[ATT_PD + 1], vhi[ATT_PD + 1];
#define ATT_VLD(n_) do { vlo[(n_) % (ATT_PD + 1)] = vtr(vb + (16 * ((n_) >> 2)) * VSTR + ((n_) & 3) * 64); vhi[(n_) % (ATT_PD + 1)] = vtr(vb + (16 * ((n_) >> 2) + 8) * VSTR + ((n_) & 3) * 64); } while (0)
#pragma unroll
            for (int n = 0; n < ATT_PD; ++n) ATT_VLD(n);
            __builtin_amdgcn_sched_barrier(0);
#else
#pragma unroll
            for (int d0 = 0; d0 < ND; ++d0) {
                const bf16x8 a0 = *(const LAS bf16x8*)(kb + d0 * 32), a1 = *(const LAS bf16x8*)(kb + 32 * L::KSTR + d0 * 32);
                const bf16x8 qf = QLOOP ? *(const bf16x8*)(qwl + d0 * 16) : qr[d0];
#if ATT_LAZY == 2
                if (d0 == 0) { p0 = MFMA32(a0, qf, nbv); p1 = MFMA32(a1, qf, nbv); } else { p0 = MFMA32(a0, qf, p0); p1 = MFMA32(a1, qf, p1); }
#else
                p0 = MFMA32(a0, qf, p0); p1 = MFMA32(a1, qf, p1);
#endif
                if ((d0 & 3) == 3) __builtin_amdgcn_sched_barrier(0);
            }
#endif
            if (MODE == 1) {
#pragma unroll
                for (int i = 0; i < 16; ++i) { const unsigned bit = 1u << ((i & 3) + 8 * (i >> 2));
                    p0[i] = (mw0 & bit) ? p0[i] : -INFINITY; p1[i] = (mw1 & bit) ? p1[i] : -INFINITY; }
            }
            float tmax = p0[0];
#pragma unroll
            for (int i = 1; i < 16; ++i) tmax = fmaxf(tmax, p0[i]);
#pragma unroll
            for (int i = 0; i < 16; ++i) tmax = fmaxf(tmax, p1[i]);
            tmax = half_swap_max(tmax);
#if ATT_LAZY == 0
            const float m_new = fmaxf(m_run, tmax), alpha = __builtin_amdgcn_exp2f(m_run - m_new);
            m_run = m_new;
            float ps = 0.f;
#pragma unroll
            for (int i = 0; i < 16; ++i) { p0[i] = __builtin_amdgcn_exp2f(p0[i] - m_new); ps += p0[i]; }
#pragma unroll
            for (int i = 0; i < 16; ++i) { p1[i] = __builtin_amdgcn_exp2f(p1[i] - m_new); ps += p1[i]; }
            ps = half_swap_sum(ps);
            l_run = l_run * alpha + ps;
            if (__any(alpha < 1.0f)) {
#pragma unroll
                for (int d = 0; d < 4; ++d)
#pragma unroll
                    for (int i = 0; i < 16; ++i) o[d][i] *= alpha;
            }
#elif ATT_LAZY == 1
            if (__any(tmax > m_run + ATT_TAU)) {
                const float m_new = fmaxf(m_run, tmax), alpha = __builtin_amdgcn_exp2f(m_run - m_new);
                m_run = m_new; l_run *= alpha;
#pragma unroll
                for (int d = 0; d < 4; ++d)
#pragma unroll
                    for (int i = 0; i < 16; ++i) o[d][i] *= alpha;
            }
            float ps = 0.f;
#pragma unroll
            for (int i = 0; i < 16; ++i) { p0[i] = __builtin_amdgcn_exp2f(p0[i] - m_run); ps += p0[i]; }
#pragma unroll
            for (int i = 0; i < 16; ++i) { p1[i] = __builtin_amdgcn_exp2f(p1[i] - m_run); ps += p1[i]; }
            ps = half_swap_sum(ps);
            l_run += ps;
#else
            if (__any(tmax + base > m_run + ATT_TAU)) {
                const float m_new = fmaxf(m_run, tmax + base), base_new = (m_new > -1e29f) ? m_new : 0.f, dlt = base_new - base, alpha = __builtin_amdgcn_exp2f(m_run - m_new);
#pragma unroll
                for (int i = 0; i < 16; ++i) { p0[i] -= dlt; p1[i] -= dlt; }
                m_run = m_new; base = base_new; l_run *= alpha;
#pragma unroll
                for (int i = 0; i < 16; ++i) nbv[i] = -base_new;
#pragma unroll
                for (int d = 0; d < 4; ++d)
#pragma unroll
                    for (int i = 0; i < 16; ++i) o[d][i] *= alpha;
            }
            float ps = 0.f;
#pragma unroll
            for (int i = 0; i < 16; ++i) { p0[i] = __builtin_amdgcn_exp2f(p0[i]); ps += p0[i]; }
#pragma unroll
            for (int i = 0; i < 16; ++i) { p1[i] = __builtin_amdgcn_exp2f(p1[i]); ps += p1[i]; }
            ps = half_swap_sum(ps);
            l_run += ps;
#endif
            bf16x8 pb[4];
#pragma unroll
            for (int s = 0; s < 4; ++s) { v4u w;
                if (s < 2) { w.x = cvtpk(p0[8 * s + 0], p0[8 * s + 1]); w.y = cvtpk(p0[8 * s + 2], p0[8 * s + 3]); w.z = cvtpk(p0[8 * s + 4], p0[8 * s + 5]); w.w = cvtpk(p0[8 * s + 6], p0[8 * s + 7]); }
                else { const int s2 = s - 2; w.x = cvtpk(p1[8 * s2 + 0], p1[8 * s2 + 1]); w.y = cvtpk(p1[8 * s2 + 2], p1[8 * s2 + 3]); w.z = cvtpk(p1[8 * s2 + 4], p1[8 * s2 + 5]); w.w = cvtpk(p1[8 * s2 + 6], p1[8 * s2 + 7]); }
                pb[s] = __builtin_bit_cast(bf16x8, w); }
#if ATT_PIPE
            __builtin_amdgcn_sched_barrier(0);
#pragma unroll
            for (int n = 0; n < 16; ++n) {
                if (n + ATT_PD < 16) ATT_VLD(n + ATT_PD);
                const s16x4 lo = vlo[n % (ATT_PD + 1)], hh = vhi[n % (ATT_PD + 1)];
                const bf16x8 va = (bf16x8){lo[0], lo[1], lo[2], lo[3], hh[0], hh[1], hh[2], hh[3]};
                o[n & 3] = MFMA32(va, pb[n >> 2], o[n & 3]);
                __builtin_amdgcn_sched_barrier(0);
            }
#undef ATT_VLD
#else
            const LAS unsigned char* vb = lds + L::V0 + cur * L::VB + vbase;
#pragma unroll
            for (int d0 = 0; d0 < 4; ++d0)
#pragma unroll
                for (int s = 0; s < 4; ++s) {
                    const s16x4 lo = vtr(vb + (16 * s) * VSTR + d0 * 64), hh = vtr(vb + (16 * s + 8) * VSTR + d0 * 64);
                    const bf16x8 va = (bf16x8){lo[0], lo[1], lo[2], lo[3], hh[0], hh[1], hh[2], hh[3]};
                    o[d0] = MFMA32(va, pb[s], o[d0]);
                    if (s == 3) __builtin_amdgcn_sched_barrier(0);
                }
#endif
        }
        if (j + 1 < NT) ATT_WRITE(cur ^ 1);
        __syncthreads();
    }
    const float rl = Y_SCALE / l_run;
    unsigned char* ow = Op + (size_t)(wid * 32 + r32) * LDO + 4 * hi;
#pragma unroll
    for (int d0 = 0; d0 < 4; ++d0)
#pragma unroll
        for (int g = 0; g < 4; ++g) *(unsigned*)(ow + 32 * d0 + 8 * g) = pack_fp8x4(o[d0][4 * g] * rl, o[d0][4 * g + 1] * rl, o[d0][4 * g + 2] * rl, o[d0][4 * g + 3] * rl);
#undef ATT_LOAD
#undef ATT_WRITE
}
#ifndef MK_MULTI
#define MK_MULTI 0
#endif
#ifndef DBG_SKIP_MIXER
#define DBG_SKIP_MIXER 0
#endif
#ifndef STAMP_A
#define STAMP_A -1
#define STAMP_B -1
#endif
#define CW_STAMP 12288
constexpr int NPH = 16;
#ifndef ATT_MASK
#define ATT_MASK 7
#endif
struct Args { const float* in[30]; float* out; unsigned char* ws; int ph_lo, ph_hi; };
static_assert(sizeof(Args) == 30 * 8 + 8 + 8 + 8, "no padding");

#ifndef FFN1_DOWN_FP8
#define FFN1_DOWN_FP8 0
#endif
#ifndef FFN2_DOWN_FP8
#define FFN2_DOWN_FP8 1
#define FFN2_F8_PANELS 64
#endif
#ifndef MEMKV_FP8
#define MEMKV_FP8 0
#endif
constexpr float WMKV_SCALE = 64.0f;
#ifndef FFN2_DOWN_CONV_IN_P14
#define FFN2_DOWN_CONV_IN_P14 1
#endif
#ifndef NO_X1
#define NO_X1 1
#endif
#define D1buf (NO_X1 ? (bf16*)XRES : Pbuf)
#ifndef X2_BF16
#define X2_BF16 1
#endif
#ifndef DEFER_FFN1_RESID
#define DEFER_FFN1_RESID 1
#endif
#ifndef DEFER_MIX_RESID
#define DEFER_MIX_RESID 1
#endif
#ifndef MEMKV_IN_P3
#define MEMKV_IN_P3 1
#endif
#ifndef FFN1_DOWN_CONV_IN_P1
#define FFN1_DOWN_CONV_IN_P1 1
#endif
#ifndef FFN2_CONV_IN_ATTN
#define FFN2_CONV_IN_ATTN 1
#endif
#ifndef FFN_UP_ALIGN
#define FFN_UP_ALIGN true
#endif
#ifndef FFN1_UP_I8
#define FFN1_UP_I8 true
#endif
#ifndef FFN2_UP_I8
#define FFN2_UP_I8 true
#endif
template <int F8, bool I8> DI void ffn_up_phase(LAS unsigned char* lds, const bf16* A, const bf16* WGUt, unsigned char* Hmid, int G, const float* rowscale, unsigned char* Hmid8 = nullptr) {
    pg8::Gemm g{A, WGUt, MTOK, NGU, I8 ? DM / 2 : DM}; pg8::StaticOrder S; S.init(MTOK, NGU, G, (int)blockIdx.x);
    pg8::EpiSwiGLU<F8, I8> E{Hmid, DFF, H_SCALE, rowscale, Hmid8, FFN2_F8_PANELS};
    pg8::gemm_phase<pg8::EpiSwiGLU<F8, I8>, pg8::StaticOrder, FFN_UP_ALIGN, true>(lds, g, S, E);
}
template <int F8> DI void ffn_down_phase(LAS unsigned char* lds, const unsigned char* Hmid, const unsigned char* WDt, const float* base, float* out, int G,
                                         const unsigned char* Hmid8 = nullptr, const unsigned char* WDt8 = nullptr, const bf16* addend = nullptr, bf16* defer = nullptr) {
    if constexpr (F8 == 1) {
        pg8::Gemm g{(const bf16*)Hmid, (const bf16*)WDt, MTOK, DM, DFF / 2}; pg8::StaticOrder S; S.init(MTOK, DM, G, (int)blockIdx.x);
        if (addend && !base) { pg8::EpiResid8B E{addend, out, DM, 0.5f / (H_SCALE * WD_SCALE)};
            pg8::gemm_phase<pg8::EpiResid8B, pg8::StaticOrder, true, true>(lds, g, S, E); }
        else if (addend) { pg8::EpiResid8A E{base, addend, out, DM, 0.5f / (H_SCALE * WD_SCALE)};
            pg8::gemm_phase<pg8::EpiResid8A, pg8::StaticOrder, true, true>(lds, g, S, E); }
        else { pg8::EpiResid8 E{base, out, DM, 0.5f / (H_SCALE * WD_SCALE)};
            pg8::gemm_phase<pg8::EpiResid8, pg8::StaticOrder, true, true>(lds, g, S, E); }
    } else if constexpr (F8 == 2) {
        constexpr int MS = FFN2_F8_PANELS * 256;
        { pg8::Gemm g{(const bf16*)Hmid8, (const bf16*)WDt8, MS, DM, DFF / 2}; pg8::StaticOrder S; S.init(MS, DM, G, (int)blockIdx.x);
          pg8::EpiResid8 E{base, out, DM, 0.5f / (H_SCALE * WD_SCALE)};
          pg8::gemm_phase<pg8::EpiResid8, pg8::StaticOrder, true, true>(lds, g, S, E); }
        { pg8::Gemm g{(const bf16*)Hmid + (size_t)MS * DFF, (const bf16*)WDt, MTOK - MS, DM, DFF}; pg8::StaticOrder S; S.init(MTOK - MS, DM, G, (int)blockIdx.x);
          pg8::EpiResid E{base + (size_t)MS * DM, out + (size_t)MS * DM, DM, 0.5f};
          pg8::gemm_phase<pg8::EpiResid, pg8::StaticOrder, true, true>(lds, g, S, E); }
    } else {
        pg8::Gemm g{(const bf16*)Hmid, (const bf16*)WDt, MTOK, DM, DFF}; pg8::StaticOrder S; S.init(MTOK, DM, G, (int)blockIdx.x);
        if (defer) { pg8::EpiPlain E{defer, DM};
            pg8::gemm_phase<pg8::EpiPlain, pg8::StaticOrder, true, true>(lds, g, S, E); }
        else { pg8::EpiResid E{base, out, DM, 0.5f};
            pg8::gemm_phase<pg8::EpiResid, pg8::StaticOrder, true, true>(lds, g, S, E); }
    }
}

__global__ void __launch_bounds__(NWAVES * 64, 2) mega_fwd(Args args) {
    extern __shared__ __attribute__((aligned(16))) unsigned char lds_raw[];
    LAS unsigned char* lds = (LAS unsigned char*)lds_raw;
    const int GRID = gridDim.x;
    const __attribute__((address_space(4))) unsigned char* ka = (const __attribute__((address_space(4))) unsigned char*)__builtin_amdgcn_kernarg_segment_ptr();
#define ARGQ(k) (*(void* const __attribute__((address_space(4)))*)(ka + 8 * (k)))
#define ARGP(k) ((const float*)ARGQ(k))
    unsigned char* ws = (unsigned char*)ARGQ(31);
    unsigned* ctl = (unsigned*)(ws + WS_CTL);
    volatile LAS unsigned* MISC = (volatile LAS unsigned*)(lds + MISC_OFF);
    for (int u = threadIdx.x; u < (LDS_BYTES - MISC_OFF) / 4; u += NWAVES * 64) ((LAS unsigned*)(lds + MISC_OFF))[u] = 0u;
    __syncthreads();
    const int lo = *(const __attribute__((address_space(4))) int*)(ka + 256), hi = *(const __attribute__((address_space(4))) int*)(ka + 260);
    XcdBarrier bar; bar.bar = ctl + CW_BAR; bar.x = 0; bar.st = nullptr;
    if (hi - lo > 1) bar = xcd_barrier_post(ctl + CW_BAR, MISC);
#ifndef PH_MASK
#define PH_MASK 0xffff
#endif
#define IN(k) ((((PH_MASK) >> (k)) & 1) && lo <= (k) && (k) < hi)
    if (STAMP_A >= 0 && blockIdx.x == 0 && threadIdx.x == 0) ctl[CW_STAMP] = (unsigned)__builtin_amdgcn_s_memrealtime();
#define SEAM(k) do { if (IN(k) && IN((k) + 1)) xcd_barrier(bar); if (STAMP_A >= 0 && blockIdx.x == 0 && threadIdx.x == 0) ctl[CW_STAMP + 2 * ((k) + 1)] = (unsigned)__builtin_amdgcn_s_memrealtime(); } while (0)
#ifndef REPEAT_MASK
#define REPEAT_MASK 0
#endif
#ifndef STAGGER_US
#define STAGGER_US 0
#define STAGGER_SHIFT 6
#endif
#define STAGGER() do { const unsigned sg_ = (blockIdx.x >> STAGGER_SHIFT) & 3u; if (STAGGER_US > 0 && sg_) { const unsigned long long t0_ = __builtin_amdgcn_s_memrealtime(); \
        while (__builtin_amdgcn_s_memrealtime() - t0_ < (unsigned long long)(sg_ * STAGGER_US * 100u)) __builtin_amdgcn_s_sleep(8); } } while (0)
#define NREP(k) (1 + (((REPEAT_MASK) >> (k)) & 1))
#define REPBAR(k) do { if (((REPEAT_MASK) >> (k)) & 1) xcd_barrier(bar); } while (0)

#define WGUt ((bf16*)(ws + WS_WGU))
#define WDt ((unsigned char*)(ws + WS_WD))
#define WINt ((unsigned char*)(ws + WS_WIN))
#define WINIt ((bf16*)(ws + WS_WINI))
#define WG8t ((unsigned char*)(ws + WS_WG8))
#define Hn8 ((unsigned char*)(ws + WS_HN8))
#define WUQt ((unsigned char*)(ws + WS_WUQ))
#define WUKVt ((unsigned char*)(ws + WS_WUKV))
#define WMKVt ((bf16*)(ws + WS_WMKV))
#define WOCATt ((unsigned char*)(ws + WS_WOCAT))
#define WOUTt ((unsigned char*)(ws + WS_WOUT))
#define Abuf ((bf16*)(ws + WS_A))
#define Hmid ((unsigned char*)(ws + WS_HMID))
#if GATES_U8
#define Gt ((unsigned char*)(ws + WS_G))
#else
#define Gt ((bf16*)(ws + WS_G))
#endif
#define Pbuf ((bf16*)(ws + WS_P))
#define QmlaRaw ((bf16*)(ws + WS_QMLARAW))
#define KVraw ((bf16*)(ws + WS_KVRAW))
#define Qmla ((bf16*)(ws + WS_QMLA))
#define Kmla ((bf16*)(ws + WS_KMLA))
#define CQn ((unsigned char*)(ws + WS_CQN))
#define CKVn ((unsigned char*)(ws + WS_CKVN))
#define Qd ((bf16*)(ws + WS_QD))
#define Kd ((bf16*)(ws + WS_KD))
#define Vd ((bf16*)(ws + WS_VD))
#define Qi ((bf16*)(ws + WS_QI))
#define Ki ((bf16*)(ws + WS_KI))
#define Wi ((float*)(ws + WS_WI))
#define Kr ((bf16*)(ws + WS_KR))
#define Qm ((bf16*)(ws + WS_QM))
#define Ycat ((unsigned char*)(ws + WS_YCAT))
#define BM ((unsigned*)(ws + WS_BM))
#define memn ((bf16*)(ws + WS_MEMN))
#define MKVraw ((bf16*)(ws + WS_MKVRAW))
#define MemK ((bf16*)(ws + WS_MEMK))
#define Sc ((float*)(ws + WS_SC))
#define X_IN (ARGP(0))
#define MEM_IN (ARGP(1))
#define POS_IN ((const int*)ARGP(2))
#define XRES ((float*)ARGQ(30))
    _Pragma("unroll") for (int rep_ = 0; rep_ < NREP(0); ++rep_) { if (rep_) REPBAR(0); if (IN(0)) { const Ctx C = make_ctx(lds);
#if FFN1_DOWN_CONV_IN_P1
        conv_ffn<FFN1_DOWN_FP8, FFN1_UP_I8>(C, ARGP(4), ARGP(5), ARGP(6), WGUt, WDt, nullptr, C.gw, (DM / 64) * (NGU / 32), C.NGW);
#else
        conv_ffn<FFN1_DOWN_FP8, FFN1_UP_I8>(C, ARGP(4), ARGP(5), ARGP(6), WGUt, WDt);
#endif
#if !DBG_SKIP_MIXER
        conv_win(C, ARGP(8), ARGP(24), WINt, WINIt, WG8t);
        int dummy = 0;
        conv_plain8(C, ARGP(10), 1536, 2304, WUQt, WUQ_SCALE);
        conv_plain8(C, ARGP(12), 512, 3072, WUKVt, WUKV_SCALE);
#if MEMKV_FP8
        conv_plain8(C, ARGP(18), 4096, 2048, (unsigned char*)WMKVt, WMKV_SCALE);
#else
        conv_plain(C, ARGP(18), 4096, 2048, WMKVt, dummy, 0);
#endif
#if !FFN2_CONV_IN_ATTN
        conv_wocat(C, ARGP(21), ARGP(22), ARGP(23), WOCATt);
        conv_plain8(C, ARGP(25), 4096, 4096, WOUTt, WOUT_SCALE);
#endif
#if MEMKV_FP8
        rms_rows_dual(C, MEM_IN, ARGP(17), memn, ws + WS_WMKV + 8 * MiB, MROWS);
#else
        rms_rows(C, MEM_IN, ARGP(17), memn, MROWS);
#endif
#endif
        if (FFN1_UP_I8) rms_rows_i8(C, X_IN, ARGP(3), (unsigned char*)Abuf, (float*)(ws + WS_RS1), WGU_I8_SCALE, MTOK);
        else rms_rows(C, X_IN, ARGP(3), Abuf, MTOK);
    }
    }
    SEAM(0);
    _Pragma("unroll") for (int rep_ = 0; rep_ < NREP(1); ++rep_) { if (rep_) REPBAR(1); if (IN(1)) { ffn_up_phase<FFN1_DOWN_FP8, FFN1_UP_I8>(lds, Abuf, WGUt, Hmid, GRID, (const float*)(ws + WS_RS1));
#if FFN1_DOWN_CONV_IN_P1
        constexpr int CW0 = MEMKV_IN_P3 ? 128 : 144;
        if ((int)blockIdx.x >= CW0) { const Ctx C = make_ctx(lds); __syncthreads();
            conv_ffn<FFN1_DOWN_FP8, FFN1_UP_I8>(C, ARGP(4), ARGP(5), ARGP(6), WGUt, WDt, nullptr, (DM / 64) * (NGU / 32) + ((int)blockIdx.x - CW0) * 8 + C.wave, CONV_FFN_ITEMS, (256 - CW0) * 8); __syncthreads(); }
#endif
#if MEMKV_IN_P3
        }
#elif MEMKV_FP8
        { pg8::Gemm g{(const bf16*)(ws + WS_WMKV + 8 * MiB), WMKVt, MROWS, 2048, DM / 2}; pg8::StaticOrder S; S.init(MROWS, 2048, GRID, (int)((blockIdx.x + 128u) % (unsigned)GRID)); pg8::EpiPlain8 E{MKVraw, 2048, 1.0f / WMKV_SCALE};
          pg8::gemm_phase<pg8::EpiPlain8, pg8::StaticOrder, true, true>(lds, g, S, E); } }
#else
        { pg8::Gemm g{memn, WMKVt, MROWS, 2048, DM}; pg8::StaticOrder S; S.init(MROWS, 2048, GRID, (int)((blockIdx.x + 128u) % (unsigned)GRID)); pg8::EpiPlain E{MKVraw, 2048};
          pg8::gemm_phase<pg8::EpiPlain, pg8::StaticOrder, true, true>(lds, g, S, E); } }
#endif
    }
    SEAM(1);
    _Pragma("unroll") for (int rep_ = 0; rep_ < NREP(2); ++rep_) { if (rep_) REPBAR(2); if (IN(2)) ffn_down_phase<FFN1_DOWN_FP8>(lds, Hmid, WDt, X_IN, XRES, GRID, nullptr, nullptr, nullptr, DEFER_FFN1_RESID ? D1buf : nullptr);
    }
    SEAM(2);
#if !DBG_SKIP_MIXER
#if MEMKV_IN_P3
    if (IN(3)) { if (blockIdx.x < 16) { pg8::Gemm g{memn, WMKVt, MROWS, 2048, DM}; pg8::StaticOrder S; S.init(MROWS, 2048, GRID, (int)blockIdx.x); pg8::EpiPlain E{MKVraw, 2048};
                                        pg8::gemm_phase<pg8::EpiPlain, pg8::StaticOrder, true, true>(lds, g, S, E); }
                 else { Ctx C = make_ctx(lds); C.gw -= 16 * 8; C.NGW -= 16 * 8;
                        if (DEFER_FFN1_RESID) rms_rows_dual_add(C, X_IN, D1buf, 0.5f, NO_X1 ? nullptr : XRES, ARGP(7), Abuf, Hn8, MTOK);
                        else rms_rows_dual(C, XRES, ARGP(7), Abuf, Hn8, MTOK); } }
#else
    if (IN(3)) { const Ctx C = make_ctx(lds); rms_rows_dual(C, XRES, ARGP(7), Abuf, Hn8, MTOK); }
#endif
    SEAM(3);
    _Pragma("unroll") for (int rep_ = 0; rep_ < NREP(4); ++rep_) { if (rep_) REPBAR(4); if (IN(4)) {
#if VD_DIRECT
        { pg8::Gemm g{(const bf16*)Hn8, (const bf16*)WINt, MTOK, NF8, DM / 2}; pg8::StaticOrder S; S.init(MTOK, NF8, GRID, (int)blockIdx.x);
          static_assert(PC_VD % 256 == 0 && PC_QM == PC_VD + 1536, "v_d block = whole column tiles");
          pg8::EpiPlain8R E{Pbuf, NPC, 1.0f / WIN_SCALE, Vd, 1536, PC_VD / 256, PC_QM / 256};
          pg8::gemm_phase<pg8::EpiPlain8R, pg8::StaticOrder, true, true>(lds, g, S, E); }
#else
        { pg8::Gemm g{(const bf16*)Hn8, (const bf16*)WINt, MTOK, NF8, DM / 2}; pg8::StaticOrder S; S.init(MTOK, NF8, GRID, (int)blockIdx.x); pg8::EpiPlain8 E{Pbuf, NPC, 1.0f / WIN_SCALE};
          pg8::gemm_phase<pg8::EpiPlain8, pg8::StaticOrder, true, true>(lds, g, S, E); }
#endif
        { pg8::Gemm g{Abuf, WINIt, MTOK, NIDX, DM}; pg8::StaticOrder S; S.init(MTOK, NIDX, GRID, (int)((blockIdx.x + 192u) % (unsigned)GRID)); pg8::EpiPlain E{Pbuf + NF8, NPC};
          pg8::gemm_phase<pg8::EpiPlain, pg8::StaticOrder, true, true>(lds, g, S, E); }
        { pg8::Gemm g{(const bf16*)Hn8, (const bf16*)WG8t, MTOK, NGC, DM / 2}; pg8::StaticOrder S; S.init(MTOK, NGC, GRID, (int)blockIdx.x); pg8::EpiGates8 E{Gt, NGC, 1.0f / WG_SCALE};
          pg8::gemm_phase<pg8::EpiGates8, pg8::StaticOrder, true, true>(lds, g, S, E); }
    }
    }
    SEAM(4);
    _Pragma("unroll") for (int rep_ = 0; rep_ < NREP(5); ++rep_) { if (rep_) REPBAR(5); if (IN(5)) { const Ctx C = make_ctx(lds);
        PP1 A{Pbuf, POS_IN, ARGP(9), ARGP(11), ARGP(15), ARGP(16), ARGP(19), CQn, CKVn, Qd, Kd, Vd, Qi, Ki, Kr, Qm, Wi, Ycat};
        LAS float* GL = (LAS float*)(lds + 4096);
        for (int i = C.tid; i < 2560; i += NWAVES * 64) GL[i] = i < 1536 ? A.g_cq[i] : i < 2048 ? A.g_ckv[i - 1536] : i < 2176 ? A.g_qd[i - 2048] : i < 2304 ? A.g_kd[i - 2176] : A.g_qm[i - 2304];
        __syncthreads();
        v4u R[20]; int posi = 0; int t = C.gw;
#pragma unroll
        for (int i = 0; i < 20; ++i) R[i] = (v4u){0u, 0u, 0u, 0u};
        if (t < MTOK) pp1_load(A, t, C.lane, R, posi);
#pragma unroll 1
        for (; t < MTOK; t += C.NGW) {
            v4u N[20]; int nposi = 0; const int nt = t + C.NGW;
#pragma unroll
            for (int i = 0; i < 20; ++i) N[i] = (v4u){0u, 0u, 0u, 0u};
            if (nt < MTOK) pp1_load(A, nt, C.lane, N, nposi);
            pp1_token(A, t, C.lane, (LAS float*)(lds + C.wave * 256), R, posi, GL);
#pragma unroll
            for (int i = 0; i < 20; ++i) R[i] = N[i];
            posi = nposi;
        }
        __syncthreads();
    }
    }
    SEAM(5);
    _Pragma("unroll") for (int rep_ = 0; rep_ < NREP(6); ++rep_) { if (rep_) REPBAR(6); if (IN(6)) {
        { pg8::Gemm g{(const bf16*)CQn, (const bf16*)WUQt, MTOK, 2304, 1536 / 2}; pg8::StaticOrder S; S.init(MTOK, 2304, GRID, (int)blockIdx.x); pg8::EpiPlain8 E{QmlaRaw, 2304, 1.0f / WUQ_SCALE};
          pg8::gemm_phase<pg8::EpiPlain8, pg8::StaticOrder, true, true>(lds, g, S, E); }
        if (GRID != 256 || blockIdx.x >= 64)
        { pg8::Gemm g{(const bf16*)CKVn, (const bf16*)WUKVt, MTOK, 3072, 512 / 2}; pg8::StaticOrder S;
          if (GRID == 256) S.init(MTOK, 3072, 192, (int)blockIdx.x - 64); else S.init(MTOK, 3072, GRID, (int)blockIdx.x);
          pg8::EpiPlain8 E{KVraw, 3072, 1.0f / WUKV_SCALE};
          pg8::gemm_phase<pg8::EpiPlain8, pg8::StaticOrder, true, true>(lds, g, S, E); }
        for (int p = blockIdx.x; p < 256; p += GRID) idx_item(p, Qi, Ki, Wi, Sc, lds);
    }
    }
    SEAM(6);
    _Pragma("unroll") for (int rep_ = 0; rep_ < NREP(7); ++rep_) { if (rep_) REPBAR(7); if (IN(7)) { const Ctx C = make_ctx(lds);
        PP2 A{QmlaRaw, KVraw, Kr, MKVraw, POS_IN, ARGP(13), ARGP(14), ARGP(20), Qmla, Kmla, MemK};
#pragma unroll 1
        for (int step = 0; step < 2; ++step) {
            if ((step ^ (int)(blockIdx.x & 1u)) == 0) {
                for (int t = C.gw; t < MTOK; t += C.NGW) pp2_token(A, t, C.lane, (LAS float*)(lds + C.wave * 256));
                for (int r = C.gw; r < MROWS; r += C.NGW) pp2_memrow(A, r, C.lane);
            } else {
                for (int t = C.gw; t < MTOK; t += C.NGW) select_row(Sc, (unsigned long long*)BM, t, C.lane, (LAS unsigned*)(lds + C.wave * 16384), (LAS unsigned long long*)(lds + MISC_OFF + 64 + C.wave * 1024));
            }
            __syncthreads();
        }
    }
    }
    SEAM(7);
    _Pragma("unroll") for (int rep_ = 0; rep_ < NREP(10); ++rep_) { if (rep_) REPBAR(10); if (IN(10)) {
        for (;;) {
            if (threadIdx.x == 0) MISC[4] = __hip_atomic_fetch_add(ctl + CW_QUEUE + 64 * rep_, 1u, __ATOMIC_RELAXED, __HIP_MEMORY_SCOPE_AGENT);
            __syncthreads();
            const int u0 = __builtin_amdgcn_readfirstlane((int)MISC[4]);
            __syncthreads();
#if FFN2_CONV_IN_ATTN
            if (u0 >= 2304) break;
            if (u0 < 2048 && (u0 & 7) == 7) { const int c = u0 >> 3; const Ctx C = make_ctx(lds);   constexpr int CVN = FFN2_DOWN_CONV_IN_P14 ? (DM / 64) * (NGU / 32) : CONV_FFN_ITEMS;        constexpr int PER = CVN / 256; static_assert(PER * 256 == CVN, "slices");
                conv_ffn<FFN2_DOWN_FP8, FFN2_UP_I8>(C, ARGP(27), ARGP(28), ARGP(29), WGUt, WDt, ws + WS_WD8, c * PER + C.wave, (c + 1) * PER, 8);
                constexpr int PWO = CONV_WOCAT_ITEMS / 256, PWT = CONV_WOUT_ITEMS / 256; static_assert(PWO * 256 == CONV_WOCAT_ITEMS && PWT * 256 == CONV_WOUT_ITEMS, "slices");
                conv_wocat(C, ARGP(21), ARGP(22), ARGP(23), WOCATt, c * PWO + C.wave, (c + 1) * PWO, 8);
                conv_plain8(C, ARGP(25), 4096, 4096, WOUTt, WOUT_SCALE, c * PWT + C.wave, (c + 1) * PWT, 8);
                continue; }
            const int u = u0 < 2048 ? u0 - (u0 >> 3) : u0 - 256;
#else
            const int u = u0;
            if (u >= 2048) break;
#endif
            if (u < 1536) {
                const int qt = 31 - u / 48, r = u % 48, type = r / 24, bh = r % 24, b = bh / 12, h = bh % 12;
                const size_t row0 = (size_t)b * SEQ + 256 * qt, krow0 = (size_t)b * SEQ;
                if (type == 0) attn_unit<192, 0>(lds, Qmla + row0 * 2304 + h * 192, 2304, Kmla + krow0 * 2304 + h * 192, 2304, KVraw + krow0 * 3072 + h * 256 + 128, 3072,
                                                 Ycat + row0 * KCAT + h * 128, KCAT, 4 * qt + 4, 4 * qt, nullptr);
                else attn_unit<128, 1>(lds, Qd + row0 * 1536 + h * 128, 1536, Kd + krow0 * 1536 + h * 128, 1536, Vd + krow0 * 1536 + h * 128, 1536,
                                       Ycat + row0 * KCAT + 1536 + h * 128, KCAT, 4 * qt + 4, 4 * qt, BM + row0 * 256);
            } else {
                const int v = u - 1536, b = v >> 8, h = (v >> 6) & 3, qt = (v >> 1) & 31, dvh = v & 1;
                const size_t row0 = (size_t)b * SEQ + 256 * qt, krow0 = (size_t)b * MEMLEN;
                attn_unit<256, 2>(lds, Qm + row0 * 1024 + h * 256, 1024, MemK + krow0 * 1024 + h * 256, 1024, MKVraw + krow0 * 2048 + 1024 + h * 256 + dvh * 128, 2048,
                                  Ycat + row0 * KCAT + 3072 + h * 256 + dvh * 128, KCAT, 4, 0, nullptr);
            }
        }
    }}
        SEAM(10);
    _Pragma("unroll") for (int rep_ = 0; rep_ < NREP(11); ++rep_) { if (rep_) REPBAR(11); if (IN(11)) {
        pg8::Gemm g{(const bf16*)Ycat, (const bf16*)WOCATt, MTOK, DM, KCAT / 2}; pg8::StaticOrder S; S.init(MTOK, DM, GRID, (int)blockIdx.x);
        pg8::EpiGateCat E{Gt, NGC, DM, (unsigned char*)Abuf, DM, GS_SCALE / (Y_SCALE * WO_SCALE)};
        pg8::gemm_phase<pg8::EpiGateCat, pg8::StaticOrder, true, true>(lds, g, S, E);
    }}
        SEAM(11);
#if defined(PROBE_P12)
    if (IN(12)) {
        pg8::Gemm g{Abuf, (const bf16*)WOUTt, MTOK, DM, DM / 2}; pg8::StaticOrder S; S.init(MTOK, DM, GRID, (int)blockIdx.x); pg8::EpiPlain8 E{Pbuf, DM, 1.0f};
        pg8::gemm_phase<pg8::EpiPlain8, pg8::StaticOrder, true, true>(lds, g, S, E);
        xcd_barrier(bar);
    }
#endif
    if (IN(12)) {
        STAGGER();
#if DEFER_MIX_RESID
        pg8::Gemm g{Abuf, (const bf16*)WOUTt, MTOK, DM, DM / 2}; pg8::StaticOrder S; S.init(MTOK, DM, GRID, (int)blockIdx.x); pg8::EpiPlain8 E{Pbuf, DM, 1.0f / (GS_SCALE * WOUT_SCALE)};
        pg8::gemm_phase<pg8::EpiPlain8, pg8::StaticOrder, true, true>(lds, g, S, E);
#else
        pg8::Gemm g{Abuf, (const bf16*)WOUTt, MTOK, DM, DM / 2}; pg8::StaticOrder S; S.init(MTOK, DM, GRID, (int)blockIdx.x); pg8::EpiResid8 E{XRES, XRES, DM, 1.0f / (GS_SCALE * WOUT_SCALE)};
        pg8::gemm_phase<pg8::EpiResid8, pg8::StaticOrder, true, true>(lds, g, S, E);
#endif
    }
    SEAM(12);
#endif
    if (IN(13)) { const Ctx C = make_ctx(lds);
#if !FFN2_CONV_IN_ATTN
        conv_ffn<FFN2_DOWN_FP8, FFN2_UP_I8>(C, ARGP(27), ARGP(28), ARGP(29), WGUt, WDt, ws + WS_WD8);
#endif
#if DEFER_MIX_RESID
        static_assert(FFN2_UP_I8 && FFN2_DOWN_FP8 == 1 && !DBG_SKIP_MIXER, "the deferred residual is wired for the int8 / MX-fp8 FFN2 only");
        if (NO_X1) rms_rows_i8_add(C, X_IN, Pbuf, ARGP(26), (unsigned char*)Abuf, (float*)(ws + WS_MEMN), WGU_I8_SCALE, MTOK, Pbuf + (size_t)MTOK * DM, D1buf, 0.5f);
        else rms_rows_i8_add(C, XRES, Pbuf, ARGP(26), (unsigned char*)Abuf, (float*)(ws + WS_MEMN), WGU_I8_SCALE, MTOK, X2_BF16 ? Pbuf + (size_t)MTOK * DM : nullptr);
#else
        if (FFN2_UP_I8) rms_rows_i8(C, XRES, ARGP(26), (unsigned char*)Abuf, (float*)(ws + WS_MEMN), WGU_I8_SCALE, MTOK);
        else rms_rows(C, XRES, ARGP(26), Abuf, MTOK);
#endif
    }
    SEAM(13);
    if (IN(14)) { ffn_up_phase<FFN2_DOWN_FP8, FFN2_UP_I8>(lds, Abuf, WGUt, Hmid, GRID, (const float*)(ws + WS_MEMN), ws + WS_HMID8);
#if FFN2_DOWN_CONV_IN_P14 && FFN2_CONV_IN_ATTN
        if (blockIdx.x >= 128) { const Ctx C = make_ctx(lds); __syncthreads();
            conv_ffn<FFN2_DOWN_FP8, FFN2_UP_I8>(C, ARGP(27), ARGP(28), ARGP(29), WGUt, WDt, ws + WS_WD8, (DM / 64) * (NGU / 32) + ((int)blockIdx.x - 128) * 8 + C.wave, CONV_FFN_ITEMS, 128 * 8); __syncthreads(); }
#endif
    }
    SEAM(14);
#if DEFER_MIX_RESID
    if (IN(15)) { if (X2_BF16) ffn_down_phase<FFN2_DOWN_FP8>(lds, Hmid, WDt, nullptr, XRES, GRID, ws + WS_HMID8, ws + WS_WD8, Pbuf + (size_t)MTOK * DM);
                  else ffn_down_phase<FFN2_DOWN_FP8>(lds, Hmid, WDt, XRES, XRES, GRID, ws + WS_HMID8, ws + WS_WD8, Pbuf); }
#else
    if (IN(15)) ffn_down_phase<FFN2_DOWN_FP8>(lds, Hmid, WDt, XRES, XRES, GRID, ws + WS_HMID8, ws + WS_WD8);
#endif
    if (STAMP_A >= 0) {
        if (blockIdx.x == 0 && threadIdx.x == 0) ctl[CW_STAMP + 2 * 16] = (unsigned)__builtin_amdgcn_s_memrealtime();
        xcd_barrier(bar);
        if (blockIdx.x == 0 && threadIdx.x < 64) {
            const unsigned a0 = __hip_atomic_load(ctl + CW_STAMP + 2 * (STAMP_A >= 16 ? 0 : STAMP_A), __ATOMIC_RELAXED, __HIP_MEMORY_SCOPE_AGENT), a1 = __hip_atomic_load(ctl + CW_STAMP + 2 * (STAMP_A >= 16 ? 16 : STAMP_A + 1), __ATOMIC_RELAXED, __HIP_MEMORY_SCOPE_AGENT);
            const unsigned b0 = __hip_atomic_load(ctl + CW_STAMP + 2 * STAMP_B, __ATOMIC_RELAXED, __HIP_MEMORY_SCOPE_AGENT), b1 = __hip_atomic_load(ctl + CW_STAMP + 2 * (STAMP_B + 1), __ATOMIC_RELAXED, __HIP_MEMORY_SCOPE_AGENT);
            const float va = (float)(a1 - a0) * (STAMP_A == 16 ? 0.00002f : 0.0002f), vb = (float)(b1 - b0) * 0.0002f;
            float* o = XRES;
            if (threadIdx.x == 0) o[0] = (STAMP_A == 17) ? 3.0f : va;
            if (STAMP_B >= 0) o[(threadIdx.x + 1) * 4096] = vb;
        }
    }
#undef IN
#undef SEAM
}

#undef WGUt
#undef WDt
#undef WINt
#undef WINIt
#undef WG8t
#undef Hn8
#undef WUQt
#undef WUKVt
#undef WMKVt
#undef WOCATt
#undef WOUTt
#undef Abuf
#undef Hmid
#undef Gt
#undef Pbuf
#undef QmlaRaw
#undef KVraw
#undef Qmla
#undef Kmla
#undef CQn
#undef CKVn
#undef Qd
#undef Kd
#undef Vd
#undef Qi
#undef Ki
#undef Wi
#undef Kr
#undef Qm
#undef Ycat
#undef BM
#undef memn
#undef MKVraw
#undef MemK
#undef Sc
#undef X_IN
#undef MEM_IN
#undef POS_IN
#undef D1buf
#undef XRES
#undef ARGQ
#undef ARGP
extern "C" void kernel_launch(void* const* d_in, const int* in_sizes, int n_in, void* d_out, int out_size, void* d_ws, size_t ws_size, hipStream_t stream) {
    static int grid = 0;
    if (grid == 0) {
        if (n_in != 30 || in_sizes[0] != MTOK * DM || out_size != MTOK * DM || ws_size < WS_END) {
            fprintf(stderr, "kernel_launch: built for 30 inputs, x/out of %d floats, >= %zu bytes of workspace; got n_in %d, in0 %d, out %d, ws %zu; nothing launched\n", MTOK * DM, (size_t)WS_END, n_in, n_in > 0 ? in_sizes[0] : -1, out_size, ws_size);
            grid = -1; return; }
        int dev = 0, cus = 0, per_cu = 0;
        if (hipGetDevice(&dev) != hipSuccess || hipDeviceGetAttribute(&cus, hipDeviceAttributeMultiprocessorCount, dev) != hipSuccess) { fprintf(stderr, "kernel_launch: device query failed\n"); grid = -1; return; }
        if (hipFuncSetAttribute((const void*)mega_fwd, hipFuncAttributeMaxDynamicSharedMemorySize, LDS_BYTES) != hipSuccess) { fprintf(stderr, "kernel_launch: hipFuncSetAttribute failed\n"); grid = -1; return; }
        if (hipOccupancyMaxActiveBlocksPerMultiprocessor(&per_cu, (const void*)mega_fwd, NWAVES * 64, LDS_BYTES) != hipSuccess || per_cu < 1)
            fprintf(stderr, "kernel_launch: note: occupancy query reports %d workgroups per CU\n", per_cu);
        (void)hipGetLastError();
        grid = cus;
    }
    if (grid < 0) return;
    if (hipMemsetAsync((char*)d_ws + WS_CTL, 0, CTL_ZERO_BYTES, stream) != hipSuccess) { fprintf(stderr, "kernel_launch: memset failed\n"); return; }
    Args a{};
    for (int i = 0; i < 30; ++i) a.in[i] = (const float*)d_in[i];
    a.out = (float*)d_out; a.ws = (unsigned char*)d_ws;
#if MK_MULTI
    for (int k = 0; k < NPH; ++k) { a.ph_lo = k; a.ph_hi = k + 1; hipLaunchKernelGGL(mega_fwd, dim3(grid), dim3(NWAVES * 64), LDS_BYTES, stream, a); }
#else
    a.ph_lo = 0; a.ph_hi = NPH;
    hipLaunchKernelGGL(mega_fwd, dim3(grid), dim3(NWAVES * 64), LDS_BYTES, stream, a);
#if defined(PROBE_TWICE)
    (void)hipMemsetAsync((char*)d_ws + WS_CTL, 0, CTL_ZERO_BYTES, stream);
    hipLaunchKernelGGL(mega_fwd, dim3(grid), dim3(NWAVES * 64), LDS_BYTES, stream, a);
#endif
#endif
    const hipError_t le = hipPeekAtLastError();
    if (le != hipSuccess) fprintf(stderr, "kernel_launch: launch failed: %s\n", hipGetErrorName(le));
}
```
